# Optimizing an MI355X kernel written in HIP

```python
import jax, jax.numpy as jnp
from jax import lax
import numpy as np

D_MODEL = 1024
BATCH = 32
SEQ = 2048
DEPTH = 4

CHUNK = 64
N_META = 16
POOL_WINDOWS = (2, 4, 8, 16)
N_POOL_GROUPS = len(POOL_WINDOWS)
POOL_GROUP = D_MODEL // N_POOL_GROUPS
CONV_WIDTH = 3
D_FF = 7 * D_MODEL // 2
N_EXPERTS = 8
TOP_K = 2
EPS = 1e-6
N_POOL_LAYERS = (DEPTH + 1) // 2
N_CONV_LAYERS = DEPTH // 2

kernel_name = "hybrid_pool_shortconv_moe_encoder"


def rms_norm(x, g):
    xf = x.astype(jnp.float32)
    y = xf * lax.rsqrt(jnp.mean(xf * xf, axis=-1, keepdims=True) + EPS)
    return (y * g.astype(jnp.float32)).astype(x.dtype)


def pool_mixer(h, w_grp, scale):
    T = h.shape[1]
    hf = h.astype(jnp.float32)
    cs = jnp.cumsum(hf, axis=1)
    pos = jnp.arange(1, T + 1, dtype=jnp.float32)[:, None]
    outs = []
    for g, w in enumerate(POOL_WINDOWS):
        sl = slice(g * POOL_GROUP, (g + 1) * POOL_GROUP)
        c = cs[..., sl]
        lower = jnp.pad(c, ((0, 0), (w, 0), (0, 0)))[:, :T]
        mean = (c - lower) / jnp.minimum(pos, float(w))
        d = (mean - hf[..., sl]).astype(h.dtype)
        outs.append(jnp.einsum('btc,cd->btd', d, w_grp[g]))
    return jnp.concatenate(outs, axis=-1) * scale


def conv_mixer(h, w_in, conv_k, w_out):
    bcv = jnp.einsum('btd,de->bte', h, w_in)
    b, c, v = jnp.split(bcv, 3, axis=-1)
    u = c * v
    y = lax.conv_general_dilated(
        u, conv_k[:, None, :], window_strides=(1,), padding=[(CONV_WIDTH - 1, 0)],
        dimension_numbers=('NWC', 'WIO', 'NWC'), feature_group_count=u.shape[-1])
    return jnp.einsum('btd,de->bte', b * y, w_out)


def swiglu(h, w_gate, w_up, w_down):
    a = jnp.einsum('btd,df->btf', h, w_gate)
    u = jnp.einsum('btd,df->btf', h, w_up)
    return jnp.einsum('btf,fd->btd', jax.nn.silu(a) * u, w_down)


def moe_swiglu(h, router, w_gate, w_up, w_down):
    logits = jnp.einsum('btd,de->bte', h, router).astype(jnp.float32)
    top_v, top_i = lax.top_k(logits, TOP_K)
    top_w = jax.nn.softmax(top_v, axis=-1)
    gates = jnp.sum(jax.nn.one_hot(top_i, N_EXPERTS, dtype=jnp.float32) * top_w[..., None], axis=-2)
    gates = gates.astype(h.dtype)
    out = jnp.zeros_like(h)
    for e in range(N_EXPERTS):
        out = out + gates[..., e:e + 1] * swiglu(h, w_gate[e], w_up[e], w_down[e])
    return out


def setup_inputs(seed: int = 0) -> dict:
    key = jax.random.key(seed)
    ks = jax.random.split(key, 20)
    D, F, E, G, Dg = D_MODEL, D_FF, N_EXPERTS, N_POOL_GROUPS, POOL_GROUP
    Lp, Lc = N_POOL_LAYERS, N_CONV_LAYERS
    nrm = lambda k, s, sc: jax.random.normal(k, s, jnp.float32) * sc
    gain = lambda k, s: 1.0 + 0.05 * jax.random.normal(k, s, jnp.float32)
    return {
        "x": nrm(ks[0], (BATCH, SEQ, D), 1.0),
        "meta_tokens": nrm(ks[1], (N_META, D), 1.0),
        "pool_norm": gain(ks[2], (Lp, D)),
        "pool_w": nrm(ks[3], (Lp, G, Dg, Dg), Dg ** -0.5),
        "pool_scale": gain(ks[4], (Lp, D)),
        "dense_norm": gain(ks[5], (Lp, D)),
        "dense_w_gate": nrm(ks[6], (Lp, D, F), D ** -0.5),
        "dense_w_up": nrm(ks[7], (Lp, D, F), D ** -0.5),
        "dense_w_down": nrm(ks[8], (Lp, F, D), F ** -0.5),
        "conv_norm": gain(ks[9], (Lc, D)),
        "conv_w_in": nrm(ks[10], (Lc, D, 3 * D), D ** -0.5),
        "conv_kernel": nrm(ks[11], (Lc, CONV_WIDTH, D), CONV_WIDTH ** -0.5),
        "conv_w_out": nrm(ks[12], (Lc, D, D), D ** -0.5),
        "moe_norm": gain(ks[13], (Lc, D)),
        "moe_router": nrm(ks[14], (Lc, D, E), D ** -0.5),
        "moe_w_gate": nrm(ks[15], (Lc, E, D, F), D ** -0.5),
        "moe_w_up": nrm(ks[16], (Lc, E, D, F), D ** -0.5),
        "moe_w_down": nrm(ks[17], (Lc, E, F, D), F ** -0.5),
        "final_norm": gain(ks[18], (D,)),
    }


def reference(x, meta_tokens, pool_norm, pool_w, pool_scale, dense_norm, dense_w_gate, dense_w_up,
              dense_w_down, conv_norm, conv_w_in, conv_kernel, conv_w_out, moe_norm, moe_router,
              moe_w_gate, moe_w_up, moe_w_down, final_norm):
    B = x.shape[0]
    meta = jnp.broadcast_to(meta_tokens[None].astype(x.dtype), (B, N_META, x.shape[-1]))
    h = jnp.concatenate([meta, x], axis=1)
    for i in range(DEPTH):
        j = i // 2
        if i % 2 == 0:
            h = h + pool_mixer(rms_norm(h, pool_norm[j]), pool_w[j], pool_scale[j])
            h = h + swiglu(rms_norm(h, dense_norm[j]), dense_w_gate[j], dense_w_up[j], dense_w_down[j])
        else:
            h = h + conv_mixer(rms_norm(h, conv_norm[j]), conv_w_in[j], conv_kernel[j], conv_w_out[j])
            h = h + moe_swiglu(rms_norm(h, moe_norm[j]), moe_router[j], moe_w_gate[j], moe_w_up[j],
                               moe_w_down[j])
    out = rms_norm(h, final_norm)
    return out[:, N_META:]
```

```cpp
#include <hip/hip_runtime.h>
#include <cstdio>
#include <cstdint>

#ifndef MK_ONE_LAUNCH
#define MK_ONE_LAUNCH 0
#endif

constexpr int D = 1024, FF = 3584, NE = 8, NB = 32, TS = 2048, NMETA = 16;
constexpr int MROWS = NB * TS;
constexpr int RTOT = MROWS + NMETA;
constexpr int MT_ALL = 257;
constexpr int RPAD = MT_ALL * 256;
constexpr int CAP = RPAD;
constexpr float EPS = 1e-6f;
constexpr int NWAVES = 8;
constexpr int MOE_CH = 132, MOE_PASSES = 4;
constexpr int DENSE_H0 = 128;

constexpr size_t MiB = 1u << 20;
constexpr size_t WS_CTL = 0, CTL_ZERO_BYTES = 1 * MiB;
constexpr size_t WS_WPOOL = 1 * MiB;
constexpr size_t WS_WGU = 2 * MiB;
constexpr size_t WS_WDN = 30 * MiB;
constexpr size_t WS_WIN = 44 * MiB;
constexpr size_t WS_WOUT = 56 * MiB;
constexpr size_t WS_WMGU = 60 * MiB;
constexpr size_t WS_WMDN = 172 * MiB;
constexpr size_t WS_ROWIDX = 228 * MiB;
constexpr size_t WS_SLOT = 231 * MiB;
constexpr size_t WS_RSTD = 236 * MiB;
constexpr size_t WS_H32 = 237 * MiB;
constexpr size_t WS_XN = 494 * MiB;
constexpr size_t WS_Y1 = 623 * MiB;
constexpr size_t WS_INTER = 752 * MiB;
constexpr size_t WS_END = 1009 * MiB;
constexpr size_t GU_BYTES = (size_t)7168 * 1024 * 2, DN_BYTES = (size_t)1024 * 3584 * 2;
static_assert(WS_ROWIDX + (size_t)8 * CAP * 4 <= WS_SLOT && WS_SLOT + (size_t)8 * CAP * 8 <= WS_RSTD, "lists");
static_assert(WS_H32 + (size_t)RPAD * D * 4 <= WS_XN && WS_XN + (size_t)RPAD * D * 2 <= WS_Y1 && WS_Y1 + (size_t)RPAD * D * 2 <= WS_INTER, "act map");
static_assert((size_t)MOE_CH * 256 * FF * 2 <= WS_END - WS_INTER && (size_t)129 * 256 * FF * 2 <= WS_END - WS_INTER && (size_t)2 * RPAD * D * 2 <= WS_END - WS_INTER, "inter");
constexpr int CW_BAR = 4096;
constexpr int CW_MOECNT = 16384;

constexpr int RING_BYTES = 131072;
constexpr int IDX_OFF = RING_BYTES;
constexpr int MISC_OFF = IDX_OFF + 2048;
constexpr int LDS_BYTES = 147456;

#define GAS __attribute__((address_space(1)))
#define LAS __attribute__((address_space(3)))
typedef unsigned short bf16;
typedef float f32x4 __attribute__((ext_vector_type(4)));
typedef unsigned v4u __attribute__((ext_vector_type(4)));
typedef unsigned v2u __attribute__((ext_vector_type(2)));
#define LDS_WAIT() asm volatile("s_waitcnt lgkmcnt(0)" ::: "memory")
#define VM_WAIT() asm volatile("s_waitcnt vmcnt(0)" ::: "memory")

__device__ __forceinline__ unsigned cvt_pk_bf16(float lo, float hi) { unsigned r; asm volatile("v_cvt_pk_bf16_f32 %0, %1, %2" : "=v"(r) : "v"(lo), "v"(hi)); return r; }
__device__ __forceinline__ float bf_lo(unsigned w) { return __uint_as_float(w << 16); }
__device__ __forceinline__ float bf_hi(unsigned w) { return __uint_as_float(w & 0xffff0000u); }
__device__ __forceinline__ float wave_sum(float v) {
#pragma unroll
    for (int o = 1; o < 64; o <<= 1) v += __shfl_xor(v, o);
    return v;
}
__device__ __forceinline__ float silu_f(float a) { return a * __builtin_amdgcn_rcpf(1.0f + __builtin_amdgcn_exp2f(a * -1.44269504f)); }

#define XB_TMO      128
#define XB_XCNT(j)  (256  + 64 * (j))
#define XB_XSUB(j)  (1280 + 64 * (j))
#define XB_XGEN(j)  (2304 + 64 * (j))
#define XB_TOP      3328
#define XB_TOPGEN   3392
#define XCD_BAR_WORDS 3456
#define XB_SPIN_CAP (1u << 18)
__device__ __forceinline__ unsigned xb_ld(unsigned* p)              { return __hip_atomic_load(p, __ATOMIC_RELAXED, __HIP_MEMORY_SCOPE_AGENT); }
__device__ __forceinline__ unsigned xb_add(unsigned* p, unsigned v) { return __hip_atomic_fetch_add(p, v, __ATOMIC_RELAXED, __HIP_MEMORY_SCOPE_AGENT); }
__device__ __forceinline__ unsigned xb_xcc_id() { return (unsigned)__builtin_amdgcn_s_getreg((3 << 11) | 20) & 0xFu; }
#define XB_SPIN(cond, bar) do { unsigned _sp = 0; while (cond) { __builtin_amdgcn_s_sleep(1); \
    if ((++_sp & 255u) == 0u) { if (xb_ld(&(bar)[XB_TMO])) break; if (_sp > XB_SPIN_CAP) { atomicAdd(&(bar)[XB_TMO], 1u); break; } } } } while (0)
struct XcdBarrier { unsigned* bar; unsigned x; volatile LAS unsigned* st; };
__device__ __forceinline__ XcdBarrier xcd_barrier_post(unsigned* bar, volatile LAS unsigned* st) {
    XcdBarrier b; b.bar = bar; b.x = xb_xcc_id(); b.st = st;
    if (threadIdx.x == 0) (void)xb_add(&bar[XB_XCNT(b.x)], 1u);
    return b;
}
__device__ __forceinline__ void xcd_barrier_complete(unsigned* bar, unsigned x, unsigned& nloc, unsigned& nx) {
    const unsigned G = gridDim.x * gridDim.y * gridDim.z;
    unsigned sum, cnt, mine, sp = 0u;
    for (;;) {
        sum = 0u; cnt = 0u; mine = 0u;
#pragma unroll
        for (unsigned j = 0; j < 16; ++j) { const unsigned c = xb_ld(&bar[XB_XCNT(j)]); sum += c; cnt += (c > 0u) ? 1u : 0u; mine = (j == x) ? c : mine; }
        if (sum == G) break;
        __builtin_amdgcn_s_sleep(1);
        if ((++sp & 255u) == 0u) { if (xb_ld(&bar[XB_TMO])) break; if (sp > XB_SPIN_CAP) { atomicAdd(&bar[XB_TMO], 1u); break; } }
    }
    nloc = mine > 0u ? mine : 1u; nx = cnt > 0u ? cnt : 1u;
}
__device__ __forceinline__ void xcd_barrier(const XcdBarrier& b) {
    asm volatile("s_waitcnt vmcnt(0)" ::: "memory");
    __syncthreads();
    if (threadIdx.x == 0) {
        unsigned* bar = b.bar;
        __builtin_amdgcn_s_waitcnt(0);
        unsigned nloc = b.st[0], nx = b.st[1];
        if (nloc == 0u) { xcd_barrier_complete(bar, b.x, nloc, nx); b.st[0] = nloc; b.st[1] = nx; }
        const unsigned old = xb_add(&bar[XB_XSUB(b.x)], 1u);
        const unsigned gen = old / nloc;
        if (old + 1u == (gen + 1u) * nloc) {
            __builtin_amdgcn_fence(__ATOMIC_RELEASE, "agent");
            asm volatile("s_waitcnt vmcnt(0)" ::: "memory");
            const unsigned og = xb_add(&bar[XB_TOP], 1u);
            const unsigned tg = og / nx;
            if (og + 1u == (tg + 1u) * nx) xb_add(&bar[XB_TOPGEN], 1u);
            else XB_SPIN(xb_ld(&bar[XB_TOPGEN]) == tg, bar);
            __builtin_amdgcn_fence(__ATOMIC_ACQUIRE, "agent");
            xb_add(&bar[XB_XGEN(b.x)], 1u);
            asm volatile("s_waitcnt vmcnt(0)" ::: "memory");
        } else {
            XB_SPIN(xb_ld(&bar[XB_XGEN(b.x)]) == gen, bar);
            __builtin_amdgcn_fence(__ATOMIC_ACQUIRE, "agent");
            asm volatile("s_waitcnt vmcnt(0)" ::: "memory");
        }
    }
    __syncthreads();
}

namespace pg8 {
typedef short bf16x8 __attribute__((ext_vector_type(8)));
constexpr int BM = 256, BK = 64, HALF = 128, HTB = HALF * BK * 2, STAGE_BYTES = 8 * HTB;
static_assert(STAGE_BYTES == RING_BYTES, "ring");
__host__ __device__ __forceinline__ int lds_byte(int r, int c) { const int st = (r >> 4) * 2 + (c >> 5), rr = r & 15, cc = c & 31, ob = rr * 64 + cc * 2; return st * 1024 + (ob ^ (((ob >> 9) & 1) << 5)); }
__host__ __device__ __forceinline__ void stage_rc(int b, int& R, int& C) { const int st = b / 1024, sb = b % 1024, swz = sb ^ (((sb >> 9) & 1) << 5); R = (st >> 1) * 16 + swz / 64; C = (st & 1) * 32 + (swz % 64) / 2; }
__host__ __device__ __forceinline__ int perm32(int rho) { const int n = rho >> 4, i = rho & 15; return 8 * (i >> 2) + 4 * n + (i & 3); }

struct Unit { int pm, pn, e, rows, slot0; };

__device__ __forceinline__ bool static_tile(int i, int G, int c, int nM, int nN, int& pm, int& pn) {
    const int nwg = nM * nN; const long L = (long)i * G + c; if (L >= nwg) return false;
    int wgid = (int)L; { const int q = nwg / 8, r = nwg % 8, xcd = wgid % 8, off = wgid / 8; wgid = (xcd < r ? xcd * (q + 1) : r * (q + 1) + (xcd - r) * q) + off; }
    const int nig = 8 * nN, gid = wgid / nig, fm = gid * 8, gsz = (nM - fm) < 8 ? (nM - fm) : 8;
    pm = fm + ((wgid % nig) % gsz); pn = (wgid % nig) / gsz; return true;
}
struct DenseSched {
    int nM, nN, G, c; const char* A; const char* Bt; size_t tstepA, tstepB, a_colstep;
    __device__ __forceinline__ bool next(int i, Unit& u) const { if (!static_tile(i, G, c, nM, nN, u.pm, u.pn)) return false; u.e = 0; u.rows = 256; u.slot0 = 0; return true; }
    __device__ __forceinline__ const char* a_base(const Unit& u) const { return A + (size_t)u.pm * tstepA + (size_t)u.pn * a_colstep; }
    __device__ __forceinline__ const char* b_base(const Unit& u) const { return Bt + (size_t)u.pn * tstepB; }
    __device__ __forceinline__ const unsigned* idx_src(const Unit&) const { return nullptr; }
};
struct MoeSched {
    int nM, nN, G, c, t0; int m1, m2, m3, m4, m5, m6, m7; int n0, n1, n2, n3, n4, n5, n6, n7;
    const char* A; size_t tstepA; const char* Bt; size_t estepB, tstepB; const unsigned* rowidx;
    __device__ __forceinline__ bool next(int i, Unit& u) const {
        if (!static_tile(i, G, c, nM, nN, u.pm, u.pn)) return false;
        const int tg = t0 + u.pm; int e = 0, base = 0, cn = __builtin_amdgcn_readfirstlane(n0);
        if (tg >= m1) { e = 1; base = m1; cn = __builtin_amdgcn_readfirstlane(n1); }
        if (tg >= m2) { e = 2; base = m2; cn = __builtin_amdgcn_readfirstlane(n2); }
        if (tg >= m3) { e = 3; base = m3; cn = __builtin_amdgcn_readfirstlane(n3); }
        if (tg >= m4) { e = 4; base = m4; cn = __builtin_amdgcn_readfirstlane(n4); }
        if (tg >= m5) { e = 5; base = m5; cn = __builtin_amdgcn_readfirstlane(n5); }
        if (tg >= m6) { e = 6; base = m6; cn = __builtin_amdgcn_readfirstlane(n6); }
        if (tg >= m7) { e = 7; base = m7; cn = __builtin_amdgcn_readfirstlane(n7); }
        const int ti = tg - base; const int rem = cn - 256 * ti;
        u.e = e; u.rows = rem < 256 ? rem : 256; u.slot0 = e * CAP + ti * 256; return true;
    }
    __device__ __forceinline__ const char* a_base(const Unit& u) const { return A + (size_t)u.pm * tstepA; }
    __device__ __forceinline__ const char* b_base(const Unit& u) const { return Bt + (size_t)u.e * estepB + (size_t)u.pn * tstepB; }
    __device__ __forceinline__ const unsigned* idx_src(const Unit& u) const { return rowidx + u.slot0; }
};

struct EpiSwiGLU {
    static constexpr bool PERM = true;
    bf16* H; int ldh;
    __device__ __forceinline__ void operator()(const f32x4 (&acc)[2][2][4][2], const Unit& u, int wr, int wc, int fr, int fq) const {
        const int row0 = u.pm * BM + wr * 64 + fr, col0 = u.pn * 128 + wc * 32 + 8 * fq;
#pragma unroll
        for (int ai = 0; ai < 2; ++ai)
#pragma unroll
            for (int m = 0; m < 4; ++m) { bf16* p = H + (size_t)(row0 + ai * HALF + m * 16) * ldh + col0;
                const f32x4 g0 = acc[ai][0][m][0], g1 = acc[ai][0][m][1], u0 = acc[ai][1][m][0], u1 = acc[ai][1][m][1];
                v4u w; w.x = cvt_pk_bf16(silu_f(g0[0]) * u0[0], silu_f(g0[1]) * u0[1]); w.y = cvt_pk_bf16(silu_f(g0[2]) * u0[2], silu_f(g0[3]) * u0[3]);
                w.z = cvt_pk_bf16(silu_f(g1[0]) * u1[0], silu_f(g1[1]) * u1[1]); w.w = cvt_pk_bf16(silu_f(g1[2]) * u1[2], silu_f(g1[3]) * u1[3]);
                *(v4u*)p = w; }
    }
};
struct EpiResid {
    static constexpr bool PERM = false;
    float* h; const bf16* y1; const float* scale; int row_off;
    __device__ __forceinline__ void operator()(const f32x4 (&acc)[2][2][4][2], const Unit& u, int wr, int wc, int fr, int fq) const {
        const int row0 = row_off + u.pm * BM + wr * 64 + fr, col0 = u.pn * BM + wc * 32 + 4 * fq;
        f32x4 sc[2][2];
#pragma unroll
        for (int bj = 0; bj < 2; ++bj)
#pragma unroll
            for (int n = 0; n < 2; ++n) sc[bj][n] = scale ? *(const f32x4*)(scale + col0 + bj * HALF + n * 16) : (f32x4){1.f, 1.f, 1.f, 1.f};
#pragma unroll
        for (int ai = 0; ai < 2; ++ai)
#pragma unroll
            for (int m = 0; m < 4; ++m) { const size_t off = (size_t)(row0 + ai * HALF + m * 16) * D + col0;
#pragma unroll
                for (int bj = 0; bj < 2; ++bj)
#pragma unroll
                    for (int n = 0; n < 2; ++n) { f32x4 b = *(const f32x4*)(h + off + bj * HALF + n * 16);
                        if (y1) { const v2u y = *(const v2u*)(y1 + off + bj * HALF + n * 16); b += (f32x4){bf_lo(y.x), bf_hi(y.x), bf_lo(y.y), bf_hi(y.y)}; }
                        *(f32x4*)(h + off + bj * HALF + n * 16) = b + acc[ai][bj][m][n] * sc[bj][n]; }
                asm volatile("" ::: "memory"); }
    }
};
struct EpiConvIn {
    static constexpr bool PERM = true;
    bf16* BG; bf16* U;
    __device__ __forceinline__ void operator()(const f32x4 (&acc)[2][2][4][2], const Unit& u, int wr, int wc, int fr, int fq) const {
        const int row0 = u.pm * BM + wr * 64 + fr;
        if (u.pn < 4) {
            const int col0 = u.pn * BM + wc * 32 + 8 * fq;
#pragma unroll
            for (int ai = 0; ai < 2; ++ai)
#pragma unroll
                for (int m = 0; m < 4; ++m) { bf16* p = BG + (size_t)(row0 + ai * HALF + m * 16) * D + col0;
#pragma unroll
                    for (int bj = 0; bj < 2; ++bj) { const f32x4 v0 = acc[ai][bj][m][0], v1 = acc[ai][bj][m][1];
                        v4u w; w.x = cvt_pk_bf16(v0[0], v0[1]); w.y = cvt_pk_bf16(v0[2], v0[3]); w.z = cvt_pk_bf16(v1[0], v1[1]); w.w = cvt_pk_bf16(v1[2], v1[3]);
                        *(v4u*)(p + bj * HALF) = w; } }
        } else {
            const int col0 = (u.pn - 4) * 128 + wc * 32 + 8 * fq;
#pragma unroll
            for (int ai = 0; ai < 2; ++ai)
#pragma unroll
                for (int m = 0; m < 4; ++m) { bf16* p = U + (size_t)(row0 + ai * HALF + m * 16) * D + col0;
                    const f32x4 c0 = acc[ai][0][m][0], c1 = acc[ai][0][m][1], v0 = acc[ai][1][m][0], v1 = acc[ai][1][m][1];
                    v4u w; w.x = cvt_pk_bf16(c0[0] * v0[0], c0[1] * v0[1]); w.y = cvt_pk_bf16(c0[2] * v0[2], c0[3] * v0[3]);
                    w.z = cvt_pk_bf16(c1[0] * v1[0], c1[1] * v1[1]); w.w = cvt_pk_bf16(c1[2] * v1[2], c1[3] * v1[3]);
                    *(v4u*)p = w; }
        }
    }
};
struct EpiMoeDown {
    static constexpr bool PERM = false;
    const int2* slot; float* h; bf16* y1;
    __device__ __forceinline__ void operator()(const f32x4 (&acc)[2][2][4][2], const Unit& u, int wr, int wc, int fr, int fq) const {
        const int col0 = u.pn * BM + wc * 32 + 4 * fq;
#pragma unroll
        for (int ai = 0; ai < 2; ++ai)
#pragma unroll
            for (int m = 0; m < 4; ++m) { const int rl = ai * HALF + wr * 64 + m * 16 + fr;
                if (rl < u.rows) {
                    const int2 inf = slot[u.slot0 + rl]; const int tok = inf.x & 0x7fffffff; const float w = __int_as_float(inf.y);
                    const size_t off = (size_t)tok * D + col0;
                    if (inf.x >= 0) {
#pragma unroll
                        for (int bj = 0; bj < 2; ++bj)
#pragma unroll
                            for (int n = 0; n < 2; ++n) { const f32x4 b = *(const f32x4*)(h + off + bj * HALF + n * 16); *(f32x4*)(h + off + bj * HALF + n * 16) = b + acc[ai][bj][m][n] * w; }
                    } else {
#pragma unroll
                        for (int bj = 0; bj < 2; ++bj)
#pragma unroll
                            for (int n = 0; n < 2; ++n) { const f32x4 v = acc[ai][bj][m][n] * w; v2u o; o.x = cvt_pk_bf16(v[0], v[1]); o.y = cvt_pk_bf16(v[2], v[3]); *(v2u*)(y1 + off + bj * HALF + n * 16) = o; }
                    }
                }
                asm volatile("" ::: "memory"); }
    }
};

template <class Epi, class Sched, bool GATHER>
__device__ __forceinline__ void gemm_phase(LAS unsigned char* lds, LAS unsigned* idxbuf, const int K, const int lda, const int ldb, const Sched& S, const Epi& E) {
    int tid_ = threadIdx.x; asm volatile("" : "+v"(tid_));
    const int tid = tid_, wid = __builtin_amdgcn_readfirstlane(tid >> 6), lane = tid & 63, wr = wid >> 2, wc = wid & 3, fr = lane & 15, fq = lane >> 4;
    const int nt = K / BK;
    unsigned voffA[2], voffB[2], voffG[2][2];
#pragma unroll
    for (int i = 0; i < 2; ++i) { int R, C; stage_rc(tid * 16 + i * 8192, R, C); const int Rb = Epi::PERM ? ((R & ~31) + perm32(R & 31)) : R;
        voffA[i] = (unsigned)(R * lda + C) * 2u; voffB[i] = (unsigned)(Rb * ldb + C) * 2u; voffG[0][i] = 0u; voffG[1][i] = 0u; }
    const size_t kstep = (size_t)(BK * 2);
    const size_t hstepA = (size_t)HALF * lda * 2, hstepB = (size_t)HALF * ldb * 2;
    const unsigned ldsw = (unsigned)wid * 1024u;
    const int aoff = lds_byte(wr * 64 + fr, fq * 8), boff = lds_byte(wc * 32 + fr, fq * 8);
#define PG8_SA(b, h) (((b) * 2 + (h)) * HTB)
#define PG8_SB(b, h) ((4 + (b) * 2 + (h)) * HTB)
#define PG8_STAGE(bufoff, gbase, voff) do { _Pragma("unroll") for (int _i = 0; _i < 2; ++_i) \
        __builtin_amdgcn_global_load_lds((const unsigned*)((const char*)(gbase) + (voff)[_i]), (LAS unsigned*)(lds + (bufoff) + ldsw + _i * 8192), 16, 0, 0); } while (0)
#define PG8_STAGE_A(bufoff, gbase, h) do { if constexpr (GATHER) { PG8_STAGE(bufoff, gbase, voffG[h]); } else { PG8_STAGE(bufoff, (gbase) + (h) * hstepA, voffA); } } while (0)
#define PG8_STAGE_B(bufoff, gbase, h) PG8_STAGE(bufoff, (gbase) + (h) * hstepB, voffB)
#define PG8_LDA(dst, b, h) do { _Pragma("unroll") for (int m = 0; m < 4; ++m) _Pragma("unroll") for (int k = 0; k < 2; ++k) dst[m][k] = *(const LAS bf16x8*)(lds + PG8_SA(b, h) + aoff + m * 2048 + k * 1024); } while (0)
#define PG8_LDB(dst, b, h) do { _Pragma("unroll") for (int n = 0; n < 2; ++n) _Pragma("unroll") for (int k = 0; k < 2; ++k) dst[n][k] = *(const LAS bf16x8*)(lds + PG8_SB(b, h) + boff + n * 2048 + k * 1024); } while (0)
#define PG8_MMA(ai, bj, At, Bt) do { __builtin_amdgcn_s_setprio(1); _Pragma("unroll") for (int m = 0; m < 4; ++m) _Pragma("unroll") for (int n = 0; n < 2; ++n) _Pragma("unroll") for (int k = 0; k < 2; ++k) \
        acc[ai][bj][m][n] = __builtin_amdgcn_mfma_f32_16x16x32_bf16(Bt[n][k], At[m][k], acc[ai][bj][m][n], 0, 0, 0); __builtin_amdgcn_s_setprio(0); } while (0)
#define PG8_WAIT_V(n) asm volatile("s_waitcnt vmcnt(" #n ")" ::: "memory")
#define PG8_WAIT_L(n) asm volatile("s_waitcnt lgkmcnt(" #n ")" ::: "memory")
#define PG8_BAR __builtin_amdgcn_s_barrier()
#define PG8_SCHED __builtin_amdgcn_sched_barrier(0)
#define PG8_LOAD_VOFFG(ib, nrows) do { asm volatile("" ::: "memory"); _Pragma("unroll") for (int _i = 0; _i < 2; ++_i) { int _R, _C; stage_rc(tid * 16 + _i * 8192, _R, _C); \
        _Pragma("unroll") for (int _h = 0; _h < 2; ++_h) { const int _rl = _h * HALF + _R; unsigned _ix = (ib)[_rl]; _ix = (_rl < (nrows)) ? _ix : 0u; voffG[_h][_i] = _ix * (unsigned)(lda * 2) + (unsigned)(_C * 2); } } } while (0)
#define PG8_IDX_DMA(src, ib) __builtin_amdgcn_global_load_lds((const unsigned*)((src) + lane * 4), (LAS unsigned*)(ib), 16, 0, 0)
    Unit cur, nxt; int ui = 0;
    if (!S.next(0, cur)) return;
    f32x4 acc[2][2][4][2];
#pragma unroll
    for (int a = 0; a < 2; ++a)
#pragma unroll
        for (int b = 0; b < 2; ++b)
#pragma unroll
            for (int m = 0; m < 4; ++m)
#pragma unroll
                for (int n = 0; n < 2; ++n) acc[a][b][m][n] = (f32x4){0.f, 0.f, 0.f, 0.f};
    bf16x8 At[4][2], B0[2][2], B1[2][2];
    const char* cA = S.a_base(cur); const char* cB = S.b_base(cur);
    if constexpr (GATHER) {
        if (wid == 0) PG8_IDX_DMA(S.idx_src(cur), idxbuf);
        PG8_WAIT_V(0); PG8_BAR;
        PG8_LOAD_VOFFG(idxbuf, cur.rows);
    }
    PG8_STAGE_B(PG8_SB(0, 0), cB, 0); PG8_STAGE_B(PG8_SB(0, 1), cB, 1); PG8_STAGE_A(PG8_SA(0, 0), cA, 0); PG8_STAGE_A(PG8_SA(0, 1), cA, 1);
    if (wr == 1) PG8_BAR;
    PG8_WAIT_V(2); PG8_BAR;
    PG8_STAGE_B(PG8_SB(1, 0), cB + kstep, 0); PG8_STAGE_A(PG8_SA(1, 0), cA + kstep, 0); PG8_STAGE_B(PG8_SB(1, 1), cB + kstep, 1);
    PG8_WAIT_V(6); PG8_BAR;
    for (;;) {
        const bool has_next = S.next(ui + 1, nxt);
        const char* nA = has_next ? S.a_base(nxt) : cA; const char* nB = has_next ? S.b_base(nxt) : cB;
        if constexpr (GATHER) { if (has_next && wid == 0) PG8_IDX_DMA(S.idx_src(nxt), idxbuf + ((ui + 1) & 1) * 256); }
        for (int t = 0; t < nt; t += 2) {
            const bool last = (t == nt - 2);
            const char* a1 = cA + (size_t)(t + 1) * kstep;
            const char* a2 = last ? nA : cA + (size_t)(t + 2) * kstep; const char* b2 = last ? nB : cB + (size_t)(t + 2) * kstep;
            const char* a3 = a2 + kstep; const char* b3 = b2 + kstep;
            PG8_LDB(B0, 0, 0); PG8_LDB(B1, 0, 1); PG8_SCHED; PG8_LDA(At, 0, 0); PG8_STAGE_A(PG8_SA(1, 1), a1, 1);
            PG8_WAIT_V(8); PG8_WAIT_L(0); PG8_BAR; PG8_MMA(0, 0, At, B0); PG8_MMA(0, 1, At, B1); PG8_BAR; PG8_SCHED;
            if constexpr (GATHER) { if (last && has_next) PG8_LOAD_VOFFG(idxbuf + ((ui + 1) & 1) * 256, nxt.rows); }
            PG8_LDA(At, 0, 1); PG8_STAGE_B(PG8_SB(0, 0), b2, 0); PG8_STAGE_B(PG8_SB(0, 1), b2, 1); PG8_STAGE_A(PG8_SA(0, 0), a2, 0);
            PG8_WAIT_V(8); PG8_WAIT_L(0); PG8_BAR; PG8_MMA(1, 0, At, B0); PG8_MMA(1, 1, At, B1); PG8_BAR; PG8_SCHED;
            PG8_LDB(B0, 1, 0); PG8_LDB(B1, 1, 1); PG8_SCHED; PG8_LDA(At, 1, 0); PG8_STAGE_A(PG8_SA(0, 1), a2, 1);
            PG8_WAIT_V(8); PG8_WAIT_L(0); PG8_BAR; PG8_MMA(0, 0, At, B0); PG8_MMA(0, 1, At, B1); PG8_BAR; PG8_SCHED;
            PG8_LDA(At, 1, 1); PG8_STAGE_B(PG8_SB(1, 0), b3, 0); PG8_STAGE_B(PG8_SB(1, 1), b3, 1); PG8_STAGE_A(PG8_SA(1, 0), a3, 0);
            PG8_WAIT_V(8); PG8_WAIT_L(0); PG8_BAR; PG8_MMA(1, 0, At, B0); PG8_MMA(1, 1, At, B1); PG8_BAR; PG8_SCHED;
        }
        if (wr == 0) PG8_BAR;
        E(acc, cur, wr, wc, fr, fq);
        if (!has_next) break;
#pragma unroll
        for (int a = 0; a < 2; ++a)
#pragma unroll
            for (int b = 0; b < 2; ++b)
#pragma unroll
                for (int m = 0; m < 4; ++m)
#pragma unroll
                    for (int n = 0; n < 2; ++n) acc[a][b][m][n] = (f32x4){0.f, 0.f, 0.f, 0.f};
        cur = nxt; cA = nA; cB = nB; ++ui;
        if (wr == 1) PG8_BAR;
    }
    PG8_WAIT_V(0);
    PG8_BAR;
#undef PG8_SA
#undef PG8_SB
#undef PG8_STAGE
#undef PG8_STAGE_A
#undef PG8_STAGE_B
#undef PG8_LDA
#undef PG8_LDB
#undef PG8_MMA
#undef PG8_WAIT_V
#undef PG8_WAIT_L
#undef PG8_BAR
#undef PG8_SCHED
#undef PG8_LOAD_VOFFG
#undef PG8_IDX_DMA
}
}

struct Args { const float* in[19]; float* out; unsigned char* ws; int ph_lo, ph_hi; };
struct Ctx {
    LAS unsigned char* lds; int tid, lane, wave, G, vcu, gw, NGW;
    unsigned char* ws; float* H32; bf16* XN; bf16* Y1; float* RSTD; unsigned* ctl;
};

__device__ __forceinline__ void tr_item(const float* W, int ldw, int k0, int n0, bf16* WT, int K, int drow0, LAS float* scr, int lane) {
#pragma unroll 8
    for (int i = 0; i < 32; ++i) { const int kk = 2 * i + (lane >> 5); scr[kk * 33 + (lane & 31)] = W[(size_t)(k0 + kk) * ldw + n0 + (lane & 31)]; }
    LDS_WAIT();
    const int c = lane & 7;
#pragma unroll
    for (int j = 0; j < 4; ++j) { const int n = (lane >> 3) + 8 * j; const LAS float* s = scr + (8 * c) * 33 + n;
        v4u o; o.x = cvt_pk_bf16(s[0 * 33], s[1 * 33]); o.y = cvt_pk_bf16(s[2 * 33], s[3 * 33]); o.z = cvt_pk_bf16(s[4 * 33], s[5 * 33]); o.w = cvt_pk_bf16(s[6 * 33], s[7 * 33]);
        *(v4u*)(WT + (size_t)(drow0 + n) * K + k0 + 8 * c) = o; }
    LDS_WAIT();
}
__device__ __forceinline__ void cv_gateup(const float* Wg, const float* Wu, bf16* dst, int item, LAS float* scr, int lane) {
    const int kind = item / 1792, r = item % 1792, kb = r / 112, nb = r % 112, n0 = 32 * nb;
    tr_item(kind ? Wu : Wg, FF, 64 * kb, n0, dst, D, (n0 >> 7) * 256 + (n0 & 127) + kind * 128, scr, lane);
}
__device__ __forceinline__ void cv_plain(const float* W, int K, int N, bf16* dst, int drow_off, int item, LAS float* scr, int lane) {
    const int nbn = N / 32, kb = item / nbn, nb = item % nbn;
    tr_item(W, N, 64 * kb, 32 * nb, dst, K, drow_off + 32 * nb, scr, lane);
}
__device__ __forceinline__ void cv_convin(const float* W, bf16* dst, int item, LAS float* scr, int lane) {
    const int kb = item / 96, nb = item % 96, n0 = 32 * nb; int dr;
    if (n0 < 1024) dr = n0; else if (n0 < 2048) dr = 1024 + ((n0 - 1024) >> 7) * 256 + (n0 & 127); else dr = 1024 + ((n0 - 2048) >> 7) * 256 + 128 + (n0 & 127);
    tr_item(W, 3 * D, 64 * kb, n0, dst, D, dr, scr, lane);
}
__device__ __forceinline__ void convert_moe_layer(Ctx& C, const Args& a, int j) {
    LAS float* scr = (LAS float*)(C.lds + C.wave * 16384);
    constexpr int PER_E = 3584 + 1792;
    for (int it = C.gw; it < NE * PER_E; it += C.NGW) {
        const int e = it / PER_E, r = it % PER_E; const size_t wo = ((size_t)j * NE + e) * D * FF;
        if (r < 3584) cv_gateup(a.in[15] + wo, a.in[16] + wo, (bf16*)(C.ws + WS_WMGU + (size_t)e * GU_BYTES), r, scr, C.lane);
        else cv_plain(a.in[17] + wo, FF, D, (bf16*)(C.ws + WS_WMDN + (size_t)e * DN_BYTES), 0, r - 3584, scr, C.lane);
    }
}
__device__ __forceinline__ void convert_small_weights(Ctx& C, const Args& a) {
    LAS float* scr = (LAS float*)(C.lds + C.wave * 16384);
    constexpr int I_POOL = 32, I_GU = 3584, I_DN = 1792, I_IN = 1536, I_OUT = 512;
    constexpr int PER_L = 4 * I_POOL + I_GU + I_DN + I_IN + I_OUT;
    for (int it = C.gw; it < 2 * PER_L; it += C.NGW) {
        const int l = it / PER_L; int r = it % PER_L;
        if (r < 4 * I_POOL) { const int g = r / I_POOL; cv_plain(a.in[3] + (size_t)(l * 4 + g) * 65536, 256, 256, (bf16*)(C.ws + WS_WPOOL + (size_t)l * 524288), g * 256, r % I_POOL, scr, C.lane); continue; } r -= 4 * I_POOL;
        if (r < I_GU) { cv_gateup(a.in[6] + (size_t)l * D * FF, a.in[7] + (size_t)l * D * FF, (bf16*)(C.ws + WS_WGU + (size_t)l * GU_BYTES), r, scr, C.lane); continue; } r -= I_GU;
        if (r < I_DN) { cv_plain(a.in[8] + (size_t)l * D * FF, FF, D, (bf16*)(C.ws + WS_WDN + (size_t)l * DN_BYTES), 0, r, scr, C.lane); continue; } r -= I_DN;
        if (r < I_IN) { cv_convin(a.in[10] + (size_t)l * D * 3 * D, (bf16*)(C.ws + WS_WIN + (size_t)l * 3 * D * D * 2), r, scr, C.lane); continue; } r -= I_IN;
        cv_plain(a.in[12] + (size_t)l * D * D, D, D, (bf16*)(C.ws + WS_WOUT + (size_t)l * D * D * 2), 0, r, scr, C.lane);
    }
}

__device__ __forceinline__ int prev_row(int row, int i) {
    if (row < MROWS) { const int tp = row & (TS - 1); return tp >= i ? row - i : MROWS + NMETA + tp - i; }
    return row - i;
}
__device__ __forceinline__ void load_heff(const Ctx& C, int row, bool addy1, f32x4 (&x)[4]) {
    const f32x4* p = (const f32x4*)(C.H32 + (size_t)row * D) + C.lane;
#pragma unroll
    for (int j = 0; j < 4; ++j) x[j] = p[64 * j];
    if (addy1) { const v2u* q = (const v2u*)(C.Y1 + (size_t)row * D) + C.lane;
#pragma unroll
        for (int j = 0; j < 4; ++j) { const v2u y = q[64 * j]; x[j] += (f32x4){bf_lo(y.x), bf_hi(y.x), bf_lo(y.y), bf_hi(y.y)}; } }
}
__device__ __forceinline__ float row_rstd(const f32x4 (&x)[4]) {
    float s = 0.f;
#pragma unroll
    for (int j = 0; j < 4; ++j) s += (x[j][0] * x[j][0] + x[j][1] * x[j][1]) + (x[j][2] * x[j][2] + x[j][3] * x[j][3]);
    return __frsqrt_rn(wave_sum(s) * (1.0f / D) + EPS);
}
__device__ __forceinline__ void store_bf16_row(bf16* dst, int row, int lane, const f32x4 (&v)[4]) {
    v2u* o = (v2u*)(dst + (size_t)row * D) + lane;
#pragma unroll
    for (int j = 0; j < 4; ++j) { v2u w; w.x = cvt_pk_bf16(v[j][0], v[j][1]); w.y = cvt_pk_bf16(v[j][2], v[j][3]); o[64 * j] = w; }
}
__device__ __forceinline__ void phase_norm(Ctx& C, const float* gain, bool addy1) {
    f32x4 g[4];
#pragma unroll
    for (int j = 0; j < 4; ++j) g[j] = ((const f32x4*)gain)[C.lane + 64 * j];
    for (int row = C.gw; row < RTOT; row += C.NGW) {
        f32x4 x[4]; load_heff(C, row, addy1, x); const float rs = row_rstd(x);
#pragma unroll
        for (int j = 0; j < 4; ++j) x[j] = x[j] * rs * g[j];
        store_bf16_row(C.XN, row, C.lane, x);
    }
}
__device__ __forceinline__ void phase_pool_stats(Ctx& C, bool addy1) {
    for (int row = C.gw; row < RTOT; row += C.NGW) { f32x4 x[4]; load_heff(C, row, addy1, x); const float rs = row_rstd(x); if (C.lane == 0) C.RSTD[row] = rs; }
}
__device__ __forceinline__ void phase_pool_diff(Ctx& C, const float* gain, bool addy1) {
    f32x4 g[4];
#pragma unroll
    for (int j = 0; j < 4; ++j) g[j] = ((const f32x4*)gain)[C.lane + 64 * j];
    for (int row = C.gw; row < RTOT; row += C.NGW) {
        const int pos = row >= MROWS ? row - MROWS : NMETA + (row & (TS - 1));
        f32x4 d[4];
#pragma unroll
        for (int j = 0; j < 4; ++j) {
            const int w = 2 << j; const int cnt = (pos + 1) < w ? (pos + 1) : w;
            f32x4 s = (f32x4){0.f, 0.f, 0.f, 0.f}, n0 = s;
            for (int i = 0; i < cnt; ++i) {
                const int pr = prev_row(row, i); const float rs = C.RSTD[pr];
                f32x4 v = ((const f32x4*)(C.H32 + (size_t)pr * D))[C.lane + 64 * j];
                if (addy1) { const v2u y = ((const v2u*)(C.Y1 + (size_t)pr * D))[C.lane + 64 * j]; v += (f32x4){bf_lo(y.x), bf_hi(y.x), bf_lo(y.y), bf_hi(y.y)}; }
                v = v * rs * g[j]; if (i == 0) n0 = v; s += v;
            }
            d[j] = s * (1.0f / (float)cnt) - n0;
        }
        store_bf16_row(C.XN, row, C.lane, d);
    }
}
__device__ __forceinline__ void phase_conv(Ctx& C, const float* ck, const bf16* BG, const bf16* U, bf16* Y) {
    float k[3][2][8];
#pragma unroll
    for (int t = 0; t < 3; ++t)
#pragma unroll
        for (int q = 0; q < 2; ++q) { const f32x4 a = *(const f32x4*)(ck + t * D + 8 * C.lane + 512 * q), b = *(const f32x4*)(ck + t * D + 8 * C.lane + 512 * q + 4);
            k[t][q][0] = a[0]; k[t][q][1] = a[1]; k[t][q][2] = a[2]; k[t][q][3] = a[3]; k[t][q][4] = b[0]; k[t][q][5] = b[1]; k[t][q][6] = b[2]; k[t][q][7] = b[3]; }
    for (int row = C.gw; row < RTOT; row += C.NGW) {
        const int pos = row >= MROWS ? row - MROWS : NMETA + (row & (TS - 1));
#pragma unroll
        for (int q = 0; q < 2; ++q) {
            const int co = 8 * C.lane + 512 * q;
            float s[8];
#pragma unroll
            for (int e = 0; e < 8; ++e) s[e] = 0.f;
#pragma unroll
            for (int t = 0; t < 3; ++t) {
                const int back = 2 - t;
                if (pos >= back) { const v4u uu = *(const v4u*)(U + (size_t)prev_row(row, back) * D + co);
                    s[0] += k[t][q][0] * bf_lo(uu.x); s[1] += k[t][q][1] * bf_hi(uu.x); s[2] += k[t][q][2] * bf_lo(uu.y); s[3] += k[t][q][3] * bf_hi(uu.y);
                    s[4] += k[t][q][4] * bf_lo(uu.z); s[5] += k[t][q][5] * bf_hi(uu.z); s[6] += k[t][q][6] * bf_lo(uu.w); s[7] += k[t][q][7] * bf_hi(uu.w); }
            }
            const v4u bb = *(const v4u*)(BG + (size_t)row * D + co);
            v4u o; o.x = cvt_pk_bf16(bf_lo(bb.x) * s[0], bf_hi(bb.x) * s[1]); o.y = cvt_pk_bf16(bf_lo(bb.y) * s[2], bf_hi(bb.y) * s[3]);
            o.z = cvt_pk_bf16(bf_lo(bb.z) * s[4], bf_hi(bb.z) * s[5]); o.w = cvt_pk_bf16(bf_lo(bb.w) * s[6], bf_hi(bb.w) * s[7]);
            *(v4u*)(Y + (size_t)row * D + co) = o;
        }
    }
}
__device__ __forceinline__ void phase_router(Ctx& C, const float* gain, const float* router, unsigned* gcnt  ) {
    LAS unsigned* lcnt = (LAS unsigned*)C.lds;
    LAS unsigned* lbase = lcnt + 8;
    LAS unsigned* ent = lcnt + 16;
    f32x4 g[4];
#pragma unroll
    for (int j = 0; j < 4; ++j) g[j] = ((const f32x4*)gain)[C.lane + 64 * j];
    unsigned* rowidx = (unsigned*)(C.ws + WS_ROWIDX); int2* slot = (int2*)(C.ws + WS_SLOT);
    const int nchunk = (RTOT + 255) / 256;
    for (int ch = blockIdx.x; ch < nchunk; ch += C.G) {
        const int r0 = ch * 256, nr = (RTOT - r0) < 256 ? (RTOT - r0) : 256;
        __syncthreads();
        if (C.tid < 16) lcnt[C.tid] = 0u;
        __syncthreads();
        for (int lr = C.wave; lr < nr; lr += NWAVES) {
            const int row = r0 + lr;
            f32x4 x[4]; load_heff(C, row, false, x); const float rs = row_rstd(x);
#pragma unroll
            for (int j = 0; j < 4; ++j) x[j] = x[j] * rs * g[j];
            store_bf16_row(C.XN, row, C.lane, x);
            float lg[8];
#pragma unroll
            for (int e = 0; e < 8; ++e) lg[e] = 0.f;
#pragma unroll
            for (int j = 0; j < 4; ++j)
#pragma unroll
                for (int i = 0; i < 4; ++i) { const f32x4* rp = (const f32x4*)(router + (size_t)(4 * C.lane + 256 * j + i) * NE); const f32x4 ra = rp[0], rb = rp[1]; const float xv = x[j][i];
                    lg[0] += xv * ra[0]; lg[1] += xv * ra[1]; lg[2] += xv * ra[2]; lg[3] += xv * ra[3]; lg[4] += xv * rb[0]; lg[5] += xv * rb[1]; lg[6] += xv * rb[2]; lg[7] += xv * rb[3]; }
#pragma unroll
            for (int e = 0; e < 8; ++e) lg[e] = wave_sum(lg[e]);
            int e1 = 0; float v1 = lg[0];
#pragma unroll
            for (int e = 1; e < 8; ++e) if (lg[e] > v1) { v1 = lg[e]; e1 = e; }
            int e2 = -1; float v2 = -3.0e38f;
#pragma unroll
            for (int e = 0; e < 8; ++e) if (e != e1 && lg[e] > v2) { v2 = lg[e]; e2 = e; }
            const float ex = __expf(v2 - v1), w1 = 1.0f / (1.0f + ex), w2 = ex * w1;
            if (C.lane == 0) {
                const unsigned k1 = atomicAdd((unsigned*)&lcnt[e1], 1u), k2 = atomicAdd((unsigned*)&lcnt[e2], 1u);
                ent[(lr * 2 + 0) * 2 + 0] = (unsigned)e1 | (k1 << 8); ent[(lr * 2 + 0) * 2 + 1] = __float_as_uint(w1);
                ent[(lr * 2 + 1) * 2 + 0] = (unsigned)e2 | (k2 << 8); ent[(lr * 2 + 1) * 2 + 1] = __float_as_uint(w2);
            }
        }
        __syncthreads();
        if (C.tid < 8) lbase[C.tid] = __hip_atomic_fetch_add(gcnt + 64 * C.tid, lcnt[C.tid], __ATOMIC_RELAXED, __HIP_MEMORY_SCOPE_AGENT);
        __syncthreads();
        for (int q = C.tid; q < nr * 2; q += NWAVES * 64) {
            const unsigned ek = ent[q * 2], wb = ent[q * 2 + 1]; const int e = ek & 255, rank = ek >> 8, row = r0 + (q >> 1), ch2 = q & 1;
            const int pos = e * CAP + (int)lbase[e] + rank;
            rowidx[pos] = (unsigned)row; slot[pos] = make_int2(row | (ch2 << 31), (int)wb);
        }
    }
    __syncthreads();
}
__device__ __forceinline__ void phase_final(Ctx& C, const float* gain, float* out) {
    f32x4 g[4];
#pragma unroll
    for (int j = 0; j < 4; ++j) g[j] = ((const f32x4*)gain)[C.lane + 64 * j];
    for (int row = C.gw; row < MROWS; row += C.NGW) {
        f32x4 x[4]; load_heff(C, row, true, x); const float rs = row_rstd(x);
        f32x4* o = (f32x4*)(out + (size_t)row * D) + C.lane;
#pragma unroll
        for (int j = 0; j < 4; ++j) o[64 * j] = x[j] * rs * g[j];
    }
}
__device__ __forceinline__ void phase_copy_in(Ctx& C, const float* x, const float* meta) {
    for (int row = C.gw; row < RTOT; row += C.NGW) {
        const f32x4* p = (const f32x4*)(row < MROWS ? x + (size_t)row * D : meta + (size_t)(row - MROWS) * D) + C.lane;
        f32x4* o = (f32x4*)(C.H32 + (size_t)row * D) + C.lane;
#pragma unroll
        for (int j = 0; j < 4; ++j) o[64 * j] = p[64 * j];
    }
}
__device__ __forceinline__ int moe_cnt(unsigned* gcnt, int e) { return __builtin_amdgcn_readfirstlane((int)__hip_atomic_load(gcnt + 64 * e, __ATOMIC_RELAXED, __HIP_MEMORY_SCOPE_AGENT)); }
__device__ __forceinline__ void moe_sched_init(pg8::MoeSched& S, const Ctx& C, unsigned* gcnt, int pass, int nN) {
    S.n0 = moe_cnt(gcnt, 0); S.n1 = moe_cnt(gcnt, 1); S.n2 = moe_cnt(gcnt, 2); S.n3 = moe_cnt(gcnt, 3); S.n4 = moe_cnt(gcnt, 4); S.n5 = moe_cnt(gcnt, 5); S.n6 = moe_cnt(gcnt, 6); S.n7 = moe_cnt(gcnt, 7);
    S.m1 = (S.n0 + 255) >> 8; S.m2 = S.m1 + ((S.n1 + 255) >> 8); S.m3 = S.m2 + ((S.n2 + 255) >> 8); S.m4 = S.m3 + ((S.n3 + 255) >> 8);
    S.m5 = S.m4 + ((S.n4 + 255) >> 8); S.m6 = S.m5 + ((S.n5 + 255) >> 8); S.m7 = S.m6 + ((S.n6 + 255) >> 8);
    const int total = S.m7 + ((S.n7 + 255) >> 8);
    S.t0 = pass * MOE_CH; int nM = total - S.t0; nM = nM < 0 ? 0 : (nM > MOE_CH ? MOE_CH : nM);
    S.nM = nM; S.nN = nN; S.G = C.G; S.c = (int)blockIdx.x;
}
__device__ __forceinline__ bool relaunder(Ctx& C) { int t = threadIdx.x; asm volatile("" : "+v"(t)); C.tid = t; C.lane = t & 63; return true; }
constexpr int N_PHASES = 1 + 2 * (8 + 13) + 1;

__global__ void __launch_bounds__(NWAVES * 64, 2) fwd(Args args) {
    extern __shared__ __attribute__((aligned(16))) unsigned char lds_raw[];
    Ctx C;
    C.lds = (LAS unsigned char*)lds_raw;
    C.tid = threadIdx.x; C.lane = C.tid & 63; C.wave = __builtin_amdgcn_readfirstlane(C.tid >> 6);
    C.G = gridDim.x; { const int bx = blockIdx.x; C.vcu = (C.G % 8 == 0) ? (bx % 8) * (C.G / 8) + bx / 8 : bx; }
    C.gw = C.vcu * NWAVES + C.wave; C.NGW = C.G * NWAVES;
    C.ws = args.ws; C.H32 = (float*)(args.ws + WS_H32); C.XN = (bf16*)(args.ws + WS_XN); C.Y1 = (bf16*)(args.ws + WS_Y1); C.RSTD = (float*)(args.ws + WS_RSTD);
    C.ctl = (unsigned*)(args.ws + WS_CTL);
    LAS unsigned* idxbuf = (LAS unsigned*)(C.lds + IDX_OFF);
    volatile LAS unsigned* MISC = (volatile LAS unsigned*)(C.lds + MISC_OFF);
    for (int u = C.tid; u < (LDS_BYTES - IDX_OFF) / 4; u += NWAVES * 64) ((LAS unsigned*)(C.lds + IDX_OFF))[u] = 0u;
    __syncthreads();
    const int lo = args.ph_lo, hi = args.ph_hi;
    XcdBarrier bar; bar.bar = C.ctl + CW_BAR; bar.x = 0; bar.st = nullptr;
    if (hi - lo > 1) bar = xcd_barrier_post(C.ctl + CW_BAR, MISC + 8);
    int ph = 0;
#define RUN() (ph >= lo && ph < hi && relaunder(C))
#define SEAM() do { if (ph >= lo && ph + 1 < hi) xcd_barrier(bar); ++ph; } while (0)
    bf16* const INTER = (bf16*)(args.ws + WS_INTER);

    if (RUN()) { convert_small_weights(C, args); convert_moe_layer(C, args, 0); phase_copy_in(C, args.in[0], args.in[1]); }
    SEAM();

    for (int lp = 0; lp < 2; ++lp) {
        const bool addy1 = lp > 0;
        if (RUN()) { phase_pool_stats(C, addy1); if (lp == 1) convert_moe_layer(C, args, 1); }
        SEAM();
        if (RUN()) phase_pool_diff(C, args.in[2] + lp * D, addy1);
        SEAM();
        if (RUN()) {
            pg8::DenseSched S; S.nM = MT_ALL; S.nN = 4; S.G = C.G; S.c = (int)blockIdx.x; S.A = (const char*)C.XN; S.Bt = (const char*)(args.ws + WS_WPOOL + (size_t)lp * 524288);
            S.tstepA = (size_t)256 * D * 2; S.tstepB = (size_t)256 * 256 * 2; S.a_colstep = 512;
            pg8::EpiResid E{C.H32, addy1 ? C.Y1 : nullptr, args.in[4] + lp * D, 0};
            pg8::gemm_phase<pg8::EpiResid, pg8::DenseSched, false>(C.lds, idxbuf, 256, D, 256, S, E);
        }
        SEAM();
        if (RUN()) phase_norm(C, args.in[5] + lp * D, false);
        SEAM();
        for (int hf = 0; hf < 2; ++hf) {
            const int pm0 = hf ? DENSE_H0 : 0, nM = hf ? (MT_ALL - DENSE_H0) : DENSE_H0;
            if (RUN()) {
                pg8::DenseSched S; S.nM = nM; S.nN = FF / 128; S.G = C.G; S.c = (int)blockIdx.x; S.A = (const char*)(C.XN + (size_t)pm0 * 256 * D); S.Bt = (const char*)(args.ws + WS_WGU + (size_t)lp * GU_BYTES);
                S.tstepA = (size_t)256 * D * 2; S.tstepB = (size_t)256 * D * 2; S.a_colstep = 0;
                pg8::EpiSwiGLU E{INTER, FF};
                pg8::gemm_phase<pg8::EpiSwiGLU, pg8::DenseSched, false>(C.lds, idxbuf, D, D, D, S, E);
            }
            SEAM();
            if (RUN()) {
                pg8::DenseSched S; S.nM = nM; S.nN = 4; S.G = C.G; S.c = (int)blockIdx.x; S.A = (const char*)INTER; S.Bt = (const char*)(args.ws + WS_WDN + (size_t)lp * DN_BYTES);
                S.tstepA = (size_t)256 * FF * 2; S.tstepB = (size_t)256 * FF * 2; S.a_colstep = 0;
                pg8::EpiResid E{C.H32, nullptr, nullptr, pm0 * 256};
                pg8::gemm_phase<pg8::EpiResid, pg8::DenseSched, false>(C.lds, idxbuf, FF, FF, FF, S, E);
            }
            SEAM();
        }
        if (RUN()) phase_norm(C, args.in[9] + lp * D, false);
        SEAM();
        bf16* const BG = INTER; bf16* const UU = INTER + (size_t)RPAD * D;
        if (RUN()) {
            pg8::DenseSched S; S.nM = MT_ALL; S.nN = 12; S.G = C.G; S.c = (int)blockIdx.x; S.A = (const char*)C.XN; S.Bt = (const char*)(args.ws + WS_WIN + (size_t)lp * 3 * D * D * 2);
            S.tstepA = (size_t)256 * D * 2; S.tstepB = (size_t)256 * D * 2; S.a_colstep = 0;
            pg8::EpiConvIn E{BG, UU};
            pg8::gemm_phase<pg8::EpiConvIn, pg8::DenseSched, false>(C.lds, idxbuf, D, D, D, S, E);
        }
        SEAM();
        if (RUN()) phase_conv(C, args.in[11] + lp * 3 * D, BG, UU, C.XN);
        SEAM();
        if (RUN()) {
            pg8::DenseSched S; S.nM = MT_ALL; S.nN = 4; S.G = C.G; S.c = (int)blockIdx.x; S.A = (const char*)C.XN; S.Bt = (const char*)(args.ws + WS_WOUT + (size_t)lp * D * D * 2);
            S.tstepA = (size_t)256 * D * 2; S.tstepB = (size_t)256 * D * 2; S.a_colstep = 0;
            pg8::EpiResid E{C.H32, nullptr, nullptr, 0};
            pg8::gemm_phase<pg8::EpiResid, pg8::DenseSched, false>(C.lds, idxbuf, D, D, D, S, E);
        }
        SEAM();
        unsigned* const gcnt = C.ctl + CW_MOECNT + lp * 8 * 64;
        if (RUN()) phase_router(C, args.in[13] + lp * D, args.in[14] + (size_t)lp * D * NE, gcnt);
        SEAM();
        for (int pass = 0; pass < MOE_PASSES; ++pass) {
            if (RUN()) {
                pg8::MoeSched S; moe_sched_init(S, C, gcnt, pass, FF / 128);
                S.A = (const char*)C.XN; S.tstepA = 0; S.Bt = (const char*)(args.ws + WS_WMGU); S.estepB = GU_BYTES; S.tstepB = (size_t)256 * D * 2; S.rowidx = (const unsigned*)(args.ws + WS_ROWIDX);
                pg8::EpiSwiGLU E{INTER, FF};
                pg8::gemm_phase<pg8::EpiSwiGLU, pg8::MoeSched, true>(C.lds, idxbuf, D, D, D, S, E);
            }
            SEAM();
            if (RUN()) {
                pg8::MoeSched S; moe_sched_init(S, C, gcnt, pass, 4);
                S.A = (const char*)INTER; S.tstepA = (size_t)256 * FF * 2; S.Bt = (const char*)(args.ws + WS_WMDN); S.estepB = DN_BYTES; S.tstepB = (size_t)256 * FF * 2; S.rowidx = nullptr;
                pg8::EpiMoeDown E{(const int2*)(args.ws + WS_SLOT), C.H32, C.Y1};
                pg8::gemm_phase<pg8::EpiMoeDown, pg8::MoeSched, false>(C.lds, idxbuf, FF, FF, FF, S, E);
            }
            SEAM();
        }
    }
    if (RUN()) phase_final(C, args.in[18], args.out);
    SEAM();
#undef RUN
#undef SEAM
}

extern "C" void kernel_launch(void* const* d_in, const int* in_sizes, int n_in, void* d_out, int out_size, void* d_ws, size_t ws_size, hipStream_t stream) {
    static int grid = 0;
    if (grid == 0) {
        if (n_in != 19 || in_sizes[0] != MROWS * D || out_size != MROWS * D || ws_size < WS_END) {
            fprintf(stderr, "kernel_launch: unexpected problem (n_in %d, in0 %d, out %d, ws %zu < %zu); nothing launched\n", n_in, n_in > 0 ? in_sizes[0] : -1, out_size, ws_size, (size_t)WS_END); grid = -1; return; }
        int dev = 0, cus = 0, per_cu = 0;
        if (hipGetDevice(&dev) != hipSuccess || hipDeviceGetAttribute(&cus, hipDeviceAttributeMultiprocessorCount, dev) != hipSuccess) { grid = -1; return; }
        if (hipFuncSetAttribute((const void*)fwd, hipFuncAttributeMaxDynamicSharedMemorySize, LDS_BYTES) != hipSuccess) { fprintf(stderr, "kernel_launch: hipFuncSetAttribute failed\n"); grid = -1; return; }
        if (hipOccupancyMaxActiveBlocksPerMultiprocessor(&per_cu, (const void*)fwd, NWAVES * 64, LDS_BYTES) != hipSuccess || per_cu < 1)
            fprintf(stderr, "kernel_launch: occupancy query reports %d workgroups per CU\n", per_cu);
        (void)hipGetLastError();
        grid = cus;
    }
    if (grid < 0) return;
    if (hipMemsetAsync((char*)d_ws + WS_CTL, 0, CTL_ZERO_BYTES, stream) != hipSuccess) { fprintf(stderr, "kernel_launch: memset failed\n"); return; }
    Args a{};
    for (int i = 0; i < 19; ++i) a.in[i] = (const float*)d_in[i];
    a.out = (float*)d_out; a.ws = (unsigned char*)d_ws;
#if MK_ONE_LAUNCH
    a.ph_lo = 0; a.ph_hi = N_PHASES;
    hipLaunchKernelGGL(fwd, dim3(grid), dim3(NWAVES * 64), LDS_BYTES, stream, a);
#else
    for (int p = 0; p < N_PHASES; ++p) { a.ph_lo = p; a.ph_hi = p + 1; hipLaunchKernelGGL(fwd, dim3(grid), dim3(NWAVES * 64), LDS_BYTES, stream, a); }
#endif
    const hipError_t le = hipPeekAtLastError();
    if (le != hipSuccess) fprintf(stderr, "kernel_launch: launch failed: %s\n", hipGetErrorName(le));
}
```

```cpp
#include <hip/hip_runtime.h>
#include <cstdio>
#include <cstdint>

#ifndef MK_ONE_LAUNCH
#define MK_ONE_LAUNCH 1
#endif

constexpr int D = 1024, FF = 3584, NE = 8, NB = 32, TS = 2048, NMETA = 16;
constexpr int MROWS = NB * TS;
constexpr int RTOT = MROWS + NMETA;
constexpr int MT_ALL = 257;
constexpr int RPAD = MT_ALL * 256;
constexpr int CAP = RPAD;
constexpr float EPS = 1e-6f;
constexpr int NWAVES = 8;
constexpr int MOE_CH = 132, MOE_PASSES = 4;
constexpr int DENSE_H0 = 128;

constexpr size_t MiB = 1u << 20;
constexpr size_t WS_CTL = 0, CTL_ZERO_BYTES = 1 * MiB;
constexpr size_t WS_WPOOL = 1 * MiB;
constexpr size_t WS_WGU = 2 * MiB;
constexpr size_t WS_WDN = 30 * MiB;
constexpr size_t WS_WIN = 44 * MiB;
constexpr size_t WS_WOUT = 56 * MiB;
constexpr size_t WS_WMGU = 60 * MiB;
constexpr size_t WS_WMDN = 172 * MiB;
constexpr size_t WS_ROWIDX = 228 * MiB;
constexpr size_t WS_SLOT = 231 * MiB;
constexpr size_t WS_RSTD = 236 * MiB;
constexpr size_t WS_H32 = 237 * MiB;
constexpr size_t WS_XN = 494 * MiB;
constexpr size_t WS_Y1 = 623 * MiB;
constexpr size_t WS_INTER = 752 * MiB;
constexpr size_t WS_END = 1009 * MiB;
constexpr size_t GU_BYTES = (size_t)7168 * 1024 * 2, DN_BYTES = (size_t)1024 * 3584 * 2;
static_assert(WS_ROWIDX + (size_t)8 * CAP * 4 <= WS_SLOT && WS_SLOT + (size_t)8 * CAP * 8 <= WS_RSTD, "lists");
static_assert(WS_H32 + (size_t)RPAD * D * 4 <= WS_XN && WS_XN + (size_t)RPAD * D * 2 <= WS_Y1 && WS_Y1 + (size_t)RPAD * D * 2 <= WS_INTER, "act map");
static_assert((size_t)MOE_CH * 256 * FF * 2 <= WS_END - WS_INTER && (size_t)129 * 256 * FF * 2 <= WS_END - WS_INTER && (size_t)2 * RPAD * D * 2 <= WS_END - WS_INTER, "inter");
constexpr int CW_BAR = 4096;
constexpr int CW_MOECNT = 16384;

constexpr int RING_BYTES = 131072;
constexpr int IDX_OFF = RING_BYTES;
constexpr int MISC_OFF = IDX_OFF + 2048;
constexpr int LDS_BYTES = 147456;

#define GAS __attribute__((address_space(1)))
#define LAS __attribute__((address_space(3)))
typedef unsigned short bf16;
typedef float f32x4 __attribute__((ext_vector_type(4)));
typedef unsigned v4u __attribute__((ext_vector_type(4)));
typedef unsigned v2u __attribute__((ext_vector_type(2)));
#define LDS_WAIT() asm volatile("s_waitcnt lgkmcnt(0)" ::: "memory")
#define VM_WAIT() asm volatile("s_waitcnt vmcnt(0)" ::: "memory")

__device__ __forceinline__ unsigned cvt_pk_bf16(float lo, float hi) { unsigned r; asm volatile("v_cvt_pk_bf16_f32 %0, %1, %2" : "=v"(r) : "v"(lo), "v"(hi)); return r; }
__device__ __forceinline__ float bf_lo(unsigned w) { return __uint_as_float(w << 16); }
__device__ __forceinline__ float bf_hi(unsigned w) { return __uint_as_float(w & 0xffff0000u); }
__device__ __forceinline__ float wave_sum(float v) {
#pragma unroll
    for (int o = 1; o < 64; o <<= 1) v += __shfl_xor(v, o);
    return v;
}
__device__ __forceinline__ float silu_f(float a) { return a * __builtin_amdgcn_rcpf(1.0f + __builtin_amdgcn_exp2f(a * -1.44269504f)); }

#define XB_TMO      128
#define XB_XCNT(j)  (256  + 64 * (j))
#define XB_XSUB(j)  (1280 + 64 * (j))
#define XB_XGEN(j)  (2304 + 64 * (j))
#define XB_TOP      3328
#define XB_TOPGEN   3392
#define XCD_BAR_WORDS 3456
#define XB_SPIN_CAP (1u << 18)
__device__ __forceinline__ unsigned xb_ld(unsigned* p)              { return __hip_atomic_load(p, __ATOMIC_RELAXED, __HIP_MEMORY_SCOPE_AGENT); }
__device__ __forceinline__ unsigned xb_add(unsigned* p, unsigned v) { return __hip_atomic_fetch_add(p, v, __ATOMIC_RELAXED, __HIP_MEMORY_SCOPE_AGENT); }
__device__ __forceinline__ unsigned xb_xcc_id() { return (unsigned)__builtin_amdgcn_s_getreg((3 << 11) | 20) & 0xFu; }
#define XB_SPIN(cond, bar) do { unsigned _sp = 0; while (cond) { __builtin_amdgcn_s_sleep(1); \
    if ((++_sp & 255u) == 0u) { if (xb_ld(&(bar)[XB_TMO])) break; if (_sp > XB_SPIN_CAP) { atomicAdd(&(bar)[XB_TMO], 1u); break; } } } } while (0)
struct XcdBarrier { unsigned* bar; unsigned x; volatile LAS unsigned* st; };
__device__ __forceinline__ XcdBarrier xcd_barrier_post(unsigned* bar, volatile LAS unsigned* st) {
    XcdBarrier b; b.bar = bar; b.x = xb_xcc_id(); b.st = st;
    if (threadIdx.x == 0) (void)xb_add(&bar[XB_XCNT(b.x)], 1u);
    return b;
}
__device__ __forceinline__ void xcd_barrier_complete(unsigned* bar, unsigned x, unsigned& nloc, unsigned& nx) {
    const unsigned G = gridDim.x * gridDim.y * gridDim.z;
    unsigned sum, cnt, mine, sp = 0u;
    for (;;) {
        sum = 0u; cnt = 0u; mine = 0u;
#pragma unroll
        for (unsigned j = 0; j < 16; ++j) { const unsigned c = xb_ld(&bar[XB_XCNT(j)]); sum += c; cnt += (c > 0u) ? 1u : 0u; mine = (j == x) ? c : mine; }
        if (sum == G) break;
        __builtin_amdgcn_s_sleep(1);
        if ((++sp & 255u) == 0u) { if (xb_ld(&bar[XB_TMO])) break; if (sp > XB_SPIN_CAP) { atomicAdd(&bar[XB_TMO], 1u); break; } }
    }
    nloc = mine > 0u ? mine : 1u; nx = cnt > 0u ? cnt : 1u;
}
__device__ __forceinline__ void xcd_barrier(const XcdBarrier& b) {
    asm volatile("s_waitcnt vmcnt(0)" ::: "memory");
    __syncthreads();
    if (threadIdx.x == 0) {
        unsigned* bar = b.bar;
        __builtin_amdgcn_s_waitcnt(0);
        unsigned nloc = b.st[0], nx = b.st[1];
        if (nloc == 0u) { xcd_barrier_complete(bar, b.x, nloc, nx); b.st[0] = nloc; b.st[1] = nx; }
        const unsigned old = xb_add(&bar[XB_XSUB(b.x)], 1u);
        const unsigned gen = old / nloc;
        if (old + 1u == (gen + 1u) * nloc) {
            __builtin_amdgcn_fence(__ATOMIC_RELEASE, "agent");
            asm volatile("s_waitcnt vmcnt(0)" ::: "memory");
            const unsigned og = xb_add(&bar[XB_TOP], 1u);
            const unsigned tg = og / nx;
            if (og + 1u == (tg + 1u) * nx) xb_add(&bar[XB_TOPGEN], 1u);
            else XB_SPIN(xb_ld(&bar[XB_TOPGEN]) == tg, bar);
            __builtin_amdgcn_fence(__ATOMIC_ACQUIRE, "agent");
            xb_add(&bar[XB_XGEN(b.x)], 1u);
            asm volatile("s_waitcnt vmcnt(0)" ::: "memory");
        } else {
            XB_SPIN(xb_ld(&bar[XB_XGEN(b.x)]) == gen, bar);
            __builtin_amdgcn_fence(__ATOMIC_ACQUIRE, "agent");
            asm volatile("s_waitcnt vmcnt(0)" ::: "memory");
        }
    }
    __syncthreads();
}

namespace pg8 {
typedef short bf16x8 __attribute__((ext_vector_type(8)));
constexpr int BM = 256, BK = 64, HALF = 128, HTB = HALF * BK * 2, STAGE_BYTES = 8 * HTB;
static_assert(STAGE_BYTES == RING_BYTES, "ring");
__host__ __device__ __forceinline__ int lds_byte(int r, int c) { const int st = (r >> 4) * 2 + (c >> 5), rr = r & 15, cc = c & 31, ob = rr * 64 + cc * 2; return st * 1024 + (ob ^ (((ob >> 9) & 1) << 5)); }
__host__ __device__ __forceinline__ void stage_rc(int b, int& R, int& C) { const int st = b / 1024, sb = b % 1024, swz = sb ^ (((sb >> 9) & 1) << 5); R = (st >> 1) * 16 + swz / 64; C = (st & 1) * 32 + (swz % 64) / 2; }
__host__ __device__ __forceinline__ int perm32(int rho) { const int n = rho >> 4, i = rho & 15; return 8 * (i >> 2) + 4 * n + (i & 3); }

struct Unit { int pm, pn, e, rows, slot0; };

__device__ __forceinline__ bool static_tile(int i, int G, int c, int nM, int nN, int& pm, int& pn) {
    const int nwg = nM * nN; const long L = (long)i * G + c; if (L >= nwg) return false;
    int wgid = (int)L; { const int q = nwg / 8, r = nwg % 8, xcd = wgid % 8, off = wgid / 8; wgid = (xcd < r ? xcd * (q + 1) : r * (q + 1) + (xcd - r) * q) + off; }
    const int nig = 8 * nN, gid = wgid / nig, fm = gid * 8, gsz = (nM - fm) < 8 ? (nM - fm) : 8;
    pm = fm + ((wgid % nig) % gsz); pn = (wgid % nig) / gsz; return true;
}
struct DenseSched {
    int nM, nN, G, c; const char* A; const char* Bt; size_t tstepA, tstepB, a_colstep;
    __device__ __forceinline__ bool next(int i, Unit& u) const { if (!static_tile(i, G, c, nM, nN, u.pm, u.pn)) return false; u.e = 0; u.rows = 256; u.slot0 = 0; return true; }
    __device__ __forceinline__ const char* a_base(const Unit& u) const { return A + (size_t)u.pm * tstepA + (size_t)u.pn * a_colstep; }
    __device__ __forceinline__ const char* b_base(const Unit& u) const { return Bt + (size_t)u.pn * tstepB; }
    __device__ __forceinline__ const unsigned* idx_src(const Unit&) const { return nullptr; }
};
struct MoeSched {
    int nM, nN, G, c, t0; int m1, m2, m3, m4, m5, m6, m7; int n0, n1, n2, n3, n4, n5, n6, n7;
    const char* A; size_t tstepA; const char* Bt; size_t estepB, tstepB; const unsigned* rowidx;
    __device__ __forceinline__ bool next(int i, Unit& u) const {
        if (!static_tile(i, G, c, nM, nN, u.pm, u.pn)) return false;
        const int tg = t0 + u.pm; int e = 0, base = 0, cn = __builtin_amdgcn_readfirstlane(n0);
        if (tg >= m1) { e = 1; base = m1; cn = __builtin_amdgcn_readfirstlane(n1); }
        if (tg >= m2) { e = 2; base = m2; cn = __builtin_amdgcn_readfirstlane(n2); }
        if (tg >= m3) { e = 3; base = m3; cn = __builtin_amdgcn_readfirstlane(n3); }
        if (tg >= m4) { e = 4; base = m4; cn = __builtin_amdgcn_readfirstlane(n4); }
        if (tg >= m5) { e = 5; base = m5; cn = __builtin_amdgcn_readfirstlane(n5); }
        if (tg >= m6) { e = 6; base = m6; cn = __builtin_amdgcn_readfirstlane(n6); }
        if (tg >= m7) { e = 7; base = m7; cn = __builtin_amdgcn_readfirstlane(n7); }
        const int ti = tg - base; const int rem = cn - 256 * ti;
        u.e = e; u.rows = rem < 256 ? rem : 256; u.slot0 = e * CAP + ti * 256; return true;
    }
    __device__ __forceinline__ const char* a_base(const Unit& u) const { return A + (size_t)u.pm * tstepA; }
    __device__ __forceinline__ const char* b_base(const Unit& u) const { return Bt + (size_t)u.e * estepB + (size_t)u.pn * tstepB; }
    __device__ __forceinline__ const unsigned* idx_src(const Unit& u) const { return rowidx + u.slot0; }
};

struct EpiSwiGLU {
    static constexpr bool PERM = true;
    bf16* H; int ldh;
    __device__ __forceinline__ void operator()(const f32x4 (&acc)[2][2][4][2], const Unit& u, int wr, int wc, int fr, int fq) const {
        const int row0 = u.pm * BM + wr * 64 + fr, col0 = u.pn * 128 + wc * 32 + 8 * fq;
#pragma unroll
        for (int ai = 0; ai < 2; ++ai)
#pragma unroll
            for (int m = 0; m < 4; ++m) { bf16* p = H + (size_t)(row0 + ai * HALF + m * 16) * ldh + col0;
                const f32x4 g0 = acc[ai][0][m][0], g1 = acc[ai][0][m][1], u0 = acc[ai][1][m][0], u1 = acc[ai][1][m][1];
                v4u w; w.x = cvt_pk_bf16(silu_f(g0[0]) * u0[0], silu_f(g0[1]) * u0[1]); w.y = cvt_pk_bf16(silu_f(g0[2]) * u0[2], silu_f(g0[3]) * u0[3]);
                w.z = cvt_pk_bf16(silu_f(g1[0]) * u1[0], silu_f(g1[1]) * u1[1]); w.w = cvt_pk_bf16(silu_f(g1[2]) * u1[2], silu_f(g1[3]) * u1[3]);
                *(v4u*)p = w; }
    }
};
struct EpiResid {
    static constexpr bool PERM = false;
    float* h; const bf16* y1; const float* scale; int row_off;
    __device__ __forceinline__ void operator()(const f32x4 (&acc)[2][2][4][2], const Unit& u, int wr, int wc, int fr, int fq) const {
        const int row0 = row_off + u.pm * BM + wr * 64 + fr, col0 = u.pn * BM + wc * 32 + 4 * fq;
        f32x4 sc[2][2];
#pragma unroll
        for (int bj = 0; bj < 2; ++bj)
#pragma unroll
            for (int n = 0; n < 2; ++n) sc[bj][n] = scale ? *(const f32x4*)(scale + col0 + bj * HALF + n * 16) : (f32x4){1.f, 1.f, 1.f, 1.f};
#pragma unroll
        for (int ai = 0; ai < 2; ++ai)
#pragma unroll
            for (int m = 0; m < 4; ++m) { const size_t off = (size_t)(row0 + ai * HALF + m * 16) * D + col0;
#pragma unroll
                for (int bj = 0; bj < 2; ++bj)
#pragma unroll
                    for (int n = 0; n < 2; ++n) { f32x4 b = *(const f32x4*)(h + off + bj * HALF + n * 16);
                        if (y1) { const v2u y = *(const v2u*)(y1 + off + bj * HALF + n * 16); b += (f32x4){bf_lo(y.x), bf_hi(y.x), bf_lo(y.y), bf_hi(y.y)}; }
                        *(f32x4*)(h + off + bj * HALF + n * 16) = b + acc[ai][bj][m][n] * sc[bj][n]; }
                asm volatile("" ::: "memory"); }
    }
};
struct EpiConvIn {
    static constexpr bool PERM = true;
    bf16* BG; bf16* U;
    __device__ __forceinline__ void operator()(const f32x4 (&acc)[2][2][4][2], const Unit& u, int wr, int wc, int fr, int fq) const {
        const int row0 = u.pm * BM + wr * 64 + fr;
        if (u.pn < 4) {
            const int col0 = u.pn * BM + wc * 32 + 8 * fq;
#pragma unroll
            for (int ai = 0; ai < 2; ++ai)
#pragma unroll
                for (int m = 0; m < 4; ++m) { bf16* p = BG + (size_t)(row0 + ai * HALF + m * 16) * D + col0;
#pragma unroll
                    for (int bj = 0; bj < 2; ++bj) { const f32x4 v0 = acc[ai][bj][m][0], v1 = acc[ai][bj][m][1];
                        v4u w; w.x = cvt_pk_bf16(v0[0], v0[1]); w.y = cvt_pk_bf16(v0[2], v0[3]); w.z = cvt_pk_bf16(v1[0], v1[1]); w.w = cvt_pk_bf16(v1[2], v1[3]);
                        *(v4u*)(p + bj * HALF) = w; } }
        } else {
            const int col0 = (u.pn - 4) * 128 + wc * 32 + 8 * fq;
#pragma unroll
            for (int ai = 0; ai < 2; ++ai)
#pragma unroll
                for (int m = 0; m < 4; ++m) { bf16* p = U + (size_t)(row0 + ai * HALF + m * 16) * D + col0;
                    const f32x4 c0 = acc[ai][0][m][0], c1 = acc[ai][0][m][1], v0 = acc[ai][1][m][0], v1 = acc[ai][1][m][1];
                    v4u w; w.x = cvt_pk_bf16(c0[0] * v0[0], c0[1] * v0[1]); w.y = cvt_pk_bf16(c0[2] * v0[2], c0[3] * v0[3]);
                    w.z = cvt_pk_bf16(c1[0] * v1[0], c1[1] * v1[1]); w.w = cvt_pk_bf16(c1[2] * v1[2], c1[3] * v1[3]);
                    *(v4u*)p = w; }
        }
    }
};
struct EpiMoeDown {
    static constexpr bool PERM = false;
    const int2* slot; float* h; bf16* y1;
    __device__ __forceinline__ void operator()(const f32x4 (&acc)[2][2][4][2], const Unit& u, int wr, int wc, int fr, int fq) const {
        const int col0 = u.pn * BM + wc * 32 + 4 * fq;
#pragma unroll
        for (int ai = 0; ai < 2; ++ai)
#pragma unroll
            for (int m = 0; m < 4; ++m) { const int rl = ai * HALF + wr * 64 + m * 16 + fr;
                if (rl < u.rows) {
                    const int2 inf = slot[u.slot0 + rl]; const int tok = inf.x & 0x7fffffff; const float w = __int_as_float(inf.y);
                    const size_t off = (size_t)tok * D + col0;
                    if (inf.x >= 0) {
#pragma unroll
                        for (int bj = 0; bj < 2; ++bj)
#pragma unroll
                            for (int n = 0; n < 2; ++n) { const f32x4 b = *(const f32x4*)(h + off + bj * HALF + n * 16); *(f32x4*)(h + off + bj * HALF + n * 16) = b + acc[ai][bj][m][n] * w; }
                    } else {
#pragma unroll
                        for (int bj = 0; bj < 2; ++bj)
#pragma unroll
                            for (int n = 0; n < 2; ++n) { const f32x4 v = acc[ai][bj][m][n] * w; v2u o; o.x = cvt_pk_bf16(v[0], v[1]); o.y = cvt_pk_bf16(v[2], v[3]); *(v2u*)(y1 + off + bj * HALF + n * 16) = o; }
                    }
                }
                asm volatile("" ::: "memory"); }
    }
};

template <class Epi, class Sched, bool GATHER>
__device__ __forceinline__ void gemm_phase(LAS unsigned char* lds, LAS unsigned* idxbuf, const int K, const int lda, const int ldb, const Sched& S, const Epi& E) {
    int tid_ = threadIdx.x; asm volatile("" : "+v"(tid_));
    const int tid = tid_, wid = __builtin_amdgcn_readfirstlane(tid >> 6), lane = tid & 63, wr = wid >> 2, wc = wid & 3, fr = lane & 15, fq = lane >> 4;
    const int nt = K / BK;
    unsigned voffA[2], voffB[2], voffG[2][2];
#pragma unroll
    for (int i = 0; i < 2; ++i) { int R, C; stage_rc(tid * 16 + i * 8192, R, C); const int Rb = Epi::PERM ? ((R & ~31) + perm32(R & 31)) : R;
        voffA[i] = (unsigned)(R * lda + C) * 2u; voffB[i] = (unsigned)(Rb * ldb + C) * 2u; voffG[0][i] = 0u; voffG[1][i] = 0u; }
    const size_t kstep = (size_t)(BK * 2);
    const size_t hstepA = (size_t)HALF * lda * 2, hstepB = (size_t)HALF * ldb * 2;
    const unsigned ldsw = (unsigned)wid * 1024u;
    const int aoff = lds_byte(wr * 64 + fr, fq * 8), boff = lds_byte(wc * 32 + fr, fq * 8);
#define PG8_SA(b, h) (((b) * 2 + (h)) * HTB)
#define PG8_SB(b, h) ((4 + (b) * 2 + (h)) * HTB)
#define PG8_STAGE(bufoff, gbase, voff) do { _Pragma("unroll") for (int _i = 0; _i < 2; ++_i) \
        __builtin_amdgcn_global_load_lds((const unsigned*)((const char*)(gbase) + (voff)[_i]), (LAS unsigned*)(lds + (bufoff) + ldsw + _i * 8192), 16, 0, 0); } while (0)
#define PG8_STAGE_A(bufoff, gbase, h) do { if constexpr (GATHER) { PG8_STAGE(bufoff, gbase, voffG[h]); } else { PG8_STAGE(bufoff, (gbase) + (h) * hstepA, voffA); } } while (0)
#define PG8_STAGE_B(bufoff, gbase, h) PG8_STAGE(bufoff, (gbase) + (h) * hstepB, voffB)
#define PG8_LDA(dst, b, h) do { _Pragma("unroll") for (int m = 0; m < 4; ++m) _Pragma("unroll") for (int k = 0; k < 2; ++k) dst[m][k] = *(const LAS bf16x8*)(lds + PG8_SA(b, h) + aoff + m * 2048 + k * 1024); } while (0)
#define PG8_LDB(dst, b, h) do { _Pragma("unroll") for (int n = 0; n < 2; ++n) _Pragma("unroll") for (int k = 0; k < 2; ++k) dst[n][k] = *(const LAS bf16x8*)(lds + PG8_SB(b, h) + boff + n * 2048 + k * 1024); } while (0)
#define PG8_MMA(ai, bj, At, Bt) do { __builtin_amdgcn_s_setprio(1); _Pragma("unroll") for (int m = 0; m < 4; ++m) _Pragma("unroll") for (int n = 0; n < 2; ++n) _Pragma("unroll") for (int k = 0; k < 2; ++k) \
        acc[ai][bj][m][n] = __builtin_amdgcn_mfma_f32_16x16x32_bf16(Bt[n][k], At[m][k], acc[ai][bj][m][n], 0, 0, 0); __builtin_amdgcn_s_setprio(0); } while (0)
#define PG8_WAIT_V(n) asm volatile("s_waitcnt vmcnt(" #n ")" ::: "memory")
#define PG8_WAIT_L(n) asm volatile("s_waitcnt lgkmcnt(" #n ")" ::: "memory")
#define PG8_BAR __builtin_amdgcn_s_barrier()
#define PG8_SCHED __builtin_amdgcn_sched_barrier(0)
#define PG8_LOAD_VOFFG(ib, nrows) do { asm volatile("" ::: "memory"); _Pragma("unroll") for (int _i = 0; _i < 2; ++_i) { int _R, _C; stage_rc(tid * 16 + _i * 8192, _R, _C); \
        _Pragma("unroll") for (int _h = 0; _h < 2; ++_h) { const int _rl = _h * HALF + _R; unsigned _ix = (ib)[_rl]; _ix = (_rl < (nrows)) ? _ix : 0u; voffG[_h][_i] = _ix * (unsigned)(lda * 2) + (unsigned)(_C * 2); } } } while (0)
#define PG8_IDX_DMA(src, ib) __builtin_amdgcn_global_load_lds((const unsigned*)((src) + lane * 4), (LAS unsigned*)(ib), 16, 0, 0)
    Unit cur, nxt; int ui = 0;
    if (!S.next(0, cur)) return;
    f32x4 acc[2][2][4][2];
#pragma unroll
    for (int a = 0; a < 2; ++a)
#pragma unroll
        for (int b = 0; b < 2; ++b)
#pragma unroll
            for (int m = 0; m < 4; ++m)
#pragma unroll
                for (int n = 0; n < 2; ++n) acc[a][b][m][n] = (f32x4){0.f, 0.f, 0.f, 0.f};
    bf16x8 At[4][2], B0[2][2], B1[2][2];
    const char* cA = S.a_base(cur); const char* cB = S.b_base(cur);
    if constexpr (GATHER) {
        if (wid == 0) PG8_IDX_DMA(S.idx_src(cur), idxbuf);
        PG8_WAIT_V(0); PG8_BAR;
        PG8_LOAD_VOFFG(idxbuf, cur.rows);
    }
    PG8_STAGE_B(PG8_SB(0, 0), cB, 0); PG8_STAGE_B(PG8_SB(0, 1), cB, 1); PG8_STAGE_A(PG8_SA(0, 0), cA, 0); PG8_STAGE_A(PG8_SA(0, 1), cA, 1);
    if (wr == 1) PG8_BAR;
    PG8_WAIT_V(2); PG8_BAR;
    PG8_STAGE_B(PG8_SB(1, 0), cB + kstep, 0); PG8_STAGE_A(PG8_SA(1, 0), cA + kstep, 0); PG8_STAGE_B(PG8_SB(1, 1), cB + kstep, 1);
    PG8_WAIT_V(6); PG8_BAR;
    for (;;) {
        const bool has_next = S.next(ui + 1, nxt);
        const char* nA = has_next ? S.a_base(nxt) : cA; const char* nB = has_next ? S.b_base(nxt) : cB;
        if constexpr (GATHER) { if (has_next && wid == 0) PG8_IDX_DMA(S.idx_src(nxt), idxbuf + ((ui + 1) & 1) * 256); }
        for (int t = 0; t < nt; t += 2) {
            const bool last = (t == nt - 2);
            const char* a1 = cA + (size_t)(t + 1) * kstep;
            const char* a2 = last ? nA : cA + (size_t)(t + 2) * kstep; const char* b2 = last ? nB : cB + (size_t)(t + 2) * kstep;
            const char* a3 = a2 + kstep; const char* b3 = b2 + kstep;
            PG8_LDB(B0, 0, 0); PG8_LDB(B1, 0, 1); PG8_SCHED; PG8_LDA(At, 0, 0); PG8_STAGE_A(PG8_SA(1, 1), a1, 1);
            PG8_WAIT_V(8); PG8_WAIT_L(0); PG8_BAR; PG8_MMA(0, 0, At, B0); PG8_MMA(0, 1, At, B1); PG8_BAR; PG8_SCHED;
            if constexpr (GATHER) { if (last && has_next) PG8_LOAD_VOFFG(idxbuf + ((ui + 1) & 1) * 256, nxt.rows); }
            PG8_LDA(At, 0, 1); PG8_STAGE_B(PG8_SB(0, 0), b2, 0); PG8_STAGE_B(PG8_SB(0, 1), b2, 1); PG8_STAGE_A(PG8_SA(0, 0), a2, 0);
            PG8_WAIT_V(8); PG8_WAIT_L(0); PG8_BAR; PG8_MMA(1, 0, At, B0); PG8_MMA(1, 1, At, B1); PG8_BAR; PG8_SCHED;
            PG8_LDB(B0, 1, 0); PG8_LDB(B1, 1, 1); PG8_SCHED; PG8_LDA(At, 1, 0); PG8_STAGE_A(PG8_SA(0, 1), a2, 1);
            PG8_WAIT_V(8); PG8_WAIT_L(0); PG8_BAR; PG8_MMA(0, 0, At, B0); PG8_MMA(0, 1, At, B1); PG8_BAR; PG8_SCHED;
            PG8_LDA(At, 1, 1); PG8_STAGE_B(PG8_SB(1, 0), b3, 0); PG8_STAGE_B(PG8_SB(1, 1), b3, 1); PG8_STAGE_A(PG8_SA(1, 0), a3, 0);
            PG8_WAIT_V(8); PG8_WAIT_L(0); PG8_BAR; PG8_MMA(1, 0, At, B0); PG8_MMA(1, 1, At, B1); PG8_BAR; PG8_SCHED;
        }
        if (wr == 0) PG8_BAR;
        E(acc, cur, wr, wc, fr, fq);
        if (!has_next) break;
#pragma unroll
        for (int a = 0; a < 2; ++a)
#pragma unroll
            for (int b = 0; b < 2; ++b)
#pragma unroll
                for (int m = 0; m < 4; ++m)
#pragma unroll
                    for (int n = 0; n < 2; ++n) acc[a][b][m][n] = (f32x4){0.f, 0.f, 0.f, 0.f};
        cur = nxt; cA = nA; cB = nB; ++ui;
        if (wr == 1) PG8_BAR;
    }
    PG8_WAIT_V(0);
    PG8_BAR;
#undef PG8_SA
#undef PG8_SB
#undef PG8_STAGE
#undef PG8_STAGE_A
#undef PG8_STAGE_B
#undef PG8_LDA
#undef PG8_LDB
#undef PG8_MMA
#undef PG8_WAIT_V
#undef PG8_WAIT_L
#undef PG8_BAR
#undef PG8_SCHED
#undef PG8_LOAD_VOFFG
#undef PG8_IDX_DMA
}
}

struct Args { const float* in[19]; float* out; unsigned char* ws; int ph_lo, ph_hi; };
struct Ctx {
    LAS unsigned char* lds; int tid, lane, wave, G, vcu, gw, NGW;
    unsigned char* ws; float* H32; bf16* XN; bf16* Y1; float* RSTD; unsigned* ctl;
};

__device__ __forceinline__ void tr_item(const float* W, int ldw, int k0, int n0, bf16* WT, int K, int drow0, LAS float* scr, int lane) {
#pragma unroll 8
    for (int i = 0; i < 32; ++i) { const int kk = 2 * i + (lane >> 5); scr[kk * 33 + (lane & 31)] = W[(size_t)(k0 + kk) * ldw + n0 + (lane & 31)]; }
    LDS_WAIT();
    const int c = lane & 7;
#pragma unroll
    for (int j = 0; j < 4; ++j) { const int n = (lane >> 3) + 8 * j; const LAS float* s = scr + (8 * c) * 33 + n;
        v4u o; o.x = cvt_pk_bf16(s[0 * 33], s[1 * 33]); o.y = cvt_pk_bf16(s[2 * 33], s[3 * 33]); o.z = cvt_pk_bf16(s[4 * 33], s[5 * 33]); o.w = cvt_pk_bf16(s[6 * 33], s[7 * 33]);
        *(v4u*)(WT + (size_t)(drow0 + n) * K + k0 + 8 * c) = o; }
    LDS_WAIT();
}
__device__ __forceinline__ void cv_gateup(const float* Wg, const float* Wu, bf16* dst, int item, LAS float* scr, int lane) {
    const int kind = item / 1792, r = item % 1792, kb = r / 112, nb = r % 112, n0 = 32 * nb;
    tr_item(kind ? Wu : Wg, FF, 64 * kb, n0, dst, D, (n0 >> 7) * 256 + (n0 & 127) + kind * 128, scr, lane);
}
__device__ __forceinline__ void cv_plain(const float* W, int K, int N, bf16* dst, int drow_off, int item, LAS float* scr, int lane) {
    const int nbn = N / 32, kb = item / nbn, nb = item % nbn;
    tr_item(W, N, 64 * kb, 32 * nb, dst, K, drow_off + 32 * nb, scr, lane);
}
__device__ __forceinline__ void cv_convin(const float* W, bf16* dst, int item, LAS float* scr, int lane) {
    const int kb = item / 96, nb = item % 96, n0 = 32 * nb; int dr;
    if (n0 < 1024) dr = n0; else if (n0 < 2048) dr = 1024 + ((n0 - 1024) >> 7) * 256 + (n0 & 127); else dr = 1024 + ((n0 - 2048) >> 7) * 256 + 128 + (n0 & 127);
    tr_item(W, 3 * D, 64 * kb, n0, dst, D, dr, scr, lane);
}
__device__ __forceinline__ void convert_moe_layer(Ctx& C, const Args& a, int j) {
    LAS float* scr = (LAS float*)(C.lds + C.wave * 16384);
    constexpr int PER_E = 3584 + 1792;
    for (int it = C.gw; it < NE * PER_E; it += C.NGW) {
        const int e = it / PER_E, r = it % PER_E; const size_t wo = ((size_t)j * NE + e) * D * FF;
        if (r < 3584) cv_gateup(a.in[15] + wo, a.in[16] + wo, (bf16*)(C.ws + WS_WMGU + (size_t)e * GU_BYTES), r, scr, C.lane);
        else cv_plain(a.in[17] + wo, FF, D, (bf16*)(C.ws + WS_WMDN + (size_t)e * DN_BYTES), 0, r - 3584, scr, C.lane);
    }
}
__device__ __forceinline__ void convert_small_weights(Ctx& C, const Args& a) {
    LAS float* scr = (LAS float*)(C.lds + C.wave * 16384);
    constexpr int I_POOL = 32, I_GU = 3584, I_DN = 1792, I_IN = 1536, I_OUT = 512;
    constexpr int PER_L = 4 * I_POOL + I_GU + I_DN + I_IN + I_OUT;
    for (int it = C.gw; it < 2 * PER_L; it += C.NGW) {
        const int l = it / PER_L; int r = it % PER_L;
        if (r < 4 * I_POOL) { const int g = r / I_POOL; cv_plain(a.in[3] + (size_t)(l * 4 + g) * 65536, 256, 256, (bf16*)(C.ws + WS_WPOOL + (size_t)l * 524288), g * 256, r % I_POOL, scr, C.lane); continue; } r -= 4 * I_POOL;
        if (r < I_GU) { cv_gateup(a.in[6] + (size_t)l * D * FF, a.in[7] + (size_t)l * D * FF, (bf16*)(C.ws + WS_WGU + (size_t)l * GU_BYTES), r, scr, C.lane); continue; } r -= I_GU;
        if (r < I_DN) { cv_plain(a.in[8] + (size_t)l * D * FF, FF, D, (bf16*)(C.ws + WS_WDN + (size_t)l * DN_BYTES), 0, r, scr, C.lane); continue; } r -= I_DN;
        if (r < I_IN) { cv_convin(a.in[10] + (size_t)l * D * 3 * D, (bf16*)(C.ws + WS_WIN + (size_t)l * 3 * D * D * 2), r, scr, C.lane); continue; } r -= I_IN;
        cv_plain(a.in[12] + (size_t)l * D * D, D, D, (bf16*)(C.ws + WS_WOUT + (size_t)l * D * D * 2), 0, r, scr, C.lane);
    }
}

__device__ __forceinline__ int prev_row(int row, int i) {
    if (row < MROWS) { const int tp = row & (TS - 1); return tp >= i ? row - i : MROWS + NMETA + tp - i; }
    return row - i;
}
__device__ __forceinline__ void load_heff(const Ctx& C, int row, bool addy1, f32x4 (&x)[4]) {
    const f32x4* p = (const f32x4*)(C.H32 + (size_t)row * D) + C.lane;
#pragma unroll
    for (int j = 0; j < 4; ++j) x[j] = p[64 * j];
    if (addy1) { const v2u* q = (const v2u*)(C.Y1 + (size_t)row * D) + C.lane;
#pragma unroll
        for (int j = 0; j < 4; ++j) { const v2u y = q[64 * j]; x[j] += (f32x4){bf_lo(y.x), bf_hi(y.x), bf_lo(y.y), bf_hi(y.y)}; } }
}
__device__ __forceinline__ float row_rstd(const f32x4 (&x)[4]) {
    float s = 0.f;
#pragma unroll
    for (int j = 0; j < 4; ++j) s += (x[j][0] * x[j][0] + x[j][1] * x[j][1]) + (x[j][2] * x[j][2] + x[j][3] * x[j][3]);
    return __frsqrt_rn(wave_sum(s) * (1.0f / D) + EPS);
}
__device__ __forceinline__ void store_bf16_row(bf16* dst, int row, int lane, const f32x4 (&v)[4]) {
    v2u* o = (v2u*)(dst + (size_t)row * D) + lane;
#pragma unroll
    for (int j = 0; j < 4; ++j) { v2u w; w.x = cvt_pk_bf16(v[j][0], v[j][1]); w.y = cvt_pk_bf16(v[j][2], v[j][3]); o[64 * j] = w; }
}
__device__ __forceinline__ void phase_norm(Ctx& C, const float* gain, bool addy1) {
    f32x4 g[4];
#pragma unroll
    for (int j = 0; j < 4; ++j) g[j] = ((const f32x4*)gain)[C.lane + 64 * j];
    for (int row = C.gw; row < RTOT; row += C.NGW) {
        f32x4 x[4]; load_heff(C, row, addy1, x); const float rs = row_rstd(x);
#pragma unroll
        for (int j = 0; j < 4; ++j) x[j] = x[j] * rs * g[j];
        store_bf16_row(C.XN, row, C.lane, x);
    }
}
__device__ __forceinline__ void phase_pool_stats(Ctx& C, bool addy1) {
    for (int row = C.gw; row < RTOT; row += C.NGW) { f32x4 x[4]; load_heff(C, row, addy1, x); const float rs = row_rstd(x); if (C.lane == 0) C.RSTD[row] = rs; }
}
__device__ __forceinline__ void phase_pool_diff(Ctx& C, const float* gain, bool addy1) {
    f32x4 g[4];
#pragma unroll
    for (int j = 0; j < 4; ++j) g[j] = ((const f32x4*)gain)[C.lane + 64 * j];
    for (int row = C.gw; row < RTOT; row += C.NGW) {
        const int pos = row >= MROWS ? row - MROWS : NMETA + (row & (TS - 1));
        f32x4 d[4];
#pragma unroll
        for (int j = 0; j < 4; ++j) {
            const int w = 2 << j; const int cnt = (pos + 1) < w ? (pos + 1) : w;
            f32x4 s = (f32x4){0.f, 0.f, 0.f, 0.f}, n0 = s;
            for (int i = 0; i < cnt; ++i) {
                const int pr = prev_row(row, i); const float rs = C.RSTD[pr];
                f32x4 v = ((const f32x4*)(C.H32 + (size_t)pr * D))[C.lane + 64 * j];
                if (addy1) { const v2u y = ((const v2u*)(C.Y1 + (size_t)pr * D))[C.lane + 64 * j]; v += (f32x4){bf_lo(y.x), bf_hi(y.x), bf_lo(y.y), bf_hi(y.y)}; }
                v = v * rs * g[j]; if (i == 0) n0 = v; s += v;
            }
            d[j] = s * (1.0f / (float)cnt) - n0;
        }
        store_bf16_row(C.XN, row, C.lane, d);
    }
}
__device__ __forceinline__ void phase_conv(Ctx& C, const float* ck, const bf16* BG, const bf16* U, bf16* Y) {
    float k[3][2][8];
#pragma unroll
    for (int t = 0; t < 3; ++t)
#pragma unroll
        for (int q = 0; q < 2; ++q) { const f32x4 a = *(const f32x4*)(ck + t * D + 8 * C.lane + 512 * q), b = *(const f32x4*)(ck + t * D + 8 * C.lane + 512 * q + 4);
            k[t][q][0] = a[0]; k[t][q][1] = a[1]; k[t][q][2] = a[2]; k[t][q][3] = a[3]; k[t][q][4] = b[0]; k[t][q][5] = b[1]; k[t][q][6] = b[2]; k[t][q][7] = b[3]; }
    for (int row = C.gw; row < RTOT; row += C.NGW) {
        const int pos = row >= MROWS ? row - MROWS : NMETA + (row & (TS - 1));
#pragma unroll
        for (int q = 0; q < 2; ++q) {
            const int co = 8 * C.lane + 512 * q;
            float s[8];
#pragma unroll
            for (int e = 0; e < 8; ++e) s[e] = 0.f;
#pragma unroll
            for (int t = 0; t < 3; ++t) {
                const int back = 2 - t;
                if (pos >= back) { const v4u uu = *(const v4u*)(U + (size_t)prev_row(row, back) * D + co);
                    s[0] += k[t][q][0] * bf_lo(uu.x); s[1] += k[t][q][1] * bf_hi(uu.x); s[2] += k[t][q][2] * bf_lo(uu.y); s[3] += k[t][q][3] * bf_hi(uu.y);
                    s[4] += k[t][q][4] * bf_lo(uu.z); s[5] += k[t][q][5] * bf_hi(uu.z); s[6] += k[t][q][6] * bf_lo(uu.w); s[7] += k[t][q][7] * bf_hi(uu.w); }
            }
            const v4u bb = *(const v4u*)(BG + (size_t)row * D + co);
            v4u o; o.x = cvt_pk_bf16(bf_lo(bb.x) * s[0], bf_hi(bb.x) * s[1]); o.y = cvt_pk_bf16(bf_lo(bb.y) * s[2], bf_hi(bb.y) * s[3]);
            o.z = cvt_pk_bf16(bf_lo(bb.z) * s[4], bf_hi(bb.z) * s[5]); o.w = cvt_pk_bf16(bf_lo(bb.w) * s[6], bf_hi(bb.w) * s[7]);
            *(v4u*)(Y + (size_t)row * D + co) = o;
        }
    }
}
__device__ __forceinline__ void phase_router(Ctx& C, const float* gain, const float* router, unsigned* gcnt  ) {
    LAS unsigned* lcnt = (LAS unsigned*)C.lds;
    LAS unsigned* lbase = lcnt + 8;
    LAS unsigned* ent = lcnt + 16;
    f32x4 g[4];
#pragma unroll
    for (int j = 0; j < 4; ++j) g[j] = ((const f32x4*)gain)[C.lane + 64 * j];
    unsigned* rowidx = (unsigned*)(C.ws + WS_ROWIDX); int2* slot = (int2*)(C.ws + WS_SLOT);
    const int nchunk = (RTOT + 255) / 256;
    for (int ch = blockIdx.x; ch < nchunk; ch += C.G) {
        const int r0 = ch * 256, nr = (RTOT - r0) < 256 ? (RTOT - r0) : 256;
        __syncthreads();
        if (C.tid < 16) lcnt[C.tid] = 0u;
        __syncthreads();
        for (int lr = C.wave; lr < nr; lr += NWAVES) {
            const int row = r0 + lr;
            f32x4 x[4]; load_heff(C, row, false, x); const float rs = row_rstd(x);
#pragma unroll
            for (int j = 0; j < 4; ++j) x[j] = x[j] * rs * g[j];
            store_bf16_row(C.XN, row, C.lane, x);
            float lg[8];
#pragma unroll
            for (int e = 0; e < 8; ++e) lg[e] = 0.f;
#pragma unroll
            for (int j = 0; j < 4; ++j)
#pragma unroll
                for (int i = 0; i < 4; ++i) { const f32x4* rp = (const f32x4*)(router + (size_t)(4 * C.lane + 256 * j + i) * NE); const f32x4 ra = rp[0], rb = rp[1]; const float xv = x[j][i];
                    lg[0] += xv * ra[0]; lg[1] += xv * ra[1]; lg[2] += xv * ra[2]; lg[3] += xv * ra[3]; lg[4] += xv * rb[0]; lg[5] += xv * rb[1]; lg[6] += xv * rb[2]; lg[7] += xv * rb[3]; }
#pragma unroll
            for (int e = 0; e < 8; ++e) lg[e] = wave_sum(lg[e]);
            int e1 = 0; float v1 = lg[0];
#pragma unroll
            for (int e = 1; e < 8; ++e) if (lg[e] > v1) { v1 = lg[e]; e1 = e; }
            int e2 = -1; float v2 = -3.0e38f;
#pragma unroll
            for (int e = 0; e < 8; ++e) if (e != e1 && lg[e] > v2) { v2 = lg[e]; e2 = e; }
            const float ex = __expf(v2 - v1), w1 = 1.0f / (1.0f + ex), w2 = ex * w1;
            if (C.lane == 0) {
                const unsigned k1 = atomicAdd((unsigned*)&lcnt[e1], 1u), k2 = atomicAdd((unsigned*)&lcnt[e2], 1u);
                ent[(lr * 2 + 0) * 2 + 0] = (unsigned)e1 | (k1 << 8); ent[(lr * 2 + 0) * 2 + 1] = __float_as_uint(w1);
                ent[(lr * 2 + 1) * 2 + 0] = (unsigned)e2 | (k2 << 8); ent[(lr * 2 + 1) * 2 + 1] = __float_as_uint(w2);
            }
        }
        __syncthreads();
        if (C.tid < 8) lbase[C.tid] = __hip_atomic_fetch_add(gcnt + 64 * C.tid, lcnt[C.tid], __ATOMIC_RELAXED, __HIP_MEMORY_SCOPE_AGENT);
        __syncthreads();
        for (int q = C.tid; q < nr * 2; q += NWAVES * 64) {
            const unsigned ek = ent[q * 2], wb = ent[q * 2 + 1]; const int e = ek & 255, rank = ek >> 8, row = r0 + (q >> 1), ch2 = q & 1;
            const int pos = e * CAP + (int)lbase[e] + rank;
            rowidx[pos] = (unsigned)row; slot[pos] = make_int2(row | (ch2 << 31), (int)wb);
        }
    }
    __syncthreads();
}
__device__ __forceinline__ void phase_final(Ctx& C, const float* gain, float* out) {
    f32x4 g[4];
#pragma unroll
    for (int j = 0; j < 4; ++j) g[j] = ((const f32x4*)gain)[C.lane + 64 * j];
    for (int row = C.gw; row < MROWS; row += C.NGW) {
        f32x4 x[4]; load_heff(C, row, true, x); const float rs = row_rstd(x);
        f32x4* o = (f32x4*)(out + (size_t)row * D) + C.lane;
#pragma unroll
        for (int j = 0; j < 4; ++j) o[64 * j] = x[j] * rs * g[j];
    }
}
__device__ __forceinline__ void phase_copy_in(Ctx& C, const float* x, const float* meta) {
    for (int row = C.gw; row < RTOT; row += C.NGW) {
        const f32x4* p = (const f32x4*)(row < MROWS ? x + (size_t)row * D : meta + (size_t)(row - MROWS) * D) + C.lane;
        f32x4* o = (f32x4*)(C.H32 + (size_t)row * D) + C.lane;
#pragma unroll
        for (int j = 0; j < 4; ++j) o[64 * j] = p[64 * j];
    }
}
__device__ __forceinline__ int moe_cnt(unsigned* gcnt, int e) { return __builtin_amdgcn_readfirstlane((int)__hip_atomic_load(gcnt + 64 * e, __ATOMIC_RELAXED, __HIP_MEMORY_SCOPE_AGENT)); }
__device__ __forceinline__ void moe_sched_init(pg8::MoeSched& S, const Ctx& C, unsigned* gcnt, int pass, int nN) {
    S.n0 = moe_cnt(gcnt, 0); S.n1 = moe_cnt(gcnt, 1); S.n2 = moe_cnt(gcnt, 2); S.n3 = moe_cnt(gcnt, 3); S.n4 = moe_cnt(gcnt, 4); S.n5 = moe_cnt(gcnt, 5); S.n6 = moe_cnt(gcnt, 6); S.n7 = moe_cnt(gcnt, 7);
    S.m1 = (S.n0 + 255) >> 8; S.m2 = S.m1 + ((S.n1 + 255) >> 8); S.m3 = S.m2 + ((S.n2 + 255) >> 8); S.m4 = S.m3 + ((S.n3 + 255) >> 8);
    S.m5 = S.m4 + ((S.n4 + 255) >> 8); S.m6 = S.m5 + ((S.n5 + 255) >> 8); S.m7 = S.m6 + ((S.n6 + 255) >> 8);
    const int total = S.m7 + ((S.n7 + 255) >> 8);
    S.t0 = pass * MOE_CH; int nM = total - S.t0; nM = nM < 0 ? 0 : (nM > MOE_CH ? MOE_CH : nM);
    S.nM = nM; S.nN = nN; S.G = C.G; S.c = (int)blockIdx.x;
}
__device__ __forceinline__ bool relaunder(Ctx& C) { int t = threadIdx.x; asm volatile("" : "+v"(t)); C.tid = t; C.lane = t & 63; return true; }
constexpr int N_PHASES = 1 + 2 * (8 + 13) + 1;

__global__ void __launch_bounds__(NWAVES * 64, 2) fwd(Args args) {
    extern __shared__ __attribute__((aligned(16))) unsigned char lds_raw[];
    Ctx C;
    C.lds = (LAS unsigned char*)lds_raw;
    C.tid = threadIdx.x; C.lane = C.tid & 63; C.wave = __builtin_amdgcn_readfirstlane(C.tid >> 6);
    C.G = gridDim.x; { const int bx = blockIdx.x; C.vcu = (C.G % 8 == 0) ? (bx % 8) * (C.G / 8) + bx / 8 : bx; }
    C.gw = C.vcu * NWAVES + C.wave; C.NGW = C.G * NWAVES;
    C.ws = args.ws; C.H32 = (float*)(args.ws + WS_H32); C.XN = (bf16*)(args.ws + WS_XN); C.Y1 = (bf16*)(args.ws + WS_Y1); C.RSTD = (float*)(args.ws + WS_RSTD);
    C.ctl = (unsigned*)(args.ws + WS_CTL);
    LAS unsigned* idxbuf = (LAS unsigned*)(C.lds + IDX_OFF);
    volatile LAS unsigned* MISC = (volatile LAS unsigned*)(C.lds + MISC_OFF);
    for (int u = C.tid; u < (LDS_BYTES - IDX_OFF) / 4; u += NWAVES * 64) ((LAS unsigned*)(C.lds + IDX_OFF))[u] = 0u;
    __syncthreads();
    const int lo = args.ph_lo, hi = args.ph_hi;
    XcdBarrier bar; bar.bar = C.ctl + CW_BAR; bar.x = 0; bar.st = nullptr;
    if (hi - lo > 1) bar = xcd_barrier_post(C.ctl + CW_BAR, MISC + 8);
    int ph = 0;
#define RUN() (ph >= lo && ph < hi && relaunder(C))
#define SEAM() do { if (ph >= lo && ph + 1 < hi) xcd_barrier(bar); ++ph; } while (0)
    bf16* const INTER = (bf16*)(args.ws + WS_INTER);

    if (RUN()) { convert_small_weights(C, args); convert_moe_layer(C, args, 0); phase_copy_in(C, args.in[0], args.in[1]); }
    SEAM();

    for (int lp = 0; lp < 2; ++lp) {
        const bool addy1 = lp > 0;
        if (RUN()) { phase_pool_stats(C, addy1); if (lp == 1) convert_moe_layer(C, args, 1); }
        SEAM();
        if (RUN()) phase_pool_diff(C, args.in[2] + lp * D, addy1);
        SEAM();
        if (RUN()) {
            pg8::DenseSched S; S.nM = MT_ALL; S.nN = 4; S.G = C.G; S.c = (int)blockIdx.x; S.A = (const char*)C.XN; S.Bt = (const char*)(args.ws + WS_WPOOL + (size_t)lp * 524288);
            S.tstepA = (size_t)256 * D * 2; S.tstepB = (size_t)256 * 256 * 2; S.a_colstep = 512;
            pg8::EpiResid E{C.H32, addy1 ? C.Y1 : nullptr, args.in[4] + lp * D, 0};
            pg8::gemm_phase<pg8::EpiResid, pg8::DenseSched, false>(C.lds, idxbuf, 256, D, 256, S, E);
        }
        SEAM();
        if (RUN()) phase_norm(C, args.in[5] + lp * D, false);
        SEAM();
        for (int hf = 0; hf < 2; ++hf) {
            const int pm0 = hf ? DENSE_H0 : 0, nM = hf ? (MT_ALL - DENSE_H0) : DENSE_H0;
            if (RUN()) {
                pg8::DenseSched S; S.nM = nM; S.nN = FF / 128; S.G = C.G; S.c = (int)blockIdx.x; S.A = (const char*)(C.XN + (size_t)pm0 * 256 * D); S.Bt = (const char*)(args.ws + WS_WGU + (size_t)lp * GU_BYTES);
                S.tstepA = (size_t)256 * D * 2; S.tstepB = (size_t)256 * D * 2; S.a_colstep = 0;
                pg8::EpiSwiGLU E{INTER, FF};
                pg8::gemm_phase<pg8::EpiSwiGLU, pg8::DenseSched, false>(C.lds, idxbuf, D, D, D, S, E);
            }
            SEAM();
            if (RUN()) {
                pg8::DenseSched S; S.nM = nM; S.nN = 4; S.G = C.G; S.c = (int)blockIdx.x; S.A = (const char*)INTER; S.Bt = (const char*)(args.ws + WS_WDN + (size_t)lp * DN_BYTES);
                S.tstepA = (size_t)256 * FF * 2; S.tstepB = (size_t)256 * FF * 2; S.a_colstep = 0;
                pg8::EpiResid E{C.H32, nullptr, nullptr, pm0 * 256};
                pg8::gemm_phase<pg8::EpiResid, pg8::DenseSched, false>(C.lds, idxbuf, FF, FF, FF, S, E);
            }
            SEAM();
        }
        if (RUN()) phase_norm(C, args.in[9] + lp * D, false);
        SEAM();
        bf16* const BG = INTER; bf16* const UU = INTER + (size_t)RPAD * D;
        if (RUN()) {
            pg8::DenseSched S; S.nM = MT_ALL; S.nN = 12; S.G = C.G; S.c = (int)blockIdx.x; S.A = (const char*)C.XN; S.Bt = (const char*)(args.ws + WS_WIN + (size_t)lp * 3 * D * D * 2);
            S.tstepA = (size_t)256 * D * 2; S.tstepB = (size_t)256 * D * 2; S.a_colstep = 0;
            pg8::EpiConvIn E{BG, UU};
            pg8::gemm_phase<pg8::EpiConvIn, pg8::DenseSched, false>(C.lds, idxbuf, D, D, D, S, E);
        }
        SEAM();
        if (RUN()) phase_conv(C, args.in[11] + lp * 3 * D, BG, UU, C.XN);
        SEAM();
        if (RUN()) {
            pg8::DenseSched S; S.nM = MT_ALL; S.nN = 4; S.G = C.G; S.c = (int)blockIdx.x; S.A = (const char*)C.XN; S.Bt = (const char*)(args.ws + WS_WOUT + (size_t)lp * D * D * 2);
            S.tstepA = (size_t)256 * D * 2; S.tstepB = (size_t)256 * D * 2; S.a_colstep = 0;
            pg8::EpiResid E{C.H32, nullptr, nullptr, 0};
            pg8::gemm_phase<pg8::EpiResid, pg8::DenseSched, false>(C.lds, idxbuf, D, D, D, S, E);
        }
        SEAM();
        unsigned* const gcnt = C.ctl + CW_MOECNT + lp * 8 * 64;
        if (RUN()) phase_router(C, args.in[13] + lp * D, args.in[14] + (size_t)lp * D * NE, gcnt);
        SEAM();
        for (int pass = 0; pass < MOE_PASSES; ++pass) {
            if (RUN()) {
                pg8::MoeSched S; moe_sched_init(S, C, gcnt, pass, FF / 128);
                S.A = (const char*)C.XN; S.tstepA = 0; S.Bt = (const char*)(args.ws + WS_WMGU); S.estepB = GU_BYTES; S.tstepB = (size_t)256 * D * 2; S.rowidx = (const unsigned*)(args.ws + WS_ROWIDX);
                pg8::EpiSwiGLU E{INTER, FF};
                pg8::gemm_phase<pg8::EpiSwiGLU, pg8::MoeSched, true>(C.lds, idxbuf, D, D, D, S, E);
            }
            SEAM();
            if (RUN()) {
                pg8::MoeSched S; moe_sched_init(S, C, gcnt, pass, 4);
                S.A = (const char*)INTER; S.tstepA = (size_t)256 * FF * 2; S.Bt = (const char*)(args.ws + WS_WMDN); S.estepB = DN_BYTES; S.tstepB = (size_t)256 * FF * 2; S.rowidx = nullptr;
                pg8::EpiMoeDown E{(const int2*)(args.ws + WS_SLOT), C.H32, C.Y1};
                pg8::gemm_phase<pg8::EpiMoeDown, pg8::MoeSched, false>(C.lds, idxbuf, FF, FF, FF, S, E);
            }
            SEAM();
        }
    }
    if (RUN()) phase_final(C, args.in[18], args.out);
    SEAM();
#undef RUN
#undef SEAM
}

extern "C" void kernel_launch(void* const* d_in, const int* in_sizes, int n_in, void* d_out, int out_size, void* d_ws, size_t ws_size, hipStream_t stream) {
    static int grid = 0;
    if (grid == 0) {
        if (n_in != 19 || in_sizes[0] != MROWS * D || out_size != MROWS * D || ws_size < WS_END) {
            fprintf(stderr, "kernel_launch: unexpected problem (n_in %d, in0 %d, out %d, ws %zu < %zu); nothing launched\n", n_in, n_in > 0 ? in_sizes[0] : -1, out_size, ws_size, (size_t)WS_END); grid = -1; return; }
        int dev = 0, cus = 0, per_cu = 0;
        if (hipGetDevice(&dev) != hipSuccess || hipDeviceGetAttribute(&cus, hipDeviceAttributeMultiprocessorCount, dev) != hipSuccess) { grid = -1; return; }
        if (hipFuncSetAttribute((const void*)fwd, hipFuncAttributeMaxDynamicSharedMemorySize, LDS_BYTES) != hipSuccess) { fprintf(stderr, "kernel_launch: hipFuncSetAttribute failed\n"); grid = -1; return; }
        if (hipOccupancyMaxActiveBlocksPerMultiprocessor(&per_cu, (const void*)fwd, NWAVES * 64, LDS_BYTES) != hipSuccess || per_cu < 1)
            fprintf(stderr, "kernel_launch: occupancy query reports %d workgroups per CU\n", per_cu);
        (void)hipGetLastError();
        grid = cus;
    }
    if (grid < 0) return;
    if (hipMemsetAsync((char*)d_ws + WS_CTL, 0, CTL_ZERO_BYTES, stream) != hipSuccess) { fprintf(stderr, "kernel_launch: memset failed\n"); return; }
    Args a{};
    for (int i = 0; i < 19; ++i) a.in[i] = (const float*)d_in[i];
    a.out = (float*)d_out; a.ws = (unsigned char*)d_ws;
#if MK_ONE_LAUNCH
    a.ph_lo = 0; a.ph_hi = N_PHASES;
    hipLaunchKernelGGL(fwd, dim3(grid), dim3(NWAVES * 64), LDS_BYTES, stream, a);
#else
    for (int p = 0; p < N_PHASES; ++p) { a.ph_lo = p; a.ph_hi = p + 1; hipLaunchKernelGGL(fwd, dim3(grid), dim3(NWAVES * 64), LDS_BYTES, stream, a); }
#endif
    const hipError_t le = hipPeekAtLastError();
    if (le != hipSuccess) fprintf(stderr, "kernel_launch: launch failed: %s\n", hipGetErrorName(le));
}
```

```cpp
#include <hip/hip_runtime.h>
#include <cstdio>
#include <cstdint>

#ifndef PROBE_REP_ELT
#define PROBE_REP_ELT 1
#endif
#ifndef PROBE_REP_GEMM
#define PROBE_REP_GEMM 1
#endif
#ifndef MK_ONE_LAUNCH
#define MK_ONE_LAUNCH 1
#endif

constexpr int D = 1024, FF = 3584, NE = 8, NB = 32, TS = 2048, NMETA = 16;
constexpr int MROWS = NB * TS;
constexpr int RTOT = MROWS + NMETA;
constexpr int MT_ALL = 257;
constexpr int RPAD = MT_ALL * 256;
constexpr int CAP = RPAD;
constexpr float EPS = 1e-6f;
constexpr int NWAVES = 8;
constexpr int MOE_CH = 256, MOE_PASSES = 2;
constexpr int MOE_LAST_MAX = 272;
constexpr float W_GU_SCALE = 64.f, W_DN_SCALE = 128.f, H8_SCALE = 4.f;
constexpr int SC_ONE = 0x7f7f7f7f, SC_GU = 0x79797979  , SC_DN = 0x78787878  , SC_H = 0x7d7d7d7d  ;
constexpr int DENSE_H0 = 128;

constexpr size_t MiB = 1u << 20;
constexpr size_t WS_CTL = 0, CTL_ZERO_BYTES = 1 * MiB;
constexpr size_t WS_WPOOL = 1 * MiB;
constexpr size_t WS_WGU = 2 * MiB;
constexpr size_t WS_WDN = 30 * MiB;
constexpr size_t WS_WIN = 44 * MiB;
constexpr size_t WS_WOUT = 56 * MiB;
constexpr size_t WS_WMGU = 60 * MiB;
constexpr size_t WS_WMDN = 172 * MiB;
constexpr size_t WS_ROWIDX = 228 * MiB;
constexpr size_t WS_SLOT = 231 * MiB;
constexpr size_t WS_RSTD = 236 * MiB;
constexpr size_t WS_PARAMS = 236 * MiB + 512 * 1024;
constexpr int PP_POOL_NORM = 0, PP_POOL_SCALE = 2048, PP_DENSE_NORM = 4096, PP_CONV_NORM = 6144, PP_MOE_NORM = 8192, PP_FINAL = 10240, PP_CONV_K = 11264, PP_ROUTER = 17408, PP_TOTAL = 17408 + 16384;
constexpr size_t WS_H32 = 237 * MiB;
constexpr size_t WS_XN = 494 * MiB;
constexpr size_t WS_Y1 = 623 * MiB;
constexpr size_t WS_INTER = 752 * MiB;
constexpr size_t WS_END = 1009 * MiB;
constexpr size_t GU_BYTES = (size_t)7168 * 1024 * 2, DN_BYTES = (size_t)1024 * 3584 * 2, GU8_BYTES = GU_BYTES / 2, DN8_BYTES = DN_BYTES / 2;
static_assert(WS_ROWIDX + (size_t)8 * CAP * 4 <= WS_SLOT && WS_SLOT + (size_t)8 * CAP * 8 <= WS_RSTD, "lists");
static_assert(WS_H32 + (size_t)RPAD * D * 4 <= WS_XN && WS_XN + (size_t)RPAD * D * 2 <= WS_Y1 && WS_Y1 + (size_t)RPAD * D * 2 <= WS_INTER, "act map");
static_assert((size_t)MOE_LAST_MAX * 256 * FF <= WS_END - WS_INTER && (size_t)129 * 256 * FF * 2 <= WS_END - WS_INTER && (size_t)2 * RPAD * D * 2 <= WS_END - WS_INTER, "inter");
constexpr int CW_BAR = 4096;
constexpr int CW_MOECNT = 16384;

constexpr int RING_BYTES = 131072;
constexpr int IDX_OFF = RING_BYTES;
constexpr int MISC_OFF = IDX_OFF + 2048;
constexpr int LDS_BYTES = 147456;

#define GAS __attribute__((address_space(1)))
#define LAS __attribute__((address_space(3)))
typedef unsigned short bf16;
typedef float f32x4 __attribute__((ext_vector_type(4)));
typedef unsigned v4u __attribute__((ext_vector_type(4)));
typedef unsigned v2u __attribute__((ext_vector_type(2)));
#define LDS_WAIT() asm volatile("s_waitcnt lgkmcnt(0)" ::: "memory")
#define VM_WAIT() asm volatile("s_waitcnt vmcnt(0)" ::: "memory")

__device__ __forceinline__ int lane_id() { int l; asm volatile("v_mbcnt_lo_u32_b32 %0, -1, 0\n\tv_mbcnt_hi_u32_b32 %0, -1, %0" : "=v"(l)); return l; }
__device__ __forceinline__ unsigned cvt_pk_bf16(float lo, float hi) { unsigned r; asm volatile("v_cvt_pk_bf16_f32 %0, %1, %2" : "=v"(r) : "v"(lo), "v"(hi)); return r; }
__device__ __forceinline__ unsigned pk4_fp8(float a, float b, float c, float d) { int w = __builtin_amdgcn_cvt_pk_fp8_f32(a, b, 0, false); w = __builtin_amdgcn_cvt_pk_fp8_f32(c, d, w, true); return (unsigned)w; }
__device__ __forceinline__ float bf_lo(unsigned w) { return __uint_as_float(w << 16); }
__device__ __forceinline__ float bf_hi(unsigned w) { return __uint_as_float(w & 0xffff0000u); }
__device__ __forceinline__ float wave_sum(float v, int lane) {
#pragma unroll
    for (int o = 1; o < 64; o <<= 1) v += __int_as_float(__builtin_amdgcn_ds_bpermute((lane ^ o) << 2, __float_as_int(v)));
    return v;
}
__device__ __forceinline__ float silu_f(float a) { return a * __builtin_amdgcn_rcpf(1.0f + __builtin_amdgcn_exp2f(a * -1.44269504f)); }

#define XB_TMO      128
#define XB_XCNT(j)  (256  + 64 * (j))
#define XB_XSUB(j)  (1280 + 64 * (j))
#define XB_XGEN(j)  (2304 + 64 * (j))
#define XB_TOP      3328
#define XB_TOPGEN   3392
#define XCD_BAR_WORDS 3456
#define XB_SPIN_CAP (1u << 18)
__device__ __forceinline__ unsigned xb_ld(unsigned* p)              { return __hip_atomic_load(p, __ATOMIC_RELAXED, __HIP_MEMORY_SCOPE_AGENT); }
__device__ __forceinline__ unsigned xb_add(unsigned* p, unsigned v) { return __hip_atomic_fetch_add(p, v, __ATOMIC_RELAXED, __HIP_MEMORY_SCOPE_AGENT); }
__device__ __forceinline__ unsigned xb_xcc_id() { return (unsigned)__builtin_amdgcn_s_getreg((3 << 11) | 20) & 0xFu; }
#define XB_SPIN(cond, bar) do { unsigned _sp = 0; while (cond) { __builtin_amdgcn_s_sleep(1); \
    if ((++_sp & 255u) == 0u) { if (xb_ld(&(bar)[XB_TMO])) break; if (_sp > XB_SPIN_CAP) { atomicAdd(&(bar)[XB_TMO], 1u); break; } } } } while (0)
struct XcdBarrier { unsigned* bar; unsigned x; volatile LAS unsigned* st; };
__device__ __forceinline__ XcdBarrier xcd_barrier_post(unsigned* bar, volatile LAS unsigned* st) {
    XcdBarrier b; b.bar = bar; b.x = xb_xcc_id(); b.st = st;
    if (threadIdx.x == 0) (void)xb_add(&bar[XB_XCNT(b.x)], 1u);
    return b;
}
__device__ __forceinline__ void xcd_barrier_complete(unsigned* bar, unsigned x, unsigned& nloc, unsigned& nx) {
    const unsigned G = gridDim.x * gridDim.y * gridDim.z;
    unsigned sum, cnt, mine, sp = 0u;
    for (;;) {
        sum = 0u; cnt = 0u; mine = 0u;
#pragma unroll
        for (unsigned j = 0; j < 16; ++j) { const unsigned c = xb_ld(&bar[XB_XCNT(j)]); sum += c; cnt += (c > 0u) ? 1u : 0u; mine = (j == x) ? c : mine; }
        if (sum == G) break;
        __builtin_amdgcn_s_sleep(1);
        if ((++sp & 255u) == 0u) { if (xb_ld(&bar[XB_TMO])) break; if (sp > XB_SPIN_CAP) { atomicAdd(&bar[XB_TMO], 1u); break; } }
    }
    nloc = mine > 0u ? mine : 1u; nx = cnt > 0u ? cnt : 1u;
}
__device__ __forceinline__ void xcd_barrier(const XcdBarrier& b, const int wave  ) {
    asm volatile("s_waitcnt vmcnt(0)" ::: "memory");
    __syncthreads();
    if (wave == 0 && lane_id() == 0) {
        size_t z_ = 0; asm volatile("" : "+s"(z_)); unsigned* bar = b.bar + z_;
        __builtin_amdgcn_s_waitcnt(0);
        unsigned nloc = b.st[0], nx = b.st[1];
        if (nloc == 0u) { xcd_barrier_complete(bar, b.x, nloc, nx); b.st[0] = nloc; b.st[1] = nx; }
        const unsigned old = xb_add(&bar[XB_XSUB(b.x)], 1u);
        const unsigned gen = old / nloc;
        if (old + 1u == (gen + 1u) * nloc) {
            __builtin_amdgcn_fence(__ATOMIC_RELEASE, "agent");
            asm volatile("s_waitcnt vmcnt(0)" ::: "memory");
            const unsigned og = xb_add(&bar[XB_TOP], 1u);
            const unsigned tg = og / nx;
            if (og + 1u == (tg + 1u) * nx) xb_add(&bar[XB_TOPGEN], 1u);
            else XB_SPIN(xb_ld(&bar[XB_TOPGEN]) == tg, bar);
            __builtin_amdgcn_fence(__ATOMIC_ACQUIRE, "agent");
            xb_add(&bar[XB_XGEN(b.x)], 1u);
            asm volatile("s_waitcnt vmcnt(0)" ::: "memory");
        } else {
            XB_SPIN(xb_ld(&bar[XB_XGEN(b.x)]) == gen, bar);
            __builtin_amdgcn_fence(__ATOMIC_ACQUIRE, "agent");
            asm volatile("s_waitcnt vmcnt(0)" ::: "memory");
        }
    }
    __syncthreads();
}

namespace pg8 {
typedef short bf16x8 __attribute__((ext_vector_type(8)));
constexpr int BM = 256, BK = 64, HALF = 128, HTB = HALF * BK * 2, STAGE_BYTES = 8 * HTB;
static_assert(STAGE_BYTES == RING_BYTES, "ring");
__host__ __device__ __forceinline__ int lds_byte(int r, int c) { const int st = (r >> 4) * 2 + (c >> 5), rr = r & 15, cc = c & 31, ob = rr * 64 + cc * 2; return st * 1024 + (ob ^ (((ob >> 9) & 1) << 5)); }
__host__ __device__ __forceinline__ void stage_rc(int b, int& R, int& C) { const int st = b / 1024, sb = b % 1024, swz = sb ^ (((sb >> 9) & 1) << 5); R = (st >> 1) * 16 + swz / 64; C = (st & 1) * 32 + (swz % 64) / 2; }
__host__ __device__ __forceinline__ int perm32(int rho) { const int n = rho >> 4, i = rho & 15; return 8 * (i >> 2) + 4 * n + (i & 3); }

struct Unit { int pm, pn, e, rows, slot0; };

__device__ __forceinline__ bool static_tile(int i, int G, int c, int nM, int nN, int& pm, int& pn) {
    const int nwg = nM * nN; const long L = (long)i * G + c; if (L >= nwg) return false;
    int wgid = (int)L; { const int q = nwg / 8, r = nwg % 8, xcd = wgid % 8, off = wgid / 8; wgid = (xcd < r ? xcd * (q + 1) : r * (q + 1) + (xcd - r) * q) + off; }
    const int nig = 8 * nN, gid = wgid / nig, fm = gid * 8, gsz = (nM - fm) < 8 ? (nM - fm) : 8;
    pm = fm + ((wgid % nig) % gsz); pn = (wgid % nig) / gsz; return true;
}
struct DenseSched {
    int nM, nN, G, c; const char* A; const char* Bt; unsigned tstepA, tstepB, a_colstep;
    __device__ __forceinline__ bool next(int i, Unit& u) const { if (!static_tile(i, G, c, nM, nN, u.pm, u.pn)) return false; u.e = 0; u.rows = 256; u.slot0 = 0; return true; }
    __device__ __forceinline__ unsigned a_off(const Unit& u) const { return (unsigned)u.pm * tstepA + (unsigned)u.pn * a_colstep; }
    __device__ __forceinline__ unsigned b_off(const Unit& u) const { return (unsigned)u.pn * tstepB; }
    __device__ __forceinline__ const unsigned* idx_src(const Unit&) const { return nullptr; }
};
struct MoeSched {
    int nM, nN, G, c, t0; int m1, m2, m3, m4, m5, m6, m7; int n0, n1, n2, n3, n4, n5, n6, n7;
    const char* A; unsigned tstepA; const char* Bt; unsigned estepB, tstepB; const unsigned* rowidx;
    __device__ __forceinline__ bool next(int i, Unit& u) const {
        if (!static_tile(i, G, c, nM, nN, u.pm, u.pn)) return false;
        const int tg = t0 + u.pm; int e = 0, base = 0, cn = __builtin_amdgcn_readfirstlane(n0);
        if (tg >= m1) { e = 1; base = m1; cn = __builtin_amdgcn_readfirstlane(n1); }
        if (tg >= m2) { e = 2; base = m2; cn = __builtin_amdgcn_readfirstlane(n2); }
        if (tg >= m3) { e = 3; base = m3; cn = __builtin_amdgcn_readfirstlane(n3); }
        if (tg >= m4) { e = 4; base = m4; cn = __builtin_amdgcn_readfirstlane(n4); }
        if (tg >= m5) { e = 5; base = m5; cn = __builtin_amdgcn_readfirstlane(n5); }
        if (tg >= m6) { e = 6; base = m6; cn = __builtin_amdgcn_readfirstlane(n6); }
        if (tg >= m7) { e = 7; base = m7; cn = __builtin_amdgcn_readfirstlane(n7); }
        const int ti = tg - base; const int rem = cn - 256 * ti;
        u.e = e; u.rows = rem < 256 ? rem : 256; u.slot0 = e * CAP + ti * 256; return true;
    }
    __device__ __forceinline__ unsigned a_off(const Unit& u) const { return (unsigned)u.pm * tstepA; }
    __device__ __forceinline__ unsigned b_off(const Unit& u) const { return (unsigned)u.e * estepB + (unsigned)u.pn * tstepB; }
    __device__ __forceinline__ const unsigned* idx_src(const Unit& u) const { return rowidx + u.slot0; }
};

struct EpiSwiGLU {
    static constexpr bool PERM = true;
    bf16* H; int ldh;
    __device__ __forceinline__ void operator()(const f32x4 (&acc)[2][2][4][2], const Unit& u, int wr, int wc, int fr, int fq) const {
        const int row0 = u.pm * BM + wr * 64 + fr, col0 = u.pn * 128 + wc * 32 + 8 * fq;
#pragma unroll
        for (int ai = 0; ai < 2; ++ai)
#pragma unroll
            for (int m = 0; m < 4; ++m) { bf16* p = H + (size_t)(row0 + ai * HALF + m * 16) * ldh + col0;
                const f32x4 g0 = acc[ai][0][m][0], g1 = acc[ai][0][m][1], u0 = acc[ai][1][m][0], u1 = acc[ai][1][m][1];
                v4u w; w.x = cvt_pk_bf16(silu_f(g0[0]) * u0[0], silu_f(g0[1]) * u0[1]); w.y = cvt_pk_bf16(silu_f(g0[2]) * u0[2], silu_f(g0[3]) * u0[3]);
                w.z = cvt_pk_bf16(silu_f(g1[0]) * u1[0], silu_f(g1[1]) * u1[1]); w.w = cvt_pk_bf16(silu_f(g1[2]) * u1[2], silu_f(g1[3]) * u1[3]);
                *(v4u*)p = w; }
    }
};
struct EpiSwiGLU8 {
    static constexpr bool PERM = true;
    unsigned char* H; int ldh;
    __device__ __forceinline__ void operator()(const f32x4 (&acc)[2][2][4][2], const Unit& u, int wr, int wc, int fr, int fq) const {
        const int row0 = u.pm * BM + wr * 64 + fr, col0 = u.pn * 128 + wc * 32 + 8 * fq;
#pragma unroll
        for (int ai = 0; ai < 2; ++ai)
#pragma unroll
            for (int m = 0; m < 4; ++m) { unsigned char* p = H + (size_t)(row0 + ai * HALF + m * 16) * ldh + col0;
                const f32x4 g0 = acc[ai][0][m][0], g1 = acc[ai][0][m][1], u0 = acc[ai][1][m][0] * H8_SCALE, u1 = acc[ai][1][m][1] * H8_SCALE;
                v2u w; w.x = pk4_fp8(silu_f(g0[0]) * u0[0], silu_f(g0[1]) * u0[1], silu_f(g0[2]) * u0[2], silu_f(g0[3]) * u0[3]);
                w.y = pk4_fp8(silu_f(g1[0]) * u1[0], silu_f(g1[1]) * u1[1], silu_f(g1[2]) * u1[2], silu_f(g1[3]) * u1[3]);
                *(v2u*)p = w; }
    }
};
struct EpiResid {
    static constexpr bool PERM = false;
    float* h; const bf16* y1; const float* scale; int row_off;
    __device__ __forceinline__ void operator()(const f32x4 (&acc)[2][2][4][2], const Unit& u, int wr, int wc, int fr, int fq) const {
        const int row0 = row_off + u.pm * BM + wr * 64 + fr, col0 = u.pn * BM + wc * 32 + 4 * fq;
        f32x4 sc[2][2];
#pragma unroll
        for (int bj = 0; bj < 2; ++bj)
#pragma unroll
            for (int n = 0; n < 2; ++n) sc[bj][n] = scale ? *(const f32x4*)(scale + col0 + bj * HALF + n * 16) : (f32x4){1.f, 1.f, 1.f, 1.f};
#pragma unroll
        for (int ai = 0; ai < 2; ++ai)
#pragma unroll
            for (int m = 0; m < 4; ++m) { const size_t off = (size_t)(row0 + ai * HALF + m * 16) * D + col0;
#pragma unroll
                for (int bj = 0; bj < 2; ++bj)
#pragma unroll
                    for (int n = 0; n < 2; ++n) { f32x4 b = *(const f32x4*)(h + off + bj * HALF + n * 16);
                        if (y1) { const v2u y = *(const v2u*)(y1 + off + bj * HALF + n * 16); b += (f32x4){bf_lo(y.x), bf_hi(y.x), bf_lo(y.y), bf_hi(y.y)}; }
                        *(f32x4*)(h + off + bj * HALF + n * 16) = b + acc[ai][bj][m][n] * sc[bj][n]; }
                asm volatile("" ::: "memory"); }
    }
};
struct EpiConvIn {
    static constexpr bool PERM = true;
    bf16* BG; bf16* U;
    __device__ __forceinline__ void operator()(const f32x4 (&acc)[2][2][4][2], const Unit& u, int wr, int wc, int fr, int fq) const {
        const int row0 = u.pm * BM + wr * 64 + fr;
        if (u.pn < 4) {
            const int col0 = u.pn * BM + wc * 32 + 8 * fq;
#pragma unroll
            for (int ai = 0; ai < 2; ++ai)
#pragma unroll
                for (int m = 0; m < 4; ++m) { bf16* p = BG + (size_t)(row0 + ai * HALF + m * 16) * D + col0;
#pragma unroll
                    for (int bj = 0; bj < 2; ++bj) { const f32x4 v0 = acc[ai][bj][m][0], v1 = acc[ai][bj][m][1];
                        v4u w; w.x = cvt_pk_bf16(v0[0], v0[1]); w.y = cvt_pk_bf16(v0[2], v0[3]); w.z = cvt_pk_bf16(v1[0], v1[1]); w.w = cvt_pk_bf16(v1[2], v1[3]);
                        *(v4u*)(p + bj * HALF) = w; } }
        } else {
            const int col0 = (u.pn - 4) * 128 + wc * 32 + 8 * fq;
#pragma unroll
            for (int ai = 0; ai < 2; ++ai)
#pragma unroll
                for (int m = 0; m < 4; ++m) { bf16* p = U + (size_t)(row0 + ai * HALF + m * 16) * D + col0;
                    const f32x4 c0 = acc[ai][0][m][0], c1 = acc[ai][0][m][1], v0 = acc[ai][1][m][0], v1 = acc[ai][1][m][1];
                    v4u w; w.x = cvt_pk_bf16(c0[0] * v0[0], c0[1] * v0[1]); w.y = cvt_pk_bf16(c0[2] * v0[2], c0[3] * v0[3]);
                    w.z = cvt_pk_bf16(c1[0] * v1[0], c1[1] * v1[1]); w.w = cvt_pk_bf16(c1[2] * v1[2], c1[3] * v1[3]);
                    *(v4u*)p = w; }
        }
    }
};
struct EpiMoeDown {
    static constexpr bool PERM = false;
    const int2* slot; float* h; bf16* y1;
    __device__ __forceinline__ void operator()(const f32x4 (&acc)[2][2][4][2], const Unit& u, int wr, int wc, int fr, int fq) const {
        const int col0 = u.pn * BM + wc * 32 + 4 * fq;
#pragma unroll
        for (int ai = 0; ai < 2; ++ai)
#pragma unroll
            for (int m = 0; m < 4; ++m) { const int rl = ai * HALF + wr * 64 + m * 16 + fr;
                if (rl < u.rows) {
                    const int2 inf = slot[u.slot0 + rl]; const int tok = inf.x & 0x7fffffff; const float w = __int_as_float(inf.y);
                    const size_t off = (size_t)tok * D + col0;
                    if (inf.x >= 0) {
#pragma unroll
                        for (int bj = 0; bj < 2; ++bj)
#pragma unroll
                            for (int n = 0; n < 2; ++n) { const f32x4 b = *(const f32x4*)(h + off + bj * HALF + n * 16); *(f32x4*)(h + off + bj * HALF + n * 16) = b + acc[ai][bj][m][n] * w; }
                    } else {
#pragma unroll
                        for (int bj = 0; bj < 2; ++bj)
#pragma unroll
                            for (int n = 0; n < 2; ++n) { const f32x4 v = acc[ai][bj][m][n] * w; v2u o; o.x = cvt_pk_bf16(v[0], v[1]); o.y = cvt_pk_bf16(v[2], v[3]); *(v2u*)(y1 + off + bj * HALF + n * 16) = o; }
                    }
                }
                asm volatile("" ::: "memory"); }
    }
};

typedef int i32x4 __attribute__((ext_vector_type(4)));
typedef int i32x8 __attribute__((ext_vector_type(8)));
template <class Epi, class Sched, bool GATHER, bool FP8 = false>
__device__ __forceinline__ void gemm_phase(LAS unsigned char* lds, LAS unsigned* idxbuf, const int wid, const int nt, const int lda, const int ldb, const Sched& S, const Epi& E, const int sc_a = 0x7f7f7f7f, const int sc_b = 0x7f7f7f7f) {
    const int lane = lane_id(), tid = wid * 64 + lane, wr = wid >> 2, wc = wid & 3, fr = lane & 15, fq = lane >> 4;
    unsigned voffA[2], voffB[2], voffG[2][2];
#pragma unroll
    for (int i = 0; i < 2; ++i) { int R, C; stage_rc(tid * 16 + i * 8192, R, C); const int Rb = Epi::PERM ? ((R & ~31) + perm32(R & 31)) : R;
        voffA[i] = (unsigned)(R * lda + C * 2); voffB[i] = (unsigned)(Rb * ldb + C * 2); voffG[0][i] = 0u; voffG[1][i] = 0u; }
    const __amdgpu_buffer_rsrc_t rA = __builtin_amdgcn_make_buffer_rsrc((void*)S.A, 0, 0x7ffffff0, 0x00020000), rB = __builtin_amdgcn_make_buffer_rsrc((void*)S.Bt, 0, 0x7ffffff0, 0x00020000);
    const unsigned kstep = (unsigned)(BK * 2);
    const unsigned hstepA = (unsigned)HALF * lda, hstepB = (unsigned)HALF * ldb;
    const unsigned ldsw = (unsigned)wid * 1024u;
    const int aoff = lds_byte(wr * 64 + fr, fq * 8), boff = lds_byte(wc * 32 + fr, fq * 8);
#define PG8_SA(b, h) (((b) * 2 + (h)) * HTB)
#define PG8_SB(b, h) ((4 + (b) * 2 + (h)) * HTB)
#define PG8_STAGE(bufoff, rsrc, soff, voff) do { _Pragma("unroll") for (int _i = 0; _i < 2; ++_i) \
        __builtin_amdgcn_raw_ptr_buffer_load_lds(rsrc, (LAS void*)(lds + (bufoff) + ldsw + _i * 8192), 16, (int)(voff)[_i], (int)(soff), 0, 0); } while (0)
#define PG8_STAGE_A(bufoff, soff, h) do { if constexpr (GATHER) { PG8_STAGE(bufoff, rA, soff, voffG[h]); } else { PG8_STAGE(bufoff, rA, (soff) + (h) * hstepA, voffA); } } while (0)
#define PG8_STAGE_B(bufoff, soff, h) PG8_STAGE(bufoff, rB, (soff) + (h) * hstepB, voffB)
#define PG8_LDA(dst, b, h) do { _Pragma("unroll") for (int m = 0; m < 4; ++m) _Pragma("unroll") for (int k = 0; k < 2; ++k) dst[m][k] = *(const LAS bf16x8*)(lds + PG8_SA(b, h) + aoff + m * 2048 + k * 1024); } while (0)
#define PG8_LDB(dst, b, h) do { _Pragma("unroll") for (int n = 0; n < 2; ++n) _Pragma("unroll") for (int k = 0; k < 2; ++k) dst[n][k] = *(const LAS bf16x8*)(lds + PG8_SB(b, h) + boff + n * 2048 + k * 1024); } while (0)
#define PG8_MMA(ai, bj, At, Bt) do { __builtin_amdgcn_s_setprio(1); _Pragma("unroll") for (int m = 0; m < 4; ++m) _Pragma("unroll") for (int n = 0; n < 2; ++n) _Pragma("unroll") for (int k = 0; k < 2; ++k) \
        acc[ai][bj][m][n] = __builtin_amdgcn_mfma_f32_16x16x32_bf16(Bt[n][k], At[m][k], acc[ai][bj][m][n], 0, 0, 0); __builtin_amdgcn_s_setprio(0); } while (0)
#define PG8_CAT(x) __builtin_shufflevector((i32x4)(x)[0], (i32x4)(x)[1], 0, 1, 2, 3, 4, 5, 6, 7)
#define PG8_MMA8(ai, bj, At, Bt) do { __builtin_amdgcn_s_setprio(1); _Pragma("unroll") for (int m = 0; m < 4; ++m) _Pragma("unroll") for (int n = 0; n < 2; ++n) \
        acc[ai][bj][m][n] = __builtin_amdgcn_mfma_scale_f32_16x16x128_f8f6f4(PG8_CAT(Bt[n]), PG8_CAT(At[m]), acc[ai][bj][m][n], 0, 0, 0, sc_b, 0, sc_a); __builtin_amdgcn_s_setprio(0); } while (0)
#define PG8_MM(ai, bj, At, Bt) do { if constexpr (FP8) PG8_MMA8(ai, bj, At, Bt); else PG8_MMA(ai, bj, At, Bt); } while (0)
#define PG8_WAIT_V(n) asm volatile("s_waitcnt vmcnt(" #n ")" ::: "memory")
#define PG8_WAIT_L(n) asm volatile("s_waitcnt lgkmcnt(" #n ")" ::: "memory")
#define PG8_BAR __builtin_amdgcn_s_barrier()
#define PG8_SCHED __builtin_amdgcn_sched_barrier(0)
#define PG8_LOAD_VOFFG(ib, nrows) do { asm volatile("" ::: "memory"); _Pragma("unroll") for (int _i = 0; _i < 2; ++_i) { int _R, _C; stage_rc(tid * 16 + _i * 8192, _R, _C); \
        _Pragma("unroll") for (int _h = 0; _h < 2; ++_h) { const int _rl = _h * HALF + _R; unsigned _ix = (ib)[_rl]; _ix = (_rl < (nrows)) ? _ix : 0u; voffG[_h][_i] = _ix * (unsigned)lda + (unsigned)(_C * 2); } } } while (0)
#define PG8_IDX_DMA(src, ib) __builtin_amdgcn_global_load_lds((const unsigned*)((src) + lane * 4), (LAS unsigned*)(ib), 16, 0, 0)
    Unit cur, nxt; int ui = 0;
    if (!S.next(0, cur)) return;
    f32x4 acc[2][2][4][2];
#pragma unroll
    for (int a = 0; a < 2; ++a)
#pragma unroll
        for (int b = 0; b < 2; ++b)
#pragma unroll
            for (int m = 0; m < 4; ++m)
#pragma unroll
                for (int n = 0; n < 2; ++n) acc[a][b][m][n] = (f32x4){0.f, 0.f, 0.f, 0.f};
    bf16x8 At[4][2], B0[2][2], B1[2][2];
    unsigned cA = S.a_off(cur), cB = S.b_off(cur);
    if constexpr (GATHER) {
        if (wid == 0) PG8_IDX_DMA(S.idx_src(cur), idxbuf);
        PG8_WAIT_V(0); PG8_BAR;
        PG8_LOAD_VOFFG(idxbuf, cur.rows);
    }
    PG8_STAGE_B(PG8_SB(0, 0), cB, 0); PG8_STAGE_B(PG8_SB(0, 1), cB, 1); PG8_STAGE_A(PG8_SA(0, 0), cA, 0); PG8_STAGE_A(PG8_SA(0, 1), cA, 1);
    if (wr == 1) PG8_BAR;
    PG8_WAIT_V(2); PG8_BAR;
    PG8_STAGE_B(PG8_SB(1, 0), cB + kstep, 0); PG8_STAGE_A(PG8_SA(1, 0), cA + kstep, 0); PG8_STAGE_B(PG8_SB(1, 1), cB + kstep, 1);
    PG8_WAIT_V(6); PG8_BAR;
    for (;;) {
        const bool has_next = S.next(ui + 1, nxt);
        const unsigned nA = has_next ? S.a_off(nxt) : cA, nB = has_next ? S.b_off(nxt) : cB;
        if constexpr (GATHER) { if (has_next && wid == 0) PG8_IDX_DMA(S.idx_src(nxt), idxbuf + ((ui + 1) & 1) * 256); }
        for (int t = 0; t < nt; t += 2) {
            const bool last = (t == nt - 2);
            const unsigned a1 = cA + (unsigned)(t + 1) * kstep;
            const unsigned a2 = last ? nA : cA + (unsigned)(t + 2) * kstep, b2 = last ? nB : cB + (unsigned)(t + 2) * kstep;
            const unsigned a3 = a2 + kstep, b3 = b2 + kstep;
            PG8_LDB(B0, 0, 0); PG8_LDB(B1, 0, 1); PG8_SCHED; PG8_LDA(At, 0, 0); PG8_STAGE_A(PG8_SA(1, 1), a1, 1);
            PG8_WAIT_V(8); PG8_WAIT_L(0); PG8_BAR; PG8_MM(0, 0, At, B0); PG8_MM(0, 1, At, B1); PG8_BAR; PG8_SCHED;
            if constexpr (GATHER) { if (last && has_next) PG8_LOAD_VOFFG(idxbuf + ((ui + 1) & 1) * 256, nxt.rows); }
            PG8_LDA(At, 0, 1); PG8_STAGE_B(PG8_SB(0, 0), b2, 0); PG8_STAGE_B(PG8_SB(0, 1), b2, 1); PG8_STAGE_A(PG8_SA(0, 0), a2, 0);
            PG8_WAIT_V(8); PG8_WAIT_L(0); PG8_BAR; PG8_MM(1, 0, At, B0); PG8_MM(1, 1, At, B1); PG8_BAR; PG8_SCHED;
            PG8_LDB(B0, 1, 0); PG8_LDB(B1, 1, 1); PG8_SCHED; PG8_LDA(At, 1, 0); PG8_STAGE_A(PG8_SA(0, 1), a2, 1);
            PG8_WAIT_V(8); PG8_WAIT_L(0); PG8_BAR; PG8_MM(0, 0, At, B0); PG8_MM(0, 1, At, B1); PG8_BAR; PG8_SCHED;
            PG8_LDA(At, 1, 1); PG8_STAGE_B(PG8_SB(1, 0), b3, 0); PG8_STAGE_B(PG8_SB(1, 1), b3, 1); PG8_STAGE_A(PG8_SA(1, 0), a3, 0);
            PG8_WAIT_V(8); PG8_WAIT_L(0); PG8_BAR; PG8_MM(1, 0, At, B0); PG8_MM(1, 1, At, B1); PG8_BAR; PG8_SCHED;
        }
        if (wr == 0) PG8_BAR;
        { const int ln = lane_id(); E(acc, cur, wr, wc, ln & 15, ln >> 4); }
        if (!has_next) break;
#pragma unroll
        for (int a = 0; a < 2; ++a)
#pragma unroll
            for (int b = 0; b < 2; ++b)
#pragma unroll
                for (int m = 0; m < 4; ++m)
#pragma unroll
                    for (int n = 0; n < 2; ++n) acc[a][b][m][n] = (f32x4){0.f, 0.f, 0.f, 0.f};
        cur = nxt; cA = nA; cB = nB; ++ui;
        if (wr == 1) PG8_BAR;
    }
    PG8_WAIT_V(0);
    PG8_BAR;
#undef PG8_SA
#undef PG8_SB
#undef PG8_STAGE
#undef PG8_STAGE_A
#undef PG8_STAGE_B
#undef PG8_LDA
#undef PG8_LDB
#undef PG8_MMA
#undef PG8_MMA8
#undef PG8_MM
#undef PG8_CAT
#undef PG8_WAIT_V
#undef PG8_WAIT_L
#undef PG8_BAR
#undef PG8_SCHED
#undef PG8_LOAD_VOFFG
#undef PG8_IDX_DMA
}
}

struct Args { const float* in[19]; float* out; unsigned char* ws; int ph_lo, ph_hi; };
struct Ctx {
    LAS unsigned char* lds; int tid, lane, wave, G, vcu, gw, NGW, gw0;
    unsigned char* ws; float* H32; bf16* XN; bf16* Y1; float* RSTD; unsigned* ctl;
};

__device__ __forceinline__ void tr_item(const float* W, int ldw, int k0, int n0, bf16* WT, int K, int drow0, LAS float* scr, int lane) {
#pragma unroll 8
    for (int i = 0; i < 32; ++i) { const int kk = 2 * i + (lane >> 5); scr[kk * 33 + (lane & 31)] = W[(size_t)(k0 + kk) * ldw + n0 + (lane & 31)]; }
    LDS_WAIT();
    const int c = lane & 7;
#pragma unroll
    for (int j = 0; j < 4; ++j) { const int n = (lane >> 3) + 8 * j; const LAS float* s = scr + (8 * c) * 33 + n;
        v4u o; o.x = cvt_pk_bf16(s[0 * 33], s[1 * 33]); o.y = cvt_pk_bf16(s[2 * 33], s[3 * 33]); o.z = cvt_pk_bf16(s[4 * 33], s[5 * 33]); o.w = cvt_pk_bf16(s[6 * 33], s[7 * 33]);
        *(v4u*)(WT + (size_t)(drow0 + n) * K + k0 + 8 * c) = o; }
    LDS_WAIT();
}
__device__ __forceinline__ void tr_item8(const float* W, int ldw, int k0, int n0, unsigned char* WT, int K, int drow0, float scale, LAS float* scr, int lane) {
#pragma unroll 8
    for (int i = 0; i < 32; ++i) { const int kk = 2 * i + (lane >> 5); scr[kk * 33 + (lane & 31)] = W[(size_t)(k0 + kk) * ldw + n0 + (lane & 31)] * scale; }
    LDS_WAIT();
    const int c = lane & 7;
#pragma unroll
    for (int j = 0; j < 4; ++j) { const int n = (lane >> 3) + 8 * j; const LAS float* s = scr + (8 * c) * 33 + n;
        v2u o; o.x = pk4_fp8(s[0 * 33], s[1 * 33], s[2 * 33], s[3 * 33]); o.y = pk4_fp8(s[4 * 33], s[5 * 33], s[6 * 33], s[7 * 33]);
        *(v2u*)(WT + (size_t)(drow0 + n) * K + k0 + 8 * c) = o; }
    LDS_WAIT();
}
__device__ __forceinline__ void cv_gateup(const float* Wg, const float* Wu, bf16* dst, int item, LAS float* scr, int lane) {
    const int kind = item / 1792, r = item % 1792, kb = r / 112, nb = r % 112, n0 = 32 * nb;
    tr_item(kind ? Wu : Wg, FF, 64 * kb, n0, dst, D, (n0 >> 7) * 256 + (n0 & 127) + kind * 128, scr, lane);
}
__device__ __forceinline__ void cv_plain(const float* W, int K, int N, bf16* dst, int drow_off, int item, LAS float* scr, int lane) {
    const int nbn = N / 32, kb = item / nbn, nb = item % nbn;
    tr_item(W, N, 64 * kb, 32 * nb, dst, K, drow_off + 32 * nb, scr, lane);
}
__device__ __forceinline__ void cv_convin(const float* W, bf16* dst, int item, LAS float* scr, int lane) {
    const int kb = item / 96, nb = item % 96, n0 = 32 * nb; int dr;
    if (n0 < 1024) dr = n0; else if (n0 < 2048) dr = 1024 + ((n0 - 1024) >> 7) * 256 + (n0 & 127); else dr = 1024 + ((n0 - 2048) >> 7) * 256 + 128 + (n0 & 127);
    tr_item(W, 3 * D, 64 * kb, n0, dst, D, dr, scr, lane);
}
__device__ __forceinline__ void convert_moe_layer(Ctx& C, const Args& a, int j) {
    LAS float* scr = (LAS float*)(C.lds + C.wave * 16384);
    constexpr int PER_E = 3584 + 1792;
    for (int it = C.gw; it < NE * PER_E; it += C.NGW) {
        const int e = it / PER_E, r = it % PER_E; const size_t wo = ((size_t)j * NE + e) * D * FF;
        if (r < 3584) { const int kind = r / 1792, q = r % 1792, kb = q / 112, nb = q % 112, n0 = 32 * nb;
            tr_item8((kind ? a.in[16] : a.in[15]) + wo, FF, 64 * kb, n0, C.ws + WS_WMGU + (size_t)(j * NE + e) * GU8_BYTES, D, (n0 >> 7) * 256 + (n0 & 127) + kind * 128, W_GU_SCALE, scr, C.lane); }
        else { const int q = r - 3584, kb = q / 32, nb = q % 32;
            tr_item8(a.in[17] + wo, D, 64 * kb, 32 * nb, C.ws + WS_WMDN + (size_t)(j * NE + e) * DN8_BYTES, FF, 32 * nb, W_DN_SCALE, scr, C.lane); }
    }
}
__device__ __forceinline__ void convert_small_weights(Ctx& C, const Args& a) {
    LAS float* scr = (LAS float*)(C.lds + C.wave * 16384);
    constexpr int I_POOL = 32, I_GU = 3584, I_DN = 1792, I_IN = 1536, I_OUT = 512;
    constexpr int PER_L = 4 * I_POOL + I_GU + I_DN + I_IN + I_OUT;
    for (int it = C.gw; it < 2 * PER_L; it += C.NGW) {
        const int l = it / PER_L; int r = it % PER_L;
        if (r < 4 * I_POOL) { const int g = r / I_POOL; cv_plain(a.in[3] + (size_t)(l * 4 + g) * 65536, 256, 256, (bf16*)(C.ws + WS_WPOOL + (size_t)l * 524288), g * 256, r % I_POOL, scr, C.lane); continue; } r -= 4 * I_POOL;
        if (r < I_GU) { cv_gateup(a.in[6] + (size_t)l * D * FF, a.in[7] + (size_t)l * D * FF, (bf16*)(C.ws + WS_WGU + (size_t)l * GU_BYTES), r, scr, C.lane); continue; } r -= I_GU;
        if (r < I_DN) { cv_plain(a.in[8] + (size_t)l * D * FF, FF, D, (bf16*)(C.ws + WS_WDN + (size_t)l * DN_BYTES), 0, r, scr, C.lane); continue; } r -= I_DN;
        if (r < I_IN) { cv_convin(a.in[10] + (size_t)l * D * 3 * D, (bf16*)(C.ws + WS_WIN + (size_t)l * 3 * D * D * 2), r, scr, C.lane); continue; } r -= I_IN;
        cv_plain(a.in[12] + (size_t)l * D * D, D, D, (bf16*)(C.ws + WS_WOUT + (size_t)l * D * D * 2), 0, r, scr, C.lane);
    }
}

__device__ __forceinline__ int prev_row(int row, int i) {
    if (row < MROWS) { const int tp = row & (TS - 1); return tp >= i ? row - i : MROWS + NMETA + tp - i; }
    return row - i;
}
__device__ __forceinline__ void load_heff(const Ctx& C, int row, bool addy1, f32x4 (&x)[4]) {
    const f32x4* p = (const f32x4*)(C.H32 + (size_t)row * D) + C.lane;
#pragma unroll
    for (int j = 0; j < 4; ++j) x[j] = p[64 * j];
    if (addy1) { const v2u* q = (const v2u*)(C.Y1 + (size_t)row * D) + C.lane;
#pragma unroll
        for (int j = 0; j < 4; ++j) { const v2u y = q[64 * j]; x[j] += (f32x4){bf_lo(y.x), bf_hi(y.x), bf_lo(y.y), bf_hi(y.y)}; } }
}
__device__ __forceinline__ float row_rstd(const f32x4 (&x)[4], int lane) {
    float s = 0.f;
#pragma unroll
    for (int j = 0; j < 4; ++j) s += (x[j][0] * x[j][0] + x[j][1] * x[j][1]) + (x[j][2] * x[j][2] + x[j][3] * x[j][3]);
    return __frsqrt_rn(wave_sum(s, lane) * (1.0f / D) + EPS);
}
__device__ __forceinline__ void store_bf16_row(bf16* dst, int row, int lane, const f32x4 (&v)[4]) {
    v2u* o = (v2u*)(dst + (size_t)row * D) + lane;
#pragma unroll
    for (int j = 0; j < 4; ++j) { v2u w; w.x = cvt_pk_bf16(v[j][0], v[j][1]); w.y = cvt_pk_bf16(v[j][2], v[j][3]); o[64 * j] = w; }
}
__device__ __forceinline__ void phase_norm(Ctx& C, const float* gain, bool addy1) {
    f32x4 g[4];
#pragma unroll
    for (int j = 0; j < 4; ++j) g[j] = ((const f32x4*)gain)[C.lane + 64 * j];
    for (int row = C.gw; row < RTOT; row += C.NGW) {
        f32x4 x[4]; load_heff(C, row, addy1, x); const float rs = row_rstd(x, C.lane);
#pragma unroll
        for (int j = 0; j < 4; ++j) x[j] = x[j] * rs * g[j];
        store_bf16_row(C.XN, row, C.lane, x);
    }
}
__device__ __forceinline__ void phase_pool_stats(Ctx& C, bool addy1) {
    for (int row = C.gw; row < RTOT; row += C.NGW) { f32x4 x[4]; load_heff(C, row, addy1, x); const float rs = row_rstd(x, C.lane); if (C.lane == 0) C.RSTD[row] = rs; }
}
__device__ __forceinline__ void phase_pool_diff(Ctx& C, const float* gain, bool addy1) {
    f32x4 g[4];
#pragma unroll
    for (int j = 0; j < 4; ++j) g[j] = ((const f32x4*)gain)[C.lane + 64 * j];
    for (int row = C.gw; row < RTOT; row += C.NGW) {
        const int pos = row >= MROWS ? row - MROWS : NMETA + (row & (TS - 1));
        f32x4 d[4];
#pragma unroll
        for (int j = 0; j < 4; ++j) {
            const int w = 2 << j; const int cnt = (pos + 1) < w ? (pos + 1) : w;
            f32x4 s = (f32x4){0.f, 0.f, 0.f, 0.f}, n0 = s;
            for (int i = 0; i < cnt; ++i) {
                const int pr = prev_row(row, i); const float rs = C.RSTD[pr];
                f32x4 v = ((const f32x4*)(C.H32 + (size_t)pr * D))[C.lane + 64 * j];
                if (addy1) { const v2u y = ((const v2u*)(C.Y1 + (size_t)pr * D))[C.lane + 64 * j]; v += (f32x4){bf_lo(y.x), bf_hi(y.x), bf_lo(y.y), bf_hi(y.y)}; }
                v = v * rs * g[j]; if (i == 0) n0 = v; s += v;
            }
            d[j] = s * (1.0f / (float)cnt) - n0;
        }
        store_bf16_row(C.XN, row, C.lane, d);
    }
}
__device__ __forceinline__ void phase_conv(Ctx& C, const float* ck, const bf16* BG, const bf16* U, bf16* Y) {
    float k[3][2][8];
#pragma unroll
    for (int t = 0; t < 3; ++t)
#pragma unroll
        for (int q = 0; q < 2; ++q) { const f32x4 a = *(const f32x4*)(ck + t * D + 8 * C.lane + 512 * q), b = *(const f32x4*)(ck + t * D + 8 * C.lane + 512 * q + 4);
            k[t][q][0] = a[0]; k[t][q][1] = a[1]; k[t][q][2] = a[2]; k[t][q][3] = a[3]; k[t][q][4] = b[0]; k[t][q][5] = b[1]; k[t][q][6] = b[2]; k[t][q][7] = b[3]; }
    for (int row = C.gw; row < RTOT; row += C.NGW) {
        const int pos = row >= MROWS ? row - MROWS : NMETA + (row & (TS - 1));
#pragma unroll
        for (int q = 0; q < 2; ++q) {
            const int co = 8 * C.lane + 512 * q;
            float s[8];
#pragma unroll
            for (int e = 0; e < 8; ++e) s[e] = 0.f;
#pragma unroll
            for (int t = 0; t < 3; ++t) {
                const int back = 2 - t;
                if (pos >= back) { const v4u uu = *(const v4u*)(U + (size_t)prev_row(row, back) * D + co);
                    s[0] += k[t][q][0] * bf_lo(uu.x); s[1] += k[t][q][1] * bf_hi(uu.x); s[2] += k[t][q][2] * bf_lo(uu.y); s[3] += k[t][q][3] * bf_hi(uu.y);
                    s[4] += k[t][q][4] * bf_lo(uu.z); s[5] += k[t][q][5] * bf_hi(uu.z); s[6] += k[t][q][6] * bf_lo(uu.w); s[7] += k[t][q][7] * bf_hi(uu.w); }
            }
            const v4u bb = *(const v4u*)(BG + (size_t)row * D + co);
            v4u o; o.x = cvt_pk_bf16(bf_lo(bb.x) * s[0], bf_hi(bb.x) * s[1]); o.y = cvt_pk_bf16(bf_lo(bb.y) * s[2], bf_hi(bb.y) * s[3]);
            o.z = cvt_pk_bf16(bf_lo(bb.z) * s[4], bf_hi(bb.z) * s[5]); o.w = cvt_pk_bf16(bf_lo(bb.w) * s[6], bf_hi(bb.w) * s[7]);
            *(v4u*)(Y + (size_t)row * D + co) = o;
        }
    }
}
__device__ __forceinline__ void phase_router(Ctx& C, const float* gain, const float* router, unsigned* gcnt  ) {
    LAS unsigned* lcnt = (LAS unsigned*)C.lds;
    LAS unsigned* lbase = lcnt + 8;
    LAS unsigned* ent = lcnt + 16;
    f32x4 g[4];
#pragma unroll
    for (int j = 0; j < 4; ++j) g[j] = ((const f32x4*)gain)[C.lane + 64 * j];
    unsigned* rowidx = (unsigned*)(C.ws + WS_ROWIDX); int2* slot = (int2*)(C.ws + WS_SLOT);
    const int nchunk = (RTOT + 255) / 256;
    for (int ch = blockIdx.x; ch < nchunk; ch += C.G) {
        const int r0 = ch * 256, nr = (RTOT - r0) < 256 ? (RTOT - r0) : 256;
        __syncthreads();
        if (C.tid < 16) lcnt[C.tid] = 0u;
        __syncthreads();
        for (int lr = C.wave; lr < nr; lr += NWAVES) {
            const int row = r0 + lr;
            f32x4 x[4]; load_heff(C, row, false, x); const float rs = row_rstd(x, C.lane);
#pragma unroll
            for (int j = 0; j < 4; ++j) x[j] = x[j] * rs * g[j];
            { unsigned* o8 = (unsigned*)((unsigned char*)C.XN + (size_t)row * D) + C.lane;
#pragma unroll
              for (int j = 0; j < 4; ++j) o8[64 * j] = pk4_fp8(x[j][0], x[j][1], x[j][2], x[j][3]); }
            float lg[8];
#pragma unroll
            for (int e = 0; e < 8; ++e) lg[e] = 0.f;
#pragma unroll
            for (int j = 0; j < 4; ++j)
#pragma unroll
                for (int i = 0; i < 4; ++i) { const f32x4* rp = (const f32x4*)(router + (size_t)(4 * C.lane + 256 * j + i) * NE); const f32x4 ra = rp[0], rb = rp[1]; const float xv = x[j][i];
                    lg[0] += xv * ra[0]; lg[1] += xv * ra[1]; lg[2] += xv * ra[2]; lg[3] += xv * ra[3]; lg[4] += xv * rb[0]; lg[5] += xv * rb[1]; lg[6] += xv * rb[2]; lg[7] += xv * rb[3]; }
#pragma unroll
            for (int e = 0; e < 8; ++e) lg[e] = wave_sum(lg[e], C.lane);
            int e1 = 0; float v1 = lg[0];
#pragma unroll
            for (int e = 1; e < 8; ++e) if (lg[e] > v1) { v1 = lg[e]; e1 = e; }
            int e2 = -1; float v2 = -3.0e38f;
#pragma unroll
            for (int e = 0; e < 8; ++e) if (e != e1 && lg[e] > v2) { v2 = lg[e]; e2 = e; }
            const float ex = __expf(v2 - v1), w1 = 1.0f / (1.0f + ex), w2 = ex * w1;
            if (C.lane == 0) {
                const unsigned k1 = atomicAdd((unsigned*)&lcnt[e1], 1u), k2 = atomicAdd((unsigned*)&lcnt[e2], 1u);
                ent[(lr * 2 + 0) * 2 + 0] = (unsigned)e1 | (k1 << 8); ent[(lr * 2 + 0) * 2 + 1] = __float_as_uint(w1);
                ent[(lr * 2 + 1) * 2 + 0] = (unsigned)e2 | (k2 << 8); ent[(lr * 2 + 1) * 2 + 1] = __float_as_uint(w2);
            }
        }
        __syncthreads();
        if (C.tid < 8) lbase[C.tid] = __hip_atomic_fetch_add(gcnt + 64 * C.tid, lcnt[C.tid], __ATOMIC_RELAXED, __HIP_MEMORY_SCOPE_AGENT);
        __syncthreads();
        for (int q = C.tid; q < nr * 2; q += NWAVES * 64) {
            const unsigned ek = ent[q * 2], wb = ent[q * 2 + 1]; const int e = ek & 255, rank = ek >> 8, row = r0 + (q >> 1), ch2 = q & 1;
            const int pos = e * CAP + (int)lbase[e] + rank;
            rowidx[pos] = (unsigned)row; slot[pos] = make_int2(row | (ch2 << 31), (int)wb);
        }
    }
    __syncthreads();
}
__device__ __forceinline__ void phase_final(Ctx& C, const float* gain, float* out) {
    f32x4 g[4];
#pragma unroll
    for (int j = 0; j < 4; ++j) g[j] = ((const f32x4*)gain)[C.lane + 64 * j];
    for (int row = C.gw; row < MROWS; row += C.NGW) {
        f32x4 x[4]; load_heff(C, row, true, x); const float rs = row_rstd(x, C.lane);
        f32x4* o = (f32x4*)(out + (size_t)row * D) + C.lane;
#pragma unroll
        for (int j = 0; j < 4; ++j) o[64 * j] = x[j] * rs * g[j];
    }
}
__device__ __forceinline__ void copy_params(Ctx& C, const Args& a) {
    float* P = (float*)(C.ws + WS_PARAMS);
    for (int i = C.gw * 64 + C.lane; i < PP_TOTAL; i += C.NGW * 64) {
        float v;
        if (i < PP_POOL_SCALE) v = a.in[2][i - PP_POOL_NORM];
        else if (i < PP_DENSE_NORM) v = a.in[4][i - PP_POOL_SCALE];
        else if (i < PP_CONV_NORM) v = a.in[5][i - PP_DENSE_NORM];
        else if (i < PP_MOE_NORM) v = a.in[9][i - PP_CONV_NORM];
        else if (i < PP_FINAL) v = a.in[13][i - PP_MOE_NORM];
        else if (i < PP_CONV_K) v = a.in[18][i - PP_FINAL];
        else if (i < PP_ROUTER) v = a.in[11][i - PP_CONV_K];
        else v = a.in[14][i - PP_ROUTER];
        P[i] = v;
    }
}
__device__ __forceinline__ void phase_copy_in(Ctx& C, const float* x, const float* meta) {
    for (int row = C.gw; row < RTOT; row += C.NGW) {
        const f32x4* p = (const f32x4*)(row < MROWS ? x + (size_t)row * D : meta + (size_t)(row - MROWS) * D) + C.lane;
        f32x4* o = (f32x4*)(C.H32 + (size_t)row * D) + C.lane;
#pragma unroll
        for (int j = 0; j < 4; ++j) o[64 * j] = p[64 * j];
    }
}
__device__ __forceinline__ int moe_cnt(unsigned* gcnt, int e) { return __builtin_amdgcn_readfirstlane((int)__hip_atomic_load(gcnt + 64 * e, __ATOMIC_RELAXED, __HIP_MEMORY_SCOPE_AGENT)); }
__device__ __forceinline__ void moe_sched_init(pg8::MoeSched& S, const Ctx& C, unsigned* gcnt, int pass, int nN) {
    S.n0 = moe_cnt(gcnt, 0); S.n1 = moe_cnt(gcnt, 1); S.n2 = moe_cnt(gcnt, 2); S.n3 = moe_cnt(gcnt, 3); S.n4 = moe_cnt(gcnt, 4); S.n5 = moe_cnt(gcnt, 5); S.n6 = moe_cnt(gcnt, 6); S.n7 = moe_cnt(gcnt, 7);
    S.m1 = (S.n0 + 255) >> 8; S.m2 = S.m1 + ((S.n1 + 255) >> 8); S.m3 = S.m2 + ((S.n2 + 255) >> 8); S.m4 = S.m3 + ((S.n3 + 255) >> 8);
    S.m5 = S.m4 + ((S.n4 + 255) >> 8); S.m6 = S.m5 + ((S.n5 + 255) >> 8); S.m7 = S.m6 + ((S.n6 + 255) >> 8);
    const int total = S.m7 + ((S.n7 + 255) >> 8);
    S.t0 = pass * MOE_CH; int nM = total - S.t0; const int cap = (pass == MOE_PASSES - 1) ? MOE_LAST_MAX : MOE_CH; nM = nM < 0 ? 0 : (nM > cap ? cap : nM);
    S.nM = nM; S.nN = nN; S.G = C.G; S.c = (int)blockIdx.x;
}
__device__ __forceinline__ bool relaunder(Ctx& C, unsigned char* ws) { C.lane = lane_id(); C.tid = C.wave * 64 + C.lane;
    { int g = C.gw0; asm volatile("" : "+s"(g)); C.gw = g; }
    size_t z_ = 0; asm volatile("" : "+s"(z_)); ws += z_; C.ws = ws;
    C.H32 = (float*)(ws + WS_H32); C.XN = (bf16*)(ws + WS_XN); C.Y1 = (bf16*)(ws + WS_Y1); C.RSTD = (float*)(ws + WS_RSTD); return true; }
constexpr int N_PHASES = 1 + 2 * (8 + 5 + 2 * MOE_PASSES) + 1;

__global__ void __launch_bounds__(NWAVES * 64, 2) fwd(Args args) {
    extern __shared__ __attribute__((aligned(16))) unsigned char lds_raw[];
    Ctx C;
    C.lds = (LAS unsigned char*)lds_raw;
    C.tid = threadIdx.x; C.lane = C.tid & 63; C.wave = __builtin_amdgcn_readfirstlane(C.tid >> 6);
    C.G = gridDim.x; { const int bx = blockIdx.x; C.vcu = (C.G % 8 == 0) ? (bx % 8) * (C.G / 8) + bx / 8 : bx; }
    C.gw0 = C.vcu * NWAVES + C.wave; C.gw = C.gw0; C.NGW = C.G * NWAVES;
    C.ws = args.ws; C.H32 = (float*)(args.ws + WS_H32); C.XN = (bf16*)(args.ws + WS_XN); C.Y1 = (bf16*)(args.ws + WS_Y1); C.RSTD = (float*)(args.ws + WS_RSTD);
    C.ctl = (unsigned*)(args.ws + WS_CTL);
    LAS unsigned* idxbuf = (LAS unsigned*)(C.lds + IDX_OFF);
    volatile LAS unsigned* MISC = (volatile LAS unsigned*)(C.lds + MISC_OFF);
    for (int u = C.tid; u < (LDS_BYTES - IDX_OFF) / 4; u += NWAVES * 64) ((LAS unsigned*)(C.lds + IDX_OFF))[u] = 0u;
    __syncthreads();
    const int lo = args.ph_lo, hi = args.ph_hi;
    XcdBarrier bar; bar.bar = C.ctl + CW_BAR; bar.x = 0; bar.st = nullptr;
    if (hi - lo > 1) bar = xcd_barrier_post(C.ctl + CW_BAR, MISC + 8);
    int ph = 0;
#define RUN() (ph >= lo && ph < hi && relaunder(C, args.ws))
#define REPE for (int rep_ = 0; rep_ < PROBE_REP_ELT; ++rep_)
#define REPG for (int rep_ = 0; rep_ < PROBE_REP_GEMM; ++rep_)
#define SEAM() do { if (ph >= lo && ph + 1 < hi) xcd_barrier(bar, C.wave); ++ph; } while (0)
#define INTER ((bf16*)(C.ws + WS_INTER))
#define PRM ((const float*)(C.ws + WS_PARAMS))

    if (RUN()) REPE { copy_params(C, args); convert_small_weights(C, args); convert_moe_layer(C, args, 0); convert_moe_layer(C, args, 1); phase_copy_in(C, args.in[0], args.in[1]); }
    SEAM();

    for (int lp = 0; lp < 2; ++lp) {
        const bool addy1 = lp > 0;
        if (RUN()) REPE phase_pool_stats(C, addy1);
        SEAM();
        if (RUN()) REPE phase_pool_diff(C, PRM + PP_POOL_NORM + lp * D, addy1);
        SEAM();
        if (RUN()) {
            pg8::DenseSched S; S.nM = MT_ALL; S.nN = 4; S.G = C.G; S.c = (int)blockIdx.x; S.A = (const char*)C.XN; S.Bt = (const char*)(C.ws + WS_WPOOL + (size_t)lp * 524288);
            S.tstepA = 256u * D * 2; S.tstepB = 256u * 256 * 2; S.a_colstep = 512;
            pg8::EpiResid E{C.H32, addy1 ? C.Y1 : nullptr, PRM + PP_POOL_SCALE + lp * D, 0};
            pg8::gemm_phase<pg8::EpiResid, pg8::DenseSched, false>(C.lds, idxbuf, C.wave, 256 / 64, D * 2, 256 * 2, S, E);
        }
        SEAM();
        if (RUN()) REPE phase_norm(C, PRM + PP_DENSE_NORM + lp * D, false);
        SEAM();
        for (int hf = 0; hf < 2; ++hf) {
            const int pm0 = hf ? DENSE_H0 : 0, nM = hf ? (MT_ALL - DENSE_H0) : DENSE_H0;
            if (RUN()) {
                pg8::DenseSched S; S.nM = nM; S.nN = FF / 128; S.G = C.G; S.c = (int)blockIdx.x; S.A = (const char*)(C.XN + (size_t)pm0 * 256 * D); S.Bt = (const char*)(C.ws + WS_WGU + (size_t)lp * GU_BYTES);
                S.tstepA = 256u * D * 2; S.tstepB = 256u * D * 2; S.a_colstep = 0;
                pg8::EpiSwiGLU E{INTER, FF};
                REPG pg8::gemm_phase<pg8::EpiSwiGLU, pg8::DenseSched, false>(C.lds, idxbuf, C.wave, D / 64, D * 2, D * 2, S, E);
            }
            SEAM();
            if (RUN()) {
                pg8::DenseSched S; S.nM = nM; S.nN = 4; S.G = C.G; S.c = (int)blockIdx.x; S.A = (const char*)INTER; S.Bt = (const char*)(C.ws + WS_WDN + (size_t)lp * DN_BYTES);
                S.tstepA = 256u * FF * 2; S.tstepB = 256u * FF * 2; S.a_colstep = 0;
                pg8::EpiResid E{C.H32, nullptr, nullptr, pm0 * 256};
                pg8::gemm_phase<pg8::EpiResid, pg8::DenseSched, false>(C.lds, idxbuf, C.wave, FF / 64, FF * 2, FF * 2, S, E);
            }
            SEAM();
        }
        if (RUN()) REPE phase_norm(C, PRM + PP_CONV_NORM + lp * D, false);
        SEAM();
#define BG INTER
#define UU (INTER + (size_t)RPAD * D)
        if (RUN()) {
            pg8::DenseSched S; S.nM = MT_ALL; S.nN = 12; S.G = C.G; S.c = (int)blockIdx.x; S.A = (const char*)C.XN; S.Bt = (const char*)(C.ws + WS_WIN + (size_t)lp * 3 * D * D * 2);
            S.tstepA = 256u * D * 2; S.tstepB = 256u * D * 2; S.a_colstep = 0;
            pg8::EpiConvIn E{BG, UU};
            REPG pg8::gemm_phase<pg8::EpiConvIn, pg8::DenseSched, false>(C.lds, idxbuf, C.wave, D / 64, D * 2, D * 2, S, E);
        }
        SEAM();
        if (RUN()) REPE phase_conv(C, PRM + PP_CONV_K + lp * 3 * D, BG, UU, C.XN);
        SEAM();
        if (RUN()) {
            pg8::DenseSched S; S.nM = MT_ALL; S.nN = 4; S.G = C.G; S.c = (int)blockIdx.x; S.A = (const char*)C.XN; S.Bt = (const char*)(C.ws + WS_WOUT + (size_t)lp * D * D * 2);
            S.tstepA = 256u * D * 2; S.tstepB = 256u * D * 2; S.a_colstep = 0;
            pg8::EpiResid E{C.H32, nullptr, nullptr, 0};
            pg8::gemm_phase<pg8::EpiResid, pg8::DenseSched, false>(C.lds, idxbuf, C.wave, D / 64, D * 2, D * 2, S, E);
        }
        SEAM();
#define gcnt ((unsigned*)(C.ws + WS_CTL) + CW_MOECNT + lp * 8 * 64)
        if (RUN()) phase_router(C, PRM + PP_MOE_NORM + lp * D, PRM + PP_ROUTER + lp * D * NE, gcnt);
        SEAM();
        for (int pass = 0; pass < MOE_PASSES; ++pass) {
            if (RUN()) {
                pg8::MoeSched S; moe_sched_init(S, C, gcnt, pass, FF / 128);
                S.A = (const char*)C.XN; S.tstepA = 0; S.Bt = (const char*)(C.ws + WS_WMGU + (size_t)lp * NE * GU8_BYTES); S.estepB = (unsigned)GU8_BYTES; S.tstepB = 256u * D; S.rowidx = (const unsigned*)(C.ws + WS_ROWIDX);
                pg8::EpiSwiGLU8 E{(unsigned char*)INTER, FF};
                REPG pg8::gemm_phase<pg8::EpiSwiGLU8, pg8::MoeSched, true, true>(C.lds, idxbuf, C.wave, D / 128, D, D, S, E, SC_ONE, SC_GU);
            }
            SEAM();
            if (RUN()) {
                pg8::MoeSched S; moe_sched_init(S, C, gcnt, pass, 4);
                S.A = (const char*)INTER; S.tstepA = 256u * FF; S.Bt = (const char*)(C.ws + WS_WMDN + (size_t)lp * NE * DN8_BYTES); S.estepB = (unsigned)DN8_BYTES; S.tstepB = 256u * FF; S.rowidx = nullptr;
                pg8::EpiMoeDown E{(const int2*)(C.ws + WS_SLOT), C.H32, C.Y1};
                pg8::gemm_phase<pg8::EpiMoeDown, pg8::MoeSched, false, true>(C.lds, idxbuf, C.wave, FF / 128, FF, FF, S, E, SC_H, SC_DN);
            }
            SEAM();
        }
    }
    if (RUN()) REPE phase_final(C, PRM + PP_FINAL, args.out);
    SEAM();
#undef RUN
#undef SEAM
#undef INTER
#undef PRM
#undef BG
#undef UU
#undef gcnt
}

extern "C" void kernel_launch(void* const* d_in, const int* in_sizes, int n_in, void* d_out, int out_size, void* d_ws, size_t ws_size, hipStream_t stream) {
    static int grid = 0;
    if (grid == 0) {
        if (n_in != 19 || in_sizes[0] != MROWS * D || out_size != MROWS * D || ws_size < WS_END) {
            fprintf(stderr, "kernel_launch: unexpected problem (n_in %d, in0 %d, out %d, ws %zu < %zu); nothing launched\n", n_in, n_in > 0 ? in_sizes[0] : -1, out_size, ws_size, (size_t)WS_END); grid = -1; return; }
        int dev = 0, cus = 0, per_cu = 0;
        if (hipGetDevice(&dev) != hipSuccess || hipDeviceGetAttribute(&cus, hipDeviceAttributeMultiprocessorCount, dev) != hipSuccess) { grid = -1; return; }
        if (hipFuncSetAttribute((const void*)fwd, hipFuncAttributeMaxDynamicSharedMemorySize, LDS_BYTES) != hipSuccess) { fprintf(stderr, "kernel_launch: hipFuncSetAttribute failed\n"); grid = -1; return; }
        if (hipOccupancyMaxActiveBlocksPerMultiprocessor(&per_cu, (const void*)fwd, NWAVES * 64, LDS_BYTES) != hipSuccess || per_cu < 1)
            fprintf(stderr, "kernel_launch: occupancy query reports %d workgroups per CU\n", per_cu);
        (void)hipGetLastError();
        grid = cus;
    }
    if (grid < 0) return;
    if (hipMemsetAsync((char*)d_ws + WS_CTL, 0, CTL_ZERO_BYTES, stream) != hipSuccess) { fprintf(stderr, "kernel_launch: memset failed\n"); return; }
    Args a{};
    for (int i = 0; i < 19; ++i) a.in[i] = (const float*)d_in[i];
    a.out = (float*)d_out; a.ws = (unsigned char*)d_ws;
#if MK_ONE_LAUNCH
    a.ph_lo = 0; a.ph_hi = N_PHASES;
    hipLaunchKernelGGL(fwd, dim3(grid), dim3(NWAVES * 64), LDS_BYTES, stream, a);
#else
    for (int p = 0; p < N_PHASES; ++p) { a.ph_lo = p; a.ph_hi = p + 1; hipLaunchKernelGGL(fwd, dim3(grid), dim3(NWAVES * 64), LDS_BYTES, stream, a); }
#endif
    const hipError_t le = hipPeekAtLastError();
    if (le != hipSuccess) fprintf(stderr, "kernel_launch: launch failed: %s\n", hipGetErrorName(le));
}
```

```cpp
#include <hip/hip_runtime.h>
#include <cstdio>
#include <cstdint>

#ifndef PROBE_REP_ELT
#define PROBE_REP_ELT 1
#endif
#ifndef PROBE_REP_GEMM
#define PROBE_REP_GEMM 1
#endif
#ifndef MK_ONE_LAUNCH
#define MK_ONE_LAUNCH 1
#endif

constexpr int D = 1024, FF = 3584, NE = 8, NB = 32, TS = 2048, NMETA = 16;
constexpr int MROWS = NB * TS;
constexpr int RTOT = MROWS + NMETA;
constexpr int MT_ALL = 257;
constexpr int RPAD = MT_ALL * 256;
constexpr int CAP = RPAD;
constexpr float EPS = 1e-6f;
constexpr int NWAVES = 8;
constexpr int MOE_CH = 256, MOE_PASSES = 2;
constexpr int MOE_LAST_MAX = 272;
constexpr float W_GU_SCALE = 64.f, W_DN_SCALE = 128.f, H8_SCALE = 4.f;
constexpr int SC_ONE = 0x7f7f7f7f, SC_GU = 0x79797979  , SC_DN = 0x78787878  , SC_H = 0x7d7d7d7d  ;
constexpr int DENSE_H0 = 128;
constexpr int DENSE_FP8_LAYER = 1;

constexpr size_t MiB = 1u << 20;
constexpr size_t WS_CTL = 0, CTL_ZERO_BYTES = 1 * MiB;
constexpr size_t WS_WPOOL = 1 * MiB;
constexpr size_t WS_WGU = 2 * MiB;
constexpr size_t WS_WDN = 30 * MiB;
constexpr size_t WS_WIN = 44 * MiB;
constexpr size_t WS_WOUT = 56 * MiB;
constexpr size_t WS_WMGU = 60 * MiB;
constexpr size_t WS_WMDN = 172 * MiB;
constexpr size_t WS_ROWIDX = 228 * MiB;
constexpr size_t WS_SLOT = 231 * MiB;
constexpr size_t WS_RSTD = 236 * MiB;
constexpr size_t WS_PARAMS = 236 * MiB + 512 * 1024;
constexpr int PP_POOL_NORM = 0, PP_POOL_SCALE = 2048, PP_DENSE_NORM = 4096, PP_CONV_NORM = 6144, PP_MOE_NORM = 8192, PP_FINAL = 10240, PP_CONV_K = 11264, PP_ROUTER = 17408, PP_TOTAL = 17408 + 16384;
constexpr size_t WS_H32 = 237 * MiB;
constexpr size_t WS_XN = 494 * MiB;
constexpr size_t WS_Y1 = 623 * MiB;
constexpr size_t WS_INTER = 752 * MiB;
constexpr size_t WS_END = 1009 * MiB;
constexpr size_t GU_BYTES = (size_t)7168 * 1024 * 2, DN_BYTES = (size_t)1024 * 3584 * 2, GU8_BYTES = GU_BYTES / 2, DN8_BYTES = DN_BYTES / 2;
static_assert(WS_ROWIDX + (size_t)8 * CAP * 4 <= WS_SLOT && WS_SLOT + (size_t)8 * CAP * 8 <= WS_RSTD, "lists");
static_assert(WS_H32 + (size_t)RPAD * D * 4 <= WS_XN && WS_XN + (size_t)RPAD * D * 2 <= WS_Y1 && WS_Y1 + (size_t)RPAD * D * 2 <= WS_INTER, "act map");
static_assert((size_t)MOE_LAST_MAX * 256 * FF <= WS_END - WS_INTER && (size_t)129 * 256 * FF * 2 <= WS_END - WS_INTER && (size_t)2 * RPAD * D * 2 <= WS_END - WS_INTER, "inter");
constexpr int CW_BAR = 4096;
constexpr int CW_MOECNT = 16384;

constexpr int RING_BYTES = 131072;
constexpr int IDX_OFF = RING_BYTES;
constexpr int MISC_OFF = IDX_OFF + 2048;
constexpr int LDS_BYTES = 147456;

#define GAS __attribute__((address_space(1)))
#define LAS __attribute__((address_space(3)))
typedef unsigned short bf16;
typedef float f32x4 __attribute__((ext_vector_type(4)));
typedef unsigned v4u __attribute__((ext_vector_type(4)));
typedef unsigned v2u __attribute__((ext_vector_type(2)));
#define LDS_WAIT() asm volatile("s_waitcnt lgkmcnt(0)" ::: "memory")
#define VM_WAIT() asm volatile("s_waitcnt vmcnt(0)" ::: "memory")

__device__ __forceinline__ int lane_id() { int l; asm volatile("v_mbcnt_lo_u32_b32 %0, -1, 0\n\tv_mbcnt_hi_u32_b32 %0, -1, %0" : "=v"(l)); return l; }
__device__ __forceinline__ unsigned cvt_pk_bf16(float lo, float hi) { unsigned r; asm volatile("v_cvt_pk_bf16_f32 %0, %1, %2" : "=v"(r) : "v"(lo), "v"(hi)); return r; }
__device__ __forceinline__ unsigned pk4_fp8(float a, float b, float c, float d) { int w = __builtin_amdgcn_cvt_pk_fp8_f32(a, b, 0, false); w = __builtin_amdgcn_cvt_pk_fp8_f32(c, d, w, true); return (unsigned)w; }
__device__ __forceinline__ float bf_lo(unsigned w) { return __uint_as_float(w << 16); }
__device__ __forceinline__ float bf_hi(unsigned w) { return __uint_as_float(w & 0xffff0000u); }
__device__ __forceinline__ float wave_sum(float v, int lane) {
#pragma unroll
    for (int o = 1; o < 64; o <<= 1) v += __int_as_float(__builtin_amdgcn_ds_bpermute((lane ^ o) << 2, __float_as_int(v)));
    return v;
}
__device__ __forceinline__ float silu_f(float a) { return a * __builtin_amdgcn_rcpf(1.0f + __builtin_amdgcn_exp2f(a * -1.44269504f)); }

#define XB_TMO      128
#define XB_XCNT(j)  (256  + 64 * (j))
#define XB_XSUB(j)  (1280 + 64 * (j))
#define XB_XGEN(j)  (2304 + 64 * (j))
#define XB_TOP      3328
#define XB_TOPGEN   3392
#define XCD_BAR_WORDS 3456
#define XB_SPIN_CAP (1u << 18)
__device__ __forceinline__ unsigned xb_ld(unsigned* p)              { return __hip_atomic_load(p, __ATOMIC_RELAXED, __HIP_MEMORY_SCOPE_AGENT); }
__device__ __forceinline__ unsigned xb_add(unsigned* p, unsigned v) { return __hip_atomic_fetch_add(p, v, __ATOMIC_RELAXED, __HIP_MEMORY_SCOPE_AGENT); }
__device__ __forceinline__ unsigned xb_xcc_id() { return (unsigned)__builtin_amdgcn_s_getreg((3 << 11) | 20) & 0xFu; }
#define XB_SPIN(cond, bar) do { unsigned _sp = 0; while (cond) { __builtin_amdgcn_s_sleep(1); \
    if ((++_sp & 255u) == 0u) { if (xb_ld(&(bar)[XB_TMO])) break; if (_sp > XB_SPIN_CAP) { atomicAdd(&(bar)[XB_TMO], 1u); break; } } } } while (0)
struct XcdBarrier { unsigned* bar; unsigned x; volatile LAS unsigned* st; };
__device__ __forceinline__ XcdBarrier xcd_barrier_post(unsigned* bar, volatile LAS unsigned* st) {
    XcdBarrier b; b.bar = bar; b.x = xb_xcc_id(); b.st = st;
    if (threadIdx.x == 0) (void)xb_add(&bar[XB_XCNT(b.x)], 1u);
    return b;
}
__device__ __forceinline__ void xcd_barrier_complete(unsigned* bar, unsigned x, unsigned& nloc, unsigned& nx) {
    const unsigned G = gridDim.x * gridDim.y * gridDim.z;
    unsigned sum, cnt, mine, sp = 0u;
    for (;;) {
        sum = 0u; cnt = 0u; mine = 0u;
#pragma unroll
        for (unsigned j = 0; j < 16; ++j) { const unsigned c = xb_ld(&bar[XB_XCNT(j)]); sum += c; cnt += (c > 0u) ? 1u : 0u; mine = (j == x) ? c : mine; }
        if (sum == G) break;
        __builtin_amdgcn_s_sleep(1);
        if ((++sp & 255u) == 0u) { if (xb_ld(&bar[XB_TMO])) break; if (sp > XB_SPIN_CAP) { atomicAdd(&bar[XB_TMO], 1u); break; } }
    }
    nloc = mine > 0u ? mine : 1u; nx = cnt > 0u ? cnt : 1u;
}
__device__ __forceinline__ void xcd_barrier(const XcdBarrier& b, const int wave  ) {
    asm volatile("s_waitcnt vmcnt(0)" ::: "memory");
    __syncthreads();
    if (wave == 0 && lane_id() == 0) {
        size_t z_ = 0; asm volatile("" : "+s"(z_)); unsigned* bar = b.bar + z_;
        __builtin_amdgcn_s_waitcnt(0);
        unsigned nloc = b.st[0], nx = b.st[1];
        if (nloc == 0u) { xcd_barrier_complete(bar, b.x, nloc, nx); b.st[0] = nloc; b.st[1] = nx; }
        const unsigned old = xb_add(&bar[XB_XSUB(b.x)], 1u);
        const unsigned gen = old / nloc;
        if (old + 1u == (gen + 1u) * nloc) {
            __builtin_amdgcn_fence(__ATOMIC_RELEASE, "agent");
            asm volatile("s_waitcnt vmcnt(0)" ::: "memory");
            const unsigned og = xb_add(&bar[XB_TOP], 1u);
            const unsigned tg = og / nx;
            if (og + 1u == (tg + 1u) * nx) xb_add(&bar[XB_TOPGEN], 1u);
            else XB_SPIN(xb_ld(&bar[XB_TOPGEN]) == tg, bar);
            __builtin_amdgcn_fence(__ATOMIC_ACQUIRE, "agent");
            xb_add(&bar[XB_XGEN(b.x)], 1u);
            asm volatile("s_waitcnt vmcnt(0)" ::: "memory");
        } else {
            XB_SPIN(xb_ld(&bar[XB_XGEN(b.x)]) == gen, bar);
            __builtin_amdgcn_fence(__ATOMIC_ACQUIRE, "agent");
            asm volatile("s_waitcnt vmcnt(0)" ::: "memory");
        }
    }
    __syncthreads();
}

namespace pg8 {
typedef short bf16x8 __attribute__((ext_vector_type(8)));
constexpr int BM = 256, BK = 64, HALF = 128, HTB = HALF * BK * 2, STAGE_BYTES = 8 * HTB;
static_assert(STAGE_BYTES == RING_BYTES, "ring");
__host__ __device__ __forceinline__ int lds_byte(int r, int c) { const int st = (r >> 4) * 2 + (c >> 5), rr = r & 15, cc = c & 31, ob = rr * 64 + cc * 2; return st * 1024 + (ob ^ (((ob >> 9) & 1) << 5)); }
__host__ __device__ __forceinline__ void stage_rc(int b, int& R, int& C) { const int st = b / 1024, sb = b % 1024, swz = sb ^ (((sb >> 9) & 1) << 5); R = (st >> 1) * 16 + swz / 64; C = (st & 1) * 32 + (swz % 64) / 2; }
__host__ __device__ __forceinline__ int perm32(int rho) { const int n = rho >> 4, i = rho & 15; return 8 * (i >> 2) + 4 * n + (i & 3); }

struct Unit { int pm, pn, e, rows, slot0; };

__device__ __forceinline__ bool static_tile(int i, int G, int c, int nM, int nN, int& pm, int& pn) {
    const int nwg = nM * nN; const long L = (long)i * G + c; if (L >= nwg) return false;
    int wgid = (int)L; { const int q = nwg / 8, r = nwg % 8, xcd = wgid % 8, off = wgid / 8; wgid = (xcd < r ? xcd * (q + 1) : r * (q + 1) + (xcd - r) * q) + off; }
    const int nig = 8 * nN, gid = wgid / nig, fm = gid * 8, gsz = (nM - fm) < 8 ? (nM - fm) : 8;
    pm = fm + ((wgid % nig) % gsz); pn = (wgid % nig) / gsz; return true;
}
struct DenseSched {
    int nM, nN, G, c; const char* A; const char* Bt; unsigned tstepA, tstepB, a_colstep;
    __device__ __forceinline__ bool next(int i, Unit& u) const { if (!static_tile(i, G, c, nM, nN, u.pm, u.pn)) return false; u.e = 0; u.rows = 256; u.slot0 = 0; return true; }
    __device__ __forceinline__ unsigned a_off(const Unit& u) const { return (unsigned)u.pm * tstepA + (unsigned)u.pn * a_colstep; }
    __device__ __forceinline__ unsigned b_off(const Unit& u) const { return (unsigned)u.pn * tstepB; }
    __device__ __forceinline__ const unsigned* idx_src(const Unit&) const { return nullptr; }
};
struct MoeSched {
    int nM, nN, G, c, t0; int m1, m2, m3, m4, m5, m6, m7; int n0, n1, n2, n3, n4, n5, n6, n7;
    const char* A; unsigned tstepA; const char* Bt; unsigned estepB, tstepB; const unsigned* rowidx;
    __device__ __forceinline__ bool next(int i, Unit& u) const {
        if (!static_tile(i, G, c, nM, nN, u.pm, u.pn)) return false;
        const int tg = t0 + u.pm; int e = 0, base = 0, cn = __builtin_amdgcn_readfirstlane(n0);
        if (tg >= m1) { e = 1; base = m1; cn = __builtin_amdgcn_readfirstlane(n1); }
        if (tg >= m2) { e = 2; base = m2; cn = __builtin_amdgcn_readfirstlane(n2); }
        if (tg >= m3) { e = 3; base = m3; cn = __builtin_amdgcn_readfirstlane(n3); }
        if (tg >= m4) { e = 4; base = m4; cn = __builtin_amdgcn_readfirstlane(n4); }
        if (tg >= m5) { e = 5; base = m5; cn = __builtin_amdgcn_readfirstlane(n5); }
        if (tg >= m6) { e = 6; base = m6; cn = __builtin_amdgcn_readfirstlane(n6); }
        if (tg >= m7) { e = 7; base = m7; cn = __builtin_amdgcn_readfirstlane(n7); }
        const int ti = tg - base; const int rem = cn - 256 * ti;
        u.e = e; u.rows = rem < 256 ? rem : 256; u.slot0 = e * CAP + ti * 256; return true;
    }
    __device__ __forceinline__ unsigned a_off(const Unit& u) const { return (unsigned)u.pm * tstepA; }
    __device__ __forceinline__ unsigned b_off(const Unit& u) const { return (unsigned)u.e * estepB + (unsigned)u.pn * tstepB; }
    __device__ __forceinline__ const unsigned* idx_src(const Unit& u) const { return rowidx + u.slot0; }
};

struct EpiSwiGLU {
    static constexpr bool PERM = true;
    bf16* H; int ldh;
    __device__ __forceinline__ void operator()(const f32x4 (&acc)[2][2][4][2], const Unit& u, int wr, int wc, int fr, int fq) const {
        const int row0 = u.pm * BM + wr * 64 + fr, col0 = u.pn * 128 + wc * 32 + 8 * fq;
#pragma unroll
        for (int ai = 0; ai < 2; ++ai)
#pragma unroll
            for (int m = 0; m < 4; ++m) { bf16* p = H + (size_t)(row0 + ai * HALF + m * 16) * ldh + col0;
                const f32x4 g0 = acc[ai][0][m][0], g1 = acc[ai][0][m][1], u0 = acc[ai][1][m][0], u1 = acc[ai][1][m][1];
                v4u w; w.x = cvt_pk_bf16(silu_f(g0[0]) * u0[0], silu_f(g0[1]) * u0[1]); w.y = cvt_pk_bf16(silu_f(g0[2]) * u0[2], silu_f(g0[3]) * u0[3]);
                w.z = cvt_pk_bf16(silu_f(g1[0]) * u1[0], silu_f(g1[1]) * u1[1]); w.w = cvt_pk_bf16(silu_f(g1[2]) * u1[2], silu_f(g1[3]) * u1[3]);
                *(v4u*)p = w; }
    }
};
struct EpiSwiGLU8 {
    static constexpr bool PERM = true;
    unsigned char* H; int ldh;
    __device__ __forceinline__ void operator()(const f32x4 (&acc)[2][2][4][2], const Unit& u, int wr, int wc, int fr, int fq) const {
        const int row0 = u.pm * BM + wr * 64 + fr, col0 = u.pn * 128 + wc * 32 + 8 * fq;
#pragma unroll
        for (int ai = 0; ai < 2; ++ai)
#pragma unroll
            for (int m = 0; m < 4; ++m) { unsigned char* p = H + (size_t)(row0 + ai * HALF + m * 16) * ldh + col0;
                const f32x4 g0 = acc[ai][0][m][0], g1 = acc[ai][0][m][1], u0 = acc[ai][1][m][0] * H8_SCALE, u1 = acc[ai][1][m][1] * H8_SCALE;
                v2u w; w.x = pk4_fp8(silu_f(g0[0]) * u0[0], silu_f(g0[1]) * u0[1], silu_f(g0[2]) * u0[2], silu_f(g0[3]) * u0[3]);
                w.y = pk4_fp8(silu_f(g1[0]) * u1[0], silu_f(g1[1]) * u1[1], silu_f(g1[2]) * u1[2], silu_f(g1[3]) * u1[3]);
                *(v2u*)p = w; }
    }
};
struct EpiResid {
    static constexpr bool PERM = false;
    float* h; const bf16* y1; const float* scale; int row_off;
    __device__ __forceinline__ void operator()(const f32x4 (&acc)[2][2][4][2], const Unit& u, int wr, int wc, int fr, int fq) const {
        const int row0 = row_off + u.pm * BM + wr * 64 + fr, col0 = u.pn * BM + wc * 32 + 4 * fq;
        f32x4 sc[2][2];
#pragma unroll
        for (int bj = 0; bj < 2; ++bj)
#pragma unroll
            for (int n = 0; n < 2; ++n) sc[bj][n] = scale ? *(const f32x4*)(scale + col0 + bj * HALF + n * 16) : (f32x4){1.f, 1.f, 1.f, 1.f};
#pragma unroll
        for (int ai = 0; ai < 2; ++ai)
#pragma unroll
            for (int m = 0; m < 4; ++m) { const size_t off = (size_t)(row0 + ai * HALF + m * 16) * D + col0;
#pragma unroll
                for (int bj = 0; bj < 2; ++bj)
#pragma unroll
                    for (int n = 0; n < 2; ++n) { f32x4 b = *(const f32x4*)(h + off + bj * HALF + n * 16);
                        if (y1) { const v2u y = *(const v2u*)(y1 + off + bj * HALF + n * 16); b += (f32x4){bf_lo(y.x), bf_hi(y.x), bf_lo(y.y), bf_hi(y.y)}; }
                        *(f32x4*)(h + off + bj * HALF + n * 16) = b + acc[ai][bj][m][n] * sc[bj][n]; }
                asm volatile("" ::: "memory"); }
    }
};
struct EpiConvIn {
    static constexpr bool PERM = true;
    bf16* BG; bf16* U;
    __device__ __forceinline__ void operator()(const f32x4 (&acc)[2][2][4][2], const Unit& u, int wr, int wc, int fr, int fq) const {
        const int row0 = u.pm * BM + wr * 64 + fr;
        if (u.pn < 4) {
            const int col0 = u.pn * BM + wc * 32 + 8 * fq;
#pragma unroll
            for (int ai = 0; ai < 2; ++ai)
#pragma unroll
                for (int m = 0; m < 4; ++m) { bf16* p = BG + (size_t)(row0 + ai * HALF + m * 16) * D + col0;
#pragma unroll
                    for (int bj = 0; bj < 2; ++bj) { const f32x4 v0 = acc[ai][bj][m][0], v1 = acc[ai][bj][m][1];
                        v4u w; w.x = cvt_pk_bf16(v0[0], v0[1]); w.y = cvt_pk_bf16(v0[2], v0[3]); w.z = cvt_pk_bf16(v1[0], v1[1]); w.w = cvt_pk_bf16(v1[2], v1[3]);
                        *(v4u*)(p + bj * HALF) = w; } }
        } else {
            const int col0 = (u.pn - 4) * 128 + wc * 32 + 8 * fq;
#pragma unroll
            for (int ai = 0; ai < 2; ++ai)
#pragma unroll
                for (int m = 0; m < 4; ++m) { bf16* p = U + (size_t)(row0 + ai * HALF + m * 16) * D + col0;
                    const f32x4 c0 = acc[ai][0][m][0], c1 = acc[ai][0][m][1], v0 = acc[ai][1][m][0], v1 = acc[ai][1][m][1];
                    v4u w; w.x = cvt_pk_bf16(c0[0] * v0[0], c0[1] * v0[1]); w.y = cvt_pk_bf16(c0[2] * v0[2], c0[3] * v0[3]);
                    w.z = cvt_pk_bf16(c1[0] * v1[0], c1[1] * v1[1]); w.w = cvt_pk_bf16(c1[2] * v1[2], c1[3] * v1[3]);
                    *(v4u*)p = w; }
        }
    }
};
struct EpiMoeDown {
    static constexpr bool PERM = false;
    const int2* slot; float* h; bf16* y1;
    __device__ __forceinline__ void operator()(const f32x4 (&acc)[2][2][4][2], const Unit& u, int wr, int wc, int fr, int fq) const {
        const int col0 = u.pn * BM + wc * 32 + 4 * fq;
#pragma unroll
        for (int ai = 0; ai < 2; ++ai)
#pragma unroll
            for (int m = 0; m < 4; ++m) { const int rl = ai * HALF + wr * 64 + m * 16 + fr;
                if (rl < u.rows) {
                    const int2 inf = slot[u.slot0 + rl]; const int tok = inf.x & 0x7fffffff; const float w = __int_as_float(inf.y);
                    const size_t off = (size_t)tok * D + col0;
                    if (inf.x >= 0) {
#pragma unroll
                        for (int bj = 0; bj < 2; ++bj)
#pragma unroll
                            for (int n = 0; n < 2; ++n) { const f32x4 b = *(const f32x4*)(h + off + bj * HALF + n * 16); *(f32x4*)(h + off + bj * HALF + n * 16) = b + acc[ai][bj][m][n] * w; }
                    } else {
#pragma unroll
                        for (int bj = 0; bj < 2; ++bj)
#pragma unroll
                            for (int n = 0; n < 2; ++n) { const f32x4 v = acc[ai][bj][m][n] * w; v2u o; o.x = cvt_pk_bf16(v[0], v[1]); o.y = cvt_pk_bf16(v[2], v[3]); *(v2u*)(y1 + off + bj * HALF + n * 16) = o; }
                    }
                }
                asm volatile("" ::: "memory"); }
    }
};

typedef int i32x4 __attribute__((ext_vector_type(4)));
typedef int i32x8 __attribute__((ext_vector_type(8)));
template <class Epi, class Sched, bool GATHER, bool FP8 = false>
__device__ __forceinline__ void gemm_phase(LAS unsigned char* lds, LAS unsigned* idxbuf, const int wid, const int nt, const int lda, const int ldb, const Sched& S, const Epi& E, const int sc_a = 0x7f7f7f7f, const int sc_b = 0x7f7f7f7f) {
    const int lane = lane_id(), tid = wid * 64 + lane, wr = wid >> 2, wc = wid & 3, fr = lane & 15, fq = lane >> 4;
    unsigned voffA[2], voffB[2], voffG[2][2];
#pragma unroll
    for (int i = 0; i < 2; ++i) { int R, C; stage_rc(tid * 16 + i * 8192, R, C); const int Rb = Epi::PERM ? ((R & ~31) + perm32(R & 31)) : R;
        voffA[i] = (unsigned)(R * lda + C * 2); voffB[i] = (unsigned)(Rb * ldb + C * 2); voffG[0][i] = 0u; voffG[1][i] = 0u; }
    const __amdgpu_buffer_rsrc_t rA = __builtin_amdgcn_make_buffer_rsrc((void*)S.A, 0, 0x7ffffff0, 0x00020000), rB = __builtin_amdgcn_make_buffer_rsrc((void*)S.Bt, 0, 0x7ffffff0, 0x00020000);
    const unsigned kstep = (unsigned)(BK * 2);
    const unsigned hstepA = (unsigned)HALF * lda, hstepB = (unsigned)HALF * ldb;
    const unsigned ldsw = (unsigned)wid * 1024u;
    const int aoff = lds_byte(wr * 64 + fr, fq * 8), boff = lds_byte(wc * 32 + fr, fq * 8);
#define PG8_SA(b, h) (((b) * 2 + (h)) * HTB)
#define PG8_SB(b, h) ((4 + (b) * 2 + (h)) * HTB)
#define PG8_STAGE(bufoff, rsrc, soff, voff) do { _Pragma("unroll") for (int _i = 0; _i < 2; ++_i) \
        __builtin_amdgcn_raw_ptr_buffer_load_lds(rsrc, (LAS void*)(lds + (bufoff) + ldsw + _i * 8192), 16, (int)(voff)[_i], (int)(soff), 0, 0); } while (0)
#define PG8_STAGE_A(bufoff, soff, h) do { if constexpr (GATHER) { PG8_STAGE(bufoff, rA, soff, voffG[h]); } else { PG8_STAGE(bufoff, rA, (soff) + (h) * hstepA, voffA); } } while (0)
#define PG8_STAGE_B(bufoff, soff, h) PG8_STAGE(bufoff, rB, (soff) + (h) * hstepB, voffB)
#define PG8_LDA(dst, b, h) do { _Pragma("unroll") for (int m = 0; m < 4; ++m) _Pragma("unroll") for (int k = 0; k < 2; ++k) dst[m][k] = *(const LAS bf16x8*)(lds + PG8_SA(b, h) + aoff + m * 2048 + k * 1024); } while (0)
#define PG8_LDB(dst, b, h) do { _Pragma("unroll") for (int n = 0; n < 2; ++n) _Pragma("unroll") for (int k = 0; k < 2; ++k) dst[n][k] = *(const LAS bf16x8*)(lds + PG8_SB(b, h) + boff + n * 2048 + k * 1024); } while (0)
#define PG8_MMA(ai, bj, At, Bt) do { __builtin_amdgcn_s_setprio(1); _Pragma("unroll") for (int m = 0; m < 4; ++m) _Pragma("unroll") for (int n = 0; n < 2; ++n) _Pragma("unroll") for (int k = 0; k < 2; ++k) \
        acc[ai][bj][m][n] = __builtin_amdgcn_mfma_f32_16x16x32_bf16(Bt[n][k], At[m][k], acc[ai][bj][m][n], 0, 0, 0); __builtin_amdgcn_s_setprio(0); } while (0)
#define PG8_CAT(x) __builtin_shufflevector((i32x4)(x)[0], (i32x4)(x)[1], 0, 1, 2, 3, 4, 5, 6, 7)
#define PG8_MMA8(ai, bj, At, Bt) do { __builtin_amdgcn_s_setprio(1); _Pragma("unroll") for (int m = 0; m < 4; ++m) _Pragma("unroll") for (int n = 0; n < 2; ++n) \
        acc[ai][bj][m][n] = __builtin_amdgcn_mfma_scale_f32_16x16x128_f8f6f4(PG8_CAT(Bt[n]), PG8_CAT(At[m]), acc[ai][bj][m][n], 0, 0, 0, sc_b, 0, sc_a); __builtin_amdgcn_s_setprio(0); } while (0)
#define PG8_MM(ai, bj, At, Bt) do { if constexpr (FP8) PG8_MMA8(ai, bj, At, Bt); else PG8_MMA(ai, bj, At, Bt); } while (0)
#define PG8_WAIT_V(n) asm volatile("s_waitcnt vmcnt(" #n ")" ::: "memory")
#define PG8_WAIT_L(n) asm volatile("s_waitcnt lgkmcnt(" #n ")" ::: "memory")
#define PG8_BAR __builtin_amdgcn_s_barrier()
#define PG8_SCHED __builtin_amdgcn_sched_barrier(0)
#define PG8_LOAD_VOFFG(ib, nrows) do { asm volatile("" ::: "memory"); _Pragma("unroll") for (int _i = 0; _i < 2; ++_i) { int _R, _C; stage_rc(tid * 16 + _i * 8192, _R, _C); \
        _Pragma("unroll") for (int _h = 0; _h < 2; ++_h) { const int _rl = _h * HALF + _R; unsigned _ix = (ib)[_rl]; _ix = (_rl < (nrows)) ? _ix : 0u; voffG[_h][_i] = _ix * (unsigned)lda + (unsigned)(_C * 2); } } } while (0)
#define PG8_IDX_DMA(src, ib) __builtin_amdgcn_global_load_lds((const unsigned*)((src) + lane * 4), (LAS unsigned*)(ib), 16, 0, 0)
    Unit cur, nxt; int ui = 0;
    if (!S.next(0, cur)) return;
    f32x4 acc[2][2][4][2];
#pragma unroll
    for (int a = 0; a < 2; ++a)
#pragma unroll
        for (int b = 0; b < 2; ++b)
#pragma unroll
            for (int m = 0; m < 4; ++m)
#pragma unroll
                for (int n = 0; n < 2; ++n) acc[a][b][m][n] = (f32x4){0.f, 0.f, 0.f, 0.f};
    bf16x8 At[4][2], B0[2][2], B1[2][2];
    unsigned cA = S.a_off(cur), cB = S.b_off(cur);
    if constexpr (GATHER) {
        if (wid == 0) PG8_IDX_DMA(S.idx_src(cur), idxbuf);
        PG8_WAIT_V(0); PG8_BAR;
        PG8_LOAD_VOFFG(idxbuf, cur.rows);
    }
    PG8_STAGE_B(PG8_SB(0, 0), cB, 0); PG8_STAGE_B(PG8_SB(0, 1), cB, 1); PG8_STAGE_A(PG8_SA(0, 0), cA, 0); PG8_STAGE_A(PG8_SA(0, 1), cA, 1);
    if (wr == 1) PG8_BAR;
    PG8_WAIT_V(2); PG8_BAR;
    PG8_STAGE_B(PG8_SB(1, 0), cB + kstep, 0); PG8_STAGE_A(PG8_SA(1, 0), cA + kstep, 0); PG8_STAGE_B(PG8_SB(1, 1), cB + kstep, 1);
    PG8_WAIT_V(6); PG8_BAR;
    for (;;) {
        const bool has_next = S.next(ui + 1, nxt);
        const unsigned nA = has_next ? S.a_off(nxt) : cA, nB = has_next ? S.b_off(nxt) : cB;
        if constexpr (GATHER) { if (has_next && wid == 0) PG8_IDX_DMA(S.idx_src(nxt), idxbuf + ((ui + 1) & 1) * 256); }
#pragma nounroll
        for (int t = 0; t < nt; t += 2) {
            const bool last = (t == nt - 2);
            const unsigned a1 = cA + (unsigned)(t + 1) * kstep;
            const unsigned a2 = last ? nA : cA + (unsigned)(t + 2) * kstep, b2 = last ? nB : cB + (unsigned)(t + 2) * kstep;
            const unsigned a3 = a2 + kstep, b3 = b2 + kstep;
            PG8_LDB(B0, 0, 0); PG8_LDB(B1, 0, 1); PG8_SCHED; PG8_LDA(At, 0, 0); PG8_STAGE_A(PG8_SA(1, 1), a1, 1);
            PG8_WAIT_V(8); PG8_WAIT_L(0); PG8_BAR; PG8_MM(0, 0, At, B0); PG8_MM(0, 1, At, B1); PG8_BAR; PG8_SCHED;
            if constexpr (GATHER) { if (last && has_next) PG8_LOAD_VOFFG(idxbuf + ((ui + 1) & 1) * 256, nxt.rows); }
            PG8_LDA(At, 0, 1); PG8_STAGE_B(PG8_SB(0, 0), b2, 0); PG8_STAGE_B(PG8_SB(0, 1), b2, 1); PG8_STAGE_A(PG8_SA(0, 0), a2, 0);
            PG8_WAIT_V(8); PG8_WAIT_L(0); PG8_BAR; PG8_MM(1, 0, At, B0); PG8_MM(1, 1, At, B1); PG8_BAR; PG8_SCHED;
            PG8_LDB(B0, 1, 0); PG8_LDB(B1, 1, 1); PG8_SCHED; PG8_LDA(At, 1, 0); PG8_STAGE_A(PG8_SA(0, 1), a2, 1);
            PG8_WAIT_V(8); PG8_WAIT_L(0); PG8_BAR; PG8_MM(0, 0, At, B0); PG8_MM(0, 1, At, B1); PG8_BAR; PG8_SCHED;
            PG8_LDA(At, 1, 1); PG8_STAGE_B(PG8_SB(1, 0), b3, 0); PG8_STAGE_B(PG8_SB(1, 1), b3, 1); PG8_STAGE_A(PG8_SA(1, 0), a3, 0);
            PG8_WAIT_V(8); PG8_WAIT_L(0); PG8_BAR; PG8_MM(1, 0, At, B0); PG8_MM(1, 1, At, B1); PG8_BAR; PG8_SCHED;
        }
        if (wr == 0) PG8_BAR;
        { const int ln = lane_id(); E(acc, cur, wr, wc, ln & 15, ln >> 4); }
        if (!has_next) break;
#pragma unroll
        for (int a = 0; a < 2; ++a)
#pragma unroll
            for (int b = 0; b < 2; ++b)
#pragma unroll
                for (int m = 0; m < 4; ++m)
#pragma unroll
                    for (int n = 0; n < 2; ++n) acc[a][b][m][n] = (f32x4){0.f, 0.f, 0.f, 0.f};
        cur = nxt; cA = nA; cB = nB; ++ui;
        if (wr == 1) PG8_BAR;
    }
    PG8_WAIT_V(0);
    PG8_BAR;
#undef PG8_SA
#undef PG8_SB
#undef PG8_STAGE
#undef PG8_STAGE_A
#undef PG8_STAGE_B
#undef PG8_LDA
#undef PG8_LDB
#undef PG8_MMA
#undef PG8_MMA8
#undef PG8_MM
#undef PG8_CAT
#undef PG8_WAIT_V
#undef PG8_WAIT_L
#undef PG8_BAR
#undef PG8_SCHED
#undef PG8_LOAD_VOFFG
#undef PG8_IDX_DMA
}
}

struct Args { const float* in[19]; float* out; unsigned char* ws; int ph_lo, ph_hi; };
struct Ctx {
    LAS unsigned char* lds; int tid, lane, wave, G, vcu, gw, NGW, gw0;
    unsigned char* ws; float* H32; bf16* XN; bf16* Y1; float* RSTD; unsigned* ctl;
};

__device__ __forceinline__ void tr_item(const float* W, int ldw, int k0, int n0, bf16* WT, int K, int drow0, LAS float* scr, int lane) {
#pragma unroll 8
    for (int i = 0; i < 32; ++i) { const int kk = 2 * i + (lane >> 5); scr[kk * 33 + (lane & 31)] = W[(size_t)(k0 + kk) * ldw + n0 + (lane & 31)]; }
    LDS_WAIT();
    const int c = lane & 7;
#pragma unroll
    for (int j = 0; j < 4; ++j) { const int n = (lane >> 3) + 8 * j; const LAS float* s = scr + (8 * c) * 33 + n;
        v4u o; o.x = cvt_pk_bf16(s[0 * 33], s[1 * 33]); o.y = cvt_pk_bf16(s[2 * 33], s[3 * 33]); o.z = cvt_pk_bf16(s[4 * 33], s[5 * 33]); o.w = cvt_pk_bf16(s[6 * 33], s[7 * 33]);
        *(v4u*)(WT + (size_t)(drow0 + n) * K + k0 + 8 * c) = o; }
    LDS_WAIT();
}
__device__ __forceinline__ void tr_item8(const float* W, int ldw, int k0, int n0, unsigned char* WT, int K, int drow0, float scale, LAS float* scr, int lane) {
#pragma unroll 8
    for (int i = 0; i < 32; ++i) { const int kk = 2 * i + (lane >> 5); scr[kk * 33 + (lane & 31)] = W[(size_t)(k0 + kk) * ldw + n0 + (lane & 31)] * scale; }
    LDS_WAIT();
    const int c = lane & 7;
#pragma unroll
    for (int j = 0; j < 4; ++j) { const int n = (lane >> 3) + 8 * j; const LAS float* s = scr + (8 * c) * 33 + n;
        v2u o; o.x = pk4_fp8(s[0 * 33], s[1 * 33], s[2 * 33], s[3 * 33]); o.y = pk4_fp8(s[4 * 33], s[5 * 33], s[6 * 33], s[7 * 33]);
        *(v2u*)(WT + (size_t)(drow0 + n) * K + k0 + 8 * c) = o; }
    LDS_WAIT();
}
__device__ __forceinline__ void cv_gateup(const float* Wg, const float* Wu, bf16* dst, int item, LAS float* scr, int lane) {
    const int kind = item / 1792, r = item % 1792, kb = r / 112, nb = r % 112, n0 = 32 * nb;
    tr_item(kind ? Wu : Wg, FF, 64 * kb, n0, dst, D, (n0 >> 7) * 256 + (n0 & 127) + kind * 128, scr, lane);
}
__device__ __forceinline__ void cv_plain(const float* W, int K, int N, bf16* dst, int drow_off, int item, LAS float* scr, int lane) {
    const int nbn = N / 32, kb = item / nbn, nb = item % nbn;
    tr_item(W, N, 64 * kb, 32 * nb, dst, K, drow_off + 32 * nb, scr, lane);
}
__device__ __forceinline__ void cv_convin(const float* W, bf16* dst, int item, LAS float* scr, int lane) {
    const int kb = item / 96, nb = item % 96, n0 = 32 * nb; int dr;
    if (n0 < 1024) dr = n0; else if (n0 < 2048) dr = 1024 + ((n0 - 1024) >> 7) * 256 + (n0 & 127); else dr = 1024 + ((n0 - 2048) >> 7) * 256 + 128 + (n0 & 127);
    tr_item(W, 3 * D, 64 * kb, n0, dst, D, dr, scr, lane);
}
__device__ __forceinline__ void convert_moe_layer(Ctx& C, const Args& a, int j) {
    LAS float* scr = (LAS float*)(C.lds + C.wave * 16384);
    constexpr int PER_E = 3584 + 1792;
    for (int it = C.gw; it < NE * PER_E; it += C.NGW) {
        const int e = it / PER_E, r = it % PER_E; const size_t wo = ((size_t)j * NE + e) * D * FF;
        if (r < 3584) { const int kind = r / 1792, q = r % 1792, kb = q / 112, nb = q % 112, n0 = 32 * nb;
            tr_item8((kind ? a.in[16] : a.in[15]) + wo, FF, 64 * kb, n0, C.ws + WS_WMGU + (size_t)(j * NE + e) * GU8_BYTES, D, (n0 >> 7) * 256 + (n0 & 127) + kind * 128, W_GU_SCALE, scr, C.lane); }
        else { const int q = r - 3584, kb = q / 32, nb = q % 32;
            tr_item8(a.in[17] + wo, D, 64 * kb, 32 * nb, C.ws + WS_WMDN + (size_t)(j * NE + e) * DN8_BYTES, FF, 32 * nb, W_DN_SCALE, scr, C.lane); }
    }
}
__device__ __forceinline__ void convert_small_weights(Ctx& C, const Args& a) {
    LAS float* scr = (LAS float*)(C.lds + C.wave * 16384);
    constexpr int I_POOL = 32, I_GU = 3584, I_DN = 1792, I_IN = 1536, I_OUT = 512;
    constexpr int PER_L = 4 * I_POOL + I_GU + I_DN + I_IN + I_OUT;
    for (int it = C.gw; it < 2 * PER_L; it += C.NGW) {
        const int l = it / PER_L; int r = it % PER_L;
        if (r < 4 * I_POOL) { const int g = r / I_POOL; cv_plain(a.in[3] + (size_t)(l * 4 + g) * 65536, 256, 256, (bf16*)(C.ws + WS_WPOOL + (size_t)l * 524288), g * 256, r % I_POOL, scr, C.lane); continue; } r -= 4 * I_POOL;
        if (r < I_GU) {
            if (l == DENSE_FP8_LAYER) { const int kind = r / 1792, q = r % 1792, kb = q / 112, nb = q % 112, n0 = 32 * nb;
                tr_item8((kind ? a.in[7] : a.in[6]) + (size_t)l * D * FF, FF, 64 * kb, n0, C.ws + WS_WGU + (size_t)l * GU_BYTES, D, (n0 >> 7) * 256 + (n0 & 127) + kind * 128, W_GU_SCALE, scr, C.lane); }
            else cv_gateup(a.in[6] + (size_t)l * D * FF, a.in[7] + (size_t)l * D * FF, (bf16*)(C.ws + WS_WGU + (size_t)l * GU_BYTES), r, scr, C.lane);
            continue; } r -= I_GU;
        if (r < I_DN) {
            if (l == DENSE_FP8_LAYER) { const int kb = r / 32, nb = r % 32; tr_item8(a.in[8] + (size_t)l * D * FF, D, 64 * kb, 32 * nb, C.ws + WS_WDN + (size_t)l * DN_BYTES, FF, 32 * nb, W_DN_SCALE, scr, C.lane); }
            else cv_plain(a.in[8] + (size_t)l * D * FF, FF, D, (bf16*)(C.ws + WS_WDN + (size_t)l * DN_BYTES), 0, r, scr, C.lane);
            continue; } r -= I_DN;
        if (r < I_IN) { cv_convin(a.in[10] + (size_t)l * D * 3 * D, (bf16*)(C.ws + WS_WIN + (size_t)l * 3 * D * D * 2), r, scr, C.lane); continue; } r -= I_IN;
        cv_plain(a.in[12] + (size_t)l * D * D, D, D, (bf16*)(C.ws + WS_WOUT + (size_t)l * D * D * 2), 0, r, scr, C.lane);
    }
}

__device__ __forceinline__ int prev_row(int row, int i) {
    if (row < MROWS) { const int tp = row & (TS - 1); return tp >= i ? row - i : MROWS + NMETA + tp - i; }
    return row - i;
}
__device__ __forceinline__ void load_heff(const Ctx& C, int row, bool addy1, f32x4 (&x)[4]) {
    const f32x4* p = (const f32x4*)(C.H32 + (size_t)row * D) + C.lane;
#pragma unroll
    for (int j = 0; j < 4; ++j) x[j] = p[64 * j];
    if (addy1) { const v2u* q = (const v2u*)(C.Y1 + (size_t)row * D) + C.lane;
#pragma unroll
        for (int j = 0; j < 4; ++j) { const v2u y = q[64 * j]; x[j] += (f32x4){bf_lo(y.x), bf_hi(y.x), bf_lo(y.y), bf_hi(y.y)}; } }
}
__device__ __forceinline__ float row_rstd(const f32x4 (&x)[4], int lane) {
    float s = 0.f;
#pragma unroll
    for (int j = 0; j < 4; ++j) s += (x[j][0] * x[j][0] + x[j][1] * x[j][1]) + (x[j][2] * x[j][2] + x[j][3] * x[j][3]);
    return __frsqrt_rn(wave_sum(s, lane) * (1.0f / D) + EPS);
}
__device__ __forceinline__ void store_bf16_row(bf16* dst, int row, int lane, const f32x4 (&v)[4]) {
    v2u* o = (v2u*)(dst + (size_t)row * D) + lane;
#pragma unroll
    for (int j = 0; j < 4; ++j) { v2u w; w.x = cvt_pk_bf16(v[j][0], v[j][1]); w.y = cvt_pk_bf16(v[j][2], v[j][3]); o[64 * j] = w; }
}
__device__ __forceinline__ void phase_norm(Ctx& C, const float* gain, bool addy1, bool out8 = false) {
    f32x4 g[4];
#pragma unroll
    for (int j = 0; j < 4; ++j) g[j] = ((const f32x4*)gain)[C.lane + 64 * j];
    for (int row = C.gw; row < RTOT; row += C.NGW) {
        f32x4 x[4]; load_heff(C, row, addy1, x); const float rs = row_rstd(x, C.lane);
#pragma unroll
        for (int j = 0; j < 4; ++j) x[j] = x[j] * rs * g[j];
        if (out8) { unsigned* o8 = (unsigned*)((unsigned char*)C.XN + (size_t)row * D) + C.lane;
#pragma unroll
            for (int j = 0; j < 4; ++j) o8[64 * j] = pk4_fp8(x[j][0], x[j][1], x[j][2], x[j][3]); }
        else store_bf16_row(C.XN, row, C.lane, x);
    }
}
__device__ __forceinline__ void phase_pool_stats(Ctx& C, bool addy1) {
    for (int row = C.gw; row < RTOT; row += C.NGW) { f32x4 x[4]; load_heff(C, row, addy1, x); const float rs = row_rstd(x, C.lane); if (C.lane == 0) C.RSTD[row] = rs; }
}
__device__ __forceinline__ void phase_pool_diff(Ctx& C, const float* gain, bool addy1) {
    f32x4 g[4];
#pragma unroll
    for (int j = 0; j < 4; ++j) g[j] = ((const f32x4*)gain)[C.lane + 64 * j];
    for (int row = C.gw; row < RTOT; row += C.NGW) {
        const int pos = row >= MROWS ? row - MROWS : NMETA + (row & (TS - 1));
        f32x4 d[4];
#pragma unroll
        for (int j = 0; j < 4; ++j) {
            const int w = 2 << j; const int cnt = (pos + 1) < w ? (pos + 1) : w;
            f32x4 s = (f32x4){0.f, 0.f, 0.f, 0.f}, n0 = s;
            for (int i = 0; i < cnt; ++i) {
                const int pr = prev_row(row, i); const float rs = C.RSTD[pr];
                f32x4 v = ((const f32x4*)(C.H32 + (size_t)pr * D))[C.lane + 64 * j];
                if (addy1) { const v2u y = ((const v2u*)(C.Y1 + (size_t)pr * D))[C.lane + 64 * j]; v += (f32x4){bf_lo(y.x), bf_hi(y.x), bf_lo(y.y), bf_hi(y.y)}; }
                v = v * rs * g[j]; if (i == 0) n0 = v; s += v;
            }
            d[j] = s * (1.0f / (float)cnt) - n0;
        }
        store_bf16_row(C.XN, row, C.lane, d);
    }
}
__device__ __forceinline__ void phase_conv(Ctx& C, const float* ck, const bf16* BG, const bf16* U, bf16* Y) {
    float k[3][2][8];
#pragma unroll
    for (int t = 0; t < 3; ++t)
#pragma unroll
        for (int q = 0; q < 2; ++q) { const f32x4 a = *(const f32x4*)(ck + t * D + 8 * C.lane + 512 * q), b = *(const f32x4*)(ck + t * D + 8 * C.lane + 512 * q + 4);
            k[t][q][0] = a[0]; k[t][q][1] = a[1]; k[t][q][2] = a[2]; k[t][q][3] = a[3]; k[t][q][4] = b[0]; k[t][q][5] = b[1]; k[t][q][6] = b[2]; k[t][q][7] = b[3]; }
    for (int row = C.gw; row < RTOT; row += C.NGW) {
        const int pos = row >= MROWS ? row - MROWS : NMETA + (row & (TS - 1));
#pragma unroll
        for (int q = 0; q < 2; ++q) {
            const int co = 8 * C.lane + 512 * q;
            float s[8];
#pragma unroll
            for (int e = 0; e < 8; ++e) s[e] = 0.f;
#pragma unroll
            for (int t = 0; t < 3; ++t) {
                const int back = 2 - t;
                if (pos >= back) { const v4u uu = *(const v4u*)(U + (size_t)prev_row(row, back) * D + co);
                    s[0] += k[t][q][0] * bf_lo(uu.x); s[1] += k[t][q][1] * bf_hi(uu.x); s[2] += k[t][q][2] * bf_lo(uu.y); s[3] += k[t][q][3] * bf_hi(uu.y);
                    s[4] += k[t][q][4] * bf_lo(uu.z); s[5] += k[t][q][5] * bf_hi(uu.z); s[6] += k[t][q][6] * bf_lo(uu.w); s[7] += k[t][q][7] * bf_hi(uu.w); }
            }
            const v4u bb = *(const v4u*)(BG + (size_t)row * D + co);
            v4u o; o.x = cvt_pk_bf16(bf_lo(bb.x) * s[0], bf_hi(bb.x) * s[1]); o.y = cvt_pk_bf16(bf_lo(bb.y) * s[2], bf_hi(bb.y) * s[3]);
            o.z = cvt_pk_bf16(bf_lo(bb.z) * s[4], bf_hi(bb.z) * s[5]); o.w = cvt_pk_bf16(bf_lo(bb.w) * s[6], bf_hi(bb.w) * s[7]);
            *(v4u*)(Y + (size_t)row * D + co) = o;
        }
    }
}
__device__ __forceinline__ void phase_router(Ctx& C, const float* gain, const float* router, unsigned* gcnt  ) {
    LAS unsigned* lcnt = (LAS unsigned*)C.lds;
    LAS unsigned* lbase = lcnt + 8;
    LAS unsigned* ent = lcnt + 16;
    f32x4 g[4];
#pragma unroll
    for (int j = 0; j < 4; ++j) g[j] = ((const f32x4*)gain)[C.lane + 64 * j];
    unsigned* rowidx = (unsigned*)(C.ws + WS_ROWIDX); int2* slot = (int2*)(C.ws + WS_SLOT);
    const int nchunk = (RTOT + 255) / 256;
    for (int ch = blockIdx.x; ch < nchunk; ch += C.G) {
        const int r0 = ch * 256, nr = (RTOT - r0) < 256 ? (RTOT - r0) : 256;
        __syncthreads();
        if (C.tid < 16) lcnt[C.tid] = 0u;
        __syncthreads();
        for (int lr = C.wave; lr < nr; lr += NWAVES) {
            const int row = r0 + lr;
            f32x4 x[4]; load_heff(C, row, false, x); const float rs = row_rstd(x, C.lane);
#pragma unroll
            for (int j = 0; j < 4; ++j) x[j] = x[j] * rs * g[j];
            { unsigned* o8 = (unsigned*)((unsigned char*)C.XN + (size_t)row * D) + C.lane;
#pragma unroll
              for (int j = 0; j < 4; ++j) o8[64 * j] = pk4_fp8(x[j][0], x[j][1], x[j][2], x[j][3]); }
            float lg[8];
#pragma unroll
            for (int e = 0; e < 8; ++e) lg[e] = 0.f;
#pragma unroll
            for (int j = 0; j < 4; ++j)
#pragma unroll
                for (int i = 0; i < 4; ++i) { const f32x4* rp = (const f32x4*)(router + (size_t)(4 * C.lane + 256 * j + i) * NE); const f32x4 ra = rp[0], rb = rp[1]; const float xv = x[j][i];
                    lg[0] += xv * ra[0]; lg[1] += xv * ra[1]; lg[2] += xv * ra[2]; lg[3] += xv * ra[3]; lg[4] += xv * rb[0]; lg[5] += xv * rb[1]; lg[6] += xv * rb[2]; lg[7] += xv * rb[3]; }
#pragma unroll
            for (int e = 0; e < 8; ++e) lg[e] = wave_sum(lg[e], C.lane);
            int e1 = 0; float v1 = lg[0];
#pragma unroll
            for (int e = 1; e < 8; ++e) if (lg[e] > v1) { v1 = lg[e]; e1 = e; }
            int e2 = -1; float v2 = -3.0e38f;
#pragma unroll
            for (int e = 0; e < 8; ++e) if (e != e1 && lg[e] > v2) { v2 = lg[e]; e2 = e; }
            const float ex = __expf(v2 - v1), w1 = 1.0f / (1.0f + ex), w2 = ex * w1;
            if (C.lane == 0) {
                const unsigned k1 = atomicAdd((unsigned*)&lcnt[e1], 1u), k2 = atomicAdd((unsigned*)&lcnt[e2], 1u);
                ent[(lr * 2 + 0) * 2 + 0] = (unsigned)e1 | (k1 << 8); ent[(lr * 2 + 0) * 2 + 1] = __float_as_uint(w1);
                ent[(lr * 2 + 1) * 2 + 0] = (unsigned)e2 | (k2 << 8); ent[(lr * 2 + 1) * 2 + 1] = __float_as_uint(w2);
            }
        }
        __syncthreads();
        if (C.tid < 8) lbase[C.tid] = __hip_atomic_fetch_add(gcnt + 64 * C.tid, lcnt[C.tid], __ATOMIC_RELAXED, __HIP_MEMORY_SCOPE_AGENT);
        __syncthreads();
        for (int q = C.tid; q < nr * 2; q += NWAVES * 64) {
            const unsigned ek = ent[q * 2], wb = ent[q * 2 + 1]; const int e = ek & 255, rank = ek >> 8, row = r0 + (q >> 1), ch2 = q & 1;
            const int pos = e * CAP + (int)lbase[e] + rank;
            rowidx[pos] = (unsigned)row; slot[pos] = make_int2(row | (ch2 << 31), (int)wb);
        }
    }
    __syncthreads();
}
__device__ __forceinline__ void phase_final(Ctx& C, const float* gain, float* out) {
    f32x4 g[4];
#pragma unroll
    for (int j = 0; j < 4; ++j) g[j] = ((const f32x4*)gain)[C.lane + 64 * j];
    for (int row = C.gw; row < MROWS; row += C.NGW) {
        f32x4 x[4]; load_heff(C, row, true, x); const float rs = row_rstd(x, C.lane);
        f32x4* o = (f32x4*)(out + (size_t)row * D) + C.lane;
#pragma unroll
        for (int j = 0; j < 4; ++j) o[64 * j] = x[j] * rs * g[j];
    }
}
__device__ __forceinline__ void copy_params(Ctx& C, const Args& a) {
    float* P = (float*)(C.ws + WS_PARAMS);
    for (int i = C.gw * 64 + C.lane; i < PP_TOTAL; i += C.NGW * 64) {
        float v;
        if (i < PP_POOL_SCALE) v = a.in[2][i - PP_POOL_NORM];
        else if (i < PP_DENSE_NORM) v = a.in[4][i - PP_POOL_SCALE];
        else if (i < PP_CONV_NORM) v = a.in[5][i - PP_DENSE_NORM];
        else if (i < PP_MOE_NORM) v = a.in[9][i - PP_CONV_NORM];
        else if (i < PP_FINAL) v = a.in[13][i - PP_MOE_NORM];
        else if (i < PP_CONV_K) v = a.in[18][i - PP_FINAL];
        else if (i < PP_ROUTER) v = a.in[11][i - PP_CONV_K];
        else v = a.in[14][i - PP_ROUTER];
        P[i] = v;
    }
}
__device__ __forceinline__ void phase_copy_in(Ctx& C, const float* x, const float* meta) {
    for (int row = C.gw; row < RTOT; row += C.NGW) {
        const f32x4* p = (const f32x4*)(row < MROWS ? x + (size_t)row * D : meta + (size_t)(row - MROWS) * D) + C.lane;
        f32x4* o = (f32x4*)(C.H32 + (size_t)row * D) + C.lane;
#pragma unroll
        for (int j = 0; j < 4; ++j) o[64 * j] = p[64 * j];
    }
}
__device__ __forceinline__ int moe_cnt(unsigned* gcnt, int e) { return __builtin_amdgcn_readfirstlane((int)__hip_atomic_load(gcnt + 64 * e, __ATOMIC_RELAXED, __HIP_MEMORY_SCOPE_AGENT)); }
__device__ __forceinline__ void moe_sched_init(pg8::MoeSched& S, const Ctx& C, unsigned* gcnt, int pass, int nN) {
    S.n0 = moe_cnt(gcnt, 0); S.n1 = moe_cnt(gcnt, 1); S.n2 = moe_cnt(gcnt, 2); S.n3 = moe_cnt(gcnt, 3); S.n4 = moe_cnt(gcnt, 4); S.n5 = moe_cnt(gcnt, 5); S.n6 = moe_cnt(gcnt, 6); S.n7 = moe_cnt(gcnt, 7);
    S.m1 = (S.n0 + 255) >> 8; S.m2 = S.m1 + ((S.n1 + 255) >> 8); S.m3 = S.m2 + ((S.n2 + 255) >> 8); S.m4 = S.m3 + ((S.n3 + 255) >> 8);
    S.m5 = S.m4 + ((S.n4 + 255) >> 8); S.m6 = S.m5 + ((S.n5 + 255) >> 8); S.m7 = S.m6 + ((S.n6 + 255) >> 8);
    const int total = S.m7 + ((S.n7 + 255) >> 8);
    S.t0 = pass * MOE_CH; int nM = total - S.t0; const int cap = (pass == MOE_PASSES - 1) ? MOE_LAST_MAX : MOE_CH; nM = nM < 0 ? 0 : (nM > cap ? cap : nM);
    S.nM = nM; S.nN = nN; S.G = C.G; S.c = (int)blockIdx.x;
}
__device__ __forceinline__ bool relaunder(Ctx& C, unsigned char* ws) { C.lane = lane_id(); C.tid = C.wave * 64 + C.lane;
    { int g = C.gw0; asm volatile("" : "+s"(g)); C.gw = g; }
    size_t z_ = 0; asm volatile("" : "+s"(z_)); ws += z_; C.ws = ws;
    C.H32 = (float*)(ws + WS_H32); C.XN = (bf16*)(ws + WS_XN); C.Y1 = (bf16*)(ws + WS_Y1); C.RSTD = (float*)(ws + WS_RSTD); return true; }
constexpr int N_PHASES = 1 + 2 * (8 + 5 + 2 * MOE_PASSES) + 1;

#define RUN() (ph >= lo && ph < hi && relaunder(C, args.ws))
#define REPE for (int rep_ = 0; rep_ < PROBE_REP_ELT; ++rep_)
#define REPG for (int rep_ = 0; rep_ < PROBE_REP_GEMM; ++rep_)
#define SEAM() do { if (ph >= lo && ph + 1 < hi) xcd_barrier(bar, C.wave); ++ph; } while (0)
#define INTER ((bf16*)(C.ws + WS_INTER))
#define PRM ((const float*)(C.ws + WS_PARAMS))

template <int lp>
__device__ __forceinline__ void layer_pair(Ctx& C, const Args& args, int& ph, const int lo, const int hi, const XcdBarrier& bar, LAS unsigned* idxbuf) {
        const bool addy1 = lp > 0;
        if (RUN()) REPE phase_pool_stats(C, addy1);
        SEAM();
        if (RUN()) REPE phase_pool_diff(C, PRM + PP_POOL_NORM + lp * D, addy1);
        SEAM();
        if (RUN()) {
            pg8::DenseSched S; S.nM = MT_ALL; S.nN = 4; S.G = C.G; S.c = (int)blockIdx.x; S.A = (const char*)C.XN; S.Bt = (const char*)(C.ws + WS_WPOOL + (size_t)lp * 524288);
            S.tstepA = 256u * D * 2; S.tstepB = 256u * 256 * 2; S.a_colstep = 512;
            pg8::EpiResid E{C.H32, addy1 ? C.Y1 : nullptr, PRM + PP_POOL_SCALE + lp * D, 0};
            pg8::gemm_phase<pg8::EpiResid, pg8::DenseSched, false>(C.lds, idxbuf, C.wave, 256 / 64, D * 2, 256 * 2, S, E);
        }
        SEAM();
        if (RUN()) REPE phase_norm(C, PRM + PP_DENSE_NORM + lp * D, false, lp == DENSE_FP8_LAYER);
        SEAM();
        for (int hf = 0; hf < 2; ++hf) {
            const int pm0 = hf ? DENSE_H0 : 0, nM = hf ? (MT_ALL - DENSE_H0) : DENSE_H0;
            if (RUN()) {
                pg8::DenseSched S; S.nM = nM; S.nN = FF / 128; S.G = C.G; S.c = (int)blockIdx.x; S.a_colstep = 0; S.Bt = (const char*)(C.ws + WS_WGU + (size_t)lp * GU_BYTES);
                if (lp == DENSE_FP8_LAYER) {
                    S.A = (const char*)C.XN + (size_t)pm0 * 256 * D; S.tstepA = 256u * D; S.tstepB = 256u * D;
                    pg8::EpiSwiGLU8 E{(unsigned char*)INTER, FF};
                    REPG pg8::gemm_phase<pg8::EpiSwiGLU8, pg8::DenseSched, false, true>(C.lds, idxbuf, C.wave, D / 128, D, D, S, E, SC_ONE, SC_GU);
                } else {
                    S.A = (const char*)(C.XN + (size_t)pm0 * 256 * D); S.tstepA = 256u * D * 2; S.tstepB = 256u * D * 2;
                    pg8::EpiSwiGLU E{INTER, FF};
                    REPG pg8::gemm_phase<pg8::EpiSwiGLU, pg8::DenseSched, false>(C.lds, idxbuf, C.wave, D / 64, D * 2, D * 2, S, E);
                }
            }
            SEAM();
            if (RUN()) {
                pg8::DenseSched S; S.nM = nM; S.nN = 4; S.G = C.G; S.c = (int)blockIdx.x; S.A = (const char*)INTER; S.a_colstep = 0; S.Bt = (const char*)(C.ws + WS_WDN + (size_t)lp * DN_BYTES);
                pg8::EpiResid E{C.H32, nullptr, nullptr, pm0 * 256};
                if (lp == DENSE_FP8_LAYER) { S.tstepA = 256u * FF; S.tstepB = 256u * FF;
                    pg8::gemm_phase<pg8::EpiResid, pg8::DenseSched, false, true>(C.lds, idxbuf, C.wave, FF / 128, FF, FF, S, E, SC_H, SC_DN); }
                else { S.tstepA = 256u * FF * 2; S.tstepB = 256u * FF * 2;
                    pg8::gemm_phase<pg8::EpiResid, pg8::DenseSched, false>(C.lds, idxbuf, C.wave, FF / 64, FF * 2, FF * 2, S, E); }
            }
            SEAM();
        }
        if (RUN()) REPE phase_norm(C, PRM + PP_CONV_NORM + lp * D, false);
        SEAM();
#define BG INTER
#define UU (INTER + (size_t)RPAD * D)
        if (RUN()) {
            pg8::DenseSched S; S.nM = MT_ALL; S.nN = 12; S.G = C.G; S.c = (int)blockIdx.x; S.A = (const char*)C.XN; S.Bt = (const char*)(C.ws + WS_WIN + (size_t)lp * 3 * D * D * 2);
            S.tstepA = 256u * D * 2; S.tstepB = 256u * D * 2; S.a_colstep = 0;
            pg8::EpiConvIn E{BG, UU};
            REPG pg8::gemm_phase<pg8::EpiConvIn, pg8::DenseSched, false>(C.lds, idxbuf, C.wave, D / 64, D * 2, D * 2, S, E);
        }
        SEAM();
        if (RUN()) REPE phase_conv(C, PRM + PP_CONV_K + lp * 3 * D, BG, UU, C.XN);
        SEAM();
        if (RUN()) {
            pg8::DenseSched S; S.nM = MT_ALL; S.nN = 4; S.G = C.G; S.c = (int)blockIdx.x; S.A = (const char*)C.XN; S.Bt = (const char*)(C.ws + WS_WOUT + (size_t)lp * D * D * 2);
            S.tstepA = 256u * D * 2; S.tstepB = 256u * D * 2; S.a_colstep = 0;
            pg8::EpiResid E{C.H32, nullptr, nullptr, 0};
            pg8::gemm_phase<pg8::EpiResid, pg8::DenseSched, false>(C.lds, idxbuf, C.wave, D / 64, D * 2, D * 2, S, E);
        }
        SEAM();
#define gcnt ((unsigned*)(C.ws + WS_CTL) + CW_MOECNT + lp * 8 * 64)
        if (RUN()) phase_router(C, PRM + PP_MOE_NORM + lp * D, PRM + PP_ROUTER + lp * D * NE, gcnt);
        SEAM();
        for (int pass = 0; pass < MOE_PASSES; ++pass) {
            if (RUN()) {
                pg8::MoeSched S; moe_sched_init(S, C, gcnt, pass, FF / 128);
                S.A = (const char*)C.XN; S.tstepA = 0; S.Bt = (const char*)(C.ws + WS_WMGU + (size_t)lp * NE * GU8_BYTES); S.estepB = (unsigned)GU8_BYTES; S.tstepB = 256u * D; S.rowidx = (const unsigned*)(C.ws + WS_ROWIDX);
                pg8::EpiSwiGLU8 E{(unsigned char*)INTER, FF};
                REPG pg8::gemm_phase<pg8::EpiSwiGLU8, pg8::MoeSched, true, true>(C.lds, idxbuf, C.wave, D / 128, D, D, S, E, SC_ONE, SC_GU);
            }
            SEAM();
            if (RUN()) {
                pg8::MoeSched S; moe_sched_init(S, C, gcnt, pass, 4);
                S.A = (const char*)INTER; S.tstepA = 256u * FF; S.Bt = (const char*)(C.ws + WS_WMDN + (size_t)lp * NE * DN8_BYTES); S.estepB = (unsigned)DN8_BYTES; S.tstepB = 256u * FF; S.rowidx = nullptr;
                pg8::EpiMoeDown E{(const int2*)(C.ws + WS_SLOT), C.H32, C.Y1};
                pg8::gemm_phase<pg8::EpiMoeDown, pg8::MoeSched, false, true>(C.lds, idxbuf, C.wave, FF / 128, FF, FF, S, E, SC_H, SC_DN);
            }
            SEAM();
        }
}

__global__ void __launch_bounds__(NWAVES * 64, 2) fwd(Args args) {
    extern __shared__ __attribute__((aligned(16))) unsigned char lds_raw[];
    Ctx C;
    C.lds = (LAS unsigned char*)lds_raw;
    C.tid = threadIdx.x; C.lane = C.tid & 63; C.wave = __builtin_amdgcn_readfirstlane(C.tid >> 6);
    C.G = gridDim.x; { const int bx = blockIdx.x; C.vcu = (C.G % 8 == 0) ? (bx % 8) * (C.G / 8) + bx / 8 : bx; }
    C.gw0 = C.vcu * NWAVES + C.wave; C.gw = C.gw0; C.NGW = C.G * NWAVES;
    C.ws = args.ws; C.H32 = (float*)(args.ws + WS_H32); C.XN = (bf16*)(args.ws + WS_XN); C.Y1 = (bf16*)(args.ws + WS_Y1); C.RSTD = (float*)(args.ws + WS_RSTD);
    C.ctl = (unsigned*)(args.ws + WS_CTL);
    LAS unsigned* idxbuf = (LAS unsigned*)(C.lds + IDX_OFF);
    volatile LAS unsigned* MISC = (volatile LAS unsigned*)(C.lds + MISC_OFF);
    for (int u = C.tid; u < (LDS_BYTES - IDX_OFF) / 4; u += NWAVES * 64) ((LAS unsigned*)(C.lds + IDX_OFF))[u] = 0u;
    __syncthreads();
    const int lo = args.ph_lo, hi = args.ph_hi;
    XcdBarrier bar; bar.bar = C.ctl + CW_BAR; bar.x = 0; bar.st = nullptr;
    if (hi - lo > 1) bar = xcd_barrier_post(C.ctl + CW_BAR, MISC + 8);
    int ph = 0;
    if (RUN()) REPE { copy_params(C, args); convert_small_weights(C, args); convert_moe_layer(C, args, 0); convert_moe_layer(C, args, 1); phase_copy_in(C, args.in[0], args.in[1]); }
    SEAM();

    layer_pair<0>(C, args, ph, lo, hi, bar, idxbuf);
    layer_pair<1>(C, args, ph, lo, hi, bar, idxbuf);
    if (RUN()) REPE phase_final(C, PRM + PP_FINAL, args.out);
    SEAM();
#undef RUN
#undef SEAM
#undef INTER
#undef PRM
#undef BG
#undef UU
#undef gcnt
}

extern "C" void kernel_launch(void* const* d_in, const int* in_sizes, int n_in, void* d_out, int out_size, void* d_ws, size_t ws_size, hipStream_t stream) {
    static int grid = 0;
    if (grid == 0) {
        if (n_in != 19 || in_sizes[0] != MROWS * D || out_size != MROWS * D || ws_size < WS_END) {
            fprintf(stderr, "kernel_launch: unexpected problem (n_in %d, in0 %d, out %d, ws %zu < %zu); nothing launched\n", n_in, n_in > 0 ? in_sizes[0] : -1, out_size, ws_size, (size_t)WS_END); grid = -1; return; }
        int dev = 0, cus = 0, per_cu = 0;
        if (hipGetDevice(&dev) != hipSuccess || hipDeviceGetAttribute(&cus, hipDeviceAttributeMultiprocessorCount, dev) != hipSuccess) { grid = -1; return; }
        if (hipFuncSetAttribute((const void*)fwd, hipFuncAttributeMaxDynamicSharedMemorySize, LDS_BYTES) != hipSuccess) { fprintf(stderr, "kernel_launch: hipFuncSetAttribute failed\n"); grid = -1; return; }
        if (hipOccupancyMaxActiveBlocksPerMultiprocessor(&per_cu, (const void*)fwd, NWAVES * 64, LDS_BYTES) != hipSuccess || per_cu < 1)
            fprintf(stderr, "kernel_launch: occupancy query reports %d workgroups per CU\n", per_cu);
        (void)hipGetLastError();
        grid = cus;
    }
    if (grid < 0) return;
    if (hipMemsetAsync((char*)d_ws + WS_CTL, 0, CTL_ZERO_BYTES, stream) != hipSuccess) { fprintf(stderr, "kernel_launch: memset failed\n"); return; }
    Args a{};
    for (int i = 0; i < 19; ++i) a.in[i] = (const float*)d_in[i];
    a.out = (float*)d_out; a.ws = (unsigned char*)d_ws;
#if MK_ONE_LAUNCH
    a.ph_lo = 0; a.ph_hi = N_PHASES;
    hipLaunchKernelGGL(fwd, dim3(grid), dim3(NWAVES * 64), LDS_BYTES, stream, a);
#else
    for (int p = 0; p < N_PHASES; ++p) { a.ph_lo = p; a.ph_hi = p + 1; hipLaunchKernelGGL(fwd, dim3(grid), dim3(NWAVES * 64), LDS_BYTES, stream, a); }
#endif
    const hipError_t le = hipPeekAtLastError();
    if (le != hipSuccess) fprintf(stderr, "kernel_launch: launch failed: %s\n", hipGetErrorName(le));
}
```

```cpp
#include <hip/hip_runtime.h>
#include <cstdio>
#include <cstdint>

#ifndef PROBE_REP_ELT
#define PROBE_REP_ELT 1
#endif
#ifndef PROBE_MASK
#define PROBE_MASK 0
#endif
#ifndef PROBE_REP_GEMM
#define PROBE_REP_GEMM 1
#endif
#ifndef MK_ONE_LAUNCH
#define MK_ONE_LAUNCH 1
#endif

constexpr int D = 1024, FF = 3584, NE = 8, NB = 32, TS = 2048, NMETA = 16;
constexpr int MROWS = NB * TS;
constexpr int RTOT = MROWS + NMETA;
constexpr int MT_ALL = 257;
constexpr int RPAD = MT_ALL * 256;
constexpr int CAP = RPAD;
constexpr float EPS = 1e-6f;
constexpr int NWAVES = 8;
constexpr int MOE_CH = 256, MOE_PASSES = 2;
constexpr int MOE_LAST_MAX = 272;
constexpr float W_GU_SCALE = 64.f, W_DN_SCALE = 128.f, H8_SCALE = 4.f;
constexpr int SC_ONE = 0x7f7f7f7f, SC_GU = 0x79797979  , SC_DN = 0x78787878  , SC_H = 0x7d7d7d7d  ;
constexpr int DENSE_H0 = 128;
constexpr int DENSE_FP8_LAYER = 1;

constexpr size_t MiB = 1u << 20;
constexpr size_t WS_CTL = 0, CTL_ZERO_BYTES = 1 * MiB;
constexpr size_t WS_WPOOL = 1 * MiB;
constexpr size_t WS_WGU = 2 * MiB;
constexpr size_t WS_WDN = 30 * MiB;
constexpr size_t WS_WIN = 44 * MiB;
constexpr size_t WS_WOUT = 56 * MiB;
constexpr size_t WS_WMGU = 60 * MiB;
constexpr size_t WS_WMDN = 172 * MiB;
constexpr size_t WS_ROWIDX = 228 * MiB;
constexpr size_t WS_SLOT = 231 * MiB;
constexpr size_t WS_RSTD = 236 * MiB;
constexpr size_t WS_PARAMS = 236 * MiB + 512 * 1024;
constexpr int PP_POOL_NORM = 0, PP_POOL_SCALE = 2048, PP_DENSE_NORM = 4096, PP_CONV_NORM = 6144, PP_MOE_NORM = 8192, PP_FINAL = 10240, PP_CONV_K = 11264, PP_ROUTER = 17408, PP_TOTAL = 17408 + 16384;
constexpr size_t WS_H32 = 237 * MiB;
constexpr size_t WS_XN = 494 * MiB;
constexpr size_t WS_Y1 = 623 * MiB;
constexpr size_t WS_INTER = 752 * MiB;
constexpr size_t WS_END = 1009 * MiB;
constexpr size_t GU_BYTES = (size_t)7168 * 1024 * 2, DN_BYTES = (size_t)1024 * 3584 * 2, GU8_BYTES = GU_BYTES / 2, DN8_BYTES = DN_BYTES / 2;
static_assert(WS_ROWIDX + (size_t)8 * CAP * 4 <= WS_SLOT && WS_SLOT + (size_t)8 * CAP * 8 <= WS_RSTD, "lists");
static_assert(WS_H32 + (size_t)RPAD * D * 4 <= WS_XN && WS_XN + (size_t)RPAD * D * 2 <= WS_Y1 && WS_Y1 + (size_t)RPAD * D * 2 <= WS_INTER, "act map");
static_assert((size_t)MOE_LAST_MAX * 256 * FF <= WS_END - WS_INTER && (size_t)129 * 256 * FF * 2 <= WS_END - WS_INTER && (size_t)2 * RPAD * D * 2 <= WS_END - WS_INTER, "inter");
constexpr int CW_BAR = 4096;
constexpr int CW_MOECNT = 16384;

constexpr int RING_BYTES = 131072;
constexpr int IDX_OFF = RING_BYTES;
constexpr int MISC_OFF = IDX_OFF + 2048;
constexpr int LDS_BYTES = 147456;

#define GAS __attribute__((address_space(1)))
#define LAS __attribute__((address_space(3)))
typedef unsigned short bf16;
typedef float f32x4 __attribute__((ext_vector_type(4)));
typedef unsigned v4u __attribute__((ext_vector_type(4)));
typedef unsigned v2u __attribute__((ext_vector_type(2)));
#define LDS_WAIT() asm volatile("s_waitcnt lgkmcnt(0)" ::: "memory")
#define VM_WAIT() asm volatile("s_waitcnt vmcnt(0)" ::: "memory")

__device__ __forceinline__ int lane_id() { int l; asm volatile("v_mbcnt_lo_u32_b32 %0, -1, 0\n\tv_mbcnt_hi_u32_b32 %0, -1, %0" : "=v"(l)); return l; }
__device__ __forceinline__ unsigned cvt_pk_bf16(float lo, float hi) { unsigned r; asm volatile("v_cvt_pk_bf16_f32 %0, %1, %2" : "=v"(r) : "v"(lo), "v"(hi)); return r; }
__device__ __forceinline__ unsigned pk4_fp8(float a, float b, float c, float d) { int w = __builtin_amdgcn_cvt_pk_fp8_f32(a, b, 0, false); w = __builtin_amdgcn_cvt_pk_fp8_f32(c, d, w, true); return (unsigned)w; }
__device__ __forceinline__ float bf_lo(unsigned w) { return __uint_as_float(w << 16); }
__device__ __forceinline__ float bf_hi(unsigned w) { return __uint_as_float(w & 0xffff0000u); }
__device__ __forceinline__ float wave_sum(float v, int lane) {
#pragma unroll
    for (int o = 1; o < 64; o <<= 1) v += __int_as_float(__builtin_amdgcn_ds_bpermute((lane ^ o) << 2, __float_as_int(v)));
    return v;
}
__device__ __forceinline__ float silu_f(float a) { return a * __builtin_amdgcn_rcpf(1.0f + __builtin_amdgcn_exp2f(a * -1.44269504f)); }

#define XB_TMO      128
#define XB_XCNT(j)  (256  + 64 * (j))
#define XB_XSUB(j)  (1280 + 64 * (j))
#define XB_XGEN(j)  (2304 + 64 * (j))
#define XB_TOP      3328
#define XB_TOPGEN   3392
#define XCD_BAR_WORDS 3456
#define XB_SPIN_CAP (1u << 18)
__device__ __forceinline__ unsigned xb_ld(unsigned* p)              { return __hip_atomic_load(p, __ATOMIC_RELAXED, __HIP_MEMORY_SCOPE_AGENT); }
__device__ __forceinline__ unsigned xb_add(unsigned* p, unsigned v) { return __hip_atomic_fetch_add(p, v, __ATOMIC_RELAXED, __HIP_MEMORY_SCOPE_AGENT); }
__device__ __forceinline__ unsigned xb_xcc_id() { return (unsigned)__builtin_amdgcn_s_getreg((3 << 11) | 20) & 0xFu; }
#define XB_SPIN(cond, bar) do { unsigned _sp = 0; while (cond) { __builtin_amdgcn_s_sleep(1); \
    if ((++_sp & 255u) == 0u) { if (xb_ld(&(bar)[XB_TMO])) break; if (_sp > XB_SPIN_CAP) { atomicAdd(&(bar)[XB_TMO], 1u); break; } } } } while (0)
struct XcdBarrier { unsigned* bar; unsigned x; volatile LAS unsigned* st; };
__device__ __forceinline__ XcdBarrier xcd_barrier_post(unsigned* bar, volatile LAS unsigned* st) {
    XcdBarrier b; b.bar = bar; b.x = xb_xcc_id(); b.st = st;
    if (threadIdx.x == 0) (void)xb_add(&bar[XB_XCNT(b.x)], 1u);
    return b;
}
__device__ __forceinline__ void xcd_barrier_complete(unsigned* bar, unsigned x, unsigned& nloc, unsigned& nx) {
    const unsigned G = gridDim.x * gridDim.y * gridDim.z;
    unsigned sum, cnt, mine, sp = 0u;
    for (;;) {
        sum = 0u; cnt = 0u; mine = 0u;
#pragma unroll
        for (unsigned j = 0; j < 16; ++j) { const unsigned c = xb_ld(&bar[XB_XCNT(j)]); sum += c; cnt += (c > 0u) ? 1u : 0u; mine = (j == x) ? c : mine; }
        if (sum == G) break;
        __builtin_amdgcn_s_sleep(1);
        if ((++sp & 255u) == 0u) { if (xb_ld(&bar[XB_TMO])) break; if (sp > XB_SPIN_CAP) { atomicAdd(&bar[XB_TMO], 1u); break; } }
    }
    nloc = mine > 0u ? mine : 1u; nx = cnt > 0u ? cnt : 1u;
}
__device__ __forceinline__ void xcd_barrier(const XcdBarrier& b, const int wave  ) {
    asm volatile("s_waitcnt vmcnt(0)" ::: "memory");
    __syncthreads();
    if (wave == 0 && lane_id() == 0) {
        size_t z_ = 0; asm volatile("" : "+s"(z_)); unsigned* bar = b.bar + z_;
        __builtin_amdgcn_s_waitcnt(0);
        unsigned nloc = b.st[0], nx = b.st[1];
        if (nloc == 0u) { xcd_barrier_complete(bar, b.x, nloc, nx); b.st[0] = nloc; b.st[1] = nx; }
        const unsigned old = xb_add(&bar[XB_XSUB(b.x)], 1u);
        const unsigned gen = old / nloc;
        if (old + 1u == (gen + 1u) * nloc) {
            __builtin_amdgcn_fence(__ATOMIC_RELEASE, "agent");
            asm volatile("s_waitcnt vmcnt(0)" ::: "memory");
            const unsigned og = xb_add(&bar[XB_TOP], 1u);
            const unsigned tg = og / nx;
            if (og + 1u == (tg + 1u) * nx) xb_add(&bar[XB_TOPGEN], 1u);
            else XB_SPIN(xb_ld(&bar[XB_TOPGEN]) == tg, bar);
            __builtin_amdgcn_fence(__ATOMIC_ACQUIRE, "agent");
            xb_add(&bar[XB_XGEN(b.x)], 1u);
            asm volatile("s_waitcnt vmcnt(0)" ::: "memory");
        } else {
            XB_SPIN(xb_ld(&bar[XB_XGEN(b.x)]) == gen, bar);
            __builtin_amdgcn_fence(__ATOMIC_ACQUIRE, "agent");
            asm volatile("s_waitcnt vmcnt(0)" ::: "memory");
        }
    }
    __syncthreads();
}

namespace pg8 {
typedef short bf16x8 __attribute__((ext_vector_type(8)));
constexpr int BM = 256, BK = 64, HALF = 128, HTB = HALF * BK * 2, STAGE_BYTES = 8 * HTB;
static_assert(STAGE_BYTES == RING_BYTES, "ring");
__host__ __device__ __forceinline__ int lds_byte(int r, int c) { const int st = (r >> 4) * 2 + (c >> 5), rr = r & 15, cc = c & 31, ob = rr * 64 + cc * 2; return st * 1024 + (ob ^ (((ob >> 9) & 1) << 5)); }
__host__ __device__ __forceinline__ void stage_rc(int b, int& R, int& C) { const int st = b / 1024, sb = b % 1024, swz = sb ^ (((sb >> 9) & 1) << 5); R = (st >> 1) * 16 + swz / 64; C = (st & 1) * 32 + (swz % 64) / 2; }
__host__ __device__ __forceinline__ int perm32(int rho) { const int n = rho >> 4, i = rho & 15; return 8 * (i >> 2) + 4 * n + (i & 3); }

struct Unit { int pm, pn, e, rows, slot0; };

__device__ __forceinline__ bool static_tile(int i, int G, int c, int nM, int nN, int& pm, int& pn) {
    const int nwg = nM * nN; const long L = (long)i * G + c; if (L >= nwg) return false;
    int wgid = (int)L; { const int q = nwg / 8, r = nwg % 8, xcd = wgid % 8, off = wgid / 8; wgid = (xcd < r ? xcd * (q + 1) : r * (q + 1) + (xcd - r) * q) + off; }
    const int nig = 8 * nN, gid = wgid / nig, fm = gid * 8, gsz = (nM - fm) < 8 ? (nM - fm) : 8;
    pm = fm + ((wgid % nig) % gsz); pn = (wgid % nig) / gsz; return true;
}
struct DenseSched {
    int nM, nN, G, c; const char* A; const char* Bt; unsigned tstepA, tstepB, a_colstep;
    __device__ __forceinline__ bool next(int i, Unit& u) const { if (!static_tile(i, G, c, nM, nN, u.pm, u.pn)) return false; u.e = 0; u.rows = 256; u.slot0 = 0; return true; }
    __device__ __forceinline__ unsigned a_off(const Unit& u) const { return (unsigned)u.pm * tstepA + (unsigned)u.pn * a_colstep; }
    __device__ __forceinline__ unsigned b_off(const Unit& u) const { return (unsigned)u.pn * tstepB; }
    __device__ __forceinline__ const unsigned* idx_src(const Unit&) const { return nullptr; }
};
struct MoeSched {
    int nM, nN, G, c, t0; int m1, m2, m3, m4, m5, m6, m7; int n0, n1, n2, n3, n4, n5, n6, n7;
    const char* A; unsigned tstepA; const char* Bt; unsigned estepB, tstepB; const unsigned* rowidx;
    __device__ __forceinline__ bool next(int i, Unit& u) const {
        if (!static_tile(i, G, c, nM, nN, u.pm, u.pn)) return false;
        const int tg = t0 + u.pm; int e = 0, base = 0, cn = __builtin_amdgcn_readfirstlane(n0);
        if (tg >= m1) { e = 1; base = m1; cn = __builtin_amdgcn_readfirstlane(n1); }
        if (tg >= m2) { e = 2; base = m2; cn = __builtin_amdgcn_readfirstlane(n2); }
        if (tg >= m3) { e = 3; base = m3; cn = __builtin_amdgcn_readfirstlane(n3); }
        if (tg >= m4) { e = 4; base = m4; cn = __builtin_amdgcn_readfirstlane(n4); }
        if (tg >= m5) { e = 5; base = m5; cn = __builtin_amdgcn_readfirstlane(n5); }
        if (tg >= m6) { e = 6; base = m6; cn = __builtin_amdgcn_readfirstlane(n6); }
        if (tg >= m7) { e = 7; base = m7; cn = __builtin_amdgcn_readfirstlane(n7); }
        const int ti = tg - base; const int rem = cn - 256 * ti;
        u.e = e; u.rows = rem < 256 ? rem : 256; u.slot0 = e * CAP + ti * 256; return true;
    }
    __device__ __forceinline__ unsigned a_off(const Unit& u) const { return (unsigned)u.pm * tstepA; }
    __device__ __forceinline__ unsigned b_off(const Unit& u) const { return (unsigned)u.e * estepB + (unsigned)u.pn * tstepB; }
    __device__ __forceinline__ const unsigned* idx_src(const Unit& u) const { return rowidx + u.slot0; }
};

struct EpiSwiGLU {
    static constexpr bool PERM = true;
    bf16* H; int ldh;
    __device__ __forceinline__ void operator()(const f32x4 (&acc)[2][2][4][2], const Unit& u, int wr, int wc, int fr, int fq) const {
        const int row0 = u.pm * BM + wr * 64 + fr, col0 = u.pn * 128 + wc * 32 + 8 * fq;
#pragma unroll
        for (int ai = 0; ai < 2; ++ai)
#pragma unroll
            for (int m = 0; m < 4; ++m) { bf16* p = H + (size_t)(row0 + ai * HALF + m * 16) * ldh + col0;
                const f32x4 g0 = acc[ai][0][m][0], g1 = acc[ai][0][m][1], u0 = acc[ai][1][m][0], u1 = acc[ai][1][m][1];
                v4u w; w.x = cvt_pk_bf16(silu_f(g0[0]) * u0[0], silu_f(g0[1]) * u0[1]); w.y = cvt_pk_bf16(silu_f(g0[2]) * u0[2], silu_f(g0[3]) * u0[3]);
                w.z = cvt_pk_bf16(silu_f(g1[0]) * u1[0], silu_f(g1[1]) * u1[1]); w.w = cvt_pk_bf16(silu_f(g1[2]) * u1[2], silu_f(g1[3]) * u1[3]);
                *(v4u*)p = w; }
    }
};
struct EpiSwiGLU8 {
    static constexpr bool PERM = true;
    unsigned char* H; int ldh;
    __device__ __forceinline__ void operator()(const f32x4 (&acc)[2][2][4][2], const Unit& u, int wr, int wc, int fr, int fq) const {
        const int row0 = u.pm * BM + wr * 64 + fr, col0 = u.pn * 128 + wc * 32 + 8 * fq;
#pragma unroll
        for (int ai = 0; ai < 2; ++ai)
#pragma unroll
            for (int m = 0; m < 4; ++m) { unsigned char* p = H + (size_t)(row0 + ai * HALF + m * 16) * ldh + col0;
                const f32x4 g0 = acc[ai][0][m][0], g1 = acc[ai][0][m][1], u0 = acc[ai][1][m][0] * H8_SCALE, u1 = acc[ai][1][m][1] * H8_SCALE;
                v2u w; w.x = pk4_fp8(silu_f(g0[0]) * u0[0], silu_f(g0[1]) * u0[1], silu_f(g0[2]) * u0[2], silu_f(g0[3]) * u0[3]);
                w.y = pk4_fp8(silu_f(g1[0]) * u1[0], silu_f(g1[1]) * u1[1], silu_f(g1[2]) * u1[2], silu_f(g1[3]) * u1[3]);
                *(v2u*)p = w; }
    }
};
struct EpiResid {
    static constexpr bool PERM = false;
    float* h; const bf16* y1; const float* scale; int row_off; const float* xin; const float* meta; float ps = 1.0f;
    __device__ __forceinline__ void operator()(const f32x4 (&acc)[2][2][4][2], const Unit& u, int wr, int wc, int fr, int fq) const {
        const int row0 = row_off + u.pm * BM + wr * 64 + fr, col0 = u.pn * BM + wc * 32 + 4 * fq;
        f32x4 sc[2][2];
#pragma unroll
        for (int bj = 0; bj < 2; ++bj)
#pragma unroll
            for (int n = 0; n < 2; ++n) sc[bj][n] = (scale ? *(const f32x4*)(scale + col0 + bj * HALF + n * 16) : (f32x4){1.f, 1.f, 1.f, 1.f}) * ps;
#pragma unroll
        for (int ai = 0; ai < 2; ++ai) {
            f32x4 b[4][2][2];
#pragma unroll
            for (int m = 0; m < 4; ++m) { const int row = row0 + ai * HALF + m * 16; const size_t off = (size_t)row * D + col0;
                const float* src = h + off;
                if (xin) { const int mr = (row - MROWS) < NMETA ? (row - MROWS) : NMETA - 1; src = row < MROWS ? xin + off : meta + (size_t)mr * D + col0; }
#pragma unroll
                for (int bj = 0; bj < 2; ++bj)
#pragma unroll
                    for (int n = 0; n < 2; ++n) b[m][bj][n] = *(const f32x4*)(src + bj * HALF + n * 16);
                if (y1) {
#pragma unroll
                    for (int bj = 0; bj < 2; ++bj)
#pragma unroll
                        for (int n = 0; n < 2; ++n) { const v2u y = *(const v2u*)(y1 + off + bj * HALF + n * 16); b[m][bj][n] += (f32x4){bf_lo(y.x), bf_hi(y.x), bf_lo(y.y), bf_hi(y.y)}; } } }
#pragma unroll
            for (int m = 0; m < 4; ++m) { const size_t off = (size_t)(row0 + ai * HALF + m * 16) * D + col0;
#pragma unroll
                for (int bj = 0; bj < 2; ++bj)
#pragma unroll
                    for (int n = 0; n < 2; ++n) *(f32x4*)(h + off + bj * HALF + n * 16) = b[m][bj][n] + acc[ai][bj][m][n] * sc[bj][n]; }
            asm volatile("" ::: "memory"); }
    }
};
struct EpiConvIn {
    static constexpr bool PERM = true;
    bf16* BG; bf16* U;
    __device__ __forceinline__ void operator()(const f32x4 (&acc)[2][2][4][2], const Unit& u, int wr, int wc, int fr, int fq) const {
        const int row0 = u.pm * BM + wr * 64 + fr;
        if (u.pn < 4) {
            const int col0 = u.pn * BM + wc * 32 + 8 * fq;
#pragma unroll
            for (int ai = 0; ai < 2; ++ai)
#pragma unroll
                for (int m = 0; m < 4; ++m) { bf16* p = BG + (size_t)(row0 + ai * HALF + m * 16) * D + col0;
#pragma unroll
                    for (int bj = 0; bj < 2; ++bj) { const f32x4 v0 = acc[ai][bj][m][0], v1 = acc[ai][bj][m][1];
                        v4u w; w.x = cvt_pk_bf16(v0[0], v0[1]); w.y = cvt_pk_bf16(v0[2], v0[3]); w.z = cvt_pk_bf16(v1[0], v1[1]); w.w = cvt_pk_bf16(v1[2], v1[3]);
                        *(v4u*)(p + bj * HALF) = w; } }
        } else {
            const int col0 = (u.pn - 4) * 128 + wc * 32 + 8 * fq;
#pragma unroll
            for (int ai = 0; ai < 2; ++ai)
#pragma unroll
                for (int m = 0; m < 4; ++m) { bf16* p = U + (size_t)(row0 + ai * HALF + m * 16) * D + col0;
                    const f32x4 c0 = acc[ai][0][m][0], c1 = acc[ai][0][m][1], v0 = acc[ai][1][m][0], v1 = acc[ai][1][m][1];
                    v4u w; w.x = cvt_pk_bf16(c0[0] * v0[0], c0[1] * v0[1]); w.y = cvt_pk_bf16(c0[2] * v0[2], c0[3] * v0[3]);
                    w.z = cvt_pk_bf16(c1[0] * v1[0], c1[1] * v1[1]); w.w = cvt_pk_bf16(c1[2] * v1[2], c1[3] * v1[3]);
                    *(v4u*)p = w; }
        }
    }
};
struct EpiMoeDown {
    static constexpr bool PERM = false;
    const int2* slot; float* h; bf16* y1; float ps = 1.0f;
    __device__ __forceinline__ void operator()(const f32x4 (&acc)[2][2][4][2], const Unit& u, int wr, int wc, int fr, int fq) const {
        const int col0 = u.pn * BM + wc * 32 + 4 * fq;
        int2 inf[2][4];
#pragma unroll
        for (int ai = 0; ai < 2; ++ai)
#pragma unroll
            for (int m = 0; m < 4; ++m) { const int rl = ai * HALF + wr * 64 + m * 16 + fr; inf[ai][m] = (rl < u.rows) ? slot[u.slot0 + rl] : make_int2(0, 0); }
#pragma unroll
        for (int ai = 0; ai < 2; ++ai) {
            f32x4 b[4][2][2];
#pragma unroll
            for (int m = 0; m < 4; ++m) { const size_t off = (size_t)(inf[ai][m].x & 0x7fffffff) * D + col0;
#pragma unroll
                for (int bj = 0; bj < 2; ++bj)
#pragma unroll
                    for (int n = 0; n < 2; ++n) b[m][bj][n] = *(const f32x4*)(h + off + bj * HALF + n * 16); }
#pragma unroll
            for (int m = 0; m < 4; ++m) { const int rl = ai * HALF + wr * 64 + m * 16 + fr; const int ix = inf[ai][m].x; const float w = __int_as_float(inf[ai][m].y);
                const size_t off = (size_t)(ix & 0x7fffffff) * D + col0;
                if (rl < u.rows) {
                    if (ix >= 0) {
#pragma unroll
                        for (int bj = 0; bj < 2; ++bj)
#pragma unroll
                            for (int n = 0; n < 2; ++n) *(f32x4*)(h + off + bj * HALF + n * 16) = b[m][bj][n] + acc[ai][bj][m][n] * (w * ps);
                    } else {
#pragma unroll
                        for (int bj = 0; bj < 2; ++bj)
#pragma unroll
                            for (int n = 0; n < 2; ++n) { const f32x4 v = acc[ai][bj][m][n] * w; v2u o; o.x = cvt_pk_bf16(v[0], v[1]); o.y = cvt_pk_bf16(v[2], v[3]); *(v2u*)(y1 + off + bj * HALF + n * 16) = o; }
                    }
                } }
            asm volatile("" ::: "memory"); }
    }
};

typedef int i32x4 __attribute__((ext_vector_type(4)));
typedef int i32x8 __attribute__((ext_vector_type(8)));
template <class Epi, class Sched, bool GATHER, bool FP8 = false>
__device__ __forceinline__ void gemm_phase(LAS unsigned char* lds, LAS unsigned* idxbuf, const int wid, const int nt, const int lda, const int ldb, const Sched& S, const Epi& E, const int sc_a = 0x7f7f7f7f, const int sc_b = 0x7f7f7f7f) {
    const int lane = lane_id(), tid = wid * 64 + lane, wr = wid >> 2, wc = wid & 3, fr = lane & 15, fq = lane >> 4;
    unsigned voffA[2], voffB[2], voffG[2][2];
#pragma unroll
    for (int i = 0; i < 2; ++i) { int R, C; stage_rc(tid * 16 + i * 8192, R, C); const int Rb = Epi::PERM ? ((R & ~31) + perm32(R & 31)) : R;
        voffA[i] = (unsigned)(R * lda + C * 2); voffB[i] = (unsigned)(Rb * ldb + C * 2); voffG[0][i] = 0u; voffG[1][i] = 0u; }
    const __amdgpu_buffer_rsrc_t rA = __builtin_amdgcn_make_buffer_rsrc((void*)S.A, 0, 0x7ffffff0, 0x00020000), rB = __builtin_amdgcn_make_buffer_rsrc((void*)S.Bt, 0, 0x7ffffff0, 0x00020000);
    const unsigned kstep = (unsigned)(BK * 2);
    const unsigned hstepA = (unsigned)HALF * lda, hstepB = (unsigned)HALF * ldb;
    const unsigned ldsw = (unsigned)wid * 1024u; unsigned ldsw_ = ldsw;
    const int aoff = lds_byte(wr * 64 + fr, fq * 8), boff = lds_byte(wc * 32 + fr, fq * 8);
#define PG8_SA(b, h) (((b) * 2 + (h)) * HTB)
#define PG8_SB(b, h) ((4 + (b) * 2 + (h)) * HTB)
#define PG8_STAGE(bufoff, rsrc, soff, voff) do { _Pragma("unroll") for (int _i = 0; _i < 2; ++_i) \
        __builtin_amdgcn_raw_ptr_buffer_load_lds(rsrc, (LAS void*)(lds + (bufoff) + ldsw_ + _i * 8192), 16, (int)(voff)[_i], (int)(soff), 0, 0); } while (0)
#define PG8_STAGE_A(bufoff, soff, h) do { if constexpr (GATHER) { PG8_STAGE(bufoff, rA, soff, voffG[h]); } else { PG8_STAGE(bufoff, rA, (soff) + (h) * hstepA, voffA); } } while (0)
#define PG8_STAGE_B(bufoff, soff, h) PG8_STAGE(bufoff, rB, (soff) + (h) * hstepB, voffB)
#define PG8_LDA(dst, b, h) do { _Pragma("unroll") for (int m = 0; m < 4; ++m) _Pragma("unroll") for (int k = 0; k < 2; ++k) dst[m][k] = *(const LAS bf16x8*)(lds + PG8_SA(b, h) + aoff + m * 2048 + k * 1024); } while (0)
#define PG8_LDB(dst, b, h) do { _Pragma("unroll") for (int n = 0; n < 2; ++n) _Pragma("unroll") for (int k = 0; k < 2; ++k) dst[n][k] = *(const LAS bf16x8*)(lds + PG8_SB(b, h) + boff + n * 2048 + k * 1024); } while (0)
#define PG8_MMA(ai, bj, At, Bt) do { __builtin_amdgcn_s_setprio(1); _Pragma("unroll") for (int m = 0; m < 4; ++m) _Pragma("unroll") for (int n = 0; n < 2; ++n) _Pragma("unroll") for (int k = 0; k < 2; ++k) \
        acc[ai][bj][m][n] = __builtin_amdgcn_mfma_f32_16x16x32_bf16(Bt[n][k], At[m][k], acc[ai][bj][m][n], 0, 0, 0); __builtin_amdgcn_s_setprio(0); } while (0)
#define PG8_CAT(x) __builtin_shufflevector((i32x4)(x)[0], (i32x4)(x)[1], 0, 1, 2, 3, 4, 5, 6, 7)
#define PG8_MMA8(ai, bj, At, Bt) do { __builtin_amdgcn_s_setprio(1); _Pragma("unroll") for (int m = 0; m < 4; ++m) _Pragma("unroll") for (int n = 0; n < 2; ++n) \
        acc[ai][bj][m][n] = __builtin_amdgcn_mfma_scale_f32_16x16x128_f8f6f4(PG8_CAT(Bt[n]), PG8_CAT(At[m]), acc[ai][bj][m][n], 0, 0, 0, sc_b, 0, sc_a); __builtin_amdgcn_s_setprio(0); } while (0)
#define PG8_MM(ai, bj, At, Bt) do { if constexpr (FP8) PG8_MMA8(ai, bj, At, Bt); else PG8_MMA(ai, bj, At, Bt); } while (0)
#define PG8_WAIT_V(n) asm volatile("s_waitcnt vmcnt(" #n ")" ::: "memory")
#define PG8_WAIT_L(n) asm volatile("s_waitcnt lgkmcnt(" #n ")" ::: "memory")
#define PG8_BAR __builtin_amdgcn_s_barrier()
#define PG8_SCHED __builtin_amdgcn_sched_barrier(0)
#define PG8_LOAD_VOFFG(ib, nrows) do { asm volatile("" ::: "memory"); _Pragma("unroll") for (int _i = 0; _i < 2; ++_i) { int _R, _C; stage_rc(tid * 16 + _i * 8192, _R, _C); \
        _Pragma("unroll") for (int _h = 0; _h < 2; ++_h) { const int _rl = _h * HALF + _R; unsigned _ix = (ib)[_rl]; _ix = (_rl < (nrows)) ? _ix : 0u; voffG[_h][_i] = _ix * (unsigned)lda + (unsigned)(_C * 2); } } } while (0)
#define PG8_IDX_DMA(src, ib) __builtin_amdgcn_global_load_lds((const unsigned*)((src) + lane * 4), (LAS unsigned*)(ib), 16, 0, 0)
    Unit cur, nxt; int ui = 0;
    if (!S.next(0, cur)) return;
    f32x4 acc[2][2][4][2];
#pragma unroll
    for (int a = 0; a < 2; ++a)
#pragma unroll
        for (int b = 0; b < 2; ++b)
#pragma unroll
            for (int m = 0; m < 4; ++m)
#pragma unroll
                for (int n = 0; n < 2; ++n) acc[a][b][m][n] = (f32x4){0.f, 0.f, 0.f, 0.f};
    bf16x8 At[4][2], B0[2][2], B1[2][2];
    unsigned cA = S.a_off(cur), cB = S.b_off(cur);
    if constexpr (GATHER) {
        if (wid == 0) PG8_IDX_DMA(S.idx_src(cur), idxbuf);
        PG8_WAIT_V(0); PG8_BAR;
        PG8_LOAD_VOFFG(idxbuf, cur.rows);
    }
    PG8_STAGE_B(PG8_SB(0, 0), cB, 0); PG8_STAGE_B(PG8_SB(0, 1), cB, 1); PG8_STAGE_A(PG8_SA(0, 0), cA, 0); PG8_STAGE_A(PG8_SA(0, 1), cA, 1);
    if (wr == 1) PG8_BAR;
    PG8_WAIT_V(2); PG8_BAR;
    PG8_STAGE_B(PG8_SB(1, 0), cB + kstep, 0); PG8_STAGE_A(PG8_SA(1, 0), cA + kstep, 0); PG8_STAGE_B(PG8_SB(1, 1), cB + kstep, 1);
    PG8_WAIT_V(6); PG8_BAR;
    for (;;) {
        const bool has_next = S.next(ui + 1, nxt);
        const unsigned nA = has_next ? S.a_off(nxt) : cA, nB = has_next ? S.b_off(nxt) : cB;
        if constexpr (GATHER) { if (has_next && wid == 0) PG8_IDX_DMA(S.idx_src(nxt), idxbuf + ((ui + 1) & 1) * 256); }
#pragma nounroll
        for (int t = 0; t < nt; t += 2) {
            const bool last = (t == nt - 2);
            asm volatile("" : "+s"(ldsw_));
            const unsigned a1 = cA + (unsigned)(t + 1) * kstep;
            const unsigned a2 = last ? nA : cA + (unsigned)(t + 2) * kstep, b2 = last ? nB : cB + (unsigned)(t + 2) * kstep;
            const unsigned a3 = a2 + kstep, b3 = b2 + kstep;
            PG8_LDB(B0, 0, 0); PG8_LDB(B1, 0, 1); PG8_SCHED; PG8_LDA(At, 0, 0); PG8_STAGE_A(PG8_SA(1, 1), a1, 1);
            PG8_WAIT_V(8); PG8_WAIT_L(0); PG8_BAR; PG8_MM(0, 0, At, B0); PG8_MM(0, 1, At, B1); PG8_BAR; PG8_SCHED;
            if constexpr (GATHER) { if (last && has_next) PG8_LOAD_VOFFG(idxbuf + ((ui + 1) & 1) * 256, nxt.rows); }
            PG8_LDA(At, 0, 1); PG8_STAGE_B(PG8_SB(0, 0), b2, 0); PG8_STAGE_B(PG8_SB(0, 1), b2, 1); PG8_STAGE_A(PG8_SA(0, 0), a2, 0);
            PG8_WAIT_V(8); PG8_WAIT_L(0); PG8_BAR; PG8_MM(1, 0, At, B0); PG8_MM(1, 1, At, B1); PG8_BAR; PG8_SCHED;
            PG8_LDB(B0, 1, 0); PG8_LDB(B1, 1, 1); PG8_SCHED; PG8_LDA(At, 1, 0); PG8_STAGE_A(PG8_SA(0, 1), a2, 1);
            PG8_WAIT_V(8); PG8_WAIT_L(0); PG8_BAR; PG8_MM(0, 0, At, B0); PG8_MM(0, 1, At, B1); PG8_BAR; PG8_SCHED;
            PG8_LDA(At, 1, 1); PG8_STAGE_B(PG8_SB(1, 0), b3, 0); PG8_STAGE_B(PG8_SB(1, 1), b3, 1); PG8_STAGE_A(PG8_SA(1, 0), a3, 0);
            PG8_WAIT_V(8); PG8_WAIT_L(0); PG8_BAR; PG8_MM(1, 0, At, B0); PG8_MM(1, 1, At, B1); PG8_BAR; PG8_SCHED;
        }
        if (wr == 0) PG8_BAR;
        { const int ln = lane_id(); E(acc, cur, wr, wc, ln & 15, ln >> 4); }
        if (!has_next) break;
#pragma unroll
        for (int a = 0; a < 2; ++a)
#pragma unroll
            for (int b = 0; b < 2; ++b)
#pragma unroll
                for (int m = 0; m < 4; ++m)
#pragma unroll
                    for (int n = 0; n < 2; ++n) acc[a][b][m][n] = (f32x4){0.f, 0.f, 0.f, 0.f};
        cur = nxt; cA = nA; cB = nB; ++ui;
        if (wr == 1) PG8_BAR;
    }
    PG8_WAIT_V(0);
    PG8_BAR;
#undef PG8_SA
#undef PG8_SB
#undef PG8_STAGE
#undef PG8_STAGE_A
#undef PG8_STAGE_B
#undef PG8_LDA
#undef PG8_LDB
#undef PG8_MMA
#undef PG8_MMA8
#undef PG8_MM
#undef PG8_CAT
#undef PG8_WAIT_V
#undef PG8_WAIT_L
#undef PG8_BAR
#undef PG8_SCHED
#undef PG8_LOAD_VOFFG
#undef PG8_IDX_DMA
}
}

struct Args { const float* in[19]; float* out; unsigned char* ws; int ph_lo, ph_hi; };
struct Ctx {
    LAS unsigned char* lds; int tid, lane, wave, G, vcu, gw, NGW, gw0, wave0;
    unsigned char* ws; float* H32; bf16* XN; bf16* Y1; float* RSTD; unsigned* ctl;
};

__device__ __forceinline__ void tr_item(const float* W, int ldw, int k0, int n0, bf16* WT, int K, int drow0, LAS float* scr, int lane) {
#pragma unroll 8
    for (int i = 0; i < 32; ++i) { const int kk = 2 * i + (lane >> 5); scr[kk * 33 + (lane & 31)] = W[(size_t)(k0 + kk) * ldw + n0 + (lane & 31)]; }
    LDS_WAIT();
    const int c = lane & 7;
#pragma unroll
    for (int j = 0; j < 4; ++j) { const int n = (lane >> 3) + 8 * j; const LAS float* s = scr + (8 * c) * 33 + n;
        v4u o; o.x = cvt_pk_bf16(s[0 * 33], s[1 * 33]); o.y = cvt_pk_bf16(s[2 * 33], s[3 * 33]); o.z = cvt_pk_bf16(s[4 * 33], s[5 * 33]); o.w = cvt_pk_bf16(s[6 * 33], s[7 * 33]);
        *(v4u*)(WT + (size_t)(drow0 + n) * K + k0 + 8 * c) = o; }
    LDS_WAIT();
}
__device__ __forceinline__ void tr_item8(const float* W, int ldw, int k0, int n0, unsigned char* WT, int K, int drow0, float scale, LAS float* scr, int lane) {
#pragma unroll 8
    for (int i = 0; i < 32; ++i) { const int kk = 2 * i + (lane >> 5); scr[kk * 33 + (lane & 31)] = W[(size_t)(k0 + kk) * ldw + n0 + (lane & 31)] * scale; }
    LDS_WAIT();
    const int c = lane & 7;
#pragma unroll
    for (int j = 0; j < 4; ++j) { const int n = (lane >> 3) + 8 * j; const LAS float* s = scr + (8 * c) * 33 + n;
        v2u o; o.x = pk4_fp8(s[0 * 33], s[1 * 33], s[2 * 33], s[3 * 33]); o.y = pk4_fp8(s[4 * 33], s[5 * 33], s[6 * 33], s[7 * 33]);
        *(v2u*)(WT + (size_t)(drow0 + n) * K + k0 + 8 * c) = o; }
    LDS_WAIT();
}
__device__ __forceinline__ void cv_gateup(const float* Wg, const float* Wu, bf16* dst, int item, LAS float* scr, int lane) {
    const int kind = item / 1792, r = item % 1792, kb = r / 112, nb = r % 112, n0 = 32 * nb;
    tr_item(kind ? Wu : Wg, FF, 64 * kb, n0, dst, D, (n0 >> 7) * 256 + (n0 & 127) + kind * 128, scr, lane);
}
__device__ __forceinline__ void cv_plain(const float* W, int K, int N, bf16* dst, int drow_off, int item, LAS float* scr, int lane) {
    const int nbn = N / 32, kb = item / nbn, nb = item % nbn;
    tr_item(W, N, 64 * kb, 32 * nb, dst, K, drow_off + 32 * nb, scr, lane);
}
__device__ __forceinline__ void cv_convin(const float* W, bf16* dst, int item, LAS float* scr, int lane) {
    const int kb = item / 96, nb = item % 96, n0 = 32 * nb; int dr;
    if (n0 < 1024) dr = n0; else if (n0 < 2048) dr = 1024 + ((n0 - 1024) >> 7) * 256 + (n0 & 127); else dr = 1024 + ((n0 - 2048) >> 7) * 256 + 128 + (n0 & 127);
    tr_item(W, 3 * D, 64 * kb, n0, dst, D, dr, scr, lane);
}
__device__ __forceinline__ void convert_moe_layer(Ctx& C, const Args& a, int j) {
    LAS float* scr = (LAS float*)(C.lds + C.wave * 16384);
    constexpr int PER_E = 3584 + 1792;
    for (int it = C.gw; it < NE * PER_E; it += C.NGW) {
        const int e = it / PER_E, r = it % PER_E; const size_t wo = ((size_t)j * NE + e) * D * FF;
        if (r < 3584) { const int kind = r / 1792, q = r % 1792, kb = q / 112, nb = q % 112, n0 = 32 * nb;
            tr_item8((kind ? a.in[16] : a.in[15]) + wo, FF, 64 * kb, n0, C.ws + WS_WMGU + (size_t)(j * NE + e) * GU8_BYTES, D, (n0 >> 7) * 256 + (n0 & 127) + kind * 128, W_GU_SCALE, scr, C.lane); }
        else { const int q = r - 3584, kb = q / 32, nb = q % 32;
            tr_item8(a.in[17] + wo, D, 64 * kb, 32 * nb, C.ws + WS_WMDN + (size_t)(j * NE + e) * DN8_BYTES, FF, 32 * nb, W_DN_SCALE, scr, C.lane); }
    }
}
__device__ __forceinline__ void convert_small_weights(Ctx& C, const Args& a) {
    LAS float* scr = (LAS float*)(C.lds + C.wave * 16384);
    constexpr int I_POOL = 32, I_GU = 3584, I_DN = 1792, I_IN = 1536, I_OUT = 512;
    constexpr int PER_L = 4 * I_POOL + I_GU + I_DN + I_IN + I_OUT;
    for (int it = C.gw; it < 2 * PER_L; it += C.NGW) {
        const int l = it / PER_L; int r = it % PER_L;
        if (r < 4 * I_POOL) { const int g = r / I_POOL; cv_plain(a.in[3] + (size_t)(l * 4 + g) * 65536, 256, 256, (bf16*)(C.ws + WS_WPOOL + (size_t)l * 524288), g * 256, r % I_POOL, scr, C.lane); continue; } r -= 4 * I_POOL;
        if (r < I_GU) {
            if (l == DENSE_FP8_LAYER) { const int kind = r / 1792, q = r % 1792, kb = q / 112, nb = q % 112, n0 = 32 * nb;
                tr_item8((kind ? a.in[7] : a.in[6]) + (size_t)l * D * FF, FF, 64 * kb, n0, C.ws + WS_WGU + (size_t)l * GU_BYTES, D, (n0 >> 7) * 256 + (n0 & 127) + kind * 128, W_GU_SCALE, scr, C.lane); }
            else cv_gateup(a.in[6] + (size_t)l * D * FF, a.in[7] + (size_t)l * D * FF, (bf16*)(C.ws + WS_WGU + (size_t)l * GU_BYTES), r, scr, C.lane);
            continue; } r -= I_GU;
        if (r < I_DN) {
            if (l == DENSE_FP8_LAYER) { const int kb = r / 32, nb = r % 32; tr_item8(a.in[8] + (size_t)l * D * FF, D, 64 * kb, 32 * nb, C.ws + WS_WDN + (size_t)l * DN_BYTES, FF, 32 * nb, W_DN_SCALE, scr, C.lane); }
            else cv_plain(a.in[8] + (size_t)l * D * FF, FF, D, (bf16*)(C.ws + WS_WDN + (size_t)l * DN_BYTES), 0, r, scr, C.lane);
            continue; } r -= I_DN;
        if (r < I_IN) { cv_convin(a.in[10] + (size_t)l * D * 3 * D, (bf16*)(C.ws + WS_WIN + (size_t)l * 3 * D * D * 2), r, scr, C.lane); continue; } r -= I_IN;
        cv_plain(a.in[12] + (size_t)l * D * D, D, D, (bf16*)(C.ws + WS_WOUT + (size_t)l * D * D * 2), 0, r, scr, C.lane);
    }
}

__device__ __forceinline__ int prev_row(int row, int i) {
    if (row < MROWS) { const int tp = row & (TS - 1); return tp >= i ? row - i : MROWS + NMETA + tp - i; }
    return row - i;
}
__device__ __forceinline__ void load_heff(const Ctx& C, int row, bool addy1, f32x4 (&x)[4]) {
    const f32x4* p = (const f32x4*)(C.H32 + (size_t)row * D) + C.lane;
#pragma unroll
    for (int j = 0; j < 4; ++j) x[j] = p[64 * j];
    if (addy1) { const v2u* q = (const v2u*)(C.Y1 + (size_t)row * D) + C.lane;
#pragma unroll
        for (int j = 0; j < 4; ++j) { const v2u y = q[64 * j]; x[j] += (f32x4){bf_lo(y.x), bf_hi(y.x), bf_lo(y.y), bf_hi(y.y)}; } }
}
__device__ __forceinline__ float row_rstd(const f32x4 (&x)[4], int lane) {
    float s = 0.f;
#pragma unroll
    for (int j = 0; j < 4; ++j) s += (x[j][0] * x[j][0] + x[j][1] * x[j][1]) + (x[j][2] * x[j][2] + x[j][3] * x[j][3]);
    return __frsqrt_rn(wave_sum(s, lane) * (1.0f / D) + EPS);
}
__device__ __forceinline__ void store_bf16_row(bf16* dst, int row, int lane, const f32x4 (&v)[4]) {
    v2u* o = (v2u*)(dst + (size_t)row * D) + lane;
#pragma unroll
    for (int j = 0; j < 4; ++j) { v2u w; w.x = cvt_pk_bf16(v[j][0], v[j][1]); w.y = cvt_pk_bf16(v[j][2], v[j][3]); o[64 * j] = w; }
}
__device__ __forceinline__ void phase_norm(Ctx& C, const float* gain, bool addy1, bool out8 = false) {
    f32x4 g[4];
#pragma unroll
    for (int j = 0; j < 4; ++j) g[j] = ((const f32x4*)gain)[C.lane + 64 * j];
    f32x4 x[4], xnx[4];
    if (C.gw < RTOT) load_heff(C, C.gw, addy1, x);
    for (int row = C.gw; row < RTOT; row += C.NGW) {
        const int nrow = row + C.NGW;
        if (nrow < RTOT) load_heff(C, nrow, addy1, xnx);
        const float rs = row_rstd(x, C.lane);
#pragma unroll
        for (int j = 0; j < 4; ++j) x[j] = x[j] * rs * g[j];
        if (out8) { unsigned* o8 = (unsigned*)((unsigned char*)C.XN + (size_t)row * D) + C.lane;
#pragma unroll
            for (int j = 0; j < 4; ++j) o8[64 * j] = pk4_fp8(x[j][0], x[j][1], x[j][2], x[j][3]); }
        else store_bf16_row(C.XN, row, C.lane, x);
#pragma unroll
        for (int j = 0; j < 4; ++j) x[j] = xnx[j];
    }
}
template <bool L0>
__device__ __forceinline__ void phase_pool(Ctx& C, const float* gain, bool addy1, const float* xin, const float* meta) {
    f32x4 g[4];
#pragma unroll
    for (int j = 0; j < 4; ++j) g[j] = ((const f32x4*)gain)[C.lane + 64 * j];
    constexpr int RUN = 32, NRUN = MROWS / RUN + 1;
    for (int run = C.gw; run < NRUN; run += C.NGW) {
        const bool mrun = run == NRUN - 1;
        const int r0 = run * RUN, tp0 = r0 & (TS - 1), nsteps = mrun ? NMETA : RUN + 15;
        f32x4 r1[2], r2[4], r3[8], r4[16], S[4];
#pragma unroll
        for (int q = 0; q < 2; ++q) r1[q] = (f32x4){0.f, 0.f, 0.f, 0.f};
#pragma unroll
        for (int q = 0; q < 4; ++q) r2[q] = (f32x4){0.f, 0.f, 0.f, 0.f};
#pragma unroll
        for (int q = 0; q < 8; ++q) r3[q] = (f32x4){0.f, 0.f, 0.f, 0.f};
#pragma unroll
        for (int q = 0; q < 16; ++q) r4[q] = (f32x4){0.f, 0.f, 0.f, 0.f};
#pragma unroll
        for (int j = 0; j < 4; ++j) S[j] = (f32x4){0.f, 0.f, 0.f, 0.f};
#define POOL_ROW(k_) (mrun ? MROWS + (k_) : ((tp0 + (k_) - 15 >= 0) ? r0 + (k_) - 15 : MROWS + NMETA + tp0 + (k_) - 15))
#define POOL_LOAD(dst, row_) do { if (L0) { const f32x4* p_ = (const f32x4*)((row_) < MROWS ? xin + (size_t)(row_) * D : meta + (size_t)((row_) - MROWS) * D) + C.lane; \
        _Pragma("unroll") for (int j = 0; j < 4; ++j) dst[j] = p_[64 * j]; } else load_heff(C, row_, addy1, dst); } while (0)
        f32x4 x[4], xnx[4];
        POOL_LOAD(x, POOL_ROW(0));
        for (int kb = 0; kb < nsteps; kb += 16) {
#pragma unroll
            for (int kk = 0; kk < 16; ++kk) {
                const int k = kb + kk;
                if (k < nsteps) {
                    const int i = mrun ? k : k - 15;
                    const int row = POOL_ROW(k);
                    if (k + 1 < nsteps) POOL_LOAD(xnx, POOL_ROW(k + 1));
                    const float rs = row_rstd(x, C.lane);
#pragma unroll
                    for (int j = 0; j < 4; ++j) x[j] = x[j] * rs * g[j];
                    S[0] += x[0] - r1[kk & 1]; r1[kk & 1] = x[0];
                    S[1] += x[1] - r2[kk & 3]; r2[kk & 3] = x[1];
                    S[2] += x[2] - r3[kk & 7]; r3[kk & 7] = x[2];
                    S[3] += x[3] - r4[kk]; r4[kk] = x[3];
                    if (i >= 0) {
                        const int pos = mrun ? k : NMETA;
                        f32x4 d[4];
#pragma unroll
                        for (int j = 0; j < 4; ++j) { const int w = 2 << j; const int cnt = (pos + 1) < w ? (pos + 1) : w; d[j] = S[j] * (1.0f / (float)cnt) - x[j]; }
                        store_bf16_row(C.XN, row, C.lane, d);
                    }
#pragma unroll
                    for (int j = 0; j < 4; ++j) x[j] = xnx[j];
                }
            }
        }
#undef POOL_ROW
#undef POOL_LOAD
    }
}
__device__ __forceinline__ void conv_tap(float (&s)[8], const float (&k)[8], const v4u& uu) {
    s[0] += k[0] * bf_lo(uu.x); s[1] += k[1] * bf_hi(uu.x); s[2] += k[2] * bf_lo(uu.y); s[3] += k[3] * bf_hi(uu.y);
    s[4] += k[4] * bf_lo(uu.z); s[5] += k[5] * bf_hi(uu.z); s[6] += k[6] * bf_lo(uu.w); s[7] += k[7] * bf_hi(uu.w);
}
__device__ __forceinline__ void phase_conv(Ctx& C, const float* ck, const bf16* BGp, const bf16* Up, bf16* Y) {
    float k[3][2][8];
#pragma unroll
    for (int t = 0; t < 3; ++t)
#pragma unroll
        for (int q = 0; q < 2; ++q) { const f32x4 a = *(const f32x4*)(ck + t * D + 8 * C.lane + 512 * q), b = *(const f32x4*)(ck + t * D + 8 * C.lane + 512 * q + 4);
            k[t][q][0] = a[0]; k[t][q][1] = a[1]; k[t][q][2] = a[2]; k[t][q][3] = a[3]; k[t][q][4] = b[0]; k[t][q][5] = b[1]; k[t][q][6] = b[2]; k[t][q][7] = b[3]; }
    constexpr int RUN = 32, NRUN = MROWS / RUN + 1;
    const v4u zero4 = (v4u){0u, 0u, 0u, 0u};
    for (int run = C.gw; run < NRUN; run += C.NGW) {
        const bool mrun = run == NRUN - 1;
        const int r0 = mrun ? MROWS : run * RUN, n = mrun ? NMETA : RUN;
        v4u um1[2], um2[2];
#pragma unroll
        for (int q = 0; q < 2; ++q) { const int co = 8 * C.lane + 512 * q;
            um1[q] = mrun ? zero4 : *(const v4u*)(Up + (size_t)prev_row(r0, 1) * D + co); um2[q] = mrun ? zero4 : *(const v4u*)(Up + (size_t)prev_row(r0, 2) * D + co); }
        v4u uc[2], bc[2], un[2], bn[2];
#pragma unroll
        for (int q = 0; q < 2; ++q) { const int co = 8 * C.lane + 512 * q; uc[q] = *(const v4u*)(Up + (size_t)r0 * D + co); bc[q] = *(const v4u*)(BGp + (size_t)r0 * D + co); }
        for (int i = 0; i < n; ++i) {
            const int row = r0 + i;
            if (i + 1 < n) {
#pragma unroll
                for (int q = 0; q < 2; ++q) { const int co = 8 * C.lane + 512 * q; un[q] = *(const v4u*)(Up + (size_t)(row + 1) * D + co); bn[q] = *(const v4u*)(BGp + (size_t)(row + 1) * D + co); } }
#pragma unroll
            for (int q = 0; q < 2; ++q) {
                const int co = 8 * C.lane + 512 * q;
                const v4u uu = uc[q], bb = bc[q];
                float sacc[8];
#pragma unroll
                for (int e = 0; e < 8; ++e) sacc[e] = 0.f;
                conv_tap(sacc, k[0][q], um2[q]); conv_tap(sacc, k[1][q], um1[q]); conv_tap(sacc, k[2][q], uu);
                um2[q] = um1[q]; um1[q] = uu;
                v4u o; o.x = cvt_pk_bf16(bf_lo(bb.x) * sacc[0], bf_hi(bb.x) * sacc[1]); o.y = cvt_pk_bf16(bf_lo(bb.y) * sacc[2], bf_hi(bb.y) * sacc[3]);
                o.z = cvt_pk_bf16(bf_lo(bb.z) * sacc[4], bf_hi(bb.z) * sacc[5]); o.w = cvt_pk_bf16(bf_lo(bb.w) * sacc[6], bf_hi(bb.w) * sacc[7]);
                *(v4u*)(Y + (size_t)row * D + co) = o;
                uc[q] = un[q]; bc[q] = bn[q];
            }
        }
    }
}
__device__ __forceinline__ float xchg(float v, int lane, int m) { return __int_as_float(__builtin_amdgcn_ds_bpermute((lane ^ m) << 2, __float_as_int(v))); }
__device__ __forceinline__ void phase_router(Ctx& C, const float* gain, const float* router, unsigned* gcnt  ) {
    LAS unsigned* lcnt = (LAS unsigned*)C.lds;
    LAS unsigned* lbase = lcnt + 8;
    LAS unsigned* ent = lcnt + 16;
    f32x4 g[4];
#pragma unroll
    for (int j = 0; j < 4; ++j) g[j] = ((const f32x4*)gain)[C.lane + 64 * j];
    f32x4 ra[4][4], rb[4][4];
#pragma unroll
    for (int j = 0; j < 4; ++j)
#pragma unroll
        for (int i = 0; i < 4; ++i) { const f32x4* rp = (const f32x4*)(router + (size_t)(4 * C.lane + 256 * j + i) * NE); ra[j][i] = rp[0]; rb[j][i] = rp[1]; }
    unsigned* rowidx = (unsigned*)(C.ws + WS_ROWIDX); int2* slot = (int2*)(C.ws + WS_SLOT);
    const int nchunk = (RTOT + 255) / 256;
    const bool up32 = (C.lane & 32) != 0, up16 = (C.lane & 16) != 0, up8 = (C.lane & 8) != 0;
    for (int ch = blockIdx.x; ch < nchunk; ch += C.G) {
        const int r0 = ch * 256, nr = (RTOT - r0) < 256 ? (RTOT - r0) : 256;
        __syncthreads();
        if (C.tid < 16) lcnt[C.tid] = 0u;
        __syncthreads();
        f32x4 x[4], xnx[4];
        if (C.wave < nr) load_heff(C, r0 + C.wave, false, x);
        for (int lr = C.wave; lr < nr; lr += NWAVES) {
            const int row = r0 + lr;
            if (lr + NWAVES < nr) load_heff(C, row + NWAVES, false, xnx);
            const float rs = row_rstd(x, C.lane);
#pragma unroll
            for (int j = 0; j < 4; ++j) x[j] = x[j] * rs * g[j];
            { unsigned* o8 = (unsigned*)((unsigned char*)C.XN + (size_t)row * D) + C.lane;
#pragma unroll
              for (int j = 0; j < 4; ++j) o8[64 * j] = pk4_fp8(x[j][0], x[j][1], x[j][2], x[j][3]); }
            f32x4 la = (f32x4){0.f, 0.f, 0.f, 0.f}, lb = la;
#pragma unroll
            for (int j = 0; j < 4; ++j)
#pragma unroll
                for (int i = 0; i < 4; ++i) { la += ra[j][i] * x[j][i]; lb += rb[j][i] * x[j][i]; }
            f32x4 k4; { const f32x4 keep = up32 ? lb : la, give = up32 ? la : lb;
                k4[0] = keep[0] + xchg(give[0], C.lane, 32); k4[1] = keep[1] + xchg(give[1], C.lane, 32); k4[2] = keep[2] + xchg(give[2], C.lane, 32); k4[3] = keep[3] + xchg(give[3], C.lane, 32); }
            float k2a, k2b; { const float keep0 = up16 ? k4[2] : k4[0], keep1 = up16 ? k4[3] : k4[1], give0 = up16 ? k4[0] : k4[2], give1 = up16 ? k4[1] : k4[3];
                k2a = keep0 + xchg(give0, C.lane, 16); k2b = keep1 + xchg(give1, C.lane, 16); }
            float k1; { const float keep = up8 ? k2b : k2a, give = up8 ? k2a : k2b; k1 = keep + xchg(give, C.lane, 8); }
            k1 += xchg(k1, C.lane, 4); k1 += xchg(k1, C.lane, 2); k1 += xchg(k1, C.lane, 1);
            float lg[8];
#pragma unroll
            for (int e = 0; e < 8; ++e) lg[e] = __int_as_float(__builtin_amdgcn_readlane(__float_as_int(k1), 8 * e));
            int e1 = 0; float v1 = lg[0];
#pragma unroll
            for (int e = 1; e < 8; ++e) if (lg[e] > v1) { v1 = lg[e]; e1 = e; }
            int e2 = -1; float v2 = -3.0e38f;
#pragma unroll
            for (int e = 0; e < 8; ++e) if (e != e1 && lg[e] > v2) { v2 = lg[e]; e2 = e; }
            const float ex = __expf(v2 - v1), w1 = 1.0f / (1.0f + ex), w2 = ex * w1;
            if (C.lane == 0) {
                const unsigned k1_ = atomicAdd((unsigned*)&lcnt[e1], 1u), k2_ = atomicAdd((unsigned*)&lcnt[e2], 1u);
                ent[(lr * 2 + 0) * 2 + 0] = (unsigned)e1 | (k1_ << 8); ent[(lr * 2 + 0) * 2 + 1] = __float_as_uint(w1);
                ent[(lr * 2 + 1) * 2 + 0] = (unsigned)e2 | (k2_ << 8); ent[(lr * 2 + 1) * 2 + 1] = __float_as_uint(w2);
            }
#pragma unroll
            for (int j = 0; j < 4; ++j) x[j] = xnx[j];
        }
        __syncthreads();
        if (C.tid < 8) lbase[C.tid] = __hip_atomic_fetch_add(gcnt + 64 * C.tid, lcnt[C.tid], __ATOMIC_RELAXED, __HIP_MEMORY_SCOPE_AGENT);
        __syncthreads();
        for (int q = C.tid; q < nr * 2; q += NWAVES * 64) {
            const unsigned ek = ent[q * 2], wb = ent[q * 2 + 1]; const int e = ek & 255, rank = ek >> 8, row = r0 + (q >> 1), ch2 = q & 1;
            const int pos = e * CAP + (int)lbase[e] + rank;
            rowidx[pos] = (unsigned)row; slot[pos] = make_int2(row | (ch2 << 31), (int)wb);
        }
    }
    __syncthreads();
}
__device__ __forceinline__ void phase_final(Ctx& C, const float* gain, float* out) {
    f32x4 g[4];
#pragma unroll
    for (int j = 0; j < 4; ++j) g[j] = ((const f32x4*)gain)[C.lane + 64 * j];
    f32x4 x[4], xnx[4];
    if (C.gw < MROWS) load_heff(C, C.gw, true, x);
    for (int row = C.gw; row < MROWS; row += C.NGW) {
        const int nrow = row + C.NGW;
        if (nrow < MROWS) load_heff(C, nrow, true, xnx);
        const float rs = row_rstd(x, C.lane);
        f32x4* o = (f32x4*)(out + (size_t)row * D) + C.lane;
#pragma unroll
        for (int j = 0; j < 4; ++j) o[64 * j] = x[j] * rs * g[j];
#pragma unroll
        for (int j = 0; j < 4; ++j) x[j] = xnx[j];
    }
}
__device__ __forceinline__ void copy_params(Ctx& C, const Args& a) {
    float* P = (float*)(C.ws + WS_PARAMS);
    for (int i = C.gw * 64 + C.lane; i < PP_TOTAL; i += C.NGW * 64) {
        float v;
        if (i < PP_POOL_SCALE) v = a.in[2][i - PP_POOL_NORM];
        else if (i < PP_DENSE_NORM) v = a.in[4][i - PP_POOL_SCALE];
        else if (i < PP_CONV_NORM) v = a.in[5][i - PP_DENSE_NORM];
        else if (i < PP_MOE_NORM) v = a.in[9][i - PP_CONV_NORM];
        else if (i < PP_FINAL) v = a.in[13][i - PP_MOE_NORM];
        else if (i < PP_CONV_K) v = a.in[18][i - PP_FINAL];
        else if (i < PP_ROUTER) v = a.in[11][i - PP_CONV_K];
        else v = a.in[14][i - PP_ROUTER];
        P[i] = v;
    }
}
__device__ __forceinline__ void phase_copy_in(Ctx& C, const float* x, const float* meta) {
    for (int row = C.gw; row < RTOT; row += C.NGW) {
        const f32x4* p = (const f32x4*)(row < MROWS ? x + (size_t)row * D : meta + (size_t)(row - MROWS) * D) + C.lane;
        f32x4* o = (f32x4*)(C.H32 + (size_t)row * D) + C.lane;
#pragma unroll
        for (int j = 0; j < 4; ++j) o[64 * j] = p[64 * j];
    }
}
__device__ __forceinline__ int moe_cnt(unsigned* gcnt, int e) { return __builtin_amdgcn_readfirstlane((int)__hip_atomic_load(gcnt + 64 * e, __ATOMIC_RELAXED, __HIP_MEMORY_SCOPE_AGENT)); }
__device__ __forceinline__ void moe_sched_init(pg8::MoeSched& S, const Ctx& C, unsigned* gcnt, int pass, int nN) {
    S.n0 = moe_cnt(gcnt, 0); S.n1 = moe_cnt(gcnt, 1); S.n2 = moe_cnt(gcnt, 2); S.n3 = moe_cnt(gcnt, 3); S.n4 = moe_cnt(gcnt, 4); S.n5 = moe_cnt(gcnt, 5); S.n6 = moe_cnt(gcnt, 6); S.n7 = moe_cnt(gcnt, 7);
    S.m1 = (S.n0 + 255) >> 8; S.m2 = S.m1 + ((S.n1 + 255) >> 8); S.m3 = S.m2 + ((S.n2 + 255) >> 8); S.m4 = S.m3 + ((S.n3 + 255) >> 8);
    S.m5 = S.m4 + ((S.n4 + 255) >> 8); S.m6 = S.m5 + ((S.n5 + 255) >> 8); S.m7 = S.m6 + ((S.n6 + 255) >> 8);
    const int total = S.m7 + ((S.n7 + 255) >> 8);
    S.t0 = pass * MOE_CH; int nM = total - S.t0; const int cap = (pass == MOE_PASSES - 1) ? MOE_LAST_MAX : MOE_CH; nM = nM < 0 ? 0 : (nM > cap ? cap : nM);
    S.nM = nM; S.nN = nN; S.G = C.G; S.c = (int)blockIdx.x;
}
__device__ __forceinline__ bool relaunder(Ctx& C, unsigned char* ws) { C.lane = lane_id(); C.tid = C.wave * 64 + C.lane;
    { int g = C.gw0, w = C.wave0; asm volatile("" : "+s"(g), "+s"(w)); C.gw = g; C.wave = w; }
    size_t z_ = 0; asm volatile("" : "+s"(z_)); ws += z_; C.ws = ws;
    C.H32 = (float*)(ws + WS_H32); C.XN = (bf16*)(ws + WS_XN); C.Y1 = (bf16*)(ws + WS_Y1); C.RSTD = (float*)(ws + WS_RSTD); return true; }
constexpr int N_PHASES = 1 + 2 * (7 + 5 + 2 * MOE_PASSES) + 1;

#define RUN() (ph >= lo && ph < hi && relaunder(C, args.ws))
#define REPE for (int rep_ = 0; rep_ < PROBE_REP_ELT; ++rep_)
#define REPG for (int rep_ = 0; rep_ < PROBE_REP_GEMM; ++rep_)
#define SEAM() do { if (ph >= lo && ph + 1 < hi) xcd_barrier(bar, C.wave0); ++ph; } while (0)
#define INTER ((bf16*)(C.ws + WS_INTER))
#define PRM ((const float*)(C.ws + WS_PARAMS))

template <int lp>
__device__ __forceinline__ void layer_pair(Ctx& C, const Args& args, int& ph, const int lo, const int hi, const XcdBarrier& bar, LAS unsigned* idxbuf) {
        const bool addy1 = lp > 0;
        if (RUN()) REPE phase_pool<lp == 0>(C, PRM + PP_POOL_NORM + lp * D, addy1, args.in[0], args.in[1]);
    SEAM();
    if (RUN()) {
            pg8::DenseSched S; S.nM = MT_ALL; S.nN = 4; S.G = C.G; S.c = (int)blockIdx.x; S.A = (const char*)C.XN; S.Bt = (const char*)(C.ws + WS_WPOOL + (size_t)lp * 524288);
            S.tstepA = 256u * D * 2; S.tstepB = 256u * 256 * 2; S.a_colstep = 512;
            pg8::EpiResid E{C.H32, addy1 ? C.Y1 : nullptr, PRM + PP_POOL_SCALE + lp * D, 0, lp == 0 ? args.in[0] : nullptr, lp == 0 ? args.in[1] : nullptr};
            pg8::gemm_phase<pg8::EpiResid, pg8::DenseSched, false>(C.lds, idxbuf, C.wave, 256 / 64, D * 2, 256 * 2, S, E);
        }
        SEAM();
        if (RUN()) REPE phase_norm(C, PRM + PP_DENSE_NORM + lp * D, false, lp == DENSE_FP8_LAYER);
        SEAM();
        for (int hf = 0; hf < 2; ++hf) {
            const int pm0 = hf ? DENSE_H0 : 0, nM = hf ? (MT_ALL - DENSE_H0) : DENSE_H0;
            if (RUN()) {
                pg8::DenseSched S; S.nM = nM; S.nN = FF / 128; S.G = C.G; S.c = (int)blockIdx.x; S.a_colstep = 0; S.Bt = (const char*)(C.ws + WS_WGU + (size_t)lp * GU_BYTES);
                if (lp == DENSE_FP8_LAYER) {
                    S.A = (const char*)C.XN + (size_t)pm0 * 256 * D; S.tstepA = 256u * D; S.tstepB = 256u * D;
                    pg8::EpiSwiGLU8 E{(unsigned char*)INTER, FF};
                    for (int rep_ = 0; rep_ < ((PROBE_MASK & 2) ? 2 : 1); ++rep_) pg8::gemm_phase<pg8::EpiSwiGLU8, pg8::DenseSched, false, true>(C.lds, idxbuf, C.wave, D / 128, D, D, S, E, SC_ONE, SC_GU);
                } else {
                    S.A = (const char*)(C.XN + (size_t)pm0 * 256 * D); S.tstepA = 256u * D * 2; S.tstepB = 256u * D * 2;
                    pg8::EpiSwiGLU E{INTER, FF};
                    for (int rep_ = 0; rep_ < ((PROBE_MASK & 1) ? 2 : 1); ++rep_) pg8::gemm_phase<pg8::EpiSwiGLU, pg8::DenseSched, false>(C.lds, idxbuf, C.wave, D / 64, D * 2, D * 2, S, E);
                }
            }
            SEAM();
            if (RUN()) {
                pg8::DenseSched S; S.nM = nM; S.nN = 4; S.G = C.G; S.c = (int)blockIdx.x; S.A = (const char*)INTER; S.a_colstep = 0; S.Bt = (const char*)(C.ws + WS_WDN + (size_t)lp * DN_BYTES);
                constexpr int PB = (lp == DENSE_FP8_LAYER) ? 2 : 1, NR = (PROBE_MASK & PB) ? 2 : 1;
                pg8::EpiResid E{C.H32, nullptr, nullptr, pm0 * 256, nullptr, nullptr, 1.0f / NR};
                if (lp == DENSE_FP8_LAYER) { S.tstepA = 256u * FF; S.tstepB = 256u * FF;
                    for (int rep_ = 0; rep_ < NR; ++rep_) pg8::gemm_phase<pg8::EpiResid, pg8::DenseSched, false, true>(C.lds, idxbuf, C.wave, FF / 128, FF, FF, S, E, SC_H, SC_DN); }
                else { S.tstepA = 256u * FF * 2; S.tstepB = 256u * FF * 2;
                    for (int rep_ = 0; rep_ < NR; ++rep_) pg8::gemm_phase<pg8::EpiResid, pg8::DenseSched, false>(C.lds, idxbuf, C.wave, FF / 64, FF * 2, FF * 2, S, E); }
            }
            SEAM();
        }
        if (RUN()) REPE phase_norm(C, PRM + PP_CONV_NORM + lp * D, false);
        SEAM();
#define BG INTER
#define UU (INTER + (size_t)RPAD * D)
        if (RUN()) {
            pg8::DenseSched S; S.nM = MT_ALL; S.nN = 12; S.G = C.G; S.c = (int)blockIdx.x; S.A = (const char*)C.XN; S.Bt = (const char*)(C.ws + WS_WIN + (size_t)lp * 3 * D * D * 2);
            S.tstepA = 256u * D * 2; S.tstepB = 256u * D * 2; S.a_colstep = 0;
            pg8::EpiConvIn E{BG, UU};
            for (int rep_ = 0; rep_ < ((PROBE_MASK & 4) ? 2 : 1); ++rep_) pg8::gemm_phase<pg8::EpiConvIn, pg8::DenseSched, false>(C.lds, idxbuf, C.wave, D / 64, D * 2, D * 2, S, E);
        }
        SEAM();
        if (RUN()) REPE phase_conv(C, PRM + PP_CONV_K + lp * 3 * D, BG, UU, C.XN);
        SEAM();
        if (RUN()) {
            pg8::DenseSched S; S.nM = MT_ALL; S.nN = 4; S.G = C.G; S.c = (int)blockIdx.x; S.A = (const char*)C.XN; S.Bt = (const char*)(C.ws + WS_WOUT + (size_t)lp * D * D * 2);
            S.tstepA = 256u * D * 2; S.tstepB = 256u * D * 2; S.a_colstep = 0;
            constexpr int NR = (PROBE_MASK & 4) ? 2 : 1;
            pg8::EpiResid E{C.H32, nullptr, nullptr, 0, nullptr, nullptr, 1.0f / NR};
            for (int rep_ = 0; rep_ < NR; ++rep_) pg8::gemm_phase<pg8::EpiResid, pg8::DenseSched, false>(C.lds, idxbuf, C.wave, D / 64, D * 2, D * 2, S, E);
        }
        SEAM();
#define gcnt ((unsigned*)(C.ws + WS_CTL) + CW_MOECNT + lp * 8 * 64)
        if (RUN()) phase_router(C, PRM + PP_MOE_NORM + lp * D, PRM + PP_ROUTER + lp * D * NE, gcnt);
        SEAM();
        for (int pass = 0; pass < MOE_PASSES; ++pass) {
            if (RUN()) {
                pg8::MoeSched S; moe_sched_init(S, C, gcnt, pass, FF / 128);
                S.A = (const char*)C.XN; S.tstepA = 0; S.Bt = (const char*)(C.ws + WS_WMGU + (size_t)lp * NE * GU8_BYTES); S.estepB = (unsigned)GU8_BYTES; S.tstepB = 256u * D; S.rowidx = (const unsigned*)(C.ws + WS_ROWIDX);
                pg8::EpiSwiGLU8 E{(unsigned char*)INTER, FF};
                for (int rep_ = 0; rep_ < ((PROBE_MASK & 8) ? 2 : 1); ++rep_) pg8::gemm_phase<pg8::EpiSwiGLU8, pg8::MoeSched, true, true>(C.lds, idxbuf, C.wave, D / 128, D, D, S, E, SC_ONE, SC_GU);
            }
            SEAM();
            if (RUN()) {
                pg8::MoeSched S; moe_sched_init(S, C, gcnt, pass, 4);
                S.A = (const char*)INTER; S.tstepA = 256u * FF; S.Bt = (const char*)(C.ws + WS_WMDN + (size_t)lp * NE * DN8_BYTES); S.estepB = (unsigned)DN8_BYTES; S.tstepB = 256u * FF; S.rowidx = nullptr;
                constexpr int NR = (PROBE_MASK & 16) ? 2 : 1;
                pg8::EpiMoeDown E{(const int2*)(C.ws + WS_SLOT), C.H32, C.Y1, 1.0f / NR};
                for (int rep_ = 0; rep_ < NR; ++rep_) pg8::gemm_phase<pg8::EpiMoeDown, pg8::MoeSched, false, true>(C.lds, idxbuf, C.wave, FF / 128, FF, FF, S, E, SC_H, SC_DN);
            }
            SEAM();
        }
}

__global__ void __launch_bounds__(NWAVES * 64, 2) fwd(Args args) {
    extern __shared__ __attribute__((aligned(16))) unsigned char lds_raw[];
    Ctx C;
    C.lds = (LAS unsigned char*)lds_raw;
    C.tid = threadIdx.x; C.lane = C.tid & 63; C.wave0 = __builtin_amdgcn_readfirstlane(C.tid >> 6); C.wave = C.wave0;
    C.G = gridDim.x; { const int bx = blockIdx.x; C.vcu = (C.G % 8 == 0) ? (bx % 8) * (C.G / 8) + bx / 8 : bx; }
    C.gw0 = C.vcu * NWAVES + C.wave; C.gw = C.gw0; C.NGW = C.G * NWAVES;
    C.ws = args.ws; C.H32 = (float*)(args.ws + WS_H32); C.XN = (bf16*)(args.ws + WS_XN); C.Y1 = (bf16*)(args.ws + WS_Y1); C.RSTD = (float*)(args.ws + WS_RSTD);
    C.ctl = (unsigned*)(args.ws + WS_CTL);
    LAS unsigned* idxbuf = (LAS unsigned*)(C.lds + IDX_OFF);
    volatile LAS unsigned* MISC = (volatile LAS unsigned*)(C.lds + MISC_OFF);
    for (int u = C.tid; u < (LDS_BYTES - IDX_OFF) / 4; u += NWAVES * 64) ((LAS unsigned*)(C.lds + IDX_OFF))[u] = 0u;
    __syncthreads();
    const int lo = args.ph_lo, hi = args.ph_hi;
    XcdBarrier bar; bar.bar = C.ctl + CW_BAR; bar.x = 0; bar.st = nullptr;
    if (hi - lo > 1) bar = xcd_barrier_post(C.ctl + CW_BAR, MISC + 8);
    int ph = 0;
    if (RUN()) REPE { copy_params(C, args); convert_small_weights(C, args); convert_moe_layer(C, args, 0); convert_moe_layer(C, args, 1); }
    SEAM();

    layer_pair<0>(C, args, ph, lo, hi, bar, idxbuf);
    layer_pair<1>(C, args, ph, lo, hi, bar, idxbuf);
    if (RUN()) REPE phase_final(C, PRM + PP_FINAL, args.out);
    SEAM();
#undef RUN
#undef SEAM
#undef INTER
#undef PRM
#undef BG
#undef UU
#undef gcnt
}

extern "C" void kernel_launch(void* const* d_in, const int* in_sizes, int n_in, void* d_out, int out_size, void* d_ws, size_t ws_size, hipStream_t stream) {
    static int grid = 0;
    if (grid == 0) {
        if (n_in != 19 || in_sizes[0] != MROWS * D || out_size != MROWS * D || ws_size < WS_END) {
            fprintf(stderr, "kernel_launch: unexpected problem (n_in %d, in0 %d, out %d, ws %zu < %zu); nothing launched\n", n_in, n_in > 0 ? in_sizes[0] : -1, out_size, ws_size, (size_t)WS_END); grid = -1; return; }
        int dev = 0, cus = 0, per_cu = 0;
        if (hipGetDevice(&dev) != hipSuccess || hipDeviceGetAttribute(&cus, hipDeviceAttributeMultiprocessorCount, dev) != hipSuccess) { grid = -1; return; }
        if (hipFuncSetAttribute((const void*)fwd, hipFuncAttributeMaxDynamicSharedMemorySize, LDS_BYTES) != hipSuccess) { fprintf(stderr, "kernel_launch: hipFuncSetAttribute failed\n"); grid = -1; return; }
        if (hipOccupancyMaxActiveBlocksPerMultiprocessor(&per_cu, (const void*)fwd, NWAVES * 64, LDS_BYTES) != hipSuccess || per_cu < 1)
            fprintf(stderr, "kernel_launch: occupancy query reports %d workgroups per CU\n", per_cu);
        (void)hipGetLastError();
        grid = cus;
    }
    if (grid < 0) return;
    if (hipMemsetAsync((char*)d_ws + WS_CTL, 0, CTL_ZERO_BYTES, stream) != hipSuccess) { fprintf(stderr, "kernel_launch: memset failed\n"); return; }
    Args a{};
    for (int i = 0; i < 19; ++i) a.in[i] = (const float*)d_in[i];
    a.out = (float*)d_out; a.ws = (unsigned char*)d_ws;
#if MK_ONE_LAUNCH
    a.ph_lo = 0; a.ph_hi = N_PHASES;
    hipLaunchKernelGGL(fwd, dim3(grid), dim3(NWAVES * 64), LDS_BYTES, stream, a);
#else
    for (int p = 0; p < N_PHASES; ++p) { a.ph_lo = p; a.ph_hi = p + 1; hipLaunchKernelGGL(fwd, dim3(grid), dim3(NWAVES * 64), LDS_BYTES, stream, a); }
#endif
    const hipError_t le = hipPeekAtLastError();
    if (le != hipSuccess) fprintf(stderr, "kernel_launch: launch failed: %s\n", hipGetErrorName(le));
}
```

```cpp
#include <hip/hip_runtime.h>
#include <cstdio>
#include <cstdint>

#ifndef PROBE_REP_ELT
#define PROBE_REP_ELT 1
#endif
#ifndef PROBE_MASK
#define PROBE_MASK 0
#endif
#ifndef PROBE_REP_GEMM
#define PROBE_REP_GEMM 1
#endif
#ifndef MK_ONE_LAUNCH
#define MK_ONE_LAUNCH 1
#endif

constexpr int D = 1024, FF = 3584, NE = 8, NB = 32, TS = 2048, NMETA = 16;
constexpr int MROWS = NB * TS;
constexpr int RTOT = MROWS + NMETA;
constexpr int MT_ALL = 257;
constexpr int RPAD = MT_ALL * 256;
constexpr int CAP = RPAD;
constexpr float EPS = 1e-6f;
constexpr int NWAVES = 8;
constexpr int MOE_CH = 256, MOE_PASSES = 2;
constexpr int MOE_LAST_MAX = 272;
constexpr float W_GU_SCALE = 64.f, W_DN_SCALE = 128.f, H8_SCALE = 4.f;
constexpr int SC_ONE = 0x7f7f7f7f, SC_GU = 0x79797979  , SC_DN = 0x78787878  , SC_H = 0x7d7d7d7d  ;
constexpr int DENSE_H0 = 128;
constexpr int DENSE_FP8_LAYER = 1;

constexpr size_t MiB = 1u << 20;
constexpr size_t WS_CTL = 0, CTL_ZERO_BYTES = 1 * MiB;
constexpr size_t WS_WPOOL = 1 * MiB;
constexpr size_t WS_WGU = 2 * MiB;
constexpr size_t WS_WDN = 30 * MiB;
constexpr size_t WS_WIN = 44 * MiB;
constexpr size_t WS_WOUT = 56 * MiB;
constexpr size_t WS_WMGU = 60 * MiB;
constexpr size_t WS_WMDN = 172 * MiB;
constexpr size_t WS_ROWIDX = 228 * MiB;
constexpr size_t WS_SLOT = 231 * MiB;
constexpr size_t WS_RSTD = 236 * MiB;
constexpr size_t WS_PARAMS = 236 * MiB + 512 * 1024;
constexpr int PP_POOL_NORM = 0, PP_POOL_SCALE = 2048, PP_DENSE_NORM = 4096, PP_CONV_NORM = 6144, PP_MOE_NORM = 8192, PP_FINAL = 10240, PP_CONV_K = 11264, PP_ROUTER = 17408, PP_TOTAL = 17408 + 16384;
constexpr size_t WS_H32 = 237 * MiB;
constexpr size_t WS_XN = 494 * MiB;
constexpr size_t WS_Y1 = 623 * MiB;
constexpr size_t WS_INTER = 752 * MiB;
constexpr size_t WS_END = 1009 * MiB;
constexpr size_t GU_BYTES = (size_t)7168 * 1024 * 2, DN_BYTES = (size_t)1024 * 3584 * 2, GU8_BYTES = GU_BYTES / 2, DN8_BYTES = DN_BYTES / 2;
static_assert(WS_ROWIDX + (size_t)8 * CAP * 4 <= WS_SLOT && WS_SLOT + (size_t)8 * CAP * 8 <= WS_RSTD, "lists");
static_assert(WS_H32 + (size_t)RPAD * D * 4 <= WS_XN && WS_XN + (size_t)RPAD * D * 2 <= WS_Y1 && WS_Y1 + (size_t)RPAD * D * 2 <= WS_INTER, "act map");
static_assert((size_t)MOE_LAST_MAX * 256 * FF <= WS_END - WS_INTER && (size_t)129 * 256 * FF * 2 <= WS_END - WS_INTER && (size_t)2 * RPAD * D * 2 <= WS_END - WS_INTER, "inter");
constexpr int CW_BAR = 4096;
constexpr int CW_MOECNT = 16384;

constexpr int RING_BYTES = 131072;
constexpr int IDX_OFF = RING_BYTES;
constexpr int MISC_OFF = IDX_OFF + 2048;
constexpr int LDS_BYTES = 147456;

#define GAS __attribute__((address_space(1)))
#define LAS __attribute__((address_space(3)))
typedef unsigned short bf16;
typedef float f32x4 __attribute__((ext_vector_type(4)));
typedef unsigned v4u __attribute__((ext_vector_type(4)));
typedef unsigned v2u __attribute__((ext_vector_type(2)));
#define LDS_WAIT() asm volatile("s_waitcnt lgkmcnt(0)" ::: "memory")
#define VM_WAIT() asm volatile("s_waitcnt vmcnt(0)" ::: "memory")

__device__ __forceinline__ int lane_id() { int l; asm volatile("v_mbcnt_lo_u32_b32 %0, -1, 0\n\tv_mbcnt_hi_u32_b32 %0, -1, %0" : "=v"(l)); return l; }
__device__ __forceinline__ unsigned cvt_pk_bf16(float lo, float hi) { unsigned r; asm volatile("v_cvt_pk_bf16_f32 %0, %1, %2" : "=v"(r) : "v"(lo), "v"(hi)); return r; }
__device__ __forceinline__ unsigned pk4_fp8(float a, float b, float c, float d) { int w = __builtin_amdgcn_cvt_pk_fp8_f32(a, b, 0, false); w = __builtin_amdgcn_cvt_pk_fp8_f32(c, d, w, true); return (unsigned)w; }
__device__ __forceinline__ float bf_lo(unsigned w) { return __uint_as_float(w << 16); }
__device__ __forceinline__ float bf_hi(unsigned w) { return __uint_as_float(w & 0xffff0000u); }
__device__ __forceinline__ float wave_sum(float v, int lane) {
#pragma unroll
    for (int o = 1; o < 64; o <<= 1) v += __int_as_float(__builtin_amdgcn_ds_bpermute((lane ^ o) << 2, __float_as_int(v)));
    return v;
}
typedef float f32x2 __attribute__((ext_vector_type(2)));
__device__ __forceinline__ f32x2 silu_mul_pk(f32x2 g, f32x2 u, float inv) {
    const f32x2 t = g * -1.44269504f; f32x2 e; e.x = __builtin_amdgcn_exp2f(t.x); e.y = __builtin_amdgcn_exp2f(t.y);
    const f32x2 d = e * inv + inv; f32x2 r; r.x = __builtin_amdgcn_rcpf(d.x); r.y = __builtin_amdgcn_rcpf(d.y);
    return (g * u) * r;
}
__device__ __forceinline__ float silu_f(float a) { return a * __builtin_amdgcn_rcpf(1.0f + __builtin_amdgcn_exp2f(a * -1.44269504f)); }

#define XB_TMO      128
#define XB_XCNT(j)  (256  + 64 * (j))
#define XB_XSUB(j)  (1280 + 64 * (j))
#define XB_XGEN(j)  (2304 + 64 * (j))
#define XB_TOP      3328
#define XB_TOPGEN   3392
#define XCD_BAR_WORDS 3456
#define XB_SPIN_CAP (1u << 18)
__device__ __forceinline__ unsigned xb_ld(unsigned* p)              { return __hip_atomic_load(p, __ATOMIC_RELAXED, __HIP_MEMORY_SCOPE_AGENT); }
__device__ __forceinline__ unsigned xb_add(unsigned* p, unsigned v) { return __hip_atomic_fetch_add(p, v, __ATOMIC_RELAXED, __HIP_MEMORY_SCOPE_AGENT); }
__device__ __forceinline__ unsigned xb_xcc_id() { return (unsigned)__builtin_amdgcn_s_getreg((3 << 11) | 20) & 0xFu; }
#define XB_SPIN(cond, bar) do { unsigned _sp = 0; while (cond) { __builtin_amdgcn_s_sleep(1); \
    if ((++_sp & 255u) == 0u) { if (xb_ld(&(bar)[XB_TMO])) break; if (_sp > XB_SPIN_CAP) { atomicAdd(&(bar)[XB_TMO], 1u); break; } } } } while (0)
struct XcdBarrier { unsigned* bar; unsigned x; volatile LAS unsigned* st; };
__device__ __forceinline__ XcdBarrier xcd_barrier_post(unsigned* bar, volatile LAS unsigned* st) {
    XcdBarrier b; b.bar = bar; b.x = xb_xcc_id(); b.st = st;
    if (threadIdx.x == 0) (void)xb_add(&bar[XB_XCNT(b.x)], 1u);
    return b;
}
__device__ __forceinline__ void xcd_barrier_complete(unsigned* bar, unsigned x, unsigned& nloc, unsigned& nx) {
    const unsigned G = gridDim.x * gridDim.y * gridDim.z;
    unsigned sum, cnt, mine, sp = 0u;
    for (;;) {
        sum = 0u; cnt = 0u; mine = 0u;
#pragma unroll
        for (unsigned j = 0; j < 16; ++j) { const unsigned c = xb_ld(&bar[XB_XCNT(j)]); sum += c; cnt += (c > 0u) ? 1u : 0u; mine = (j == x) ? c : mine; }
        if (sum == G) break;
        __builtin_amdgcn_s_sleep(1);
        if ((++sp & 255u) == 0u) { if (xb_ld(&bar[XB_TMO])) break; if (sp > XB_SPIN_CAP) { atomicAdd(&bar[XB_TMO], 1u); break; } }
    }
    nloc = mine > 0u ? mine : 1u; nx = cnt > 0u ? cnt : 1u;
}
__device__ __forceinline__ void xcd_barrier(const XcdBarrier& b, const int wave  ) {
    asm volatile("s_waitcnt vmcnt(0)" ::: "memory");
    __syncthreads();
    if (wave == 0 && lane_id() == 0) {
        size_t z_ = 0; asm volatile("" : "+s"(z_)); unsigned* bar = b.bar + z_;
        __builtin_amdgcn_s_waitcnt(0);
        unsigned nloc = b.st[0], nx = b.st[1];
        if (nloc == 0u) { xcd_barrier_complete(bar, b.x, nloc, nx); b.st[0] = nloc; b.st[1] = nx; }
        const unsigned old = xb_add(&bar[XB_XSUB(b.x)], 1u);
        const unsigned gen = old / nloc;
        if (old + 1u == (gen + 1u) * nloc) {
            __builtin_amdgcn_fence(__ATOMIC_RELEASE, "agent");
            asm volatile("s_waitcnt vmcnt(0)" ::: "memory");
            const unsigned og = xb_add(&bar[XB_TOP], 1u);
            const unsigned tg = og / nx;
            if (og + 1u == (tg + 1u) * nx) xb_add(&bar[XB_TOPGEN], 1u);
            else XB_SPIN(xb_ld(&bar[XB_TOPGEN]) == tg, bar);
            __builtin_amdgcn_fence(__ATOMIC_ACQUIRE, "agent");
            xb_add(&bar[XB_XGEN(b.x)], 1u);
            asm volatile("s_waitcnt vmcnt(0)" ::: "memory");
        } else {
            XB_SPIN(xb_ld(&bar[XB_XGEN(b.x)]) == gen, bar);
            __builtin_amdgcn_fence(__ATOMIC_ACQUIRE, "agent");
            asm volatile("s_waitcnt vmcnt(0)" ::: "memory");
        }
    }
    __syncthreads();
}

namespace pg8 {
typedef short bf16x8 __attribute__((ext_vector_type(8)));
constexpr int BM = 256, BK = 64, HALF = 128, HTB = HALF * BK * 2, STAGE_BYTES = 8 * HTB;
static_assert(STAGE_BYTES == RING_BYTES, "ring");
__host__ __device__ __forceinline__ int lds_byte(int r, int c) { const int st = (r >> 4) * 2 + (c >> 5), rr = r & 15, cc = c & 31, ob = rr * 64 + cc * 2; return st * 1024 + (ob ^ (((ob >> 9) & 1) << 5)); }
__host__ __device__ __forceinline__ void stage_rc(int b, int& R, int& C) { const int st = b / 1024, sb = b % 1024, swz = sb ^ (((sb >> 9) & 1) << 5); R = (st >> 1) * 16 + swz / 64; C = (st & 1) * 32 + (swz % 64) / 2; }
__host__ __device__ __forceinline__ int perm32(int rho) { const int n = rho >> 4, i = rho & 15; return 8 * (i >> 2) + 4 * n + (i & 3); }

struct Unit { int pm, pn, e, rows, slot0; };

__device__ __forceinline__ bool static_tile(int i, int G, int c, int nM, int nN, int& pm, int& pn) {
    const int nwg = nM * nN; const long L = (long)i * G + c; if (L >= nwg) return false;
    int wgid = (int)L; { const int q = nwg / 8, r = nwg % 8, xcd = wgid % 8, off = wgid / 8; wgid = (xcd < r ? xcd * (q + 1) : r * (q + 1) + (xcd - r) * q) + off; }
    const int nig = 8 * nN, gid = wgid / nig, fm = gid * 8, gsz = (nM - fm) < 8 ? (nM - fm) : 8;
    pm = fm + ((wgid % nig) % gsz); pn = (wgid % nig) / gsz; return true;
}
struct DenseSched {
    int nM, nN, G, c; const char* A; const char* Bt; unsigned tstepA, tstepB, a_colstep; int meta_pm = -1;
    __device__ __forceinline__ bool next(int i, Unit& u) const { if (!static_tile(i, G, c, nM, nN, u.pm, u.pn)) return false; u.e = 0; u.rows = (u.pm == meta_pm) ? NMETA : 256; u.slot0 = 0; return true; }
    __device__ __forceinline__ unsigned a_off(const Unit& u) const { return (unsigned)u.pm * tstepA + (unsigned)u.pn * a_colstep; }
    __device__ __forceinline__ unsigned b_off(const Unit& u) const { return (unsigned)u.pn * tstepB; }
    __device__ __forceinline__ const unsigned* idx_src(const Unit&) const { return nullptr; }
};
struct MoeSched {
    int nM, nN, G, c, t0; int m1, m2, m3, m4, m5, m6, m7; int n0, n1, n2, n3, n4, n5, n6, n7;
    const char* A; unsigned tstepA; const char* Bt; unsigned estepB, tstepB; const unsigned* rowidx;
    __device__ __forceinline__ bool next(int i, Unit& u) const {
        if (!static_tile(i, G, c, nM, nN, u.pm, u.pn)) return false;
        const int tg = t0 + u.pm; int e = 0, base = 0, cn = __builtin_amdgcn_readfirstlane(n0);
        if (tg >= m1) { e = 1; base = m1; cn = __builtin_amdgcn_readfirstlane(n1); }
        if (tg >= m2) { e = 2; base = m2; cn = __builtin_amdgcn_readfirstlane(n2); }
        if (tg >= m3) { e = 3; base = m3; cn = __builtin_amdgcn_readfirstlane(n3); }
        if (tg >= m4) { e = 4; base = m4; cn = __builtin_amdgcn_readfirstlane(n4); }
        if (tg >= m5) { e = 5; base = m5; cn = __builtin_amdgcn_readfirstlane(n5); }
        if (tg >= m6) { e = 6; base = m6; cn = __builtin_amdgcn_readfirstlane(n6); }
        if (tg >= m7) { e = 7; base = m7; cn = __builtin_amdgcn_readfirstlane(n7); }
        const int ti = tg - base; const int rem = cn - 256 * ti;
        u.e = e; u.rows = rem < 256 ? rem : 256; u.slot0 = e * CAP + ti * 256; return true;
    }
    __device__ __forceinline__ unsigned a_off(const Unit& u) const { return (unsigned)u.pm * tstepA; }
    __device__ __forceinline__ unsigned b_off(const Unit& u) const { return (unsigned)u.e * estepB + (unsigned)u.pn * tstepB; }
    __device__ __forceinline__ const unsigned* idx_src(const Unit& u) const { return rowidx + u.slot0; }
};

struct EpiSwiGLU {
    static constexpr bool PERM = true;
    bf16* H; int ldh;
    __device__ __forceinline__ void operator()(const f32x4 (&acc)[2][2][4][2], const Unit& u, int wr, int wc, int fr, int fq) const {
        const int row0 = u.pm * BM + wr * 64 + fr, col0 = u.pn * 128 + wc * 32 + 8 * fq;
#pragma unroll
        for (int ai = 0; ai < 2; ++ai)
#pragma unroll
            for (int m = 0; m < 4; ++m) { bf16* p = H + (size_t)(row0 + ai * HALF + m * 16) * ldh + col0;
                const f32x4 g0 = acc[ai][0][m][0], g1 = acc[ai][0][m][1], u0 = acc[ai][1][m][0], u1 = acc[ai][1][m][1];
                const f32x2 a = silu_mul_pk((f32x2){g0[0], g0[1]}, (f32x2){u0[0], u0[1]}, 1.0f), b = silu_mul_pk((f32x2){g0[2], g0[3]}, (f32x2){u0[2], u0[3]}, 1.0f);
                const f32x2 c = silu_mul_pk((f32x2){g1[0], g1[1]}, (f32x2){u1[0], u1[1]}, 1.0f), d = silu_mul_pk((f32x2){g1[2], g1[3]}, (f32x2){u1[2], u1[3]}, 1.0f);
                v4u w; w.x = cvt_pk_bf16(a.x, a.y); w.y = cvt_pk_bf16(b.x, b.y); w.z = cvt_pk_bf16(c.x, c.y); w.w = cvt_pk_bf16(d.x, d.y);
                *(v4u*)p = w; }
    }
};
struct EpiSwiGLU8 {
    static constexpr bool PERM = true;
    unsigned char* H; int ldh;
    __device__ __forceinline__ void operator()(const f32x4 (&acc)[2][2][4][2], const Unit& u, int wr, int wc, int fr, int fq) const {
        const int row0 = u.pm * BM + wr * 64 + fr, col0 = u.pn * 128 + wc * 32 + 8 * fq;
#pragma unroll
        for (int ai = 0; ai < 2; ++ai)
#pragma unroll
            for (int m = 0; m < 4; ++m) { unsigned char* p = H + (size_t)(row0 + ai * HALF + m * 16) * ldh + col0;
                const f32x4 g0 = acc[ai][0][m][0], g1 = acc[ai][0][m][1], u0 = acc[ai][1][m][0], u1 = acc[ai][1][m][1];
                constexpr float inv = 1.0f / H8_SCALE;
                const f32x2 a = silu_mul_pk((f32x2){g0[0], g0[1]}, (f32x2){u0[0], u0[1]}, inv), b = silu_mul_pk((f32x2){g0[2], g0[3]}, (f32x2){u0[2], u0[3]}, inv);
                const f32x2 c = silu_mul_pk((f32x2){g1[0], g1[1]}, (f32x2){u1[0], u1[1]}, inv), d = silu_mul_pk((f32x2){g1[2], g1[3]}, (f32x2){u1[2], u1[3]}, inv);
                v2u w; w.x = pk4_fp8(a.x, a.y, b.x, b.y); w.y = pk4_fp8(c.x, c.y, d.x, d.y);
                *(v2u*)p = w; }
    }
};
struct EpiResid {
    static constexpr bool PERM = false;
    float* h; const bf16* y1; const float* scale; int row_off; const float* xin; const float* meta; float ps = 1.0f;
    __device__ __forceinline__ void operator()(const f32x4 (&acc)[2][2][4][2], const Unit& u, int wr, int wc, int fr, int fq) const {
        const int row0 = row_off + u.pm * BM + wr * 64 + fr, col0 = u.pn * BM + wc * 32 + 4 * fq;
        f32x4 sc[2][2];
#pragma unroll
        for (int bj = 0; bj < 2; ++bj)
#pragma unroll
            for (int n = 0; n < 2; ++n) sc[bj][n] = (scale ? *(const f32x4*)(scale + col0 + bj * HALF + n * 16) : (f32x4){1.f, 1.f, 1.f, 1.f}) * ps;
#pragma unroll
        for (int ai = 0; ai < 2; ++ai) {
            f32x4 b[4][2][2];
#pragma unroll
            for (int m = 0; m < 4; ++m) { const int row = row0 + ai * HALF + m * 16; const size_t off = (size_t)row * D + col0;
                const float* src = h + off;
                if (xin) { const int mr = (row - MROWS) < NMETA ? (row - MROWS) : NMETA - 1; src = row < MROWS ? xin + off : meta + (size_t)mr * D + col0; }
#pragma unroll
                for (int bj = 0; bj < 2; ++bj)
#pragma unroll
                    for (int n = 0; n < 2; ++n) b[m][bj][n] = *(const f32x4*)(src + bj * HALF + n * 16);
                if (y1) {
#pragma unroll
                    for (int bj = 0; bj < 2; ++bj)
#pragma unroll
                        for (int n = 0; n < 2; ++n) { const v2u y = *(const v2u*)(y1 + off + bj * HALF + n * 16); b[m][bj][n] += (f32x4){bf_lo(y.x), bf_hi(y.x), bf_lo(y.y), bf_hi(y.y)}; } } }
#pragma unroll
            for (int m = 0; m < 4; ++m) { const size_t off = (size_t)(row0 + ai * HALF + m * 16) * D + col0;
#pragma unroll
                for (int bj = 0; bj < 2; ++bj)
#pragma unroll
                    for (int n = 0; n < 2; ++n) *(f32x4*)(h + off + bj * HALF + n * 16) = b[m][bj][n] + acc[ai][bj][m][n] * sc[bj][n]; }
            asm volatile("" ::: "memory"); }
    }
};
struct EpiConvIn {
    static constexpr bool PERM = true;
    bf16* BG; bf16* U;
    __device__ __forceinline__ void operator()(const f32x4 (&acc)[2][2][4][2], const Unit& u, int wr, int wc, int fr, int fq) const {
        const int row0 = u.pm * BM + wr * 64 + fr;
        if (u.pn < 4) {
            const int col0 = u.pn * BM + wc * 32 + 8 * fq;
#pragma unroll
            for (int ai = 0; ai < 2; ++ai)
#pragma unroll
                for (int m = 0; m < 4; ++m) { bf16* p = BG + (size_t)(row0 + ai * HALF + m * 16) * D + col0;
#pragma unroll
                    for (int bj = 0; bj < 2; ++bj) { const f32x4 v0 = acc[ai][bj][m][0], v1 = acc[ai][bj][m][1];
                        v4u w; w.x = cvt_pk_bf16(v0[0], v0[1]); w.y = cvt_pk_bf16(v0[2], v0[3]); w.z = cvt_pk_bf16(v1[0], v1[1]); w.w = cvt_pk_bf16(v1[2], v1[3]);
                        *(v4u*)(p + bj * HALF) = w; } }
        } else {
            const int col0 = (u.pn - 4) * 128 + wc * 32 + 8 * fq;
#pragma unroll
            for (int ai = 0; ai < 2; ++ai)
#pragma unroll
                for (int m = 0; m < 4; ++m) { bf16* p = U + (size_t)(row0 + ai * HALF + m * 16) * D + col0;
                    const f32x4 c0 = acc[ai][0][m][0], c1 = acc[ai][0][m][1], v0 = acc[ai][1][m][0], v1 = acc[ai][1][m][1];
                    v4u w; w.x = cvt_pk_bf16(c0[0] * v0[0], c0[1] * v0[1]); w.y = cvt_pk_bf16(c0[2] * v0[2], c0[3] * v0[3]);
                    w.z = cvt_pk_bf16(c1[0] * v1[0], c1[1] * v1[1]); w.w = cvt_pk_bf16(c1[2] * v1[2], c1[3] * v1[3]);
                    *(v4u*)p = w; }
        }
    }
};
struct EpiMoeDown {
    static constexpr bool PERM = false;
    const int2* slot; float* h; bf16* y1; float ps = 1.0f;
    __device__ __forceinline__ void operator()(const f32x4 (&acc)[2][2][4][2], const Unit& u, int wr, int wc, int fr, int fq) const {
        const int col0 = u.pn * BM + wc * 32 + 4 * fq;
        int2 inf[2][4];
#pragma unroll
        for (int ai = 0; ai < 2; ++ai)
#pragma unroll
            for (int m = 0; m < 4; ++m) { const int rl = ai * HALF + wr * 64 + m * 16 + fr; inf[ai][m] = (rl < u.rows) ? slot[u.slot0 + rl] : make_int2(0, 0); }
#pragma unroll
        for (int ai = 0; ai < 2; ++ai) {
            f32x4 b[4][2][2];
#pragma unroll
            for (int m = 0; m < 4; ++m) { const size_t off = (size_t)(inf[ai][m].x & 0x7fffffff) * D + col0;
#pragma unroll
                for (int bj = 0; bj < 2; ++bj)
#pragma unroll
                    for (int n = 0; n < 2; ++n) b[m][bj][n] = *(const f32x4*)(h + off + bj * HALF + n * 16); }
#pragma unroll
            for (int m = 0; m < 4; ++m) { const int rl = ai * HALF + wr * 64 + m * 16 + fr; const int ix = inf[ai][m].x; const float w = __int_as_float(inf[ai][m].y);
                const size_t off = (size_t)(ix & 0x7fffffff) * D + col0;
                if (rl < u.rows) {
                    if (ix >= 0) {
#pragma unroll
                        for (int bj = 0; bj < 2; ++bj)
#pragma unroll
                            for (int n = 0; n < 2; ++n) *(f32x4*)(h + off + bj * HALF + n * 16) = b[m][bj][n] + acc[ai][bj][m][n] * (w * ps);
                    } else {
#pragma unroll
                        for (int bj = 0; bj < 2; ++bj)
#pragma unroll
                            for (int n = 0; n < 2; ++n) { const f32x4 v = acc[ai][bj][m][n] * w; v2u o; o.x = cvt_pk_bf16(v[0], v[1]); o.y = cvt_pk_bf16(v[2], v[3]); *(v2u*)(y1 + off + bj * HALF + n * 16) = o; }
                    }
                } }
            asm volatile("" ::: "memory"); }
    }
};

#ifndef PG8_ALIGN_EPI
#define PG8_ALIGN_EPI 1
#endif
constexpr bool ALIGN_EPI = PG8_ALIGN_EPI;
typedef int i32x4 __attribute__((ext_vector_type(4)));
typedef int i32x8 __attribute__((ext_vector_type(8)));
template <class Epi, class Sched, bool GATHER, bool FP8 = false>
__device__ __forceinline__ void gemm_phase(LAS unsigned char* lds, LAS unsigned* idxbuf, const int wid, const int nt, const int lda, const int ldb, const Sched& S, const Epi& E, const int sc_a = 0x7f7f7f7f, const int sc_b = 0x7f7f7f7f) {
    const int lane = lane_id(), tid = wid * 64 + lane, wr = wid >> 2, wc = wid & 3, fr = lane & 15, fq = lane >> 4;
    unsigned voffA[2], voffB[2], voffG[2][2];
#pragma unroll
    for (int i = 0; i < 2; ++i) { int R, C; stage_rc(tid * 16 + i * 8192, R, C); const int Rb = Epi::PERM ? ((R & ~31) + perm32(R & 31)) : R;
        voffA[i] = (unsigned)(R * lda + C * 2); voffB[i] = (unsigned)(Rb * ldb + C * 2); voffG[0][i] = 0u; voffG[1][i] = 0u; }
    const __amdgpu_buffer_rsrc_t rA = __builtin_amdgcn_make_buffer_rsrc((void*)S.A, 0, 0x7ffffff0, 0x00020000), rB = __builtin_amdgcn_make_buffer_rsrc((void*)S.Bt, 0, 0x7ffffff0, 0x00020000);
    const unsigned kstep = (unsigned)(BK * 2);
    const unsigned hstepA = (unsigned)HALF * lda, hstepB = (unsigned)HALF * ldb;
    const unsigned ldsw = (unsigned)wid * 1024u; unsigned ldsw_ = ldsw;
    const int aoff = lds_byte(wr * 64 + fr, fq * 8), boff = lds_byte(wc * 32 + fr, fq * 8);
#define PG8_SA(b, h) (((b) * 2 + (h)) * HTB)
#define PG8_SB(b, h) ((4 + (b) * 2 + (h)) * HTB)
#define PG8_STAGE(bufoff, rsrc, soff, voff) do { _Pragma("unroll") for (int _i = 0; _i < 2; ++_i) \
        __builtin_amdgcn_raw_ptr_buffer_load_lds(rsrc, (LAS void*)(lds + (bufoff) + ldsw_ + _i * 8192), 16, (int)(voff)[_i], (int)(soff), 0, 0); } while (0)
#define PG8_STAGE_A(bufoff, soff, h) do { if constexpr (GATHER) { PG8_STAGE(bufoff, rA, soff, voffG[h]); } else { PG8_STAGE(bufoff, rA, (soff) + (h) * hstepA, voffA); } } while (0)
#define PG8_STAGE_B(bufoff, soff, h) PG8_STAGE(bufoff, rB, (soff) + (h) * hstepB, voffB)
#define PG8_LDA(dst, b, h) do { _Pragma("unroll") for (int m = 0; m < 4; ++m) _Pragma("unroll") for (int k = 0; k < 2; ++k) dst[m][k] = *(const LAS bf16x8*)(lds + PG8_SA(b, h) + aoff + m * 2048 + k * 1024); } while (0)
#define PG8_LDB(dst, b, h) do { _Pragma("unroll") for (int n = 0; n < 2; ++n) _Pragma("unroll") for (int k = 0; k < 2; ++k) dst[n][k] = *(const LAS bf16x8*)(lds + PG8_SB(b, h) + boff + n * 2048 + k * 1024); } while (0)
#define PG8_MMA(ai, bj, At, Bt) do { __builtin_amdgcn_s_setprio(1); _Pragma("unroll") for (int m = 0; m < 4; ++m) _Pragma("unroll") for (int n = 0; n < 2; ++n) _Pragma("unroll") for (int k = 0; k < 2; ++k) \
        acc[ai][bj][m][n] = __builtin_amdgcn_mfma_f32_16x16x32_bf16(Bt[n][k], At[m][k], acc[ai][bj][m][n], 0, 0, 0); __builtin_amdgcn_s_setprio(0); } while (0)
#define PG8_CAT(x) __builtin_shufflevector((i32x4)(x)[0], (i32x4)(x)[1], 0, 1, 2, 3, 4, 5, 6, 7)
#define PG8_MMA8(ai, bj, At, Bt) do { __builtin_amdgcn_s_setprio(1); _Pragma("unroll") for (int m = 0; m < 4; ++m) _Pragma("unroll") for (int n = 0; n < 2; ++n) \
        acc[ai][bj][m][n] = __builtin_amdgcn_mfma_scale_f32_16x16x128_f8f6f4(PG8_CAT(Bt[n]), PG8_CAT(At[m]), acc[ai][bj][m][n], 0, 0, 0, sc_b, 0, sc_a); __builtin_amdgcn_s_setprio(0); } while (0)
#define PG8_MM(ai, bj, At, Bt) do { if ((ai) * HALF + wr * 64 < cur.rows) { if constexpr (FP8) PG8_MMA8(ai, bj, At, Bt); else PG8_MMA(ai, bj, At, Bt); } } while (0)
#define PG8_WAIT_V(n) asm volatile("s_waitcnt vmcnt(" #n ")" ::: "memory")
#define PG8_WAIT_L(n) asm volatile("s_waitcnt lgkmcnt(" #n ")" ::: "memory")
#define PG8_BAR __builtin_amdgcn_s_barrier()
#define PG8_SCHED __builtin_amdgcn_sched_barrier(0)
#define PG8_LOAD_VOFFG(ib, nrows) do { asm volatile("" ::: "memory"); _Pragma("unroll") for (int _i = 0; _i < 2; ++_i) { int _R, _C; stage_rc(tid * 16 + _i * 8192, _R, _C); \
        _Pragma("unroll") for (int _h = 0; _h < 2; ++_h) { const int _rl = _h * HALF + _R; unsigned _ix = (ib)[_rl]; _ix = (_rl < (nrows)) ? _ix : 0u; voffG[_h][_i] = _ix * (unsigned)lda + (unsigned)(_C * 2); } } } while (0)
#define PG8_IDX_DMA(src, ib) __builtin_amdgcn_global_load_lds((const unsigned*)((src) + lane * 4), (LAS unsigned*)(ib), 16, 0, 0)
    Unit cur, nxt; int ui = 0;
    if (!S.next(0, cur)) return;
    f32x4 acc[2][2][4][2];
#pragma unroll
    for (int a = 0; a < 2; ++a)
#pragma unroll
        for (int b = 0; b < 2; ++b)
#pragma unroll
            for (int m = 0; m < 4; ++m)
#pragma unroll
                for (int n = 0; n < 2; ++n) acc[a][b][m][n] = (f32x4){0.f, 0.f, 0.f, 0.f};
    bf16x8 At[4][2], B0[2][2], B1[2][2];
    unsigned cA = S.a_off(cur), cB = S.b_off(cur);
    if constexpr (GATHER) {
        if (wid == 0) PG8_IDX_DMA(S.idx_src(cur), idxbuf);
        PG8_WAIT_V(0); PG8_BAR;
        PG8_LOAD_VOFFG(idxbuf, cur.rows);
    }
    PG8_STAGE_B(PG8_SB(0, 0), cB, 0); PG8_STAGE_B(PG8_SB(0, 1), cB, 1); PG8_STAGE_A(PG8_SA(0, 0), cA, 0); PG8_STAGE_A(PG8_SA(0, 1), cA, 1);
    if (wr == 1) PG8_BAR;
    PG8_WAIT_V(2); PG8_BAR;
    PG8_STAGE_B(PG8_SB(1, 0), cB + kstep, 0); PG8_STAGE_A(PG8_SA(1, 0), cA + kstep, 0); PG8_STAGE_B(PG8_SB(1, 1), cB + kstep, 1);
    PG8_WAIT_V(6); PG8_BAR;
    for (;;) {
        const bool has_next = S.next(ui + 1, nxt);
        const unsigned nA = has_next ? S.a_off(nxt) : cA, nB = has_next ? S.b_off(nxt) : cB;
        if constexpr (GATHER) { if (has_next && wid == 0) PG8_IDX_DMA(S.idx_src(nxt), idxbuf + ((ui + 1) & 1) * 256); }
#pragma nounroll
        for (int t = 0; t < nt; t += 2) {
            const bool last = (t == nt - 2);
            asm volatile("" : "+s"(ldsw_));
            const unsigned a1 = cA + (unsigned)(t + 1) * kstep;
            const unsigned a2 = last ? nA : cA + (unsigned)(t + 2) * kstep, b2 = last ? nB : cB + (unsigned)(t + 2) * kstep;
            const unsigned a3 = a2 + kstep, b3 = b2 + kstep;
            PG8_LDB(B0, 0, 0); PG8_LDB(B1, 0, 1); PG8_SCHED; PG8_LDA(At, 0, 0); PG8_STAGE_A(PG8_SA(1, 1), a1, 1);
            PG8_WAIT_V(8); PG8_WAIT_L(0); PG8_BAR; PG8_MM(0, 0, At, B0); PG8_MM(0, 1, At, B1); PG8_BAR; PG8_SCHED;
            if constexpr (GATHER) { if (last && has_next) PG8_LOAD_VOFFG(idxbuf + ((ui + 1) & 1) * 256, nxt.rows); }
            PG8_LDA(At, 0, 1); PG8_STAGE_B(PG8_SB(0, 0), b2, 0); PG8_STAGE_B(PG8_SB(0, 1), b2, 1); PG8_STAGE_A(PG8_SA(0, 0), a2, 0);
            PG8_WAIT_V(8); PG8_WAIT_L(0); PG8_BAR; PG8_MM(1, 0, At, B0); PG8_MM(1, 1, At, B1); PG8_BAR; PG8_SCHED;
            PG8_LDB(B0, 1, 0); PG8_LDB(B1, 1, 1); PG8_SCHED; PG8_LDA(At, 1, 0); PG8_STAGE_A(PG8_SA(0, 1), a2, 1);
            PG8_WAIT_V(8); PG8_WAIT_L(0); PG8_BAR; PG8_MM(0, 0, At, B0); PG8_MM(0, 1, At, B1); PG8_BAR; PG8_SCHED;
            PG8_LDA(At, 1, 1); PG8_STAGE_B(PG8_SB(1, 0), b3, 0); PG8_STAGE_B(PG8_SB(1, 1), b3, 1); PG8_STAGE_A(PG8_SA(1, 0), a3, 0);
            PG8_WAIT_V(8); PG8_WAIT_L(0); PG8_BAR; PG8_MM(1, 0, At, B0); PG8_MM(1, 1, At, B1); PG8_BAR; PG8_SCHED;
        }
        if (ALIGN_EPI) { if (wr == 0) PG8_BAR; }
        { const int ln = lane_id(); E(acc, cur, wr, wc, ln & 15, ln >> 4); }
        if (!has_next) break;
#pragma unroll
        for (int a = 0; a < 2; ++a)
#pragma unroll
            for (int b = 0; b < 2; ++b)
#pragma unroll
                for (int m = 0; m < 4; ++m)
#pragma unroll
                    for (int n = 0; n < 2; ++n) acc[a][b][m][n] = (f32x4){0.f, 0.f, 0.f, 0.f};
        cur = nxt; cA = nA; cB = nB; ++ui;
        if (ALIGN_EPI) { if (wr == 1) PG8_BAR; }
    }
    PG8_WAIT_V(0);
    if (!ALIGN_EPI) { if (wr == 0) PG8_BAR; }
    PG8_BAR;
#undef PG8_SA
#undef PG8_SB
#undef PG8_STAGE
#undef PG8_STAGE_A
#undef PG8_STAGE_B
#undef PG8_LDA
#undef PG8_LDB
#undef PG8_MMA
#undef PG8_MMA8
#undef PG8_MM
#undef PG8_CAT
#undef PG8_WAIT_V
#undef PG8_WAIT_L
#undef PG8_BAR
#undef PG8_SCHED
#undef PG8_LOAD_VOFFG
#undef PG8_IDX_DMA
}
}

struct Args { const float* in[19]; float* out; unsigned char* ws; int ph_lo, ph_hi; };
struct Ctx {
    LAS unsigned char* lds; int tid, lane, wave, G, vcu, gw, NGW, gw0, wave0;
    unsigned char* ws; float* H32; bf16* XN; bf16* Y1; float* RSTD; unsigned* ctl;
};

__device__ __forceinline__ void tr_item(const float* W, int ldw, int k0, int n0, bf16* WT, int K, int drow0, LAS float* scr, int lane) {
#pragma unroll 8
    for (int i = 0; i < 32; ++i) { const int kk = 2 * i + (lane >> 5); scr[kk * 33 + (lane & 31)] = W[(size_t)(k0 + kk) * ldw + n0 + (lane & 31)]; }
    LDS_WAIT();
    const int c = lane & 7;
#pragma unroll
    for (int j = 0; j < 4; ++j) { const int n = (lane >> 3) + 8 * j; const LAS float* s = scr + (8 * c) * 33 + n;
        v4u o; o.x = cvt_pk_bf16(s[0 * 33], s[1 * 33]); o.y = cvt_pk_bf16(s[2 * 33], s[3 * 33]); o.z = cvt_pk_bf16(s[4 * 33], s[5 * 33]); o.w = cvt_pk_bf16(s[6 * 33], s[7 * 33]);
        *(v4u*)(WT + (size_t)(drow0 + n) * K + k0 + 8 * c) = o; }
    LDS_WAIT();
}
__device__ __forceinline__ void tr_item8(const float* W, int ldw, int k0, int n0, unsigned char* WT, int K, int drow0, float scale, LAS float* scr, int lane) {
#pragma unroll 8
    for (int i = 0; i < 32; ++i) { const int kk = 2 * i + (lane >> 5); scr[kk * 33 + (lane & 31)] = W[(size_t)(k0 + kk) * ldw + n0 + (lane & 31)] * scale; }
    LDS_WAIT();
    const int c = lane & 7;
#pragma unroll
    for (int j = 0; j < 4; ++j) { const int n = (lane >> 3) + 8 * j; const LAS float* s = scr + (8 * c) * 33 + n;
        v2u o; o.x = pk4_fp8(s[0 * 33], s[1 * 33], s[2 * 33], s[3 * 33]); o.y = pk4_fp8(s[4 * 33], s[5 * 33], s[6 * 33], s[7 * 33]);
        *(v2u*)(WT + (size_t)(drow0 + n) * K + k0 + 8 * c) = o; }
    LDS_WAIT();
}
__device__ __forceinline__ void cv_gateup(const float* Wg, const float* Wu, bf16* dst, int item, LAS float* scr, int lane) {
    const int kind = item / 1792, r = item % 1792, kb = r / 112, nb = r % 112, n0 = 32 * nb;
    tr_item(kind ? Wu : Wg, FF, 64 * kb, n0, dst, D, (n0 >> 7) * 256 + (n0 & 127) + kind * 128, scr, lane);
}
__device__ __forceinline__ void cv_plain(const float* W, int K, int N, bf16* dst, int drow_off, int item, LAS float* scr, int lane) {
    const int nbn = N / 32, kb = item / nbn, nb = item % nbn;
    tr_item(W, N, 64 * kb, 32 * nb, dst, K, drow_off + 32 * nb, scr, lane);
}
__device__ __forceinline__ void cv_convin(const float* W, bf16* dst, int item, LAS float* scr, int lane) {
    const int kb = item / 96, nb = item % 96, n0 = 32 * nb; int dr;
    if (n0 < 1024) dr = n0; else if (n0 < 2048) dr = 1024 + ((n0 - 1024) >> 7) * 256 + (n0 & 127); else dr = 1024 + ((n0 - 2048) >> 7) * 256 + 128 + (n0 & 127);
    tr_item(W, 3 * D, 64 * kb, n0, dst, D, dr, scr, lane);
}
__device__ __forceinline__ void convert_moe_layer(Ctx& C, const Args& a, int j) {
    LAS float* scr = (LAS float*)(C.lds + C.wave * 16384);
    constexpr int PER_E = 3584 + 1792;
    for (int it = C.gw; it < NE * PER_E; it += C.NGW) {
        const int e = it / PER_E, r = it % PER_E; const size_t wo = ((size_t)j * NE + e) * D * FF;
        if (r < 3584) { const int kind = r / 1792, q = r % 1792, kb = q / 112, nb = q % 112, n0 = 32 * nb;
            tr_item8((kind ? a.in[16] : a.in[15]) + wo, FF, 64 * kb, n0, C.ws + WS_WMGU + (size_t)(j * NE + e) * GU8_BYTES, D, (n0 >> 7) * 256 + (n0 & 127) + kind * 128, W_GU_SCALE, scr, C.lane); }
        else { const int q = r - 3584, kb = q / 32, nb = q % 32;
            tr_item8(a.in[17] + wo, D, 64 * kb, 32 * nb, C.ws + WS_WMDN + (size_t)(j * NE + e) * DN8_BYTES, FF, 32 * nb, W_DN_SCALE, scr, C.lane); }
    }
}
__device__ __forceinline__ void convert_small_weights(Ctx& C, const Args& a) {
    LAS float* scr = (LAS float*)(C.lds + C.wave * 16384);
    constexpr int I_POOL = 32, I_GU = 3584, I_DN = 1792, I_IN = 1536, I_OUT = 512;
    constexpr int PER_L = 4 * I_POOL + I_GU + I_DN + I_IN + I_OUT;
    for (int it = C.gw; it < 2 * PER_L; it += C.NGW) {
        const int l = it / PER_L; int r = it % PER_L;
        if (r < 4 * I_POOL) { const int g = r / I_POOL; cv_plain(a.in[3] + (size_t)(l * 4 + g) * 65536, 256, 256, (bf16*)(C.ws + WS_WPOOL + (size_t)l * 524288), g * 256, r % I_POOL, scr, C.lane); continue; } r -= 4 * I_POOL;
        if (r < I_GU) {
            if (l == DENSE_FP8_LAYER) { const int kind = r / 1792, q = r % 1792, kb = q / 112, nb = q % 112, n0 = 32 * nb;
                tr_item8((kind ? a.in[7] : a.in[6]) + (size_t)l * D * FF, FF, 64 * kb, n0, C.ws + WS_WGU + (size_t)l * GU_BYTES, D, (n0 >> 7) * 256 + (n0 & 127) + kind * 128, W_GU_SCALE, scr, C.lane); }
            else cv_gateup(a.in[6] + (size_t)l * D * FF, a.in[7] + (size_t)l * D * FF, (bf16*)(C.ws + WS_WGU + (size_t)l * GU_BYTES), r, scr, C.lane);
            continue; } r -= I_GU;
        if (r < I_DN) {
            if (l == DENSE_FP8_LAYER) { const int kb = r / 32, nb = r % 32; tr_item8(a.in[8] + (size_t)l * D * FF, D, 64 * kb, 32 * nb, C.ws + WS_WDN + (size_t)l * DN_BYTES, FF, 32 * nb, W_DN_SCALE, scr, C.lane); }
            else cv_plain(a.in[8] + (size_t)l * D * FF, FF, D, (bf16*)(C.ws + WS_WDN + (size_t)l * DN_BYTES), 0, r, scr, C.lane);
            continue; } r -= I_DN;
        if (r < I_IN) { cv_convin(a.in[10] + (size_t)l * D * 3 * D, (bf16*)(C.ws + WS_WIN + (size_t)l * 3 * D * D * 2), r, scr, C.lane); continue; } r -= I_IN;
        cv_plain(a.in[12] + (size_t)l * D * D, D, D, (bf16*)(C.ws + WS_WOUT + (size_t)l * D * D * 2), 0, r, scr, C.lane);
    }
}

__device__ __forceinline__ int prev_row(int row, int i) {
    if (row < MROWS) { const int tp = row & (TS - 1); return tp >= i ? row - i : MROWS + NMETA + tp - i; }
    return row - i;
}
__device__ __forceinline__ void load_heff(const Ctx& C, int row, bool addy1, f32x4 (&x)[4]) {
    const f32x4* p = (const f32x4*)(C.H32 + (size_t)row * D) + C.lane;
#pragma unroll
    for (int j = 0; j < 4; ++j) x[j] = p[64 * j];
    if (addy1) { const v2u* q = (const v2u*)(C.Y1 + (size_t)row * D) + C.lane;
#pragma unroll
        for (int j = 0; j < 4; ++j) { const v2u y = q[64 * j]; x[j] += (f32x4){bf_lo(y.x), bf_hi(y.x), bf_lo(y.y), bf_hi(y.y)}; } }
}
__device__ __forceinline__ float row_rstd(const f32x4 (&x)[4], int lane) {
    float s = 0.f;
#pragma unroll
    for (int j = 0; j < 4; ++j) s += (x[j][0] * x[j][0] + x[j][1] * x[j][1]) + (x[j][2] * x[j][2] + x[j][3] * x[j][3]);
    return __frsqrt_rn(wave_sum(s, lane) * (1.0f / D) + EPS);
}
__device__ __forceinline__ void store_bf16_row(bf16* dst, int row, int lane, const f32x4 (&v)[4]) {
    v2u* o = (v2u*)(dst + (size_t)row * D) + lane;
#pragma unroll
    for (int j = 0; j < 4; ++j) { v2u w; w.x = cvt_pk_bf16(v[j][0], v[j][1]); w.y = cvt_pk_bf16(v[j][2], v[j][3]); o[64 * j] = w; }
}
__device__ __forceinline__ void phase_norm(Ctx& C, const float* gain, bool addy1, bool out8 = false) {
    f32x4 g[4];
#pragma unroll
    for (int j = 0; j < 4; ++j) g[j] = ((const f32x4*)gain)[C.lane + 64 * j];
    f32x4 x[4], xnx[4];
    if (C.gw < RTOT) load_heff(C, C.gw, addy1, x);
    for (int row = C.gw; row < RTOT; row += C.NGW) {
        const int nrow = row + C.NGW;
        if (nrow < RTOT) load_heff(C, nrow, addy1, xnx);
        const float rs = row_rstd(x, C.lane);
#pragma unroll
        for (int j = 0; j < 4; ++j) x[j] = x[j] * rs * g[j];
        if (out8) { unsigned* o8 = (unsigned*)((unsigned char*)C.XN + (size_t)row * D) + C.lane;
#pragma unroll
            for (int j = 0; j < 4; ++j) o8[64 * j] = pk4_fp8(x[j][0], x[j][1], x[j][2], x[j][3]); }
        else store_bf16_row(C.XN, row, C.lane, x);
#pragma unroll
        for (int j = 0; j < 4; ++j) x[j] = xnx[j];
    }
}
template <bool L0>
__device__ __forceinline__ void phase_pool(Ctx& C, const float* gain, bool addy1, const float* xin, const float* meta) {
    f32x4 g[4];
#pragma unroll
    for (int j = 0; j < 4; ++j) g[j] = ((const f32x4*)gain)[C.lane + 64 * j];
    constexpr int RUN = 32, NRUN = MROWS / RUN + 1;
    for (int run = C.gw; run < NRUN; run += C.NGW) {
        const bool mrun = run == NRUN - 1;
        const int r0 = run * RUN, tp0 = r0 & (TS - 1), nsteps = mrun ? NMETA : RUN + 15;
        f32x4 r1[2], r2[4], r3[8], r4[16], S[4];
#pragma unroll
        for (int q = 0; q < 2; ++q) r1[q] = (f32x4){0.f, 0.f, 0.f, 0.f};
#pragma unroll
        for (int q = 0; q < 4; ++q) r2[q] = (f32x4){0.f, 0.f, 0.f, 0.f};
#pragma unroll
        for (int q = 0; q < 8; ++q) r3[q] = (f32x4){0.f, 0.f, 0.f, 0.f};
#pragma unroll
        for (int q = 0; q < 16; ++q) r4[q] = (f32x4){0.f, 0.f, 0.f, 0.f};
#pragma unroll
        for (int j = 0; j < 4; ++j) S[j] = (f32x4){0.f, 0.f, 0.f, 0.f};
#define POOL_ROW(k_) (mrun ? MROWS + (k_) : ((tp0 + (k_) - 15 >= 0) ? r0 + (k_) - 15 : MROWS + NMETA + tp0 + (k_) - 15))
#define POOL_LOAD(dst, row_) do { if (L0) { const f32x4* p_ = (const f32x4*)((row_) < MROWS ? xin + (size_t)(row_) * D : meta + (size_t)((row_) - MROWS) * D) + C.lane; \
        _Pragma("unroll") for (int j = 0; j < 4; ++j) dst[j] = p_[64 * j]; } else load_heff(C, row_, addy1, dst); } while (0)
        f32x4 x[4], xnx[4];
        POOL_LOAD(x, POOL_ROW(0));
        for (int kb = 0; kb < nsteps; kb += 16) {
#pragma unroll
            for (int kk = 0; kk < 16; ++kk) {
                const int k = kb + kk;
                if (k < nsteps) {
                    const int i = mrun ? k : k - 15;
                    const int row = POOL_ROW(k);
                    if (k + 1 < nsteps) POOL_LOAD(xnx, POOL_ROW(k + 1));
                    const float rs = row_rstd(x, C.lane);
#pragma unroll
                    for (int j = 0; j < 4; ++j) x[j] = x[j] * rs * g[j];
                    S[0] += x[0] - r1[kk & 1]; r1[kk & 1] = x[0];
                    S[1] += x[1] - r2[kk & 3]; r2[kk & 3] = x[1];
                    S[2] += x[2] - r3[kk & 7]; r3[kk & 7] = x[2];
                    S[3] += x[3] - r4[kk]; r4[kk] = x[3];
                    if (i >= 0) {
                        const int pos = mrun ? k : NMETA;
                        f32x4 d[4];
#pragma unroll
                        for (int j = 0; j < 4; ++j) { const int w = 2 << j; const int cnt = (pos + 1) < w ? (pos + 1) : w; d[j] = S[j] * (1.0f / (float)cnt) - x[j]; }
                        store_bf16_row(C.XN, row, C.lane, d);
                    }
#pragma unroll
                    for (int j = 0; j < 4; ++j) x[j] = xnx[j];
                }
            }
        }
#undef POOL_ROW
#undef POOL_LOAD
    }
}
__device__ __forceinline__ void conv_tap(float (&s)[8], const float (&k)[8], const v4u& uu) {
    s[0] += k[0] * bf_lo(uu.x); s[1] += k[1] * bf_hi(uu.x); s[2] += k[2] * bf_lo(uu.y); s[3] += k[3] * bf_hi(uu.y);
    s[4] += k[4] * bf_lo(uu.z); s[5] += k[5] * bf_hi(uu.z); s[6] += k[6] * bf_lo(uu.w); s[7] += k[7] * bf_hi(uu.w);
}
__device__ __forceinline__ void phase_conv(Ctx& C, const float* ck, const bf16* BGp, const bf16* Up, bf16* Y) {
    float k[3][2][8];
#pragma unroll
    for (int t = 0; t < 3; ++t)
#pragma unroll
        for (int q = 0; q < 2; ++q) { const f32x4 a = *(const f32x4*)(ck + t * D + 8 * C.lane + 512 * q), b = *(const f32x4*)(ck + t * D + 8 * C.lane + 512 * q + 4);
            k[t][q][0] = a[0]; k[t][q][1] = a[1]; k[t][q][2] = a[2]; k[t][q][3] = a[3]; k[t][q][4] = b[0]; k[t][q][5] = b[1]; k[t][q][6] = b[2]; k[t][q][7] = b[3]; }
    constexpr int RUN = 32, NRUN = MROWS / RUN + 1;
    const v4u zero4 = (v4u){0u, 0u, 0u, 0u};
    for (int run = C.gw; run < NRUN; run += C.NGW) {
        const bool mrun = run == NRUN - 1;
        const int r0 = mrun ? MROWS : run * RUN, n = mrun ? NMETA : RUN;
        v4u um1[2], um2[2];
#pragma unroll
        for (int q = 0; q < 2; ++q) { const int co = 8 * C.lane + 512 * q;
            um1[q] = mrun ? zero4 : *(const v4u*)(Up + (size_t)prev_row(r0, 1) * D + co); um2[q] = mrun ? zero4 : *(const v4u*)(Up + (size_t)prev_row(r0, 2) * D + co); }
        v4u uc[2], bc[2], un[2], bn[2];
#pragma unroll
        for (int q = 0; q < 2; ++q) { const int co = 8 * C.lane + 512 * q; uc[q] = *(const v4u*)(Up + (size_t)r0 * D + co); bc[q] = *(const v4u*)(BGp + (size_t)r0 * D + co); }
        for (int i = 0; i < n; ++i) {
            const int row = r0 + i;
            if (i + 1 < n) {
#pragma unroll
                for (int q = 0; q < 2; ++q) { const int co = 8 * C.lane + 512 * q; un[q] = *(const v4u*)(Up + (size_t)(row + 1) * D + co); bn[q] = *(const v4u*)(BGp + (size_t)(row + 1) * D + co); } }
#pragma unroll
            for (int q = 0; q < 2; ++q) {
                const int co = 8 * C.lane + 512 * q;
                const v4u uu = uc[q], bb = bc[q];
                float sacc[8];
#pragma unroll
                for (int e = 0; e < 8; ++e) sacc[e] = 0.f;
                conv_tap(sacc, k[0][q], um2[q]); conv_tap(sacc, k[1][q], um1[q]); conv_tap(sacc, k[2][q], uu);
                um2[q] = um1[q]; um1[q] = uu;
                v4u o; o.x = cvt_pk_bf16(bf_lo(bb.x) * sacc[0], bf_hi(bb.x) * sacc[1]); o.y = cvt_pk_bf16(bf_lo(bb.y) * sacc[2], bf_hi(bb.y) * sacc[3]);
                o.z = cvt_pk_bf16(bf_lo(bb.z) * sacc[4], bf_hi(bb.z) * sacc[5]); o.w = cvt_pk_bf16(bf_lo(bb.w) * sacc[6], bf_hi(bb.w) * sacc[7]);
                *(v4u*)(Y + (size_t)row * D + co) = o;
                uc[q] = un[q]; bc[q] = bn[q];
            }
        }
    }
}
__device__ __forceinline__ float xchg(float v, int lane, int m) { return __int_as_float(__builtin_amdgcn_ds_bpermute((lane ^ m) << 2, __float_as_int(v))); }
__device__ __forceinline__ void phase_router(Ctx& C, const float* gain, const float* router, unsigned* gcnt  ) {
    LAS unsigned* lcnt = (LAS unsigned*)C.lds;
    LAS unsigned* lbase = lcnt + 8;
    LAS unsigned* ent = lcnt + 16;
    f32x4 g[4];
#pragma unroll
    for (int j = 0; j < 4; ++j) g[j] = ((const f32x4*)gain)[C.lane + 64 * j];
    f32x4 ra[4][4], rb[4][4];
#pragma unroll
    for (int j = 0; j < 4; ++j)
#pragma unroll
        for (int i = 0; i < 4; ++i) { const f32x4* rp = (const f32x4*)(router + (size_t)(4 * C.lane + 256 * j + i) * NE); ra[j][i] = rp[0]; rb[j][i] = rp[1]; }
    unsigned* rowidx = (unsigned*)(C.ws + WS_ROWIDX); int2* slot = (int2*)(C.ws + WS_SLOT);
    const int nchunk = (RTOT + 255) / 256;
    const bool up32 = (C.lane & 32) != 0, up16 = (C.lane & 16) != 0, up8 = (C.lane & 8) != 0;
    for (int ch = blockIdx.x; ch < nchunk; ch += C.G) {
        const int r0 = ch * 256, nr = (RTOT - r0) < 256 ? (RTOT - r0) : 256;
        __syncthreads();
        if (C.tid < 16) lcnt[C.tid] = 0u;
        __syncthreads();
        f32x4 x[4], xnx[4];
        if (C.wave < nr) load_heff(C, r0 + C.wave, false, x);
        for (int lr = C.wave; lr < nr; lr += NWAVES) {
            const int row = r0 + lr;
            if (lr + NWAVES < nr) load_heff(C, row + NWAVES, false, xnx);
            const float rs = row_rstd(x, C.lane);
#pragma unroll
            for (int j = 0; j < 4; ++j) x[j] = x[j] * rs * g[j];
            { unsigned* o8 = (unsigned*)((unsigned char*)C.XN + (size_t)row * D) + C.lane;
#pragma unroll
              for (int j = 0; j < 4; ++j) o8[64 * j] = pk4_fp8(x[j][0], x[j][1], x[j][2], x[j][3]); }
            f32x4 la = (f32x4){0.f, 0.f, 0.f, 0.f}, lb = la;
#pragma unroll
            for (int j = 0; j < 4; ++j)
#pragma unroll
                for (int i = 0; i < 4; ++i) { la += ra[j][i] * x[j][i]; lb += rb[j][i] * x[j][i]; }
            f32x4 k4; { const f32x4 keep = up32 ? lb : la, give = up32 ? la : lb;
                k4[0] = keep[0] + xchg(give[0], C.lane, 32); k4[1] = keep[1] + xchg(give[1], C.lane, 32); k4[2] = keep[2] + xchg(give[2], C.lane, 32); k4[3] = keep[3] + xchg(give[3], C.lane, 32); }
            float k2a, k2b; { const float keep0 = up16 ? k4[2] : k4[0], keep1 = up16 ? k4[3] : k4[1], give0 = up16 ? k4[0] : k4[2], give1 = up16 ? k4[1] : k4[3];
                k2a = keep0 + xchg(give0, C.lane, 16); k2b = keep1 + xchg(give1, C.lane, 16); }
            float k1; { const float keep = up8 ? k2b : k2a, give = up8 ? k2a : k2b; k1 = keep + xchg(give, C.lane, 8); }
            k1 += xchg(k1, C.lane, 4); k1 += xchg(k1, C.lane, 2); k1 += xchg(k1, C.lane, 1);
            float lg[8];
#pragma unroll
            for (int e = 0; e < 8; ++e) lg[e] = __int_as_float(__builtin_amdgcn_readlane(__float_as_int(k1), 8 * e));
            int e1 = 0; float v1 = lg[0];
#pragma unroll
            for (int e = 1; e < 8; ++e) if (lg[e] > v1) { v1 = lg[e]; e1 = e; }
            int e2 = -1; float v2 = -3.0e38f;
#pragma unroll
            for (int e = 0; e < 8; ++e) if (e != e1 && lg[e] > v2) { v2 = lg[e]; e2 = e; }
            const float ex = __expf(v2 - v1), w1 = 1.0f / (1.0f + ex), w2 = ex * w1;
            if (C.lane == 0) {
                const unsigned k1_ = atomicAdd((unsigned*)&lcnt[e1], 1u), k2_ = atomicAdd((unsigned*)&lcnt[e2], 1u);
                ent[(lr * 2 + 0) * 2 + 0] = (unsigned)e1 | (k1_ << 8); ent[(lr * 2 + 0) * 2 + 1] = __float_as_uint(w1);
                ent[(lr * 2 + 1) * 2 + 0] = (unsigned)e2 | (k2_ << 8); ent[(lr * 2 + 1) * 2 + 1] = __float_as_uint(w2);
            }
#pragma unroll
            for (int j = 0; j < 4; ++j) x[j] = xnx[j];
        }
        __syncthreads();
        if (C.tid < 8) lbase[C.tid] = __hip_atomic_fetch_add(gcnt + 64 * C.tid, lcnt[C.tid], __ATOMIC_RELAXED, __HIP_MEMORY_SCOPE_AGENT);
        __syncthreads();
        for (int q = C.tid; q < nr * 2; q += NWAVES * 64) {
            const unsigned ek = ent[q * 2], wb = ent[q * 2 + 1]; const int e = ek & 255, rank = ek >> 8, row = r0 + (q >> 1), ch2 = q & 1;
            const int pos = e * CAP + (int)lbase[e] + rank;
            rowidx[pos] = (unsigned)row; slot[pos] = make_int2(row | (ch2 << 31), (int)wb);
        }
    }
    __syncthreads();
}
__device__ __forceinline__ void phase_final(Ctx& C, const float* gain, float* out) {
    f32x4 g[4];
#pragma unroll
    for (int j = 0; j < 4; ++j) g[j] = ((const f32x4*)gain)[C.lane + 64 * j];
    f32x4 x[4], xnx[4];
    if (C.gw < MROWS) load_heff(C, C.gw, true, x);
    for (int row = C.gw; row < MROWS; row += C.NGW) {
        const int nrow = row + C.NGW;
        if (nrow < MROWS) load_heff(C, nrow, true, xnx);
        const float rs = row_rstd(x, C.lane);
        f32x4* o = (f32x4*)(out + (size_t)row * D) + C.lane;
#pragma unroll
        for (int j = 0; j < 4; ++j) o[64 * j] = x[j] * rs * g[j];
#pragma unroll
        for (int j = 0; j < 4; ++j) x[j] = xnx[j];
    }
}
__device__ __forceinline__ void copy_params(Ctx& C, const Args& a) {
    float* P = (float*)(C.ws + WS_PARAMS);
    for (int i = C.gw * 64 + C.lane; i < PP_TOTAL; i += C.NGW * 64) {
        float v;
        if (i < PP_POOL_SCALE) v = a.in[2][i - PP_POOL_NORM];
        else if (i < PP_DENSE_NORM) v = a.in[4][i - PP_POOL_SCALE];
        else if (i < PP_CONV_NORM) v = a.in[5][i - PP_DENSE_NORM];
        else if (i < PP_MOE_NORM) v = a.in[9][i - PP_CONV_NORM];
        else if (i < PP_FINAL) v = a.in[13][i - PP_MOE_NORM];
        else if (i < PP_CONV_K) v = a.in[18][i - PP_FINAL];
        else if (i < PP_ROUTER) v = a.in[11][i - PP_CONV_K];
        else v = a.in[14][i - PP_ROUTER];
        P[i] = v;
    }
}
__device__ __forceinline__ void phase_copy_in(Ctx& C, const float* x, const float* meta) {
    for (int row = C.gw; row < RTOT; row += C.NGW) {
        const f32x4* p = (const f32x4*)(row < MROWS ? x + (size_t)row * D : meta + (size_t)(row - MROWS) * D) + C.lane;
        f32x4* o = (f32x4*)(C.H32 + (size_t)row * D) + C.lane;
#pragma unroll
        for (int j = 0; j < 4; ++j) o[64 * j] = p[64 * j];
    }
}
__device__ __forceinline__ int moe_cnt(unsigned* gcnt, int e) { return __builtin_amdgcn_readfirstlane((int)__hip_atomic_load(gcnt + 64 * e, __ATOMIC_RELAXED, __HIP_MEMORY_SCOPE_AGENT)); }
__device__ __forceinline__ void moe_sched_init(pg8::MoeSched& S, const Ctx& C, unsigned* gcnt, int pass, int nN) {
    S.n0 = moe_cnt(gcnt, 0); S.n1 = moe_cnt(gcnt, 1); S.n2 = moe_cnt(gcnt, 2); S.n3 = moe_cnt(gcnt, 3); S.n4 = moe_cnt(gcnt, 4); S.n5 = moe_cnt(gcnt, 5); S.n6 = moe_cnt(gcnt, 6); S.n7 = moe_cnt(gcnt, 7);
    S.m1 = (S.n0 + 255) >> 8; S.m2 = S.m1 + ((S.n1 + 255) >> 8); S.m3 = S.m2 + ((S.n2 + 255) >> 8); S.m4 = S.m3 + ((S.n3 + 255) >> 8);
    S.m5 = S.m4 + ((S.n4 + 255) >> 8); S.m6 = S.m5 + ((S.n5 + 255) >> 8); S.m7 = S.m6 + ((S.n6 + 255) >> 8);
    const int total = S.m7 + ((S.n7 + 255) >> 8);
    S.t0 = pass * MOE_CH; int nM = total - S.t0; const int cap = (pass == MOE_PASSES - 1) ? MOE_LAST_MAX : MOE_CH; nM = nM < 0 ? 0 : (nM > cap ? cap : nM);
    S.nM = nM; S.nN = nN; S.G = C.G; S.c = (int)blockIdx.x;
}
__device__ __forceinline__ bool relaunder(Ctx& C, unsigned char* ws) { C.lane = lane_id(); C.tid = C.wave * 64 + C.lane;
    { int g = C.gw0, w = C.wave0; asm volatile("" : "+s"(g), "+s"(w)); C.gw = g; C.wave = w; }
    size_t z_ = 0; asm volatile("" : "+s"(z_)); ws += z_; C.ws = ws;
    C.H32 = (float*)(ws + WS_H32); C.XN = (bf16*)(ws + WS_XN); C.Y1 = (bf16*)(ws + WS_Y1); C.RSTD = (float*)(ws + WS_RSTD); return true; }
constexpr int N_PHASES = 1 + 2 * (7 + 5 + 2 * MOE_PASSES) + 1;

#define RUN() (ph >= lo && ph < hi && relaunder(C, args.ws))
#define REPE for (int rep_ = 0; rep_ < PROBE_REP_ELT; ++rep_)
#define REPG for (int rep_ = 0; rep_ < PROBE_REP_GEMM; ++rep_)
#define SEAM() do { if (ph >= lo && ph + 1 < hi) xcd_barrier(bar, C.wave0); ++ph; } while (0)
#define INTER ((bf16*)(C.ws + WS_INTER))
#define PRM ((const float*)(C.ws + WS_PARAMS))

template <int lp>
__device__ __forceinline__ void layer_pair(Ctx& C, const Args& args, int& ph, const int lo, const int hi, const XcdBarrier& bar, LAS unsigned* idxbuf) {
        const bool addy1 = lp > 0;
        if (RUN()) REPE phase_pool<lp == 0>(C, PRM + PP_POOL_NORM + lp * D, addy1, args.in[0], args.in[1]);
    SEAM();
    if (RUN()) {
            pg8::DenseSched S; S.nM = MT_ALL; S.meta_pm = MT_ALL - 1; S.nN = 4; S.G = C.G; S.c = (int)blockIdx.x; S.A = (const char*)C.XN; S.Bt = (const char*)(C.ws + WS_WPOOL + (size_t)lp * 524288);
            S.tstepA = 256u * D * 2; S.tstepB = 256u * 256 * 2; S.a_colstep = 512;
            pg8::EpiResid E{C.H32, addy1 ? C.Y1 : nullptr, PRM + PP_POOL_SCALE + lp * D, 0, lp == 0 ? args.in[0] : nullptr, lp == 0 ? args.in[1] : nullptr};
            pg8::gemm_phase<pg8::EpiResid, pg8::DenseSched, false>(C.lds, idxbuf, C.wave, 256 / 64, D * 2, 256 * 2, S, E);
        }
        SEAM();
        if (RUN()) REPE phase_norm(C, PRM + PP_DENSE_NORM + lp * D, false, lp == DENSE_FP8_LAYER);
        SEAM();
        for (int hf = 0; hf < 2; ++hf) {
            const int pm0 = hf ? DENSE_H0 : 0, nM = hf ? (MT_ALL - DENSE_H0) : DENSE_H0;
            if (RUN()) {
                pg8::DenseSched S; S.nM = nM; S.meta_pm = hf ? nM - 1 : -1; S.nN = FF / 128; S.G = C.G; S.c = (int)blockIdx.x; S.a_colstep = 0; S.Bt = (const char*)(C.ws + WS_WGU + (size_t)lp * GU_BYTES);
                if (lp == DENSE_FP8_LAYER) {
                    S.A = (const char*)C.XN + (size_t)pm0 * 256 * D; S.tstepA = 256u * D; S.tstepB = 256u * D;
                    pg8::EpiSwiGLU8 E{(unsigned char*)INTER, FF};
                    for (int rep_ = 0; rep_ < ((PROBE_MASK & 2) ? 2 : 1); ++rep_) pg8::gemm_phase<pg8::EpiSwiGLU8, pg8::DenseSched, false, true>(C.lds, idxbuf, C.wave, D / 128, D, D, S, E, SC_ONE, SC_GU);
                } else {
                    S.A = (const char*)(C.XN + (size_t)pm0 * 256 * D); S.tstepA = 256u * D * 2; S.tstepB = 256u * D * 2;
                    pg8::EpiSwiGLU E{INTER, FF};
                    for (int rep_ = 0; rep_ < ((PROBE_MASK & 1) ? 2 : 1); ++rep_) pg8::gemm_phase<pg8::EpiSwiGLU, pg8::DenseSched, false>(C.lds, idxbuf, C.wave, D / 64, D * 2, D * 2, S, E);
                }
            }
            SEAM();
            if (RUN()) {
                pg8::DenseSched S; S.nM = nM; S.meta_pm = hf ? nM - 1 : -1; S.nN = 4; S.G = C.G; S.c = (int)blockIdx.x; S.A = (const char*)INTER; S.a_colstep = 0; S.Bt = (const char*)(C.ws + WS_WDN + (size_t)lp * DN_BYTES);
                constexpr int PB = (lp == DENSE_FP8_LAYER) ? 2 : 1, NR = (PROBE_MASK & PB) ? 2 : 1;
                pg8::EpiResid E{C.H32, nullptr, nullptr, pm0 * 256, nullptr, nullptr, 1.0f / NR};
                if (lp == DENSE_FP8_LAYER) { S.tstepA = 256u * FF; S.tstepB = 256u * FF;
                    for (int rep_ = 0; rep_ < NR; ++rep_) pg8::gemm_phase<pg8::EpiResid, pg8::DenseSched, false, true>(C.lds, idxbuf, C.wave, FF / 128, FF, FF, S, E, SC_H, SC_DN); }
                else { S.tstepA = 256u * FF * 2; S.tstepB = 256u * FF * 2;
                    for (int rep_ = 0; rep_ < NR; ++rep_) pg8::gemm_phase<pg8::EpiResid, pg8::DenseSched, false>(C.lds, idxbuf, C.wave, FF / 64, FF * 2, FF * 2, S, E); }
            }
            SEAM();
        }
        if (RUN()) REPE phase_norm(C, PRM + PP_CONV_NORM + lp * D, false);
        SEAM();
#define BG INTER
#define UU (INTER + (size_t)RPAD * D)
        if (RUN()) {
            pg8::DenseSched S; S.nM = MT_ALL; S.meta_pm = MT_ALL - 1; S.nN = 12; S.G = C.G; S.c = (int)blockIdx.x; S.A = (const char*)C.XN; S.Bt = (const char*)(C.ws + WS_WIN + (size_t)lp * 3 * D * D * 2);
            S.tstepA = 256u * D * 2; S.tstepB = 256u * D * 2; S.a_colstep = 0;
            pg8::EpiConvIn E{BG, UU};
            for (int rep_ = 0; rep_ < ((PROBE_MASK & 4) ? 2 : 1); ++rep_) pg8::gemm_phase<pg8::EpiConvIn, pg8::DenseSched, false>(C.lds, idxbuf, C.wave, D / 64, D * 2, D * 2, S, E);
        }
        SEAM();
        if (RUN()) REPE phase_conv(C, PRM + PP_CONV_K + lp * 3 * D, BG, UU, C.XN);
        SEAM();
        if (RUN()) {
            pg8::DenseSched S; S.nM = MT_ALL; S.meta_pm = MT_ALL - 1; S.nN = 4; S.G = C.G; S.c = (int)blockIdx.x; S.A = (const char*)C.XN; S.Bt = (const char*)(C.ws + WS_WOUT + (size_t)lp * D * D * 2);
            S.tstepA = 256u * D * 2; S.tstepB = 256u * D * 2; S.a_colstep = 0;
            constexpr int NR = (PROBE_MASK & 4) ? 2 : 1;
            pg8::EpiResid E{C.H32, nullptr, nullptr, 0, nullptr, nullptr, 1.0f / NR};
            for (int rep_ = 0; rep_ < NR; ++rep_) pg8::gemm_phase<pg8::EpiResid, pg8::DenseSched, false>(C.lds, idxbuf, C.wave, D / 64, D * 2, D * 2, S, E);
        }
        SEAM();
#define gcnt ((unsigned*)(C.ws + WS_CTL) + CW_MOECNT + lp * 8 * 64)
        if (RUN()) phase_router(C, PRM + PP_MOE_NORM + lp * D, PRM + PP_ROUTER + lp * D * NE, gcnt);
        SEAM();
        for (int pass = 0; pass < MOE_PASSES; ++pass) {
            if (RUN()) {
                pg8::MoeSched S; moe_sched_init(S, C, gcnt, pass, FF / 128);
                S.A = (const char*)C.XN; S.tstepA = 0; S.Bt = (const char*)(C.ws + WS_WMGU + (size_t)lp * NE * GU8_BYTES); S.estepB = (unsigned)GU8_BYTES; S.tstepB = 256u * D; S.rowidx = (const unsigned*)(C.ws + WS_ROWIDX);
                pg8::EpiSwiGLU8 E{(unsigned char*)INTER, FF};
                for (int rep_ = 0; rep_ < ((PROBE_MASK & 8) ? 2 : 1); ++rep_) pg8::gemm_phase<pg8::EpiSwiGLU8, pg8::MoeSched, true, true>(C.lds, idxbuf, C.wave, D / 128, D, D, S, E, SC_ONE, SC_GU);
            }
            SEAM();
            if (RUN()) {
                pg8::MoeSched S; moe_sched_init(S, C, gcnt, pass, 4);
                S.A = (const char*)INTER; S.tstepA = 256u * FF; S.Bt = (const char*)(C.ws + WS_WMDN + (size_t)lp * NE * DN8_BYTES); S.estepB = (unsigned)DN8_BYTES; S.tstepB = 256u * FF; S.rowidx = nullptr;
                constexpr int NR = (PROBE_MASK & 16) ? 2 : 1;
                pg8::EpiMoeDown E{(const int2*)(C.ws + WS_SLOT), C.H32, C.Y1, 1.0f / NR};
                for (int rep_ = 0; rep_ < NR; ++rep_) pg8::gemm_phase<pg8::EpiMoeDown, pg8::MoeSched, false, true>(C.lds, idxbuf, C.wave, FF / 128, FF, FF, S, E, SC_H, SC_DN);
            }
            SEAM();
        }
}

__global__ void __launch_bounds__(NWAVES * 64, 2) fwd(Args args) {
    extern __shared__ __attribute__((aligned(16))) unsigned char lds_raw[];
    Ctx C;
    C.lds = (LAS unsigned char*)lds_raw;
    C.tid = threadIdx.x; C.lane = C.tid & 63; C.wave0 = __builtin_amdgcn_readfirstlane(C.tid >> 6); C.wave = C.wave0;
    C.G = gridDim.x; { const int bx = blockIdx.x; C.vcu = (C.G % 8 == 0) ? (bx % 8) * (C.G / 8) + bx / 8 : bx; }
    C.gw0 = C.vcu * NWAVES + C.wave; C.gw = C.gw0; C.NGW = C.G * NWAVES;
    C.ws = args.ws; C.H32 = (float*)(args.ws + WS_H32); C.XN = (bf16*)(args.ws + WS_XN); C.Y1 = (bf16*)(args.ws + WS_Y1); C.RSTD = (float*)(args.ws + WS_RSTD);
    C.ctl = (unsigned*)(args.ws + WS_CTL);
    LAS unsigned* idxbuf = (LAS unsigned*)(C.lds + IDX_OFF);
    volatile LAS unsigned* MISC = (volatile LAS unsigned*)(C.lds + MISC_OFF);
    for (int u = C.tid; u < (LDS_BYTES - IDX_OFF) / 4; u += NWAVES * 64) ((LAS unsigned*)(C.lds + IDX_OFF))[u] = 0u;
    __syncthreads();
    const int lo = args.ph_lo, hi = args.ph_hi;
    XcdBarrier bar; bar.bar = C.ctl + CW_BAR; bar.x = 0; bar.st = nullptr;
    if (hi - lo > 1) bar = xcd_barrier_post(C.ctl + CW_BAR, MISC + 8);
    int ph = 0;
    if (RUN()) REPE { copy_params(C, args); convert_small_weights(C, args); convert_moe_layer(C, args, 0); convert_moe_layer(C, args, 1); }
    SEAM();

    layer_pair<0>(C, args, ph, lo, hi, bar, idxbuf);
    layer_pair<1>(C, args, ph, lo, hi, bar, idxbuf);
    if (RUN()) REPE phase_final(C, PRM + PP_FINAL, args.out);
    SEAM();
#undef RUN
#undef SEAM
#undef INTER
#undef PRM
#undef BG
#undef UU
#undef gcnt
}

extern "C" void kernel_launch(void* const* d_in, const int* in_sizes, int n_in, void* d_out, int out_size, void* d_ws, size_t ws_size, hipStream_t stream) {
    static int grid = 0;
    if (grid == 0) {
        if (n_in != 19 || in_sizes[0] != MROWS * D || out_size != MROWS * D || ws_size < WS_END) {
            fprintf(stderr, "kernel_launch: unexpected problem (n_in %d, in0 %d, out %d, ws %zu < %zu); nothing launched\n", n_in, n_in > 0 ? in_sizes[0] : -1, out_size, ws_size, (size_t)WS_END); grid = -1; return; }
        int dev = 0, cus = 0, per_cu = 0;
        if (hipGetDevice(&dev) != hipSuccess || hipDeviceGetAttribute(&cus, hipDeviceAttributeMultiprocessorCount, dev) != hipSuccess) { grid = -1; return; }
        if (hipFuncSetAttribute((const void*)fwd, hipFuncAttributeMaxDynamicSharedMemorySize, LDS_BYTES) != hipSuccess) { fprintf(stderr, "kernel_launch: hipFuncSetAttribute failed\n"); grid = -1; return; }
        if (hipOccupancyMaxActiveBlocksPerMultiprocessor(&per_cu, (const void*)fwd, NWAVES * 64, LDS_BYTES) != hipSuccess || per_cu < 1)
            fprintf(stderr, "kernel_launch: occupancy query reports %d workgroups per CU\n", per_cu);
        (void)hipGetLastError();
        grid = cus;
    }
    if (grid < 0) return;
    if (hipMemsetAsync((char*)d_ws + WS_CTL, 0, CTL_ZERO_BYTES, stream) != hipSuccess) { fprintf(stderr, "kernel_launch: memset failed\n"); return; }
    Args a{};
    for (int i = 0; i < 19; ++i) a.in[i] = (const float*)d_in[i];
    a.out = (float*)d_out; a.ws = (unsigned char*)d_ws;
#if MK_ONE_LAUNCH
    a.ph_lo = 0; a.ph_hi = N_PHASES;
    hipLaunchKernelGGL(fwd, dim3(grid), dim3(NWAVES * 64), LDS_BYTES, stream, a);
#else
    for (int p = 0; p < N_PHASES; ++p) { a.ph_lo = p; a.ph_hi = p + 1; hipLaunchKernelGGL(fwd, dim3(grid), dim3(NWAVES * 64), LDS_BYTES, stream, a); }
#endif
    const hipError_t le = hipPeekAtLastError();
    if (le != hipSuccess) fprintf(stderr, "kernel_launch: launch failed: %s\n", hipGetErrorName(le));
}
```

```cpp
#include <hip/hip_runtime.h>
#include <cstdio>
#include <cstdint>

#ifndef PROBE_REP_ELT
#define PROBE_REP_ELT 1
#endif
#ifndef PROBE_MASK
#define PROBE_MASK 0
#endif
#ifndef PROBE_REP_GEMM
#define PROBE_REP_GEMM 1
#endif
#ifndef MK_ONE_LAUNCH
#define MK_ONE_LAUNCH 1
#endif

constexpr int D = 1024, FF = 3584, NE = 8, NB = 32, TS = 2048, NMETA = 16;
constexpr int MROWS = NB * TS;
constexpr int RTOT = MROWS + NMETA;
constexpr int MT_ALL = 257;
constexpr int RPAD = MT_ALL * 256;
constexpr int CAP = RPAD;
constexpr float EPS = 1e-6f;
constexpr int NWAVES = 8;
constexpr int MOE_CH = 256, MOE_PASSES = 2;
constexpr int MOE_LAST_MAX = 272;
constexpr float W_GU_SCALE = 64.f, W_DN_SCALE = 128.f, H8_SCALE = 4.f;
constexpr int SC_ONE = 0x7f7f7f7f, SC_GU = 0x79797979  , SC_DN = 0x78787878  , SC_H = 0x7d7d7d7d  ;
constexpr int DENSE_H0 = 128;
constexpr int DENSE_FP8_LAYER = 1;

constexpr size_t MiB = 1u << 20;
constexpr size_t WS_CTL = 0, CTL_ZERO_BYTES = 1 * MiB;
constexpr size_t WS_WPOOL = 1 * MiB;
constexpr size_t WS_WGU = 2 * MiB;
constexpr size_t WS_WDN = 30 * MiB;
constexpr size_t WS_WIN = 44 * MiB;
constexpr size_t WS_WOUT = 56 * MiB;
constexpr size_t WS_WMGU = 60 * MiB;
constexpr size_t WS_WMDN = 172 * MiB;
constexpr size_t WS_ROWIDX = 228 * MiB;
constexpr size_t WS_SLOT = 231 * MiB;
constexpr size_t WS_RSTD = 236 * MiB;
constexpr size_t WS_PARAMS = 236 * MiB + 512 * 1024;
constexpr int PP_POOL_NORM = 0, PP_POOL_SCALE = 2048, PP_DENSE_NORM = 4096, PP_CONV_NORM = 6144, PP_MOE_NORM = 8192, PP_FINAL = 10240, PP_CONV_K = 11264, PP_ROUTER = 17408, PP_TOTAL = 17408 + 16384;
constexpr size_t WS_H32 = 237 * MiB;
constexpr size_t WS_XN = 494 * MiB;
constexpr size_t WS_Y1 = 623 * MiB;
constexpr size_t WS_INTER = 752 * MiB;
constexpr size_t WS_END = 1009 * MiB;
constexpr size_t GU_BYTES = (size_t)7168 * 1024 * 2, DN_BYTES = (size_t)1024 * 3584 * 2, GU8_BYTES = GU_BYTES / 2, DN8_BYTES = DN_BYTES / 2;
static_assert(WS_ROWIDX + (size_t)8 * CAP * 4 <= WS_SLOT && WS_SLOT + (size_t)8 * CAP * 8 <= WS_RSTD, "lists");
static_assert(WS_H32 + (size_t)RPAD * D * 4 <= WS_XN && WS_XN + (size_t)RPAD * D * 2 <= WS_Y1 && WS_Y1 + (size_t)RPAD * D * 2 <= WS_INTER, "act map");
static_assert((size_t)MOE_LAST_MAX * 256 * FF <= WS_END - WS_INTER && (size_t)129 * 256 * FF * 2 <= WS_END - WS_INTER && (size_t)2 * RPAD * D * 2 <= WS_END - WS_INTER, "inter");
constexpr int CW_BAR = 4096;
constexpr int CW_MOECNT = 16384;

constexpr int RING_BYTES = 131072;
constexpr int IDX_OFF = RING_BYTES;
constexpr int MISC_OFF = IDX_OFF + 2048;
constexpr int LDS_BYTES = 147456;

#define GAS __attribute__((address_space(1)))
#define LAS __attribute__((address_space(3)))
typedef unsigned short bf16;
typedef float f32x4 __attribute__((ext_vector_type(4)));
typedef unsigned v4u __attribute__((ext_vector_type(4)));
typedef unsigned v2u __attribute__((ext_vector_type(2)));
#define LDS_WAIT() asm volatile("s_waitcnt lgkmcnt(0)" ::: "memory")
#define VM_WAIT() asm volatile("s_waitcnt vmcnt(0)" ::: "memory")

__device__ __forceinline__ int lane_id() { int l; asm volatile("v_mbcnt_lo_u32_b32 %0, -1, 0\n\tv_mbcnt_hi_u32_b32 %0, -1, %0" : "=v"(l)); return l; }
__device__ __forceinline__ unsigned cvt_pk_bf16(float lo, float hi) { unsigned r; asm volatile("v_cvt_pk_bf16_f32 %0, %1, %2" : "=v"(r) : "v"(lo), "v"(hi)); return r; }
__device__ __forceinline__ unsigned pk4_fp8(float a, float b, float c, float d) { int w = __builtin_amdgcn_cvt_pk_fp8_f32(a, b, 0, false); w = __builtin_amdgcn_cvt_pk_fp8_f32(c, d, w, true); return (unsigned)w; }
__device__ __forceinline__ float bf_lo(unsigned w) { return __uint_as_float(w << 16); }
__device__ __forceinline__ float bf_hi(unsigned w) { return __uint_as_float(w & 0xffff0000u); }
__device__ __forceinline__ float wave_sum(float v, int lane) {
#pragma unroll
    for (int o = 1; o < 64; o <<= 1) v += __int_as_float(__builtin_amdgcn_ds_bpermute((lane ^ o) << 2, __float_as_int(v)));
    return v;
}
typedef float f32x2 __attribute__((ext_vector_type(2)));
__device__ __forceinline__ f32x2 silu_mul_pk(f32x2 g, f32x2 u, float inv) {
    const f32x2 t = g * -1.44269504f; f32x2 e; e.x = __builtin_amdgcn_exp2f(t.x); e.y = __builtin_amdgcn_exp2f(t.y);
    const f32x2 d = e * inv + inv; f32x2 r; r.x = __builtin_amdgcn_rcpf(d.x); r.y = __builtin_amdgcn_rcpf(d.y);
    return (g * u) * r;
}
__device__ __forceinline__ float silu_f(float a) { return a * __builtin_amdgcn_rcpf(1.0f + __builtin_amdgcn_exp2f(a * -1.44269504f)); }

#define XB_TMO      128
#define XB_XCNT(j)  (256  + 64 * (j))
#define XB_XSUB(j)  (1280 + 64 * (j))
#define XB_XGEN(j)  (2304 + 64 * (j))
#define XB_TOP      3328
#define XB_TOPGEN   3392
#define XCD_BAR_WORDS 3456
#define XB_SPIN_CAP (1u << 18)
__device__ __forceinline__ unsigned xb_ld(unsigned* p)              { return __hip_atomic_load(p, __ATOMIC_RELAXED, __HIP_MEMORY_SCOPE_AGENT); }
__device__ __forceinline__ unsigned xb_add(unsigned* p, unsigned v) { return __hip_atomic_fetch_add(p, v, __ATOMIC_RELAXED, __HIP_MEMORY_SCOPE_AGENT); }
__device__ __forceinline__ unsigned xb_xcc_id() { return (unsigned)__builtin_amdgcn_s_getreg((3 << 11) | 20) & 0xFu; }
#define XB_SPIN(cond, bar) do { unsigned _sp = 0; while (cond) { __builtin_amdgcn_s_sleep(1); \
    if ((++_sp & 255u) == 0u) { if (xb_ld(&(bar)[XB_TMO])) break; if (_sp > XB_SPIN_CAP) { atomicAdd(&(bar)[XB_TMO], 1u); break; } } } } while (0)
struct XcdBarrier { unsigned* bar; unsigned x; volatile LAS unsigned* st; };
__device__ __forceinline__ XcdBarrier xcd_barrier_post(unsigned* bar, volatile LAS unsigned* st) {
    XcdBarrier b; b.bar = bar; b.x = xb_xcc_id(); b.st = st;
    if (threadIdx.x == 0) (void)xb_add(&bar[XB_XCNT(b.x)], 1u);
    return b;
}
__device__ __forceinline__ void xcd_barrier_complete(unsigned* bar, unsigned x, unsigned& nloc, unsigned& nx) {
    const unsigned G = gridDim.x * gridDim.y * gridDim.z;
    unsigned sum, cnt, mine, sp = 0u;
    for (;;) {
        sum = 0u; cnt = 0u; mine = 0u;
#pragma unroll
        for (unsigned j = 0; j < 16; ++j) { const unsigned c = xb_ld(&bar[XB_XCNT(j)]); sum += c; cnt += (c > 0u) ? 1u : 0u; mine = (j == x) ? c : mine; }
        if (sum == G) break;
        __builtin_amdgcn_s_sleep(1);
        if ((++sp & 255u) == 0u) { if (xb_ld(&bar[XB_TMO])) break; if (sp > XB_SPIN_CAP) { atomicAdd(&bar[XB_TMO], 1u); break; } }
    }
    nloc = mine > 0u ? mine : 1u; nx = cnt > 0u ? cnt : 1u;
}
__device__ __forceinline__ void xcd_barrier(const XcdBarrier& b, const int wave  ) {
    asm volatile("s_waitcnt vmcnt(0)" ::: "memory");
    __syncthreads();
    if (wave == 0 && lane_id() == 0) {
        size_t z_ = 0; asm volatile("" : "+s"(z_)); unsigned* bar = b.bar + z_;
        __builtin_amdgcn_s_waitcnt(0);
        unsigned nloc = b.st[0], nx = b.st[1];
        if (nloc == 0u) { xcd_barrier_complete(bar, b.x, nloc, nx); b.st[0] = nloc; b.st[1] = nx; }
        const unsigned old = xb_add(&bar[XB_XSUB(b.x)], 1u);
        const unsigned gen = old / nloc;
        if (old + 1u == (gen + 1u) * nloc) {
            __builtin_amdgcn_fence(__ATOMIC_RELEASE, "agent");
            asm volatile("s_waitcnt vmcnt(0)" ::: "memory");
            const unsigned og = xb_add(&bar[XB_TOP], 1u);
            const unsigned tg = og / nx;
            if (og + 1u == (tg + 1u) * nx) xb_add(&bar[XB_TOPGEN], 1u);
            else XB_SPIN(xb_ld(&bar[XB_TOPGEN]) == tg, bar);
            __builtin_amdgcn_fence(__ATOMIC_ACQUIRE, "agent");
            xb_add(&bar[XB_XGEN(b.x)], 1u);
            asm volatile("s_waitcnt vmcnt(0)" ::: "memory");
        } else {
            XB_SPIN(xb_ld(&bar[XB_XGEN(b.x)]) == gen, bar);
            __builtin_amdgcn_fence(__ATOMIC_ACQUIRE, "agent");
            asm volatile("s_waitcnt vmcnt(0)" ::: "memory");
        }
    }
    __syncthreads();
}

namespace pg8 {
typedef short bf16x8 __attribute__((ext_vector_type(8)));
constexpr int BM = 256, BK = 64, HALF = 128, HTB = HALF * BK * 2, STAGE_BYTES = 8 * HTB;
static_assert(STAGE_BYTES == RING_BYTES, "ring");
__host__ __device__ __forceinline__ int lds_byte(int r, int c) { const int st = (r >> 4) * 2 + (c >> 5), rr = r & 15, cc = c & 31, ob = rr * 64 + cc * 2; return st * 1024 + (ob ^ (((ob >> 9) & 1) << 5)); }
__host__ __device__ __forceinline__ void stage_rc(int b, int& R, int& C) { const int st = b / 1024, sb = b % 1024, swz = sb ^ (((sb >> 9) & 1) << 5); R = (st >> 1) * 16 + swz / 64; C = (st & 1) * 32 + (swz % 64) / 2; }
__host__ __device__ __forceinline__ int perm32(int rho) { const int n = rho >> 4, i = rho & 15; return 8 * (i >> 2) + 4 * n + (i & 3); }

struct Unit { int pm, pn, e, rows, slot0; };

__device__ __forceinline__ bool static_tile(int i, int G, int c, int nM, int nN, int& pm, int& pn) {
    const int nwg = nM * nN; const long L = (long)i * G + c; if (L >= nwg) return false;
    int wgid = (int)L; { const int q = nwg / 8, r = nwg % 8, xcd = wgid % 8, off = wgid / 8; wgid = (xcd < r ? xcd * (q + 1) : r * (q + 1) + (xcd - r) * q) + off; }
    const int nig = 8 * nN, gid = wgid / nig, fm = gid * 8, gsz = (nM - fm) < 8 ? (nM - fm) : 8;
    pm = fm + ((wgid % nig) % gsz); pn = (wgid % nig) / gsz; return true;
}
struct DenseSched {
    int nM, nN, G, c; const char* A; const char* Bt; unsigned tstepA, tstepB, a_colstep; int meta_pm = -1;
    __device__ __forceinline__ bool next(int i, Unit& u) const { if (!static_tile(i, G, c, nM, nN, u.pm, u.pn)) return false; u.e = 0; u.rows = (u.pm == meta_pm) ? NMETA : 256; u.slot0 = 0; return true; }
    __device__ __forceinline__ unsigned a_off(const Unit& u) const { return (unsigned)u.pm * tstepA + (unsigned)u.pn * a_colstep; }
    __device__ __forceinline__ unsigned b_off(const Unit& u) const { return (unsigned)u.pn * tstepB; }
    __device__ __forceinline__ const unsigned* idx_src(const Unit&) const { return nullptr; }
};
struct MoeSched {
    int nM, nN, G, c, t0; int m1, m2, m3, m4, m5, m6, m7; int n0, n1, n2, n3, n4, n5, n6, n7;
    const char* A; unsigned tstepA; const char* Bt; unsigned estepB, tstepB; const unsigned* rowidx;
    __device__ __forceinline__ bool next(int i, Unit& u) const {
        if (!static_tile(i, G, c, nM, nN, u.pm, u.pn)) return false;
        const int tg = t0 + u.pm; int e = 0, base = 0, cn = __builtin_amdgcn_readfirstlane(n0);
        if (tg >= m1) { e = 1; base = m1; cn = __builtin_amdgcn_readfirstlane(n1); }
        if (tg >= m2) { e = 2; base = m2; cn = __builtin_amdgcn_readfirstlane(n2); }
        if (tg >= m3) { e = 3; base = m3; cn = __builtin_amdgcn_readfirstlane(n3); }
        if (tg >= m4) { e = 4; base = m4; cn = __builtin_amdgcn_readfirstlane(n4); }
        if (tg >= m5) { e = 5; base = m5; cn = __builtin_amdgcn_readfirstlane(n5); }
        if (tg >= m6) { e = 6; base = m6; cn = __builtin_amdgcn_readfirstlane(n6); }
        if (tg >= m7) { e = 7; base = m7; cn = __builtin_amdgcn_readfirstlane(n7); }
        const int ti = tg - base; const int rem = cn - 256 * ti;
        u.e = e; u.rows = rem < 256 ? rem : 256; u.slot0 = e * CAP + ti * 256; return true;
    }
    __device__ __forceinline__ unsigned a_off(const Unit& u) const { return (unsigned)u.pm * tstepA; }
    __device__ __forceinline__ unsigned b_off(const Unit& u) const { return (unsigned)u.e * estepB + (unsigned)u.pn * tstepB; }
    __device__ __forceinline__ const unsigned* idx_src(const Unit& u) const { return rowidx + u.slot0; }
};

struct EpiSwiGLU {
    static constexpr bool PERM = true;
    bf16* H; int ldh;
    __device__ __forceinline__ void operator()(const f32x4 (&acc)[2][2][4][2], const Unit& u, int wr, int wc, int fr, int fq) const {
        const int row0 = u.pm * BM + wr * 64 + fr, col0 = u.pn * 128 + wc * 32 + 8 * fq;
#pragma unroll
        for (int ai = 0; ai < 2; ++ai)
#pragma unroll
            for (int m = 0; m < 4; ++m) { bf16* p = H + (size_t)(row0 + ai * HALF + m * 16) * ldh + col0;
                const f32x4 g0 = acc[ai][0][m][0], g1 = acc[ai][0][m][1], u0 = acc[ai][1][m][0], u1 = acc[ai][1][m][1];
                const f32x2 a = silu_mul_pk((f32x2){g0[0], g0[1]}, (f32x2){u0[0], u0[1]}, 1.0f), b = silu_mul_pk((f32x2){g0[2], g0[3]}, (f32x2){u0[2], u0[3]}, 1.0f);
                const f32x2 c = silu_mul_pk((f32x2){g1[0], g1[1]}, (f32x2){u1[0], u1[1]}, 1.0f), d = silu_mul_pk((f32x2){g1[2], g1[3]}, (f32x2){u1[2], u1[3]}, 1.0f);
                v4u w; w.x = cvt_pk_bf16(a.x, a.y); w.y = cvt_pk_bf16(b.x, b.y); w.z = cvt_pk_bf16(c.x, c.y); w.w = cvt_pk_bf16(d.x, d.y);
                *(v4u*)p = w; }
    }
};
struct EpiSwiGLU8 {
    static constexpr bool PERM = true;
    unsigned char* H; int ldh;
    __device__ __forceinline__ void operator()(const f32x4 (&acc)[2][2][4][2], const Unit& u, int wr, int wc, int fr, int fq) const {
        const int row0 = u.pm * BM + wr * 64 + fr, col0 = u.pn * 128 + wc * 32 + 8 * fq;
#pragma unroll
        for (int ai = 0; ai < 2; ++ai)
#pragma unroll
            for (int m = 0; m < 4; ++m) { unsigned char* p = H + (size_t)(row0 + ai * HALF + m * 16) * ldh + col0;
                const f32x4 g0 = acc[ai][0][m][0], g1 = acc[ai][0][m][1], u0 = acc[ai][1][m][0], u1 = acc[ai][1][m][1];
                constexpr float inv = 1.0f / H8_SCALE;
                const f32x2 a = silu_mul_pk((f32x2){g0[0], g0[1]}, (f32x2){u0[0], u0[1]}, inv), b = silu_mul_pk((f32x2){g0[2], g0[3]}, (f32x2){u0[2], u0[3]}, inv);
                const f32x2 c = silu_mul_pk((f32x2){g1[0], g1[1]}, (f32x2){u1[0], u1[1]}, inv), d = silu_mul_pk((f32x2){g1[2], g1[3]}, (f32x2){u1[2], u1[3]}, inv);
                v2u w; w.x = pk4_fp8(a.x, a.y, b.x, b.y); w.y = pk4_fp8(c.x, c.y, d.x, d.y);
                *(v2u*)p = w; }
    }
};
struct EpiResid {
    static constexpr bool PERM = true;
    bf16* h; const bf16* y1; const float* scale; int row_off; const float* xin; const float* meta; float ps = 1.0f;
    __device__ __forceinline__ void operator()(const f32x4 (&acc)[2][2][4][2], const Unit& u, int wr, int wc, int fr, int fq) const {
        const int row0 = row_off + u.pm * BM + wr * 64 + fr, col0 = u.pn * BM + wc * 32 + 8 * fq;
        f32x4 sc[2][2];
#pragma unroll
        for (int bj = 0; bj < 2; ++bj)
#pragma unroll
            for (int n = 0; n < 2; ++n) sc[bj][n] = (scale ? *(const f32x4*)(scale + col0 + bj * HALF + n * 4) : (f32x4){1.f, 1.f, 1.f, 1.f}) * ps;
#pragma unroll
        for (int ai = 0; ai < 2; ++ai) {
            f32x4 b[4][2][2];
#pragma unroll
            for (int m = 0; m < 4; ++m) { const int row = row0 + ai * HALF + m * 16; const size_t off = (size_t)row * D + col0;
                if (xin) { const int mr = (row - MROWS) < NMETA ? (row - MROWS) : NMETA - 1; const float* src = row < MROWS ? xin + off : meta + (size_t)mr * D + col0;
#pragma unroll
                    for (int bj = 0; bj < 2; ++bj)
#pragma unroll
                        for (int n = 0; n < 2; ++n) b[m][bj][n] = *(const f32x4*)(src + bj * HALF + n * 4); }
                else {
#pragma unroll
                    for (int bj = 0; bj < 2; ++bj) { const v4u v = *(const v4u*)(h + off + bj * HALF);
                        b[m][bj][0] = (f32x4){bf_lo(v.x), bf_hi(v.x), bf_lo(v.y), bf_hi(v.y)}; b[m][bj][1] = (f32x4){bf_lo(v.z), bf_hi(v.z), bf_lo(v.w), bf_hi(v.w)}; } }
                if (y1) {
#pragma unroll
                    for (int bj = 0; bj < 2; ++bj) { const v4u y = *(const v4u*)(y1 + off + bj * HALF);
                        b[m][bj][0] += (f32x4){bf_lo(y.x), bf_hi(y.x), bf_lo(y.y), bf_hi(y.y)}; b[m][bj][1] += (f32x4){bf_lo(y.z), bf_hi(y.z), bf_lo(y.w), bf_hi(y.w)}; } } }
#pragma unroll
            for (int m = 0; m < 4; ++m) { const size_t off = (size_t)(row0 + ai * HALF + m * 16) * D + col0;
#pragma unroll
                for (int bj = 0; bj < 2; ++bj) { const f32x4 v0 = b[m][bj][0] + acc[ai][bj][m][0] * sc[bj][0], v1 = b[m][bj][1] + acc[ai][bj][m][1] * sc[bj][1];
                    v4u w; w.x = cvt_pk_bf16(v0[0], v0[1]); w.y = cvt_pk_bf16(v0[2], v0[3]); w.z = cvt_pk_bf16(v1[0], v1[1]); w.w = cvt_pk_bf16(v1[2], v1[3]);
                    *(v4u*)(h + off + bj * HALF) = w; } }
            asm volatile("" ::: "memory"); }
    }
};
struct EpiConvIn {
    static constexpr bool PERM = true;
    bf16* BG; bf16* U;
    __device__ __forceinline__ void operator()(const f32x4 (&acc)[2][2][4][2], const Unit& u, int wr, int wc, int fr, int fq) const {
        const int row0 = u.pm * BM + wr * 64 + fr;
        if (u.pn < 4) {
            const int col0 = u.pn * BM + wc * 32 + 8 * fq;
#pragma unroll
            for (int ai = 0; ai < 2; ++ai)
#pragma unroll
                for (int m = 0; m < 4; ++m) { bf16* p = BG + (size_t)(row0 + ai * HALF + m * 16) * D + col0;
#pragma unroll
                    for (int bj = 0; bj < 2; ++bj) { const f32x4 v0 = acc[ai][bj][m][0], v1 = acc[ai][bj][m][1];
                        v4u w; w.x = cvt_pk_bf16(v0[0], v0[1]); w.y = cvt_pk_bf16(v0[2], v0[3]); w.z = cvt_pk_bf16(v1[0], v1[1]); w.w = cvt_pk_bf16(v1[2], v1[3]);
                        *(v4u*)(p + bj * HALF) = w; } }
        } else {
            const int col0 = (u.pn - 4) * 128 + wc * 32 + 8 * fq;
#pragma unroll
            for (int ai = 0; ai < 2; ++ai)
#pragma unroll
                for (int m = 0; m < 4; ++m) { bf16* p = U + (size_t)(row0 + ai * HALF + m * 16) * D + col0;
                    const f32x4 c0 = acc[ai][0][m][0], c1 = acc[ai][0][m][1], v0 = acc[ai][1][m][0], v1 = acc[ai][1][m][1];
                    v4u w; w.x = cvt_pk_bf16(c0[0] * v0[0], c0[1] * v0[1]); w.y = cvt_pk_bf16(c0[2] * v0[2], c0[3] * v0[3]);
                    w.z = cvt_pk_bf16(c1[0] * v1[0], c1[1] * v1[1]); w.w = cvt_pk_bf16(c1[2] * v1[2], c1[3] * v1[3]);
                    *(v4u*)p = w; }
        }
    }
};
struct EpiMoeDown {
    static constexpr bool PERM = true;
    const int2* slot; bf16* h; bf16* y1; float ps = 1.0f;
    __device__ __forceinline__ void operator()(const f32x4 (&acc)[2][2][4][2], const Unit& u, int wr, int wc, int fr, int fq) const {
        const int col0 = u.pn * BM + wc * 32 + 8 * fq;
        int2 inf[2][4];
#pragma unroll
        for (int ai = 0; ai < 2; ++ai)
#pragma unroll
            for (int m = 0; m < 4; ++m) { const int rl = ai * HALF + wr * 64 + m * 16 + fr; inf[ai][m] = (rl < u.rows) ? slot[u.slot0 + rl] : make_int2(0, 0); }
#pragma unroll
        for (int ai = 0; ai < 2; ++ai) {
            v4u b[4][2];
#pragma unroll
            for (int m = 0; m < 4; ++m) { const size_t off = (size_t)(inf[ai][m].x & 0x7fffffff) * D + col0;
#pragma unroll
                for (int bj = 0; bj < 2; ++bj) b[m][bj] = *(const v4u*)(h + off + bj * HALF); }
#pragma unroll
            for (int m = 0; m < 4; ++m) { const int rl = ai * HALF + wr * 64 + m * 16 + fr; const int ix = inf[ai][m].x; const float w = __int_as_float(inf[ai][m].y);
                const size_t off = (size_t)(ix & 0x7fffffff) * D + col0;
                if (rl < u.rows) {
                    const bool top1 = ix >= 0; const float ws = top1 ? w * ps : w; bf16* dst = top1 ? h : y1;
#pragma unroll
                    for (int bj = 0; bj < 2; ++bj) { const v4u v = b[m][bj];
                        f32x4 v0 = acc[ai][bj][m][0] * ws, v1 = acc[ai][bj][m][1] * ws;
                        if (top1) { v0 += (f32x4){bf_lo(v.x), bf_hi(v.x), bf_lo(v.y), bf_hi(v.y)}; v1 += (f32x4){bf_lo(v.z), bf_hi(v.z), bf_lo(v.w), bf_hi(v.w)}; }
                        v4u o; o.x = cvt_pk_bf16(v0[0], v0[1]); o.y = cvt_pk_bf16(v0[2], v0[3]); o.z = cvt_pk_bf16(v1[0], v1[1]); o.w = cvt_pk_bf16(v1[2], v1[3]);
                        *(v4u*)(dst + off + bj * HALF) = o; }
                } }
            asm volatile("" ::: "memory"); }
    }
};

#ifndef PG8_ALIGN_EPI
#define PG8_ALIGN_EPI 1
#endif
constexpr bool ALIGN_EPI = PG8_ALIGN_EPI;
typedef int i32x4 __attribute__((ext_vector_type(4)));
typedef int i32x8 __attribute__((ext_vector_type(8)));
template <class Epi, class Sched, bool GATHER, bool FP8 = false>
__device__ __forceinline__ void gemm_phase(LAS unsigned char* lds, LAS unsigned* idxbuf, const int wid, const int nt, const int lda, const int ldb, const Sched& S, const Epi& E, const int sc_a = 0x7f7f7f7f, const int sc_b = 0x7f7f7f7f) {
    const int lane = lane_id(), tid = wid * 64 + lane, wr = wid >> 2, wc = wid & 3, fr = lane & 15, fq = lane >> 4;
    unsigned voffA[2], voffB[2], voffG[2][2];
#pragma unroll
    for (int i = 0; i < 2; ++i) { int R, C; stage_rc(tid * 16 + i * 8192, R, C); const int Rb = Epi::PERM ? ((R & ~31) + perm32(R & 31)) : R;
        voffA[i] = (unsigned)(R * lda + C * 2); voffB[i] = (unsigned)(Rb * ldb + C * 2); voffG[0][i] = 0u; voffG[1][i] = 0u; }
    const __amdgpu_buffer_rsrc_t rA = __builtin_amdgcn_make_buffer_rsrc((void*)S.A, 0, 0x7ffffff0, 0x00020000), rB = __builtin_amdgcn_make_buffer_rsrc((void*)S.Bt, 0, 0x7ffffff0, 0x00020000);
    const unsigned kstep = (unsigned)(BK * 2);
    const unsigned hstepA = (unsigned)HALF * lda, hstepB = (unsigned)HALF * ldb;
    const unsigned ldsw = (unsigned)wid * 1024u; unsigned ldsw_ = ldsw;
    const int aoff = lds_byte(wr * 64 + fr, fq * 8), boff = lds_byte(wc * 32 + fr, fq * 8);
#define PG8_SA(b, h) (((b) * 2 + (h)) * HTB)
#define PG8_SB(b, h) ((4 + (b) * 2 + (h)) * HTB)
#define PG8_STAGE(bufoff, rsrc, soff, voff) do { _Pragma("unroll") for (int _i = 0; _i < 2; ++_i) \
        __builtin_amdgcn_raw_ptr_buffer_load_lds(rsrc, (LAS void*)(lds + (bufoff) + ldsw_ + _i * 8192), 16, (int)(voff)[_i], (int)(soff), 0, 0); } while (0)
#define PG8_STAGE_A(bufoff, soff, h) do { if constexpr (GATHER) { PG8_STAGE(bufoff, rA, soff, voffG[h]); } else { PG8_STAGE(bufoff, rA, (soff) + (h) * hstepA, voffA); } } while (0)
#define PG8_STAGE_B(bufoff, soff, h) PG8_STAGE(bufoff, rB, (soff) + (h) * hstepB, voffB)
#define PG8_LDA(dst, b, h) do { _Pragma("unroll") for (int m = 0; m < 4; ++m) _Pragma("unroll") for (int k = 0; k < 2; ++k) dst[m][k] = *(const LAS bf16x8*)(lds + PG8_SA(b, h) + aoff + m * 2048 + k * 1024); } while (0)
#define PG8_LDB(dst, b, h) do { _Pragma("unroll") for (int n = 0; n < 2; ++n) _Pragma("unroll") for (int k = 0; k < 2; ++k) dst[n][k] = *(const LAS bf16x8*)(lds + PG8_SB(b, h) + boff + n * 2048 + k * 1024); } while (0)
#define PG8_MMA(ai, bj, At, Bt) do { __builtin_amdgcn_s_setprio(1); _Pragma("unroll") for (int m = 0; m < 4; ++m) _Pragma("unroll") for (int n = 0; n < 2; ++n) _Pragma("unroll") for (int k = 0; k < 2; ++k) \
        acc[ai][bj][m][n] = __builtin_amdgcn_mfma_f32_16x16x32_bf16(Bt[n][k], At[m][k], acc[ai][bj][m][n], 0, 0, 0); __builtin_amdgcn_s_setprio(0); } while (0)
#define PG8_CAT(x) __builtin_shufflevector((i32x4)(x)[0], (i32x4)(x)[1], 0, 1, 2, 3, 4, 5, 6, 7)
#define PG8_MMA8(ai, bj, At, Bt) do { __builtin_amdgcn_s_setprio(1); _Pragma("unroll") for (int m = 0; m < 4; ++m) _Pragma("unroll") for (int n = 0; n < 2; ++n) \
        acc[ai][bj][m][n] = __builtin_amdgcn_mfma_scale_f32_16x16x128_f8f6f4(PG8_CAT(Bt[n]), PG8_CAT(At[m]), acc[ai][bj][m][n], 0, 0, 0, sc_b, 0, sc_a); __builtin_amdgcn_s_setprio(0); } while (0)
#define PG8_MM(ai, bj, At, Bt) do { if ((ai) * HALF + wr * 64 < cur.rows) { if constexpr (FP8) PG8_MMA8(ai, bj, At, Bt); else PG8_MMA(ai, bj, At, Bt); } } while (0)
#define PG8_WAIT_V(n) asm volatile("s_waitcnt vmcnt(" #n ")" ::: "memory")
#define PG8_WAIT_L(n) asm volatile("s_waitcnt lgkmcnt(" #n ")" ::: "memory")
#define PG8_BAR __builtin_amdgcn_s_barrier()
#define PG8_SCHED __builtin_amdgcn_sched_barrier(0)
#define PG8_LOAD_VOFFG(ib, nrows) do { asm volatile("" ::: "memory"); _Pragma("unroll") for (int _i = 0; _i < 2; ++_i) { int _R, _C; stage_rc(tid * 16 + _i * 8192, _R, _C); \
        _Pragma("unroll") for (int _h = 0; _h < 2; ++_h) { const int _rl = _h * HALF + _R; unsigned _ix = (ib)[_rl]; _ix = (_rl < (nrows)) ? _ix : 0u; voffG[_h][_i] = _ix * (unsigned)lda + (unsigned)(_C * 2); } } } while (0)
#define PG8_IDX_DMA(src, ib) __builtin_amdgcn_global_load_lds((const unsigned*)((src) + lane * 4), (LAS unsigned*)(ib), 16, 0, 0)
    Unit cur, nxt; int ui = 0;
    if (!S.next(0, cur)) return;
    f32x4 acc[2][2][4][2];
#pragma unroll
    for (int a = 0; a < 2; ++a)
#pragma unroll
        for (int b = 0; b < 2; ++b)
#pragma unroll
            for (int m = 0; m < 4; ++m)
#pragma unroll
                for (int n = 0; n < 2; ++n) acc[a][b][m][n] = (f32x4){0.f, 0.f, 0.f, 0.f};
    bf16x8 At[4][2], B0[2][2], B1[2][2];
    unsigned cA = S.a_off(cur), cB = S.b_off(cur);
    if constexpr (GATHER) {
        if (wid == 0) PG8_IDX_DMA(S.idx_src(cur), idxbuf);
        PG8_WAIT_V(0); PG8_BAR;
        PG8_LOAD_VOFFG(idxbuf, cur.rows);
    }
    PG8_STAGE_B(PG8_SB(0, 0), cB, 0); PG8_STAGE_B(PG8_SB(0, 1), cB, 1); PG8_STAGE_A(PG8_SA(0, 0), cA, 0); PG8_STAGE_A(PG8_SA(0, 1), cA, 1);
    if (wr == 1) PG8_BAR;
    PG8_WAIT_V(2); PG8_BAR;
    PG8_STAGE_B(PG8_SB(1, 0), cB + kstep, 0); PG8_STAGE_A(PG8_SA(1, 0), cA + kstep, 0); PG8_STAGE_B(PG8_SB(1, 1), cB + kstep, 1);
    PG8_WAIT_V(6); PG8_BAR;
    for (;;) {
        const bool has_next = S.next(ui + 1, nxt);
        const unsigned nA = has_next ? S.a_off(nxt) : cA, nB = has_next ? S.b_off(nxt) : cB;
        if constexpr (GATHER) { if (has_next && wid == 0) PG8_IDX_DMA(S.idx_src(nxt), idxbuf + ((ui + 1) & 1) * 256); }
#pragma nounroll
        for (int t = 0; t < nt; t += 2) {
            const bool last = (t == nt - 2);
            asm volatile("" : "+s"(ldsw_));
            const unsigned a1 = cA + (unsigned)(t + 1) * kstep;
            const unsigned a2 = last ? nA : cA + (unsigned)(t + 2) * kstep, b2 = last ? nB : cB + (unsigned)(t + 2) * kstep;
            const unsigned a3 = a2 + kstep, b3 = b2 + kstep;
            PG8_LDB(B0, 0, 0); PG8_LDB(B1, 0, 1); PG8_SCHED; PG8_LDA(At, 0, 0); PG8_STAGE_A(PG8_SA(1, 1), a1, 1);
            PG8_WAIT_V(8); PG8_WAIT_L(0); PG8_BAR; PG8_MM(0, 0, At, B0); PG8_MM(0, 1, At, B1); PG8_BAR; PG8_SCHED;
            if constexpr (GATHER) { if (last && has_next) PG8_LOAD_VOFFG(idxbuf + ((ui + 1) & 1) * 256, nxt.rows); }
            PG8_LDA(At, 0, 1); PG8_STAGE_B(PG8_SB(0, 0), b2, 0); PG8_STAGE_B(PG8_SB(0, 1), b2, 1); PG8_STAGE_A(PG8_SA(0, 0), a2, 0);
            PG8_WAIT_V(8); PG8_WAIT_L(0); PG8_BAR; PG8_MM(1, 0, At, B0); PG8_MM(1, 1, At, B1); PG8_BAR; PG8_SCHED;
            PG8_LDB(B0, 1, 0); PG8_LDB(B1, 1, 1); PG8_SCHED; PG8_LDA(At, 1, 0); PG8_STAGE_A(PG8_SA(0, 1), a2, 1);
            PG8_WAIT_V(8); PG8_WAIT_L(0); PG8_BAR; PG8_MM(0, 0, At, B0); PG8_MM(0, 1, At, B1); PG8_BAR; PG8_SCHED;
            PG8_LDA(At, 1, 1); PG8_STAGE_B(PG8_SB(1, 0), b3, 0); PG8_STAGE_B(PG8_SB(1, 1), b3, 1); PG8_STAGE_A(PG8_SA(1, 0), a3, 0);
            PG8_WAIT_V(8); PG8_WAIT_L(0); PG8_BAR; PG8_MM(1, 0, At, B0); PG8_MM(1, 1, At, B1); PG8_BAR; PG8_SCHED;
        }
        if (ALIGN_EPI) { if (wr == 0) PG8_BAR; }
        { const int ln = lane_id(); E(acc, cur, wr, wc, ln & 15, ln >> 4); }
        if (!has_next) break;
#pragma unroll
        for (int a = 0; a < 2; ++a)
#pragma unroll
            for (int b = 0; b < 2; ++b)
#pragma unroll
                for (int m = 0; m < 4; ++m)
#pragma unroll
                    for (int n = 0; n < 2; ++n) acc[a][b][m][n] = (f32x4){0.f, 0.f, 0.f, 0.f};
        cur = nxt; cA = nA; cB = nB; ++ui;
        if (ALIGN_EPI) { if (wr == 1) PG8_BAR; }
    }
    PG8_WAIT_V(0);
    if (!ALIGN_EPI) { if (wr == 0) PG8_BAR; }
    PG8_BAR;
#undef PG8_SA
#undef PG8_SB
#undef PG8_STAGE
#undef PG8_STAGE_A
#undef PG8_STAGE_B
#undef PG8_LDA
#undef PG8_LDB
#undef PG8_MMA
#undef PG8_MMA8
#undef PG8_MM
#undef PG8_CAT
#undef PG8_WAIT_V
#undef PG8_WAIT_L
#undef PG8_BAR
#undef PG8_SCHED
#undef PG8_LOAD_VOFFG
#undef PG8_IDX_DMA
}
}

struct Args { const float* in[19]; float* out; unsigned char* ws; int ph_lo, ph_hi; };
struct Ctx {
    LAS unsigned char* lds; int tid, lane, wave, G, vcu, gw, NGW, gw0, wave0;
    unsigned char* ws; bf16* HB; bf16* XN; bf16* Y1; float* RSTD; unsigned* ctl;
};

__device__ __forceinline__ void tr_item(const float* W, int ldw, int k0, int n0, bf16* WT, int K, int drow0, LAS float* scr, int lane) {
#pragma unroll 8
    for (int i = 0; i < 32; ++i) { const int kk = 2 * i + (lane >> 5); scr[kk * 33 + (lane & 31)] = W[(size_t)(k0 + kk) * ldw + n0 + (lane & 31)]; }
    LDS_WAIT();
    const int c = lane & 7;
#pragma unroll
    for (int j = 0; j < 4; ++j) { const int n = (lane >> 3) + 8 * j; const LAS float* s = scr + (8 * c) * 33 + n;
        v4u o; o.x = cvt_pk_bf16(s[0 * 33], s[1 * 33]); o.y = cvt_pk_bf16(s[2 * 33], s[3 * 33]); o.z = cvt_pk_bf16(s[4 * 33], s[5 * 33]); o.w = cvt_pk_bf16(s[6 * 33], s[7 * 33]);
        *(v4u*)(WT + (size_t)(drow0 + n) * K + k0 + 8 * c) = o; }
    LDS_WAIT();
}
__device__ __forceinline__ void tr_item8(const float* W, int ldw, int k0, int n0, unsigned char* WT, int K, int drow0, float scale, LAS float* scr, int lane) {
#pragma unroll 8
    for (int i = 0; i < 32; ++i) { const int kk = 2 * i + (lane >> 5); scr[kk * 33 + (lane & 31)] = W[(size_t)(k0 + kk) * ldw + n0 + (lane & 31)] * scale; }
    LDS_WAIT();
    const int c = lane & 7;
#pragma unroll
    for (int j = 0; j < 4; ++j) { const int n = (lane >> 3) + 8 * j; const LAS float* s = scr + (8 * c) * 33 + n;
        v2u o; o.x = pk4_fp8(s[0 * 33], s[1 * 33], s[2 * 33], s[3 * 33]); o.y = pk4_fp8(s[4 * 33], s[5 * 33], s[6 * 33], s[7 * 33]);
        *(v2u*)(WT + (size_t)(drow0 + n) * K + k0 + 8 * c) = o; }
    LDS_WAIT();
}
__device__ __forceinline__ void cv_gateup(const float* Wg, const float* Wu, bf16* dst, int item, LAS float* scr, int lane) {
    const int kind = item / 1792, r = item % 1792, kb = r / 112, nb = r % 112, n0 = 32 * nb;
    tr_item(kind ? Wu : Wg, FF, 64 * kb, n0, dst, D, (n0 >> 7) * 256 + (n0 & 127) + kind * 128, scr, lane);
}
__device__ __forceinline__ void cv_plain(const float* W, int K, int N, bf16* dst, int drow_off, int item, LAS float* scr, int lane) {
    const int nbn = N / 32, kb = item / nbn, nb = item % nbn;
    tr_item(W, N, 64 * kb, 32 * nb, dst, K, drow_off + 32 * nb, scr, lane);
}
__device__ __forceinline__ void cv_convin(const float* W, bf16* dst, int item, LAS float* scr, int lane) {
    const int kb = item / 96, nb = item % 96, n0 = 32 * nb; int dr;
    if (n0 < 1024) dr = n0; else if (n0 < 2048) dr = 1024 + ((n0 - 1024) >> 7) * 256 + (n0 & 127); else dr = 1024 + ((n0 - 2048) >> 7) * 256 + 128 + (n0 & 127);
    tr_item(W, 3 * D, 64 * kb, n0, dst, D, dr, scr, lane);
}
__device__ __forceinline__ void convert_moe_layer(Ctx& C, const Args& a, int j) {
    LAS float* scr = (LAS float*)(C.lds + C.wave * 16384);
    constexpr int PER_E = 3584 + 1792;
    for (int it = C.gw; it < NE * PER_E; it += C.NGW) {
        const int e = it / PER_E, r = it % PER_E; const size_t wo = ((size_t)j * NE + e) * D * FF;
        if (r < 3584) { const int kind = r / 1792, q = r % 1792, kb = q / 112, nb = q % 112, n0 = 32 * nb;
            tr_item8((kind ? a.in[16] : a.in[15]) + wo, FF, 64 * kb, n0, C.ws + WS_WMGU + (size_t)(j * NE + e) * GU8_BYTES, D, (n0 >> 7) * 256 + (n0 & 127) + kind * 128, W_GU_SCALE, scr, C.lane); }
        else { const int q = r - 3584, kb = q / 32, nb = q % 32;
            tr_item8(a.in[17] + wo, D, 64 * kb, 32 * nb, C.ws + WS_WMDN + (size_t)(j * NE + e) * DN8_BYTES, FF, 32 * nb, W_DN_SCALE, scr, C.lane); }
    }
}
__device__ __forceinline__ void convert_small_weights(Ctx& C, const Args& a) {
    LAS float* scr = (LAS float*)(C.lds + C.wave * 16384);
    constexpr int I_POOL = 32, I_GU = 3584, I_DN = 1792, I_IN = 1536, I_OUT = 512;
    constexpr int PER_L = 4 * I_POOL + I_GU + I_DN + I_IN + I_OUT;
    for (int it = C.gw; it < 2 * PER_L; it += C.NGW) {
        const int l = it / PER_L; int r = it % PER_L;
        if (r < 4 * I_POOL) { const int g = r / I_POOL; cv_plain(a.in[3] + (size_t)(l * 4 + g) * 65536, 256, 256, (bf16*)(C.ws + WS_WPOOL + (size_t)l * 524288), g * 256, r % I_POOL, scr, C.lane); continue; } r -= 4 * I_POOL;
        if (r < I_GU) {
            if (l == DENSE_FP8_LAYER) { const int kind = r / 1792, q = r % 1792, kb = q / 112, nb = q % 112, n0 = 32 * nb;
                tr_item8((kind ? a.in[7] : a.in[6]) + (size_t)l * D * FF, FF, 64 * kb, n0, C.ws + WS_WGU + (size_t)l * GU_BYTES, D, (n0 >> 7) * 256 + (n0 & 127) + kind * 128, W_GU_SCALE, scr, C.lane); }
            else cv_gateup(a.in[6] + (size_t)l * D * FF, a.in[7] + (size_t)l * D * FF, (bf16*)(C.ws + WS_WGU + (size_t)l * GU_BYTES), r, scr, C.lane);
            continue; } r -= I_GU;
        if (r < I_DN) {
            if (l == DENSE_FP8_LAYER) { const int kb = r / 32, nb = r % 32; tr_item8(a.in[8] + (size_t)l * D * FF, D, 64 * kb, 32 * nb, C.ws + WS_WDN + (size_t)l * DN_BYTES, FF, 32 * nb, W_DN_SCALE, scr, C.lane); }
            else cv_plain(a.in[8] + (size_t)l * D * FF, FF, D, (bf16*)(C.ws + WS_WDN + (size_t)l * DN_BYTES), 0, r, scr, C.lane);
            continue; } r -= I_DN;
        if (r < I_IN) { cv_convin(a.in[10] + (size_t)l * D * 3 * D, (bf16*)(C.ws + WS_WIN + (size_t)l * 3 * D * D * 2), r, scr, C.lane); continue; } r -= I_IN;
        cv_plain(a.in[12] + (size_t)l * D * D, D, D, (bf16*)(C.ws + WS_WOUT + (size_t)l * D * D * 2), 0, r, scr, C.lane);
    }
}

__device__ __forceinline__ int prev_row(int row, int i) {
    if (row < MROWS) { const int tp = row & (TS - 1); return tp >= i ? row - i : MROWS + NMETA + tp - i; }
    return row - i;
}
__device__ __forceinline__ void load_heff(const Ctx& C, int row, bool addy1, f32x4 (&x)[4]) {
    const v2u* p = (const v2u*)(C.HB + (size_t)row * D) + C.lane;
#pragma unroll
    for (int j = 0; j < 4; ++j) { const v2u v = p[64 * j]; x[j] = (f32x4){bf_lo(v.x), bf_hi(v.x), bf_lo(v.y), bf_hi(v.y)}; }
    if (addy1) { const v2u* q = (const v2u*)(C.Y1 + (size_t)row * D) + C.lane;
#pragma unroll
        for (int j = 0; j < 4; ++j) { const v2u y = q[64 * j]; x[j] += (f32x4){bf_lo(y.x), bf_hi(y.x), bf_lo(y.y), bf_hi(y.y)}; } }
}
__device__ __forceinline__ float row_rstd(const f32x4 (&x)[4], int lane) {
    float s = 0.f;
#pragma unroll
    for (int j = 0; j < 4; ++j) s += (x[j][0] * x[j][0] + x[j][1] * x[j][1]) + (x[j][2] * x[j][2] + x[j][3] * x[j][3]);
    return __frsqrt_rn(wave_sum(s, lane) * (1.0f / D) + EPS);
}
__device__ __forceinline__ void store_bf16_row(bf16* dst, int row, int lane, const f32x4 (&v)[4]) {
    v2u* o = (v2u*)(dst + (size_t)row * D) + lane;
#pragma unroll
    for (int j = 0; j < 4; ++j) { v2u w; w.x = cvt_pk_bf16(v[j][0], v[j][1]); w.y = cvt_pk_bf16(v[j][2], v[j][3]); o[64 * j] = w; }
}
__device__ __forceinline__ void phase_norm(Ctx& C, const float* gain, bool addy1, bool out8 = false) {
    f32x4 g[4];
#pragma unroll
    for (int j = 0; j < 4; ++j) g[j] = ((const f32x4*)gain)[C.lane + 64 * j];
    f32x4 x[4], xnx[4];
    if (C.gw < RTOT) load_heff(C, C.gw, addy1, x);
    for (int row = C.gw; row < RTOT; row += C.NGW) {
        const int nrow = row + C.NGW;
        if (nrow < RTOT) load_heff(C, nrow, addy1, xnx);
        const float rs = row_rstd(x, C.lane);
#pragma unroll
        for (int j = 0; j < 4; ++j) x[j] = x[j] * rs * g[j];
        if (out8) { unsigned* o8 = (unsigned*)((unsigned char*)C.XN + (size_t)row * D) + C.lane;
#pragma unroll
            for (int j = 0; j < 4; ++j) o8[64 * j] = pk4_fp8(x[j][0], x[j][1], x[j][2], x[j][3]); }
        else store_bf16_row(C.XN, row, C.lane, x);
#pragma unroll
        for (int j = 0; j < 4; ++j) x[j] = xnx[j];
    }
}
template <bool L0>
__device__ __forceinline__ void phase_pool(Ctx& C, const float* gain, bool addy1, const float* xin, const float* meta) {
    f32x4 g[4];
#pragma unroll
    for (int j = 0; j < 4; ++j) g[j] = ((const f32x4*)gain)[C.lane + 64 * j];
    constexpr int RUN = 32, NRUN = MROWS / RUN + 1;
    for (int run = C.gw; run < NRUN; run += C.NGW) {
        const bool mrun = run == NRUN - 1;
        const int r0 = run * RUN, tp0 = r0 & (TS - 1), nsteps = mrun ? NMETA : RUN + 15;
        f32x4 r1[2], r2[4], r3[8], r4[16], S[4];
#pragma unroll
        for (int q = 0; q < 2; ++q) r1[q] = (f32x4){0.f, 0.f, 0.f, 0.f};
#pragma unroll
        for (int q = 0; q < 4; ++q) r2[q] = (f32x4){0.f, 0.f, 0.f, 0.f};
#pragma unroll
        for (int q = 0; q < 8; ++q) r3[q] = (f32x4){0.f, 0.f, 0.f, 0.f};
#pragma unroll
        for (int q = 0; q < 16; ++q) r4[q] = (f32x4){0.f, 0.f, 0.f, 0.f};
#pragma unroll
        for (int j = 0; j < 4; ++j) S[j] = (f32x4){0.f, 0.f, 0.f, 0.f};
#define POOL_ROW(k_) (mrun ? MROWS + (k_) : ((tp0 + (k_) - 15 >= 0) ? r0 + (k_) - 15 : MROWS + NMETA + tp0 + (k_) - 15))
#define POOL_LOAD(dst, row_) do { if (L0) { const f32x4* p_ = (const f32x4*)((row_) < MROWS ? xin + (size_t)(row_) * D : meta + (size_t)((row_) - MROWS) * D) + C.lane; \
        _Pragma("unroll") for (int j = 0; j < 4; ++j) dst[j] = p_[64 * j]; } else load_heff(C, row_, addy1, dst); } while (0)
        f32x4 x[4], xnx[4];
        POOL_LOAD(x, POOL_ROW(0));
        for (int kb = 0; kb < nsteps; kb += 16) {
#pragma unroll
            for (int kk = 0; kk < 16; ++kk) {
                const int k = kb + kk;
                if (k < nsteps) {
                    const int i = mrun ? k : k - 15;
                    const int row = POOL_ROW(k);
                    if (k + 1 < nsteps) POOL_LOAD(xnx, POOL_ROW(k + 1));
                    const float rs = row_rstd(x, C.lane);
#pragma unroll
                    for (int j = 0; j < 4; ++j) x[j] = x[j] * rs * g[j];
                    S[0] += x[0] - r1[kk & 1]; r1[kk & 1] = x[0];
                    S[1] += x[1] - r2[kk & 3]; r2[kk & 3] = x[1];
                    S[2] += x[2] - r3[kk & 7]; r3[kk & 7] = x[2];
                    S[3] += x[3] - r4[kk]; r4[kk] = x[3];
                    if (i >= 0) {
                        const int pos = mrun ? k : NMETA;
                        f32x4 d[4];
#pragma unroll
                        for (int j = 0; j < 4; ++j) { const int w = 2 << j; const int cnt = (pos + 1) < w ? (pos + 1) : w; d[j] = S[j] * (1.0f / (float)cnt) - x[j]; }
                        store_bf16_row(C.XN, row, C.lane, d);
                    }
#pragma unroll
                    for (int j = 0; j < 4; ++j) x[j] = xnx[j];
                }
            }
        }
#undef POOL_ROW
#undef POOL_LOAD
    }
}
__device__ __forceinline__ void conv_tap(float (&s)[8], const float (&k)[8], const v4u& uu) {
    s[0] += k[0] * bf_lo(uu.x); s[1] += k[1] * bf_hi(uu.x); s[2] += k[2] * bf_lo(uu.y); s[3] += k[3] * bf_hi(uu.y);
    s[4] += k[4] * bf_lo(uu.z); s[5] += k[5] * bf_hi(uu.z); s[6] += k[6] * bf_lo(uu.w); s[7] += k[7] * bf_hi(uu.w);
}
__device__ __forceinline__ void phase_conv(Ctx& C, const float* ck, const bf16* BGp, const bf16* Up, bf16* Y) {
    float k[3][2][8];
#pragma unroll
    for (int t = 0; t < 3; ++t)
#pragma unroll
        for (int q = 0; q < 2; ++q) { const f32x4 a = *(const f32x4*)(ck + t * D + 8 * C.lane + 512 * q), b = *(const f32x4*)(ck + t * D + 8 * C.lane + 512 * q + 4);
            k[t][q][0] = a[0]; k[t][q][1] = a[1]; k[t][q][2] = a[2]; k[t][q][3] = a[3]; k[t][q][4] = b[0]; k[t][q][5] = b[1]; k[t][q][6] = b[2]; k[t][q][7] = b[3]; }
    constexpr int RUN = 32, NRUN = MROWS / RUN + 1;
    const v4u zero4 = (v4u){0u, 0u, 0u, 0u};
    for (int run = C.gw; run < NRUN; run += C.NGW) {
        const bool mrun = run == NRUN - 1;
        const int r0 = mrun ? MROWS : run * RUN, n = mrun ? NMETA : RUN;
        v4u um1[2], um2[2];
#pragma unroll
        for (int q = 0; q < 2; ++q) { const int co = 8 * C.lane + 512 * q;
            um1[q] = mrun ? zero4 : *(const v4u*)(Up + (size_t)prev_row(r0, 1) * D + co); um2[q] = mrun ? zero4 : *(const v4u*)(Up + (size_t)prev_row(r0, 2) * D + co); }
        v4u uc[2], bc[2], un[2], bn[2];
#pragma unroll
        for (int q = 0; q < 2; ++q) { const int co = 8 * C.lane + 512 * q; uc[q] = *(const v4u*)(Up + (size_t)r0 * D + co); bc[q] = *(const v4u*)(BGp + (size_t)r0 * D + co); }
        for (int i = 0; i < n; ++i) {
            const int row = r0 + i;
            if (i + 1 < n) {
#pragma unroll
                for (int q = 0; q < 2; ++q) { const int co = 8 * C.lane + 512 * q; un[q] = *(const v4u*)(Up + (size_t)(row + 1) * D + co); bn[q] = *(const v4u*)(BGp + (size_t)(row + 1) * D + co); } }
#pragma unroll
            for (int q = 0; q < 2; ++q) {
                const int co = 8 * C.lane + 512 * q;
                const v4u uu = uc[q], bb = bc[q];
                float sacc[8];
#pragma unroll
                for (int e = 0; e < 8; ++e) sacc[e] = 0.f;
                conv_tap(sacc, k[0][q], um2[q]); conv_tap(sacc, k[1][q], um1[q]); conv_tap(sacc, k[2][q], uu);
                um2[q] = um1[q]; um1[q] = uu;
                v4u o; o.x = cvt_pk_bf16(bf_lo(bb.x) * sacc[0], bf_hi(bb.x) * sacc[1]); o.y = cvt_pk_bf16(bf_lo(bb.y) * sacc[2], bf_hi(bb.y) * sacc[3]);
                o.z = cvt_pk_bf16(bf_lo(bb.z) * sacc[4], bf_hi(bb.z) * sacc[5]); o.w = cvt_pk_bf16(bf_lo(bb.w) * sacc[6], bf_hi(bb.w) * sacc[7]);
                *(v4u*)(Y + (size_t)row * D + co) = o;
                uc[q] = un[q]; bc[q] = bn[q];
            }
        }
    }
}
__device__ __forceinline__ float xchg(float v, int lane, int m) { return __int_as_float(__builtin_amdgcn_ds_bpermute((lane ^ m) << 2, __float_as_int(v))); }
__device__ __forceinline__ void phase_router(Ctx& C, const float* gain, const float* router, unsigned* gcnt  ) {
    LAS unsigned* lcnt = (LAS unsigned*)C.lds;
    LAS unsigned* lbase = lcnt + 8;
    LAS unsigned* ent = lcnt + 16;
    f32x4 g[4];
#pragma unroll
    for (int j = 0; j < 4; ++j) g[j] = ((const f32x4*)gain)[C.lane + 64 * j];
    f32x4 ra[4][4], rb[4][4];
#pragma unroll
    for (int j = 0; j < 4; ++j)
#pragma unroll
        for (int i = 0; i < 4; ++i) { const f32x4* rp = (const f32x4*)(router + (size_t)(4 * C.lane + 256 * j + i) * NE); ra[j][i] = rp[0]; rb[j][i] = rp[1]; }
    unsigned* rowidx = (unsigned*)(C.ws + WS_ROWIDX); int2* slot = (int2*)(C.ws + WS_SLOT);
    const int nchunk = (RTOT + 255) / 256;
    const bool up32 = (C.lane & 32) != 0, up16 = (C.lane & 16) != 0, up8 = (C.lane & 8) != 0;
    for (int ch = blockIdx.x; ch < nchunk; ch += C.G) {
        const int r0 = ch * 256, nr = (RTOT - r0) < 256 ? (RTOT - r0) : 256;
        __syncthreads();
        if (C.tid < 16) lcnt[C.tid] = 0u;
        __syncthreads();
        f32x4 x[4], xnx[4];
        if (C.wave < nr) load_heff(C, r0 + C.wave, false, x);
        for (int lr = C.wave; lr < nr; lr += NWAVES) {
            const int row = r0 + lr;
            if (lr + NWAVES < nr) load_heff(C, row + NWAVES, false, xnx);
            const float rs = row_rstd(x, C.lane);
#pragma unroll
            for (int j = 0; j < 4; ++j) x[j] = x[j] * rs * g[j];
            { unsigned* o8 = (unsigned*)((unsigned char*)C.XN + (size_t)row * D) + C.lane;
#pragma unroll
              for (int j = 0; j < 4; ++j) o8[64 * j] = pk4_fp8(x[j][0], x[j][1], x[j][2], x[j][3]); }
            f32x4 la = (f32x4){0.f, 0.f, 0.f, 0.f}, lb = la;
#pragma unroll
            for (int j = 0; j < 4; ++j)
#pragma unroll
                for (int i = 0; i < 4; ++i) { la += ra[j][i] * x[j][i]; lb += rb[j][i] * x[j][i]; }
            f32x4 k4; { const f32x4 keep = up32 ? lb : la, give = up32 ? la : lb;
                k4[0] = keep[0] + xchg(give[0], C.lane, 32); k4[1] = keep[1] + xchg(give[1], C.lane, 32); k4[2] = keep[2] + xchg(give[2], C.lane, 32); k4[3] = keep[3] + xchg(give[3], C.lane, 32); }
            float k2a, k2b; { const float keep0 = up16 ? k4[2] : k4[0], keep1 = up16 ? k4[3] : k4[1], give0 = up16 ? k4[0] : k4[2], give1 = up16 ? k4[1] : k4[3];
                k2a = keep0 + xchg(give0, C.lane, 16); k2b = keep1 + xchg(give1, C.lane, 16); }
            float k1; { const float keep = up8 ? k2b : k2a, give = up8 ? k2a : k2b; k1 = keep + xchg(give, C.lane, 8); }
            k1 += xchg(k1, C.lane, 4); k1 += xchg(k1, C.lane, 2); k1 += xchg(k1, C.lane, 1);
            float lg[8];
#pragma unroll
            for (int e = 0; e < 8; ++e) lg[e] = __int_as_float(__builtin_amdgcn_readlane(__float_as_int(k1), 8 * e));
            int e1 = 0; float v1 = lg[0];
#pragma unroll
            for (int e = 1; e < 8; ++e) if (lg[e] > v1) { v1 = lg[e]; e1 = e; }
            int e2 = -1; float v2 = -3.0e38f;
#pragma unroll
            for (int e = 0; e < 8; ++e) if (e != e1 && lg[e] > v2) { v2 = lg[e]; e2 = e; }
            const float ex = __expf(v2 - v1), w1 = 1.0f / (1.0f + ex), w2 = ex * w1;
            if (C.lane == 0) {
                const unsigned k1_ = atomicAdd((unsigned*)&lcnt[e1], 1u), k2_ = atomicAdd((unsigned*)&lcnt[e2], 1u);
                ent[(lr * 2 + 0) * 2 + 0] = (unsigned)e1 | (k1_ << 8); ent[(lr * 2 + 0) * 2 + 1] = __float_as_uint(w1);
                ent[(lr * 2 + 1) * 2 + 0] = (unsigned)e2 | (k2_ << 8); ent[(lr * 2 + 1) * 2 + 1] = __float_as_uint(w2);
            }
#pragma unroll
            for (int j = 0; j < 4; ++j) x[j] = xnx[j];
        }
        __syncthreads();
        if (C.tid < 8) lbase[C.tid] = __hip_atomic_fetch_add(gcnt + 64 * C.tid, lcnt[C.tid], __ATOMIC_RELAXED, __HIP_MEMORY_SCOPE_AGENT);
        __syncthreads();
        for (int q = C.tid; q < nr * 2; q += NWAVES * 64) {
            const unsigned ek = ent[q * 2], wb = ent[q * 2 + 1]; const int e = ek & 255, rank = ek >> 8, row = r0 + (q >> 1), ch2 = q & 1;
            const int pos = e * CAP + (int)lbase[e] + rank;
            rowidx[pos] = (unsigned)row; slot[pos] = make_int2(row | (ch2 << 31), (int)wb);
        }
    }
    __syncthreads();
}
__device__ __forceinline__ void phase_final(Ctx& C, const float* gain, float* out) {
    f32x4 g[4];
#pragma unroll
    for (int j = 0; j < 4; ++j) g[j] = ((const f32x4*)gain)[C.lane + 64 * j];
    f32x4 x[4], xnx[4];
    if (C.gw < MROWS) load_heff(C, C.gw, true, x);
    for (int row = C.gw; row < MROWS; row += C.NGW) {
        const int nrow = row + C.NGW;
        if (nrow < MROWS) load_heff(C, nrow, true, xnx);
        const float rs = row_rstd(x, C.lane);
        f32x4* o = (f32x4*)(out + (size_t)row * D) + C.lane;
#pragma unroll
        for (int j = 0; j < 4; ++j) o[64 * j] = x[j] * rs * g[j];
#pragma unroll
        for (int j = 0; j < 4; ++j) x[j] = xnx[j];
    }
}
__device__ __forceinline__ void copy_params(Ctx& C, const Args& a) {
    float* P = (float*)(C.ws + WS_PARAMS);
    for (int i = C.gw * 64 + C.lane; i < PP_TOTAL; i += C.NGW * 64) {
        float v;
        if (i < PP_POOL_SCALE) v = a.in[2][i - PP_POOL_NORM];
        else if (i < PP_DENSE_NORM) v = a.in[4][i - PP_POOL_SCALE];
        else if (i < PP_CONV_NORM) v = a.in[5][i - PP_DENSE_NORM];
        else if (i < PP_MOE_NORM) v = a.in[9][i - PP_CONV_NORM];
        else if (i < PP_FINAL) v = a.in[13][i - PP_MOE_NORM];
        else if (i < PP_CONV_K) v = a.in[18][i - PP_FINAL];
        else if (i < PP_ROUTER) v = a.in[11][i - PP_CONV_K];
        else v = a.in[14][i - PP_ROUTER];
        P[i] = v;
    }
}
__device__ __forceinline__ int moe_cnt(unsigned* gcnt, int e) { return __builtin_amdgcn_readfirstlane((int)__hip_atomic_load(gcnt + 64 * e, __ATOMIC_RELAXED, __HIP_MEMORY_SCOPE_AGENT)); }
__device__ __forceinline__ void moe_sched_init(pg8::MoeSched& S, const Ctx& C, unsigned* gcnt, int pass, int nN) {
    S.n0 = moe_cnt(gcnt, 0); S.n1 = moe_cnt(gcnt, 1); S.n2 = moe_cnt(gcnt, 2); S.n3 = moe_cnt(gcnt, 3); S.n4 = moe_cnt(gcnt, 4); S.n5 = moe_cnt(gcnt, 5); S.n6 = moe_cnt(gcnt, 6); S.n7 = moe_cnt(gcnt, 7);
    S.m1 = (S.n0 + 255) >> 8; S.m2 = S.m1 + ((S.n1 + 255) >> 8); S.m3 = S.m2 + ((S.n2 + 255) >> 8); S.m4 = S.m3 + ((S.n3 + 255) >> 8);
    S.m5 = S.m4 + ((S.n4 + 255) >> 8); S.m6 = S.m5 + ((S.n5 + 255) >> 8); S.m7 = S.m6 + ((S.n6 + 255) >> 8);
    const int total = S.m7 + ((S.n7 + 255) >> 8);
    S.t0 = pass * MOE_CH; int nM = total - S.t0; const int cap = (pass == MOE_PASSES - 1) ? MOE_LAST_MAX : MOE_CH; nM = nM < 0 ? 0 : (nM > cap ? cap : nM);
    S.nM = nM; S.nN = nN; S.G = C.G; S.c = (int)blockIdx.x;
}
__device__ __forceinline__ bool relaunder(Ctx& C, unsigned char* ws) { C.lane = lane_id(); C.tid = C.wave * 64 + C.lane;
    { int g = C.gw0, w = C.wave0; asm volatile("" : "+s"(g), "+s"(w)); C.gw = g; C.wave = w; }
    size_t z_ = 0; asm volatile("" : "+s"(z_)); ws += z_; C.ws = ws;
    C.HB = (bf16*)(ws + WS_H32); C.XN = (bf16*)(ws + WS_XN); C.Y1 = (bf16*)(ws + WS_Y1); C.RSTD = (float*)(ws + WS_RSTD); return true; }
constexpr int N_PHASES = 1 + 2 * (7 + 5 + 2 * MOE_PASSES) + 1;

#define RUN() (ph >= lo && ph < hi && relaunder(C, args.ws))
#define REPE for (int rep_ = 0; rep_ < PROBE_REP_ELT; ++rep_)
#define REPG for (int rep_ = 0; rep_ < PROBE_REP_GEMM; ++rep_)
#define SEAM() do { if (ph >= lo && ph + 1 < hi) xcd_barrier(bar, C.wave0); ++ph; } while (0)
#define INTER ((bf16*)(C.ws + WS_INTER))
#define PRM ((const float*)(C.ws + WS_PARAMS))

template <int lp>
__device__ __forceinline__ void layer_pair(Ctx& C, const Args& args, int& ph, const int lo, const int hi, const XcdBarrier& bar, LAS unsigned* idxbuf) {
        const bool addy1 = lp > 0;
        if (RUN()) REPE phase_pool<lp == 0>(C, PRM + PP_POOL_NORM + lp * D, addy1, args.in[0], args.in[1]);
    SEAM();
    if (RUN()) {
            pg8::DenseSched S; S.nM = MT_ALL; S.meta_pm = MT_ALL - 1; S.nN = 4; S.G = C.G; S.c = (int)blockIdx.x; S.A = (const char*)C.XN; S.Bt = (const char*)(C.ws + WS_WPOOL + (size_t)lp * 524288);
            S.tstepA = 256u * D * 2; S.tstepB = 256u * 256 * 2; S.a_colstep = 512;
            pg8::EpiResid E{C.HB, addy1 ? C.Y1 : nullptr, PRM + PP_POOL_SCALE + lp * D, 0, lp == 0 ? args.in[0] : nullptr, lp == 0 ? args.in[1] : nullptr};
            pg8::gemm_phase<pg8::EpiResid, pg8::DenseSched, false>(C.lds, idxbuf, C.wave, 256 / 64, D * 2, 256 * 2, S, E);
        }
        SEAM();
        if (RUN()) REPE phase_norm(C, PRM + PP_DENSE_NORM + lp * D, false, lp == DENSE_FP8_LAYER);
        SEAM();
        for (int hf = 0; hf < 2; ++hf) {
            const int pm0 = hf ? DENSE_H0 : 0, nM = hf ? (MT_ALL - DENSE_H0) : DENSE_H0;
            if (RUN()) {
                pg8::DenseSched S; S.nM = nM; S.meta_pm = hf ? nM - 1 : -1; S.nN = FF / 128; S.G = C.G; S.c = (int)blockIdx.x; S.a_colstep = 0; S.Bt = (const char*)(C.ws + WS_WGU + (size_t)lp * GU_BYTES);
                if (lp == DENSE_FP8_LAYER) {
                    S.A = (const char*)C.XN + (size_t)pm0 * 256 * D; S.tstepA = 256u * D; S.tstepB = 256u * D;
                    pg8::EpiSwiGLU8 E{(unsigned char*)INTER, FF};
                    for (int rep_ = 0; rep_ < ((PROBE_MASK & 2) ? 2 : 1); ++rep_) pg8::gemm_phase<pg8::EpiSwiGLU8, pg8::DenseSched, false, true>(C.lds, idxbuf, C.wave, D / 128, D, D, S, E, SC_ONE, SC_GU);
                } else {
                    S.A = (const char*)(C.XN + (size_t)pm0 * 256 * D); S.tstepA = 256u * D * 2; S.tstepB = 256u * D * 2;
                    pg8::EpiSwiGLU E{INTER, FF};
                    for (int rep_ = 0; rep_ < ((PROBE_MASK & 1) ? 2 : 1); ++rep_) pg8::gemm_phase<pg8::EpiSwiGLU, pg8::DenseSched, false>(C.lds, idxbuf, C.wave, D / 64, D * 2, D * 2, S, E);
                }
            }
            SEAM();
            if (RUN()) {
                pg8::DenseSched S; S.nM = nM; S.meta_pm = hf ? nM - 1 : -1; S.nN = 4; S.G = C.G; S.c = (int)blockIdx.x; S.A = (const char*)INTER; S.a_colstep = 0; S.Bt = (const char*)(C.ws + WS_WDN + (size_t)lp * DN_BYTES);
                constexpr int PB = (lp == DENSE_FP8_LAYER) ? 2 : 1, NR = (PROBE_MASK & PB) ? 2 : 1;
                pg8::EpiResid E{C.HB, nullptr, nullptr, pm0 * 256, nullptr, nullptr, 1.0f / NR};
                if (lp == DENSE_FP8_LAYER) { S.tstepA = 256u * FF; S.tstepB = 256u * FF;
                    for (int rep_ = 0; rep_ < NR; ++rep_) pg8::gemm_phase<pg8::EpiResid, pg8::DenseSched, false, true>(C.lds, idxbuf, C.wave, FF / 128, FF, FF, S, E, SC_H, SC_DN); }
                else { S.tstepA = 256u * FF * 2; S.tstepB = 256u * FF * 2;
                    for (int rep_ = 0; rep_ < NR; ++rep_) pg8::gemm_phase<pg8::EpiResid, pg8::DenseSched, false>(C.lds, idxbuf, C.wave, FF / 64, FF * 2, FF * 2, S, E); }
            }
            SEAM();
        }
        if (RUN()) REPE phase_norm(C, PRM + PP_CONV_NORM + lp * D, false);
        SEAM();
#define BG INTER
#define UU (INTER + (size_t)RPAD * D)
        if (RUN()) {
            pg8::DenseSched S; S.nM = MT_ALL; S.meta_pm = MT_ALL - 1; S.nN = 12; S.G = C.G; S.c = (int)blockIdx.x; S.A = (const char*)C.XN; S.Bt = (const char*)(C.ws + WS_WIN + (size_t)lp * 3 * D * D * 2);
            S.tstepA = 256u * D * 2; S.tstepB = 256u * D * 2; S.a_colstep = 0;
            pg8::EpiConvIn E{BG, UU};
            for (int rep_ = 0; rep_ < ((PROBE_MASK & 4) ? 2 : 1); ++rep_) pg8::gemm_phase<pg8::EpiConvIn, pg8::DenseSched, false>(C.lds, idxbuf, C.wave, D / 64, D * 2, D * 2, S, E);
        }
        SEAM();
        if (RUN()) REPE phase_conv(C, PRM + PP_CONV_K + lp * 3 * D, BG, UU, C.XN);
        SEAM();
        if (RUN()) {
            pg8::DenseSched S; S.nM = MT_ALL; S.meta_pm = MT_ALL - 1; S.nN = 4; S.G = C.G; S.c = (int)blockIdx.x; S.A = (const char*)C.XN; S.Bt = (const char*)(C.ws + WS_WOUT + (size_t)lp * D * D * 2);
            S.tstepA = 256u * D * 2; S.tstepB = 256u * D * 2; S.a_colstep = 0;
            constexpr int NR = (PROBE_MASK & 4) ? 2 : 1;
            pg8::EpiResid E{C.HB, nullptr, nullptr, 0, nullptr, nullptr, 1.0f / NR};
            for (int rep_ = 0; rep_ < NR; ++rep_) pg8::gemm_phase<pg8::EpiResid, pg8::DenseSched, false>(C.lds, idxbuf, C.wave, D / 64, D * 2, D * 2, S, E);
        }
        SEAM();
#define gcnt ((unsigned*)(C.ws + WS_CTL) + CW_MOECNT + lp * 8 * 64)
        if (RUN()) phase_router(C, PRM + PP_MOE_NORM + lp * D, PRM + PP_ROUTER + lp * D * NE, gcnt);
        SEAM();
        for (int pass = 0; pass < MOE_PASSES; ++pass) {
            if (RUN()) {
                pg8::MoeSched S; moe_sched_init(S, C, gcnt, pass, FF / 128);
                S.A = (const char*)C.XN; S.tstepA = 0; S.Bt = (const char*)(C.ws + WS_WMGU + (size_t)lp * NE * GU8_BYTES); S.estepB = (unsigned)GU8_BYTES; S.tstepB = 256u * D; S.rowidx = (const unsigned*)(C.ws + WS_ROWIDX);
                pg8::EpiSwiGLU8 E{(unsigned char*)INTER, FF};
                for (int rep_ = 0; rep_ < ((PROBE_MASK & 8) ? 2 : 1); ++rep_) pg8::gemm_phase<pg8::EpiSwiGLU8, pg8::MoeSched, true, true>(C.lds, idxbuf, C.wave, D / 128, D, D, S, E, SC_ONE, SC_GU);
            }
            SEAM();
            if (RUN()) {
                pg8::MoeSched S; moe_sched_init(S, C, gcnt, pass, 4);
                S.A = (const char*)INTER; S.tstepA = 256u * FF; S.Bt = (const char*)(C.ws + WS_WMDN + (size_t)lp * NE * DN8_BYTES); S.estepB = (unsigned)DN8_BYTES; S.tstepB = 256u * FF; S.rowidx = nullptr;
                constexpr int NR = (PROBE_MASK & 16) ? 2 : 1;
                pg8::EpiMoeDown E{(const int2*)(C.ws + WS_SLOT), C.HB, C.Y1, 1.0f / NR};
                for (int rep_ = 0; rep_ < NR; ++rep_) pg8::gemm_phase<pg8::EpiMoeDown, pg8::MoeSched, false, true>(C.lds, idxbuf, C.wave, FF / 128, FF, FF, S, E, SC_H, SC_DN);
            }
            SEAM();
        }
}

__global__ void __launch_bounds__(NWAVES * 64, 2) fwd(Args args) {
    extern __shared__ __attribute__((aligned(16))) unsigned char lds_raw[];
    Ctx C;
    C.lds = (LAS unsigned char*)lds_raw;
    C.tid = threadIdx.x; C.lane = C.tid & 63; C.wave0 = __builtin_amdgcn_readfirstlane(C.tid >> 6); C.wave = C.wave0;
    C.G = gridDim.x; { const int bx = blockIdx.x; C.vcu = (C.G % 8 == 0) ? (bx % 8) * (C.G / 8) + bx / 8 : bx; }
    C.gw0 = C.vcu * NWAVES + C.wave; C.gw = C.gw0; C.NGW = C.G * NWAVES;
    C.ws = args.ws; C.HB = (bf16*)(args.ws + WS_H32); C.XN = (bf16*)(args.ws + WS_XN); C.Y1 = (bf16*)(args.ws + WS_Y1); C.RSTD = (float*)(args.ws + WS_RSTD);
    C.ctl = (unsigned*)(args.ws + WS_CTL);
    LAS unsigned* idxbuf = (LAS unsigned*)(C.lds + IDX_OFF);
    volatile LAS unsigned* MISC = (volatile LAS unsigned*)(C.lds + MISC_OFF);
    for (int u = C.tid; u < (LDS_BYTES - IDX_OFF) / 4; u += NWAVES * 64) ((LAS unsigned*)(C.lds + IDX_OFF))[u] = 0u;
    __syncthreads();
    const int lo = args.ph_lo, hi = args.ph_hi;
    XcdBarrier bar; bar.bar = C.ctl + CW_BAR; bar.x = 0; bar.st = nullptr;
    if (hi - lo > 1) bar = xcd_barrier_post(C.ctl + CW_BAR, MISC + 8);
    int ph = 0;
    if (RUN()) REPE { copy_params(C, args); convert_small_weights(C, args); convert_moe_layer(C, args, 0); convert_moe_layer(C, args, 1); }
    SEAM();

    layer_pair<0>(C, args, ph, lo, hi, bar, idxbuf);
    layer_pair<1>(C, args, ph, lo, hi, bar, idxbuf);
    if (RUN()) REPE phase_final(C, PRM + PP_FINAL, args.out);
    SEAM();
#undef RUN
#undef SEAM
#undef INTER
#undef PRM
#undef BG
#undef UU
#undef gcnt
}

extern "C" void kernel_launch(void* const* d_in, const int* in_sizes, int n_in, void* d_out, int out_size, void* d_ws, size_t ws_size, hipStream_t stream) {
    static int grid = 0;
    if (grid == 0) {
        if (n_in != 19 || in_sizes[0] != MROWS * D || out_size != MROWS * D || ws_size < WS_END) {
            fprintf(stderr, "kernel_launch: unexpected problem (n_in %d, in0 %d, out %d, ws %zu < %zu); nothing launched\n", n_in, n_in > 0 ? in_sizes[0] : -1, out_size, ws_size, (size_t)WS_END); grid = -1; return; }
        int dev = 0, cus = 0, per_cu = 0;
        if (hipGetDevice(&dev) != hipSuccess || hipDeviceGetAttribute(&cus, hipDeviceAttributeMultiprocessorCount, dev) != hipSuccess) { grid = -1; return; }
        if (hipFuncSetAttribute((const void*)fwd, hipFuncAttributeMaxDynamicSharedMemorySize, LDS_BYTES) != hipSuccess) { fprintf(stderr, "kernel_launch: hipFuncSetAttribute failed\n"); grid = -1; return; }
        if (hipOccupancyMaxActiveBlocksPerMultiprocessor(&per_cu, (const void*)fwd, NWAVES * 64, LDS_BYTES) != hipSuccess || per_cu < 1)
            fprintf(stderr, "kernel_launch: occupancy query reports %d workgroups per CU\n", per_cu);
        (void)hipGetLastError();
        grid = cus;
    }
    if (grid < 0) return;
    if (hipMemsetAsync((char*)d_ws + WS_CTL, 0, CTL_ZERO_BYTES, stream) != hipSuccess) { fprintf(stderr, "kernel_launch: memset failed\n"); return; }
    Args a{};
    for (int i = 0; i < 19; ++i) a.in[i] = (const float*)d_in[i];
    a.out = (float*)d_out; a.ws = (unsigned char*)d_ws;
#if MK_ONE_LAUNCH
    a.ph_lo = 0; a.ph_hi = N_PHASES;
    hipLaunchKernelGGL(fwd, dim3(grid), dim3(NWAVES * 64), LDS_BYTES, stream, a);
#else
    for (int p = 0; p < N_PHASES; ++p) { a.ph_lo = p; a.ph_hi = p + 1; hipLaunchKernelGGL(fwd, dim3(grid), dim3(NWAVES * 64), LDS_BYTES, stream, a); }
#endif
    const hipError_t le = hipPeekAtLastError();
    if (le != hipSuccess) fprintf(stderr, "kernel_launch: launch failed: %s\n", hipGetErrorName(le));
}
```

```cpp
#include <hip/hip_runtime.h>
#include <cstdio>
#include <cstdint>
#include <type_traits>

#ifndef PROBE_REP_ELT
#define PROBE_REP_ELT 1
#endif
#ifndef PROBE_TMASK
#define PROBE_TMASK 0u
#endif
#ifndef PROBE_EPI
#define PROBE_EPI 0
#endif
#ifndef PROBE_HOTA
#define PROBE_HOTA 0
#endif
#ifndef PROBE_CLK
#define PROBE_CLK 0
#endif
#ifndef PROBE_MASK
#define PROBE_MASK 0
#endif
#ifndef PROBE_REP_GEMM
#define PROBE_REP_GEMM 1
#endif
#ifndef MK_ONE_LAUNCH
#define MK_ONE_LAUNCH 1
#endif

constexpr int D = 1024, FF = 3584, NE = 8, NB = 32, TS = 2048, NMETA = 16;
constexpr int MROWS = NB * TS;
constexpr int RTOT = MROWS + NMETA;
constexpr int MT_ALL = 257;
constexpr int RPAD = MT_ALL * 256;
constexpr int CAP = RPAD;
constexpr float EPS = 1e-6f;
constexpr int NWAVES = 8;
constexpr int MOE_CH = 256, MOE_PASSES = 1;
constexpr int MOE_LAST_MAX = 528;
constexpr float W_GU_SCALE = 64.f, W_DN_SCALE = 128.f, H8_SCALE = 4.f;
constexpr int MOE_GU_FMT = 6;
constexpr float X6_SCALE = 2.0f;
constexpr int SC_X6 = 0x7e7e7e7e  ;
constexpr size_t GU6_BYTES = (size_t)7168 * 768;
constexpr int SC_ONE = 0x7f7f7f7f, SC_GU = 0x79797979  , SC_DN = 0x78787878  , SC_H = 0x7d7d7d7d  ;
constexpr int DENSE_H0 = 128;
constexpr bool MOE_L1_CONV_IN_TAIL = true;
constexpr bool DENSE_NORM_FUSED_L0 = true;
constexpr bool DENSE_DN8_L0 = true;
constexpr int DENSE_FP8_LAYER = 1;

constexpr size_t MiB = 1u << 20;
constexpr size_t WS_CTL = 0, CTL_ZERO_BYTES = 1 * MiB;
constexpr size_t WS_WPOOL = 1 * MiB;
constexpr size_t WS_WGU = 2 * MiB;
constexpr size_t WS_WDN = 30 * MiB;
constexpr size_t WS_WIN = 44 * MiB;
constexpr size_t WS_WOUT = 56 * MiB;
constexpr size_t WS_WMGU = 60 * MiB;
constexpr size_t WS_WMDN = 172 * MiB;
constexpr size_t WS_ROWIDX = 228 * MiB;
constexpr size_t WS_SLOT = 231 * MiB;
constexpr size_t WS_RSTD = 236 * MiB;
constexpr size_t WS_PARAMS = 236 * MiB + 512 * 1024;
constexpr int PP_POOL_NORM = 0, PP_POOL_SCALE = 2048, PP_DENSE_NORM = 4096, PP_CONV_NORM = 6144, PP_MOE_NORM = 8192, PP_FINAL = 10240, PP_CONV_K = 11264, PP_ROUTER = 17408, PP_TOTAL = 17408 + 16384;
constexpr size_t WS_H32 = 237 * MiB;
constexpr size_t WS_Y1 = 366 * MiB;
constexpr size_t WS_XN = 495 * MiB;
constexpr size_t WS_XN6 = 366 * MiB;
constexpr size_t WS_H8MOE = 560 * MiB;
constexpr size_t WS_INTER = 624 * MiB;
constexpr size_t WS_DENSEH = WS_INTER;
constexpr size_t WS_ROWSQ = 1022 * MiB;
constexpr size_t ROWSQ_BYTES = (size_t)3 * 65536 * 8;
constexpr size_t WS_END = 1024 * MiB;
constexpr size_t GU_BYTES = (size_t)7168 * 1024 * 2, DN_BYTES = (size_t)1024 * 3584 * 2, GU8_BYTES = GU_BYTES / 2, DN8_BYTES = DN_BYTES / 2;
static_assert(WS_ROWIDX + (size_t)8 * CAP * 4 <= WS_SLOT && WS_SLOT + (size_t)8 * CAP * 8 <= WS_RSTD, "lists");
static_assert(WS_H32 + (size_t)RPAD * D * 2 <= WS_Y1 && WS_Y1 + (size_t)RPAD * D * 2 <= WS_XN && WS_XN + (size_t)RPAD * D * 2 <= WS_INTER && WS_XN6 == WS_Y1 && (size_t)RTOT * 1024 <= (size_t)RPAD * D * 2 && WS_H8MOE + (size_t)MOE_LAST_MAX * 256 * FF <= WS_ROWSQ && WS_ROWSQ + ROWSQ_BYTES <= WS_END, "act map");
static_assert((size_t)RPAD * FF <= WS_ROWSQ - WS_INTER && (size_t)2 * RPAD * D * 2 <= WS_ROWSQ - WS_INTER, "inter");
constexpr int CW_BAR = 4096;
constexpr int CW_METACNT = 20480;
constexpr int CW_MOECNT = 16384;

constexpr int RING_BYTES = 131072;
constexpr int IDX_OFF = RING_BYTES;
constexpr int MISC_OFF = IDX_OFF + 2048;
constexpr int TOUCH_OFF = MISC_OFF + 1024;
constexpr int LDS_BYTES = 147456;

#define GAS __attribute__((address_space(1)))
#define LAS __attribute__((address_space(3)))
typedef unsigned short bf16;
typedef float f32x4 __attribute__((ext_vector_type(4)));
typedef unsigned v4u __attribute__((ext_vector_type(4)));
typedef unsigned v2u __attribute__((ext_vector_type(2)));
#define LDS_WAIT() asm volatile("s_waitcnt lgkmcnt(0)" ::: "memory")
#define VM_WAIT() asm volatile("s_waitcnt vmcnt(0)" ::: "memory")

__device__ __forceinline__ int lane_id() { int l; asm volatile("v_mbcnt_lo_u32_b32 %0, -1, 0\n\tv_mbcnt_hi_u32_b32 %0, -1, %0" : "=v"(l)); return l; }
__device__ __forceinline__ unsigned cvt_pk_bf16(float lo, float hi) { unsigned r; asm volatile("v_cvt_pk_bf16_f32 %0, %1, %2" : "=v"(r) : "v"(lo), "v"(hi)); return r; }
__device__ __forceinline__ unsigned pk4_fp8(float a, float b, float c, float d) { int w = __builtin_amdgcn_cvt_pk_fp8_f32(a, b, 0, false); w = __builtin_amdgcn_cvt_pk_fp8_f32(c, d, w, true); return (unsigned)w; }
__device__ __forceinline__ float bf_lo(unsigned w) { return __uint_as_float(w << 16); }
__device__ __forceinline__ float bf_hi(unsigned w) { return __uint_as_float(w & 0xffff0000u); }
#define DPP_F(v, ctrl) __int_as_float(__builtin_amdgcn_update_dpp(0, __float_as_int(v), (ctrl), 0xF, 0xF, true))
__device__ __forceinline__ float row16_sum(float v) {
    v += DPP_F(v, 0xB1);     v += DPP_F(v, 0x4E);
    v += DPP_F(v, 0x141);        v += DPP_F(v, 0x140);
    return v;
}
__device__ __forceinline__ float wave_sum(float v, int lane) {
    (void)lane; v = row16_sum(v);
    const float a = __int_as_float(__builtin_amdgcn_readlane(__float_as_int(v), 0)), b = __int_as_float(__builtin_amdgcn_readlane(__float_as_int(v), 16));
    const float c = __int_as_float(__builtin_amdgcn_readlane(__float_as_int(v), 32)), d = __int_as_float(__builtin_amdgcn_readlane(__float_as_int(v), 48));
    return (a + b) + (c + d);
}
typedef float f32x2 __attribute__((ext_vector_type(2)));
__device__ __forceinline__ f32x2 silu_mul_pk(f32x2 g, f32x2 u, float inv) {
    const f32x2 t = g * -1.44269504f; f32x2 e; e.x = __builtin_amdgcn_exp2f(t.x); e.y = __builtin_amdgcn_exp2f(t.y);
    const f32x2 d = e * inv + inv; f32x2 r; r.x = __builtin_amdgcn_rcpf(d.x); r.y = __builtin_amdgcn_rcpf(d.y);
    return (g * u) * r;
}
__device__ __forceinline__ float silu_f(float a) { return a * __builtin_amdgcn_rcpf(1.0f + __builtin_amdgcn_exp2f(a * -1.44269504f)); }

#define XB_TMO      128
#define XB_XCNT(j)  (256  + 64 * (j))
#define XB_XSUB(j)  (1280 + 64 * (j))
#define XB_XGEN(j)  (2304 + 64 * (j))
#define XB_TOP      3328
#define XB_TOPGEN   3392
#define XCD_BAR_WORDS 3456
#define XB_SPIN_CAP (1u << 18)
__device__ __forceinline__ unsigned xb_ld(unsigned* p)              { return __hip_atomic_load(p, __ATOMIC_RELAXED, __HIP_MEMORY_SCOPE_AGENT); }
__device__ __forceinline__ unsigned xb_add(unsigned* p, unsigned v) { return __hip_atomic_fetch_add(p, v, __ATOMIC_RELAXED, __HIP_MEMORY_SCOPE_AGENT); }
__device__ __forceinline__ unsigned xb_xcc_id() { return (unsigned)__builtin_amdgcn_s_getreg((3 << 11) | 20) & 0xFu; }
#define XB_SPIN(cond, bar) do { unsigned _sp = 0; while (cond) { __builtin_amdgcn_s_sleep(1); \
    if ((++_sp & 255u) == 0u) { if (xb_ld(&(bar)[XB_TMO])) break; if (_sp > XB_SPIN_CAP) { atomicAdd(&(bar)[XB_TMO], 1u); break; } } } } while (0)
struct XcdBarrier { unsigned* bar; unsigned x; volatile LAS unsigned* st; };
__device__ __forceinline__ XcdBarrier xcd_barrier_post(unsigned* bar, volatile LAS unsigned* st) {
    XcdBarrier b; b.bar = bar; b.x = xb_xcc_id(); b.st = st;
    if (threadIdx.x == 0) (void)xb_add(&bar[XB_XCNT(b.x)], 1u);
    return b;
}
__device__ __forceinline__ void xcd_barrier_complete(unsigned* bar, unsigned x, unsigned& nloc, unsigned& nx) {
    const unsigned G = gridDim.x * gridDim.y * gridDim.z;
    unsigned sum, cnt, mine, sp = 0u;
    for (;;) {
        sum = 0u; cnt = 0u; mine = 0u;
#pragma unroll
        for (unsigned j = 0; j < 16; ++j) { const unsigned c = xb_ld(&bar[XB_XCNT(j)]); sum += c; cnt += (c > 0u) ? 1u : 0u; mine = (j == x) ? c : mine; }
        if (sum == G) break;
        __builtin_amdgcn_s_sleep(1);
        if ((++sp & 255u) == 0u) { if (xb_ld(&bar[XB_TMO])) break; if (sp > XB_SPIN_CAP) { atomicAdd(&bar[XB_TMO], 1u); break; } }
    }
    nloc = mine > 0u ? mine : 1u; nx = cnt > 0u ? cnt : 1u;
}
__device__ __forceinline__ void xcd_barrier(const XcdBarrier& b, const int wave  ) {
    asm volatile("s_waitcnt vmcnt(0)" ::: "memory");
    __syncthreads();
    if (wave == 0 && lane_id() == 0) {
        size_t z_ = 0; asm volatile("" : "+s"(z_)); unsigned* bar = b.bar + z_;
        __builtin_amdgcn_s_waitcnt(0);
        unsigned nloc = b.st[0], nx = b.st[1];
        if (nloc == 0u) { xcd_barrier_complete(bar, b.x, nloc, nx); b.st[0] = nloc; b.st[1] = nx; }
        const unsigned old = xb_add(&bar[XB_XSUB(b.x)], 1u);
        const unsigned gen = old / nloc;
        if (old + 1u == (gen + 1u) * nloc) {
            __builtin_amdgcn_fence(__ATOMIC_RELEASE, "agent");
            asm volatile("s_waitcnt vmcnt(0)" ::: "memory");
            const unsigned og = xb_add(&bar[XB_TOP], 1u);
            const unsigned tg = og / nx;
            if (og + 1u == (tg + 1u) * nx) xb_add(&bar[XB_TOPGEN], 1u);
            else XB_SPIN(xb_ld(&bar[XB_TOPGEN]) == tg, bar);
            __builtin_amdgcn_fence(__ATOMIC_ACQUIRE, "agent");
            xb_add(&bar[XB_XGEN(b.x)], 1u);
            asm volatile("s_waitcnt vmcnt(0)" ::: "memory");
        } else {
            XB_SPIN(xb_ld(&bar[XB_XGEN(b.x)]) == gen, bar);
            __builtin_amdgcn_fence(__ATOMIC_ACQUIRE, "agent");
            asm volatile("s_waitcnt vmcnt(0)" ::: "memory");
        }
    }
    __syncthreads();
}

namespace pg8 {
typedef short bf16x8 __attribute__((ext_vector_type(8)));
constexpr int BM = 256, BK = 64, HALF = 128, HTB = HALF * BK * 2, STAGE_BYTES = 8 * HTB;
static_assert(STAGE_BYTES == RING_BYTES, "ring");
__host__ __device__ __forceinline__ int lds_byte(int r, int c) { const int st = (r >> 4) * 2 + (c >> 5), rr = r & 15, cc = c & 31, ob = rr * 64 + cc * 2; return st * 1024 + (ob ^ (((ob >> 9) & 1) << 5)); }
__host__ __device__ __forceinline__ void stage_rc(int b, int& R, int& C) { const int st = b / 1024, sb = b % 1024, swz = sb ^ (((sb >> 9) & 1) << 5); R = (st >> 1) * 16 + swz / 64; C = (st & 1) * 32 + (swz % 64) / 2; }
__host__ __device__ __forceinline__ int perm32(int rho) { const int n = rho >> 4, i = rho & 15; return 8 * (i >> 2) + 4 * n + (i & 3); }

struct Unit { int pm, pn, e, rows, slot0; };

#ifndef PG8_WGM
#define PG8_WGM 8
#endif
constexpr int WGM = PG8_WGM;
__device__ __forceinline__ bool static_tile(int i, int G, int c, int nM, int nN, int& pm, int& pn) {
    const int nwg = nM * nN; const long L = (long)i * G + c; if (L >= nwg) return false;
    int wgid = (int)L; { const int q = nwg / 8, r = nwg % 8, xcd = wgid % 8, off = wgid / 8; wgid = (xcd < r ? xcd * (q + 1) : r * (q + 1) + (xcd - r) * q) + off; }
    const int nig = WGM * nN, gid = wgid / nig, fm = gid * WGM, gsz = (nM - fm) < WGM ? (nM - fm) : WGM;
    pm = fm + ((wgid % nig) % gsz); pn = (wgid % nig) / gsz; return true;
}
struct DenseSched {
    int nM, nN, G, c; const char* A; const char* Bt; unsigned tstepA, tstepB, a_colstep; int meta_pm = -1;
    __device__ __forceinline__ bool next(int i, Unit& u) const { if (!static_tile(i, G, c, nM, nN, u.pm, u.pn)) return false; u.e = 0; u.rows = (u.pm == meta_pm) ? NMETA : 256; u.slot0 = 0; return true; }
    __device__ __forceinline__ unsigned a_off(const Unit& u) const { return (unsigned)u.pm * tstepA + (unsigned)u.pn * a_colstep; }
    __device__ __forceinline__ unsigned b_off(const Unit& u) const { return (unsigned)u.pn * tstepB; }
    __device__ __forceinline__ const unsigned* idx_src(const Unit&) const { return nullptr; }
};
struct PanelSched {
    int nN, G, c; const char* A; const char* Bt; unsigned tstepA, tstepB, a_colstep; bool meta = true;
    __device__ __forceinline__ bool next(int i, Unit& u) const {
        const int nmain = c < 256 ? (256 - c + G - 1) / G : 0;
        u.e = 0; u.slot0 = 0;
        if (i < nmain * nN) { u.pm = c + (i / nN) * G; u.pn = i % nN; u.rows = 256; return true; }
        if (meta && i == nmain * nN && c < nN) { u.pm = 256; u.pn = c; u.rows = NMETA; return true; }
        return false;
    }
    __device__ __forceinline__ unsigned a_off(const Unit& u) const { return (unsigned)u.pm * tstepA + (unsigned)u.pn * a_colstep; }
    __device__ __forceinline__ unsigned b_off(const Unit& u) const { return (unsigned)u.pn * tstepB; }
    __device__ __forceinline__ const unsigned* idx_src(const Unit&) const { return nullptr; }
};
struct MoeSched {
    int nM, nN, G, c, t0; int m1, m2, m3, m4, m5, m6, m7; int n0, n1, n2, n3, n4, n5, n6, n7;
    const char* A; unsigned tstepA; const char* Bt; unsigned estepB, tstepB; const unsigned* rowidx;
    __device__ __forceinline__ bool next(int i, Unit& u) const {
        if (!static_tile(i, G, c, nM, nN, u.pm, u.pn)) return false;
        const int tg = t0 + u.pm; int e = 0, base = 0, cn = __builtin_amdgcn_readfirstlane(n0);
        if (tg >= m1) { e = 1; base = m1; cn = __builtin_amdgcn_readfirstlane(n1); }
        if (tg >= m2) { e = 2; base = m2; cn = __builtin_amdgcn_readfirstlane(n2); }
        if (tg >= m3) { e = 3; base = m3; cn = __builtin_amdgcn_readfirstlane(n3); }
        if (tg >= m4) { e = 4; base = m4; cn = __builtin_amdgcn_readfirstlane(n4); }
        if (tg >= m5) { e = 5; base = m5; cn = __builtin_amdgcn_readfirstlane(n5); }
        if (tg >= m6) { e = 6; base = m6; cn = __builtin_amdgcn_readfirstlane(n6); }
        if (tg >= m7) { e = 7; base = m7; cn = __builtin_amdgcn_readfirstlane(n7); }
        const int ti = tg - base; const int rem = cn - 256 * ti;
        u.e = e; u.rows = rem < 256 ? rem : 256; u.slot0 = e * CAP + ti * 256; return true;
    }
    __device__ __forceinline__ unsigned a_off(const Unit& u) const { return (unsigned)u.pm * tstepA; }
    __device__ __forceinline__ unsigned b_off(const Unit& u) const { return (unsigned)u.e * estepB + (unsigned)u.pn * tstepB; }
    __device__ __forceinline__ const unsigned* idx_src(const Unit& u) const { return rowidx + u.slot0; }
};

struct NoPre {};
struct EpiSwiGLU {
    static constexpr bool PERM = true; typedef NoPre Pre;
    __device__ __forceinline__ void load(Pre&, const Unit&, int, int, int, int) const {}
    bf16* H; int ldh;
    __device__ __forceinline__ void operator()(const f32x4 (&acc)[2][2][4][2], const Unit& u, int wr, int wc, int fr, int fq, const Pre&) const {
        const int row0 = u.pm * BM + wr * 64 + fr, col0 = u.pn * 128 + wc * 32 + 8 * fq;
#pragma unroll
        for (int ai = 0; ai < 2; ++ai)
#pragma unroll
            for (int m = 0; m < 4; ++m) {
                bf16* p = H + (size_t)u.pm * BM * ldh + (size_t)(2 * u.pn + (wc >> 1)) * (BM * 64) + (size_t)(wr * 64 + fr + ai * HALF + m * 16) * 64 + (wc & 1) * 32 + 8 * fq;
                const f32x4 g0 = acc[ai][0][m][0], g1 = acc[ai][0][m][1], u0 = acc[ai][1][m][0], u1 = acc[ai][1][m][1];
                const f32x2 a = silu_mul_pk((f32x2){g0[0], g0[1]}, (f32x2){u0[0], u0[1]}, 1.0f), b = silu_mul_pk((f32x2){g0[2], g0[3]}, (f32x2){u0[2], u0[3]}, 1.0f);
                const f32x2 c = silu_mul_pk((f32x2){g1[0], g1[1]}, (f32x2){u1[0], u1[1]}, 1.0f), d = silu_mul_pk((f32x2){g1[2], g1[3]}, (f32x2){u1[2], u1[3]}, 1.0f);
                v4u w; w.x = cvt_pk_bf16(a.x, a.y); w.y = cvt_pk_bf16(b.x, b.y); w.z = cvt_pk_bf16(c.x, c.y); w.w = cvt_pk_bf16(d.x, d.y);
                *(v4u*)p = w; }
    }
};
struct EpiSwiGLU8 {
    static constexpr bool PERM = true; typedef NoPre Pre;
    __device__ __forceinline__ void load(Pre&, const Unit&, int, int, int, int) const {}
    unsigned char* H; int ldh;
    __device__ __forceinline__ void operator()(const f32x4 (&acc)[2][2][4][2], const Unit& u, int wr, int wc, int fr, int fq, const Pre&) const {
        const int row0 = u.pm * BM + wr * 64 + fr, col0 = u.pn * 128 + wc * 32 + 8 * fq;
#pragma unroll
        for (int ai = 0; ai < 2; ++ai)
#pragma unroll
            for (int m = 0; m < 4; ++m) {
                unsigned char* p = H + (size_t)u.pm * BM * ldh + (size_t)u.pn * (BM * 128) + (size_t)(wr * 64 + fr + ai * HALF + m * 16) * 128 + wc * 32 + 8 * fq;
                const f32x4 g0 = acc[ai][0][m][0], g1 = acc[ai][0][m][1], u0 = acc[ai][1][m][0], u1 = acc[ai][1][m][1];
                constexpr float inv = 1.0f / H8_SCALE;
                const f32x2 a = silu_mul_pk((f32x2){g0[0], g0[1]}, (f32x2){u0[0], u0[1]}, inv), b = silu_mul_pk((f32x2){g0[2], g0[3]}, (f32x2){u0[2], u0[3]}, inv);
                const f32x2 c = silu_mul_pk((f32x2){g1[0], g1[1]}, (f32x2){u1[0], u1[1]}, inv), d = silu_mul_pk((f32x2){g1[2], g1[3]}, (f32x2){u1[2], u1[3]}, inv);
                v2u w; w.x = pk4_fp8(a.x, a.y, b.x, b.y); w.y = pk4_fp8(c.x, c.y, d.x, d.y);
                *(v2u*)p = w; }
    }
};
struct EpiSwiGLU8R {
    static constexpr bool PERM = true;
    struct Pre { unsigned long long q[2][4]; };
    unsigned char* H; int ldh; const unsigned long long* rowsq;
    __device__ __forceinline__ void load(Pre& P, const Unit& u, int wr, int, int fr, int) const {
#pragma unroll
        for (int ai = 0; ai < 2; ++ai)
#pragma unroll
            for (int m = 0; m < 4; ++m) P.q[ai][m] = rowsq[u.pm * BM + wr * 64 + fr + ai * HALF + m * 16];
    }
    __device__ __forceinline__ void operator()(const f32x4 (&acc)[2][2][4][2], const Unit& u, int wr, int wc, int fr, int fq, const Pre& P) const {
#pragma unroll
        for (int ai = 0; ai < 2; ++ai)
#pragma unroll
            for (int m = 0; m < 4; ++m) {
                unsigned char* p = H + (size_t)u.pm * BM * ldh + (size_t)u.pn * (BM * 128) + (size_t)(wr * 64 + fr + ai * HALF + m * 16) * 128 + wc * 32 + 8 * fq;
                const float rs = __frsqrt_rn((float)P.q[ai][m] * (1.0f / 1048576.0f / D) + EPS);
                const f32x4 g0 = acc[ai][0][m][0] * rs, g1 = acc[ai][0][m][1] * rs, u0 = acc[ai][1][m][0] * rs, u1 = acc[ai][1][m][1] * rs;
                constexpr float inv = 1.0f / H8_SCALE;
                const f32x2 a = silu_mul_pk((f32x2){g0[0], g0[1]}, (f32x2){u0[0], u0[1]}, inv), b = silu_mul_pk((f32x2){g0[2], g0[3]}, (f32x2){u0[2], u0[3]}, inv);
                const f32x2 c = silu_mul_pk((f32x2){g1[0], g1[1]}, (f32x2){u1[0], u1[1]}, inv), d = silu_mul_pk((f32x2){g1[2], g1[3]}, (f32x2){u1[2], u1[3]}, inv);
                v2u w; w.x = pk4_fp8(a.x, a.y, b.x, b.y); w.y = pk4_fp8(c.x, c.y, d.x, d.y);
                *(v2u*)p = w; }
    }
};
template <bool XIN  , bool Y1  , bool SQ = false  >
struct EpiResid {
    static constexpr bool PERM = true;
    struct PreH { v4u b[2][4][2]; };
    static constexpr bool USE_PRE = !XIN && !Y1;
    typedef typename std::conditional<USE_PRE, PreH, NoPre>::type Pre;
    bf16* h; const bf16* y1; const float* scale; int row_off; const float* xin; const float* meta; float ps = 1.0f; unsigned long long* rowsq = nullptr;
    __device__ __forceinline__ void load(Pre& P, const Unit& u, int wr, int wc, int fr, int fq) const {
        if constexpr (USE_PRE) {
            const int row0 = row_off + u.pm * BM + wr * 64 + fr, col0 = u.pn * BM + wc * 32 + 8 * fq;
#pragma unroll
            for (int ai = 0; ai < 2; ++ai)
#pragma unroll
                for (int m = 0; m < 4; ++m) { const size_t off = (size_t)(row0 + ai * HALF + m * 16) * D + col0;
#pragma unroll
                    for (int bj = 0; bj < 2; ++bj) P.b[ai][m][bj] = *(const v4u*)(h + off + bj * HALF); }
        }
    }
    __device__ __forceinline__ void operator()(const f32x4 (&acc)[2][2][4][2], const Unit& u, int wr, int wc, int fr, int fq, const Pre& P) const {
        const int row0 = row_off + u.pm * BM + wr * 64 + fr, col0 = u.pn * BM + wc * 32 + 8 * fq;
#pragma unroll
        for (int ai = 0; ai < 2; ++ai) {
            v4u yy[4][2], hh[4][2];
            if constexpr (Y1) {
#pragma unroll
                for (int m = 0; m < 4; ++m) { const size_t off = (size_t)(row0 + ai * HALF + m * 16) * D + col0;
#pragma unroll
                    for (int bj = 0; bj < 2; ++bj) { yy[m][bj] = *(const v4u*)(y1 + off + bj * HALF); hh[m][bj] = *(const v4u*)(h + off + bj * HALF); } } }
            float sq[4] = {0.f, 0.f, 0.f, 0.f};
#pragma unroll
            for (int m = 0; m < 4; ++m) { const int row = row0 + ai * HALF + m * 16; const size_t off = (size_t)row * D + col0;
#pragma unroll
                for (int bj = 0; bj < 2; ++bj) {
                    f32x4 b0, b1;
                    if constexpr (XIN) { const int mr = (row - MROWS) < NMETA ? (row - MROWS) : NMETA - 1; const float* src = (row < MROWS ? xin + off : meta + (size_t)mr * D + col0) + bj * HALF;
                        b0 = *(const f32x4*)src; b1 = *(const f32x4*)(src + 4); }
                    else { v4u v; if constexpr (USE_PRE) v = P.b[ai][m][bj]; else v = hh[m][bj]; b0 = (f32x4){bf_lo(v.x), bf_hi(v.x), bf_lo(v.y), bf_hi(v.y)}; b1 = (f32x4){bf_lo(v.z), bf_hi(v.z), bf_lo(v.w), bf_hi(v.w)}; }
                    if constexpr (Y1) { const v4u y = yy[m][bj]; b0 += (f32x4){bf_lo(y.x), bf_hi(y.x), bf_lo(y.y), bf_hi(y.y)}; b1 += (f32x4){bf_lo(y.z), bf_hi(y.z), bf_lo(y.w), bf_hi(y.w)}; }
                    f32x4 s0 = (f32x4){ps, ps, ps, ps}, s1 = s0;
                    if (scale) { s0 = *(const f32x4*)(scale + col0 + bj * HALF) * ps; s1 = *(const f32x4*)(scale + col0 + bj * HALF + 4) * ps; }
                    const f32x4 v0 = b0 + acc[ai][bj][m][0] * s0, v1 = b1 + acc[ai][bj][m][1] * s1;
                    v4u w; w.x = cvt_pk_bf16(v0[0], v0[1]); w.y = cvt_pk_bf16(v0[2], v0[3]); w.z = cvt_pk_bf16(v1[0], v1[1]); w.w = cvt_pk_bf16(v1[2], v1[3]);
                    *(v4u*)(h + off + bj * HALF) = w;
                    if constexpr (SQ) { const float a0 = bf_lo(w.x), a1 = bf_hi(w.x), a2 = bf_lo(w.y), a3 = bf_hi(w.y), a4 = bf_lo(w.z), a5 = bf_hi(w.z), a6 = bf_lo(w.w), a7 = bf_hi(w.w);
                        sq[m] += ((a0 * a0 + a1 * a1) + (a2 * a2 + a3 * a3)) + ((a4 * a4 + a5 * a5) + (a6 * a6 + a7 * a7)); } } }
            if constexpr (SQ) {
                const int ln = fr + 16 * fq, x16 = (ln ^ 16) << 2, x32 = (ln ^ 32) << 2;
#pragma unroll
                for (int m = 0; m < 4; ++m) { float t = sq[m]; t += __int_as_float(__builtin_amdgcn_ds_bpermute(x16, __float_as_int(t))); t += __int_as_float(__builtin_amdgcn_ds_bpermute(x32, __float_as_int(t))); sq[m] = t; }
                const float mine = fq == 0 ? sq[0] : fq == 1 ? sq[1] : fq == 2 ? sq[2] : sq[3];
                if (row0 + ai * HALF + fq * 16 < MROWS) __hip_atomic_fetch_add(rowsq + (row0 + ai * HALF + fq * 16), (unsigned long long)(mine * 1048576.0f + 0.5f), __ATOMIC_RELAXED, __HIP_MEMORY_SCOPE_AGENT); }
            asm volatile("" ::: "memory"); }
    }
};
struct EpiConvIn {
    static constexpr bool PERM = true;
    struct Pre { unsigned long long q[2][4]; };
    bf16* BG; bf16* U; const unsigned long long* rowsq;
    __device__ __forceinline__ void load(Pre& P, const Unit& u, int wr, int, int fr, int) const {
#pragma unroll
        for (int ai = 0; ai < 2; ++ai)
#pragma unroll
            for (int m = 0; m < 4; ++m) P.q[ai][m] = rowsq[u.pm * BM + wr * 64 + fr + ai * HALF + m * 16];
    }
    __device__ __forceinline__ void operator()(const f32x4 (&acc)[2][2][4][2], const Unit& u, int wr, int wc, int fr, int fq, const Pre& P) const {
        const int row0 = u.pm * BM + wr * 64 + fr;
        if (u.pn < 4) {
            const int col0 = u.pn * BM + wc * 32 + 8 * fq;
#pragma unroll
            for (int ai = 0; ai < 2; ++ai)
#pragma unroll
                for (int m = 0; m < 4; ++m) { bf16* p = BG + (size_t)(row0 + ai * HALF + m * 16) * D + col0;
                    const float rs = __frsqrt_rn((float)P.q[ai][m] * (1.0f / 1048576.0f / D) + EPS);
#pragma unroll
                    for (int bj = 0; bj < 2; ++bj) { const f32x4 v0 = acc[ai][bj][m][0] * rs, v1 = acc[ai][bj][m][1] * rs;
                        v4u w; w.x = cvt_pk_bf16(v0[0], v0[1]); w.y = cvt_pk_bf16(v0[2], v0[3]); w.z = cvt_pk_bf16(v1[0], v1[1]); w.w = cvt_pk_bf16(v1[2], v1[3]);
                        *(v4u*)(p + bj * HALF) = w; } }
        } else {
            const int col0 = (u.pn - 4) * 128 + wc * 32 + 8 * fq;
#pragma unroll
            for (int ai = 0; ai < 2; ++ai)
#pragma unroll
                for (int m = 0; m < 4; ++m) { bf16* p = U + (size_t)(row0 + ai * HALF + m * 16) * D + col0;
                    const float rs = __frsqrt_rn((float)P.q[ai][m] * (1.0f / 1048576.0f / D) + EPS);
                    const f32x4 c0 = acc[ai][0][m][0] * rs, c1 = acc[ai][0][m][1] * rs, v0 = acc[ai][1][m][0] * rs, v1 = acc[ai][1][m][1] * rs;
                    v4u w; w.x = cvt_pk_bf16(c0[0] * v0[0], c0[1] * v0[1]); w.y = cvt_pk_bf16(c0[2] * v0[2], c0[3] * v0[3]);
                    w.z = cvt_pk_bf16(c1[0] * v1[0], c1[1] * v1[1]); w.w = cvt_pk_bf16(c1[2] * v1[2], c1[3] * v1[3]);
                    *(v4u*)p = w; }
        }
    }
};
struct EpiMoeDown {
    static constexpr bool PERM = true;
    struct Pre { int2 inf[2][4]; };
    const int2* slot; bf16* h; bf16* y1; float ps = 1.0f;
    __device__ __forceinline__ void load(Pre& P, const Unit& u, int wr, int wc, int fr, int fq) const {
#pragma unroll
        for (int ai = 0; ai < 2; ++ai)
#pragma unroll
            for (int m = 0; m < 4; ++m) { const int rl = ai * HALF + wr * 64 + m * 16 + fr; P.inf[ai][m] = (rl < u.rows) ? slot[u.slot0 + rl] : make_int2(0, 0); }
    }
    __device__ __forceinline__ void operator()(const f32x4 (&acc)[2][2][4][2], const Unit& u, int wr, int wc, int fr, int fq, const Pre& P) const {
        const int col0 = u.pn * BM + wc * 32 + 8 * fq;
        v4u b[6][2];
        auto ldg = [&](int slot_, int ai, int m) { const size_t off = (size_t)(P.inf[ai][m].x & 0x7fffffff) * D + col0;
#pragma unroll
            for (int bj = 0; bj < 2; ++bj) { b[slot_][bj] = (v4u){0u, 0u, 0u, 0u}; if (P.inf[ai][m].x >= 0) b[slot_][bj] = *(const v4u*)(h + off + bj * HALF); } };
        auto fin = [&](int slot_, int ai, int m) { const int rl = ai * HALF + wr * 64 + m * 16 + fr; const int ix = P.inf[ai][m].x; const float w = __int_as_float(P.inf[ai][m].y);
            const size_t off = (size_t)(ix & 0x7fffffff) * D + col0;
            if (rl < u.rows) {
                const bool top1 = ix >= 0; const float ws = top1 ? w * ps : w; bf16* dst = top1 ? h : y1;
#pragma unroll
                for (int bj = 0; bj < 2; ++bj) { const v4u v = b[slot_][bj];
                    f32x4 v0 = acc[ai][bj][m][0] * ws, v1 = acc[ai][bj][m][1] * ws;
                    if (top1) { v0 += (f32x4){bf_lo(v.x), bf_hi(v.x), bf_lo(v.y), bf_hi(v.y)}; v1 += (f32x4){bf_lo(v.z), bf_hi(v.z), bf_lo(v.w), bf_hi(v.w)}; }
                    v4u o; o.x = cvt_pk_bf16(v0[0], v0[1]); o.y = cvt_pk_bf16(v0[2], v0[3]); o.z = cvt_pk_bf16(v1[0], v1[1]); o.w = cvt_pk_bf16(v1[2], v1[3]);
                    *(v4u*)(dst + off + bj * HALF) = o; }
            } };
        ldg(0, 0, 0); ldg(1, 0, 1); ldg(2, 0, 2); ldg(3, 0, 3); ldg(4, 1, 0); ldg(5, 1, 1);
        fin(0, 0, 0); fin(1, 0, 1);
        asm volatile("" ::: "memory");
        ldg(0, 1, 2); ldg(1, 1, 3);
        fin(2, 0, 2); fin(3, 0, 3); fin(4, 1, 0); fin(5, 1, 1);
        asm volatile("" ::: "memory");
        fin(0, 1, 2); fin(1, 1, 3);
    }
};

#ifndef PG8_ALIGN_EPI
#define PG8_ALIGN_EPI 1
#endif
constexpr bool ALIGN_EPI = PG8_ALIGN_EPI;
#ifndef PG8_UNIT_TOUCH
#define PG8_UNIT_TOUCH 0
#endif
constexpr bool UNIT_TOUCH = PG8_UNIT_TOUCH;
typedef int i32x4 __attribute__((ext_vector_type(4)));
typedef int i32x8 __attribute__((ext_vector_type(8)));
template <class Epi, class Sched, bool GATHER, bool FP8 = false>
__device__ __forceinline__ void gemm_phase(LAS unsigned char* lds, LAS unsigned* idxbuf, const int wid, const int nt, const int lda, const int ldb, const Sched& S, const Epi& E, const int sc_a = 0x7f7f7f7f, const int sc_b = 0x7f7f7f7f, const unsigned kstepA = 128u, const unsigned kstepB = 128u) {
    const int lane = lane_id(), tid = wid * 64 + lane, wr = wid >> 2, wc = wid & 3, fr = lane & 15, fq = lane >> 4;
    unsigned voffA[2], voffB[2], voffG[2][2];
#pragma unroll
    for (int i = 0; i < 2; ++i) { int R, C; stage_rc(tid * 16 + i * 8192, R, C); const int Rb = Epi::PERM ? ((R & ~31) + perm32(R & 31)) : R;
        voffA[i] = (unsigned)(R * lda + C * 2); voffB[i] = (unsigned)(Rb * ldb + C * 2); voffG[0][i] = 0u; voffG[1][i] = 0u; }
    const __amdgpu_buffer_rsrc_t rA = __builtin_amdgcn_make_buffer_rsrc((void*)S.A, 0, 0x7ffffff0, 0x00020000), rB = __builtin_amdgcn_make_buffer_rsrc((void*)S.Bt, 0, 0x7ffffff0, 0x00020000);
    const unsigned hstepA = (unsigned)HALF * lda, hstepB = (unsigned)HALF * ldb;
    const unsigned ldsw = (unsigned)wid * 1024u; unsigned ldsw_ = ldsw;
    const int aoff = lds_byte(wr * 64 + fr, fq * 8), boff = lds_byte(wc * 32 + fr, fq * 8);
#define PG8_SA(b, h) (((b) * 2 + (h)) * HTB)
#define PG8_SB(b, h) ((4 + (b) * 2 + (h)) * HTB)
#define PG8_STAGE(bufoff, rsrc, soff, voff) do { _Pragma("unroll") for (int _i = 0; _i < 2; ++_i) \
        __builtin_amdgcn_raw_ptr_buffer_load_lds(rsrc, (LAS void*)(lds + (bufoff) + ldsw_ + _i * 8192), 16, (int)(voff)[_i], (int)(soff), 0, 0); } while (0)
#define PG8_STAGE_A(bufoff, soff, h) do { if constexpr (GATHER) { PG8_STAGE(bufoff, rA, soff, voffG[h]); } else { PG8_STAGE(bufoff, rA, (soff) + (h) * hstepA, voffA); } } while (0)
#define PG8_STAGE_B(bufoff, soff, h) PG8_STAGE(bufoff, rB, (soff) + (h) * hstepB, voffB)
#define PG8_LDA(dst, b, h) do { _Pragma("unroll") for (int m = 0; m < 4; ++m) _Pragma("unroll") for (int k = 0; k < 2; ++k) dst[m][k] = *(const LAS bf16x8*)(lds + PG8_SA(b, h) + aoff + m * 2048 + k * 1024); } while (0)
#define PG8_LDB(dst, b, h) do { _Pragma("unroll") for (int n = 0; n < 2; ++n) _Pragma("unroll") for (int k = 0; k < 2; ++k) dst[n][k] = *(const LAS bf16x8*)(lds + PG8_SB(b, h) + boff + n * 2048 + k * 1024); } while (0)
#define PG8_MMA(ai, bj, At, Bt) do { _Pragma("unroll") for (int m = 0; m < 4; ++m) _Pragma("unroll") for (int n = 0; n < 2; ++n) _Pragma("unroll") for (int k = 0; k < 2; ++k) \
        acc[ai][bj][m][n] = __builtin_amdgcn_mfma_f32_16x16x32_bf16(Bt[n][k], At[m][k], acc[ai][bj][m][n], 0, 0, 0); } while (0)
#define PG8_CAT(x) __builtin_shufflevector((i32x4)(x)[0], (i32x4)(x)[1], 0, 1, 2, 3, 4, 5, 6, 7)
#define PG8_MMA8(ai, bj, At, Bt) do { _Pragma("unroll") for (int m = 0; m < 4; ++m) _Pragma("unroll") for (int n = 0; n < 2; ++n) \
        acc[ai][bj][m][n] = __builtin_amdgcn_mfma_scale_f32_16x16x128_f8f6f4(PG8_CAT(Bt[n]), PG8_CAT(At[m]), acc[ai][bj][m][n], 0, 0, 0, sc_b, 0, sc_a); } while (0)
#define PG8_MM(ai, bj, At, Bt) do { if ((ai) * HALF + wr * 64 < cur.rows) { if constexpr (FP8) PG8_MMA8(ai, bj, At, Bt); else PG8_MMA(ai, bj, At, Bt); } } while (0)
#define PG8_WAIT_V(n) asm volatile("s_waitcnt vmcnt(" #n ")" ::: "memory")
#define PG8_WAIT_L(n) asm volatile("s_waitcnt lgkmcnt(" #n ")" ::: "memory")
#define PG8_BAR __builtin_amdgcn_s_barrier()
#define PG8_SCHED __builtin_amdgcn_sched_barrier(0)
#define PG8_LOAD_VOFFG(ib, nrows) do { asm volatile("" ::: "memory"); _Pragma("unroll") for (int _i = 0; _i < 2; ++_i) { int _R, _C; stage_rc(tid * 16 + _i * 8192, _R, _C); \
        _Pragma("unroll") for (int _h = 0; _h < 2; ++_h) { const int _rl = _h * HALF + _R; unsigned _ix = (ib)[_rl]; _ix = (_rl < (nrows)) ? _ix : 0u; voffG[_h][_i] = _ix * (unsigned)lda + (unsigned)(_C * 2); } } } while (0)
#define PG8_IDX_DMA(src, ib) __builtin_amdgcn_global_load_lds((const unsigned*)((src) + lane * 4), (LAS unsigned*)(ib), 16, 0, 0)
    Unit cur, nxt; int ui = 0;
    if (!S.next(0, cur)) return;
    f32x4 acc[2][2][4][2];
#pragma unroll
    for (int a = 0; a < 2; ++a)
#pragma unroll
        for (int b = 0; b < 2; ++b)
#pragma unroll
            for (int m = 0; m < 4; ++m)
#pragma unroll
                for (int n = 0; n < 2; ++n) acc[a][b][m][n] = (f32x4){0.f, 0.f, 0.f, 0.f};
    bf16x8 At[4][2], B0[2][2], B1[2][2];
    unsigned cA = S.a_off(cur), cB = S.b_off(cur);
    if constexpr (GATHER) {
        if (wid == 0) PG8_IDX_DMA(S.idx_src(cur), idxbuf);
        PG8_WAIT_V(0); PG8_BAR;
        PG8_LOAD_VOFFG(idxbuf, cur.rows);
    }
    PG8_STAGE_B(PG8_SB(0, 0), cB, 0); PG8_STAGE_B(PG8_SB(0, 1), cB, 1); PG8_STAGE_A(PG8_SA(0, 0), cA, 0); PG8_STAGE_A(PG8_SA(0, 1), cA, 1);
    if (wr == 1) PG8_BAR;
    PG8_WAIT_V(2); PG8_BAR;
    PG8_STAGE_B(PG8_SB(1, 0), cB + kstepB, 0); PG8_STAGE_A(PG8_SA(1, 0), cA + kstepA, 0); PG8_STAGE_B(PG8_SB(1, 1), cB + kstepB, 1);
    PG8_WAIT_V(6); PG8_BAR;
    for (;;) {
        const bool has_next = S.next(ui + 1, nxt);
        const unsigned nA = has_next ? S.a_off(nxt) : cA, nB = has_next ? S.b_off(nxt) : cB;
        const int t_touch = nt >= 8 ? nt - 6 : 0;
        if constexpr (GATHER) { if (has_next && wid == 0) PG8_IDX_DMA(S.idx_src(nxt), idxbuf + ((ui + 1) & 1) * 256); }
#pragma nounroll
        for (int t = 0; t < nt; t += 2) {
            const bool last = (t == nt - 2);
            if (UNIT_TOUCH && has_next && t == t_touch) {
                unsigned trow = (unsigned)(tid >> 1);
                if constexpr (GATHER) { asm volatile("" ::: "memory"); const int rl_ = (int)trow; unsigned ix_ = (idxbuf + ((ui + 1) & 1) * 256)[rl_]; trow = (rl_ < nxt.rows) ? ix_ : 0u; }
                const unsigned tvo = trow * (unsigned)lda + (unsigned)(tid & 1) * 128u;
                __builtin_amdgcn_raw_ptr_buffer_load_lds(rA, (LAS void*)(lds + TOUCH_OFF + wid * 256), 4, (int)tvo, (int)nA, 0, 0);
            }
            asm volatile("" : "+s"(ldsw_));
            const unsigned a1 = cA + (unsigned)(t + 1) * kstepA;
            const unsigned a2 = last ? nA : cA + (unsigned)(t + 2) * kstepA, b2 = last ? nB : cB + (unsigned)(t + 2) * kstepB;
            const unsigned a3 = a2 + kstepA, b3 = b2 + kstepB;
            PG8_LDB(B0, 0, 0); PG8_LDB(B1, 0, 1); PG8_SCHED; PG8_LDA(At, 0, 0); PG8_STAGE_A(PG8_SA(1, 1), a1, 1);
            PG8_WAIT_V(8); PG8_WAIT_L(0); PG8_BAR; PG8_MM(0, 0, At, B0); PG8_MM(0, 1, At, B1); PG8_BAR; PG8_SCHED;
            if constexpr (GATHER) { if (last && has_next) PG8_LOAD_VOFFG(idxbuf + ((ui + 1) & 1) * 256, nxt.rows); }
            PG8_LDA(At, 0, 1); PG8_STAGE_B(PG8_SB(0, 0), b2, 0); PG8_STAGE_B(PG8_SB(0, 1), b2, 1); PG8_STAGE_A(PG8_SA(0, 0), a2, 0);
            PG8_WAIT_V(8); PG8_WAIT_L(0); PG8_BAR; PG8_MM(1, 0, At, B0); PG8_MM(1, 1, At, B1); PG8_BAR; PG8_SCHED;
            PG8_LDB(B0, 1, 0); PG8_LDB(B1, 1, 1); PG8_SCHED; PG8_LDA(At, 1, 0); PG8_STAGE_A(PG8_SA(0, 1), a2, 1);
            PG8_WAIT_V(8); PG8_WAIT_L(0); PG8_BAR; PG8_MM(0, 0, At, B0); PG8_MM(0, 1, At, B1); PG8_BAR; PG8_SCHED;
            PG8_LDA(At, 1, 1); PG8_STAGE_B(PG8_SB(1, 0), b3, 0); PG8_STAGE_B(PG8_SB(1, 1), b3, 1); PG8_STAGE_A(PG8_SA(1, 0), a3, 0);
            PG8_WAIT_V(8); PG8_WAIT_L(0); PG8_BAR; PG8_MM(1, 0, At, B0); PG8_MM(1, 1, At, B1); PG8_BAR; PG8_SCHED;
        }
        unsigned long long pe0_ = 0;
        if ((PROBE_EPI == 1 || PROBE_EPI == 3) && blockIdx.x == 0 && wid == 0) pe0_ = __builtin_amdgcn_s_memrealtime();
        typename Epi::Pre pre; const int eln = lane_id();
        E.load(pre, cur, wr, wc, eln & 15, eln >> 4);
        if (PROBE_EPI == 3 && blockIdx.x == 0 && wid == 0) { volatile LAS unsigned long long* PW = (volatile LAS unsigned long long*)(lds + MISC_OFF + 64); const unsigned long long q_ = __builtin_amdgcn_s_memrealtime(); if (lane_id() == 0) PW[4] += q_ - pe0_; }
        if (PROBE_EPI == 4 && blockIdx.x == 0 && wid == 0) pe0_ = __builtin_amdgcn_s_memrealtime();
        if (ALIGN_EPI) { if (wr == 0) PG8_BAR; }
        if (PROBE_EPI == 4 && blockIdx.x == 0 && wid == 0) { volatile LAS unsigned long long* PW = (volatile LAS unsigned long long*)(lds + MISC_OFF + 64); const unsigned long long q_ = __builtin_amdgcn_s_memrealtime(); if (lane_id() == 0) PW[4] += q_ - pe0_; }
        if (PROBE_EPI == 2 && blockIdx.x == 0 && wid == 0) pe0_ = __builtin_amdgcn_s_memrealtime();
        E(acc, cur, wr, wc, eln & 15, eln >> 4, pre);
        if ((PROBE_EPI == 1 || PROBE_EPI == 2) && blockIdx.x == 0 && wid == 0) { volatile LAS unsigned long long* PW = (volatile LAS unsigned long long*)(lds + MISC_OFF + 64);
            const unsigned long long pe1_ = __builtin_amdgcn_s_memrealtime(); if (lane_id() == 0) PW[4] += pe1_ - pe0_; }
        if (!has_next) break;
#pragma unroll
        for (int a = 0; a < 2; ++a)
#pragma unroll
            for (int b = 0; b < 2; ++b)
#pragma unroll
                for (int m = 0; m < 4; ++m)
#pragma unroll
                    for (int n = 0; n < 2; ++n) acc[a][b][m][n] = (f32x4){0.f, 0.f, 0.f, 0.f};
        cur = nxt; cA = nA; cB = nB; ++ui;
        if (ALIGN_EPI) { if (wr == 1) PG8_BAR; }
    }
    PG8_WAIT_V(0);
    if (!ALIGN_EPI) { if (wr == 0) PG8_BAR; }
    PG8_BAR;
#undef PG8_SA
#undef PG8_SB
#undef PG8_STAGE
#undef PG8_STAGE_A
#undef PG8_STAGE_B
#undef PG8_LDA
#undef PG8_LDB
#undef PG8_MMA
#undef PG8_MMA8
#undef PG8_MM
#undef PG8_CAT
#undef PG8_WAIT_V
#undef PG8_WAIT_L
#undef PG8_BAR
#undef PG8_SCHED
#undef PG8_LOAD_VOFFG
#undef PG8_IDX_DMA
}
#ifndef P6_STAGGER
#define P6_STAGGER 1
#endif
typedef int i32x2 __attribute__((ext_vector_type(2)));
typedef int i32x4 __attribute__((ext_vector_type(4)));
template <class Epi, class Sched, bool GATHER>
__device__ __forceinline__ void gemm_phase6(LAS unsigned char* lds, LAS unsigned* idxbuf, const int wid, const int nt, const Sched& S, const Epi& E, const int sc_a, const int sc_b) {
    static_assert(GATHER && Epi::PERM, "fp6 body: gathered A, permuted B image");
    constexpr int HT6 = HALF * 96; constexpr unsigned KSA = 128u, KSB = 2u * HT6, ROWA = 1024u;
    const int lane = lane_id(), tid = wid * 64 + lane, wr = wid >> 2, wc = wid & 3, fr = lane & 15, fq = lane >> 4;
    unsigned voffB[2], voffG[2][2]; int pR[2], pC[2];
#pragma unroll
    for (int i = 0; i < 2; ++i) { const int p = i ? 512 + (tid & 255) : tid; const int R = p / 6, Cc = p - 6 * R; pR[i] = R; pC[i] = (Cc < 4 ? Cc : (Cc ^ ((R >> 3) & 1))) * 16;
        voffB[i] = (unsigned)p * 16u; voffG[0][i] = 0u; voffG[1][i] = 0u; }
    const __amdgpu_buffer_rsrc_t rA = __builtin_amdgcn_make_buffer_rsrc((void*)S.A, 0, 0x7ffffff0, 0x00020000), rB = __builtin_amdgcn_make_buffer_rsrc((void*)S.Bt, 0, 0x7ffffff0, 0x00020000);
    const unsigned ldsw = (unsigned)wid * 1024u; unsigned ldsw_ = ldsw;
    const int aoff = 96 * (wr * 64 + fr) + 16 * fq, boff = 96 * (wc * 32 + fr) + 16 * fq;
    const int aoff8 = 96 * (wr * 64 + fr) + 64 + 8 * (fq ^ ((fr >> 2) & 2)), boff8 = 96 * (wc * 32 + fr) + 64 + 8 * (fq ^ ((fr >> 2) & 2));
#define P6_SA(b, h) (((b) * 2 + (h)) * HT6)
#define P6_SB(b, h) ((4 + (b) * 2 + (h)) * HT6)
#define P6_STAGE(bufoff, rsrc, soff, v0, v1, h) do { __builtin_amdgcn_raw_ptr_buffer_load_lds(rsrc, (LAS void*)(lds + (bufoff) + ldsw_), 16, (int)(v0), (int)(soff), 0, 0); \
        if (wr == (h)) __builtin_amdgcn_raw_ptr_buffer_load_lds(rsrc, (LAS void*)(lds + (bufoff) + 8192 + (ldsw_ & 3072u)), 16, (int)(v1), (int)(soff), 0, 0); } while (0)
#define P6_STAGE_A(bufoff, soff, h) P6_STAGE(bufoff, rA, soff, voffG[h][0], voffG[h][1], h)
#define P6_STAGE_B(bufoff, soff, h) P6_STAGE(bufoff, rB, (soff) + (h) * (unsigned)HT6, voffB[0], voffB[1], h)
#define P6_LDA(dst, b, h) do { _Pragma("unroll") for (int m = 0; m < 4; ++m) { dst##w[m] = *(const LAS i32x4*)(lds + P6_SA(b, h) + aoff + m * 1536); dst##n[m] = *(const LAS i32x2*)(lds + P6_SA(b, h) + aoff8 + m * 1536); } } while (0)
#define P6_LDB(dst, b, h) do { _Pragma("unroll") for (int n = 0; n < 2; ++n) { dst##w[n] = *(const LAS i32x4*)(lds + P6_SB(b, h) + boff + n * 1536); dst##n[n] = *(const LAS i32x2*)(lds + P6_SB(b, h) + boff8 + n * 1536); } } while (0)
#define P6_CAT(x, k) __builtin_shufflevector(x##w[k], __builtin_shufflevector(x##n[k], x##n[k], 0, 1, -1, -1), 0, 1, 2, 3, 4, 5, -1, -1)
#define P6_MM(ai, bj, At, Bt) do { if ((ai) * HALF + wr * 64 < cur.rows) { _Pragma("unroll") for (int m = 0; m < 4; ++m) _Pragma("unroll") for (int n = 0; n < 2; ++n) \
        acc[ai][bj][m][n] = __builtin_amdgcn_mfma_scale_f32_16x16x128_f8f6f4(P6_CAT(Bt, n), P6_CAT(At, m), acc[ai][bj][m][n], 2, 2, 0, sc_b, 0, sc_a); } } while (0)
#define P6_WAIT_V(nlead, ntrail) do { if (wr == 0) asm volatile("s_waitcnt vmcnt(" #nlead ")" ::: "memory"); else asm volatile("s_waitcnt vmcnt(" #ntrail ")" ::: "memory"); } while (0)
#define P6_WAIT_6 asm volatile("s_waitcnt vmcnt(6)" ::: "memory")
#define P6_WAIT_L0 asm volatile("s_waitcnt lgkmcnt(0)" ::: "memory")
#define P6_BAR __builtin_amdgcn_s_barrier()
#define P6_SCHED __builtin_amdgcn_sched_barrier(0)
#define P6_LOAD_VOFFG(ib, nrows) do { asm volatile("" ::: "memory"); _Pragma("unroll") for (int _i = 0; _i < 2; ++_i) _Pragma("unroll") for (int _h = 0; _h < 2; ++_h) { \
        const int _rl = _h * HALF + pR[_i]; unsigned _ix = (ib)[_rl & 255]; _ix = (_rl < (nrows)) ? _ix : 0u; voffG[_h][_i] = _ix * ROWA + (unsigned)pC[_i]; } } while (0)
#define P6_IDX_DMA(src, ib) __builtin_amdgcn_global_load_lds((const unsigned*)((src) + lane * 4), (LAS unsigned*)(ib), 16, 0, 0)
    Unit cur, nxt; int ui = 0;
    if (!S.next(0, cur)) return;
    f32x4 acc[2][2][4][2];
#pragma unroll
    for (int a = 0; a < 2; ++a)
#pragma unroll
        for (int b = 0; b < 2; ++b)
#pragma unroll
            for (int m = 0; m < 4; ++m)
#pragma unroll
                for (int n = 0; n < 2; ++n) acc[a][b][m][n] = (f32x4){0.f, 0.f, 0.f, 0.f};
    i32x4 Atw[4], B0w[2], B1w[2]; i32x2 Atn[4], B0n[2], B1n[2];
    unsigned cA = S.a_off(cur), cB = S.b_off(cur);
    if constexpr (GATHER) {
        if (wid == 0) P6_IDX_DMA(S.idx_src(cur), idxbuf);
        asm volatile("s_waitcnt vmcnt(0)" ::: "memory"); P6_BAR;
        P6_LOAD_VOFFG(idxbuf, cur.rows);
    }
    P6_STAGE_B(P6_SB(0, 0), cB, 0); P6_STAGE_B(P6_SB(0, 1), cB, 1); P6_STAGE_A(P6_SA(0, 0), cA, 0); P6_STAGE_A(P6_SA(0, 1), cA, 1);
    if (P6_STAGGER) { if (wr == 1) P6_BAR; }
    P6_WAIT_V(1, 2); P6_BAR;
    P6_STAGE_B(P6_SB(1, 0), cB + KSB, 0); P6_STAGE_A(P6_SA(1, 0), cA + KSA, 0); P6_STAGE_B(P6_SB(1, 1), cB + KSB, 1);
    P6_WAIT_V(5, 4); P6_BAR;
    for (;;) {
        const bool has_next = S.next(ui + 1, nxt);
        const unsigned nA = has_next ? S.a_off(nxt) : cA, nB = has_next ? S.b_off(nxt) : cB;
        if constexpr (GATHER) { if (has_next && wid == 0) P6_IDX_DMA(S.idx_src(nxt), idxbuf + ((ui + 1) & 1) * 256); }
#pragma nounroll
        for (int t = 0; t < nt; t += 2) {
            const bool last = (t == nt - 2);
            asm volatile("" : "+s"(ldsw_));
            const unsigned a1 = cA + (unsigned)(t + 1) * KSA;
            const unsigned a2 = last ? nA : cA + (unsigned)(t + 2) * KSA, b2 = last ? nB : cB + (unsigned)(t + 2) * KSB;
            const unsigned a3 = a2 + KSA, b3 = b2 + KSB;
            P6_LDB(B0, 0, 0); P6_LDB(B1, 0, 1); P6_SCHED; P6_LDA(At, 0, 0); P6_STAGE_A(P6_SA(1, 1), a1, 1);
            P6_WAIT_6; P6_WAIT_L0; P6_BAR; P6_MM(0, 0, At, B0); P6_MM(0, 1, At, B1); P6_BAR; P6_SCHED;
            if constexpr (GATHER) { if (last && has_next) P6_LOAD_VOFFG(idxbuf + ((ui + 1) & 1) * 256, nxt.rows); }
            P6_LDA(At, 0, 1); P6_STAGE_B(P6_SB(0, 0), b2, 0); P6_STAGE_B(P6_SB(0, 1), b2, 1); P6_STAGE_A(P6_SA(0, 0), a2, 0);
            P6_WAIT_6; P6_WAIT_L0; P6_BAR; P6_MM(1, 0, At, B0); P6_MM(1, 1, At, B1); P6_BAR; P6_SCHED;
            P6_LDB(B0, 1, 0); P6_LDB(B1, 1, 1); P6_SCHED; P6_LDA(At, 1, 0); P6_STAGE_A(P6_SA(0, 1), a2, 1);
            P6_WAIT_6; P6_WAIT_L0; P6_BAR; P6_MM(0, 0, At, B0); P6_MM(0, 1, At, B1); P6_BAR; P6_SCHED;
            P6_LDA(At, 1, 1); P6_STAGE_B(P6_SB(1, 0), b3, 0); P6_STAGE_B(P6_SB(1, 1), b3, 1); P6_STAGE_A(P6_SA(1, 0), a3, 0);
            P6_WAIT_6; P6_WAIT_L0; P6_BAR; P6_MM(1, 0, At, B0); P6_MM(1, 1, At, B1); P6_BAR; P6_SCHED;
        }
        typename Epi::Pre pre; const int eln = lane_id();
        E.load(pre, cur, wr, wc, eln & 15, eln >> 4);
        if (P6_STAGGER && ALIGN_EPI) { if (wr == 0) P6_BAR; }
        E(acc, cur, wr, wc, eln & 15, eln >> 4, pre);
        if (!has_next) break;
#pragma unroll
        for (int a = 0; a < 2; ++a)
#pragma unroll
            for (int b = 0; b < 2; ++b)
#pragma unroll
                for (int m = 0; m < 4; ++m)
#pragma unroll
                    for (int n = 0; n < 2; ++n) acc[a][b][m][n] = (f32x4){0.f, 0.f, 0.f, 0.f};
        cur = nxt; cA = nA; cB = nB; ++ui;
        if (P6_STAGGER && ALIGN_EPI) { if (wr == 1) P6_BAR; }
    }
    asm volatile("s_waitcnt vmcnt(0)" ::: "memory");
    if (P6_STAGGER && !ALIGN_EPI) { if (wr == 0) P6_BAR; }
    P6_BAR;
#undef P6_SA
#undef P6_SB
#undef P6_STAGE
#undef P6_STAGE_A
#undef P6_STAGE_B
#undef P6_LDA
#undef P6_LDB
#undef P6_CAT
#undef P6_MM
#undef P6_WAIT_V
#undef P6_WAIT_6
#undef P6_WAIT_L0
#undef P6_BAR
#undef P6_SCHED
#undef P6_LOAD_VOFFG
#undef P6_IDX_DMA
}
}


struct Args { const float* in[19]; float* out; unsigned char* ws; int ph_lo, ph_hi; };
struct Ctx {
    LAS unsigned char* lds; int tid, lane, wave, G, vcu, gw, NGW, gw0, wave0;
    unsigned char* ws; bf16* HB; bf16* XN; bf16* Y1; float* RSTD; unsigned* ctl;
};

__device__ __forceinline__ void tr_item(const float* W, int ldw, int k0, int n0, bf16* WT, int K, int drow0, LAS float* scr, int lane, const float* kg = nullptr  ) {
#pragma unroll 8
    for (int i = 0; i < 32; ++i) { const int kk = 2 * i + (lane >> 5); scr[kk * 33 + (lane & 31)] = W[(size_t)(k0 + kk) * ldw + n0 + (lane & 31)] * (kg ? kg[k0 + kk] : 1.0f); }
    LDS_WAIT();
    const int c = lane & 7;
#pragma unroll
    for (int j = 0; j < 4; ++j) { const int n = (lane >> 3) + 8 * j; const LAS float* s = scr + (8 * c) * 33 + n;
        v4u o; o.x = cvt_pk_bf16(s[0 * 33], s[1 * 33]); o.y = cvt_pk_bf16(s[2 * 33], s[3 * 33]); o.z = cvt_pk_bf16(s[4 * 33], s[5 * 33]); o.w = cvt_pk_bf16(s[6 * 33], s[7 * 33]);
        *(v4u*)(WT + (size_t)(drow0 + n) * K + k0 + 8 * c) = o; }
    LDS_WAIT();
}
__device__ __forceinline__ void tr_item8(const float* W, int ldw, int k0, int n0, unsigned char* WT, int K, int drow0, float scale, LAS float* scr, int lane) {
#pragma unroll 8
    for (int i = 0; i < 32; ++i) { const int kk = 2 * i + (lane >> 5); scr[kk * 33 + (lane & 31)] = W[(size_t)(k0 + kk) * ldw + n0 + (lane & 31)] * scale; }
    LDS_WAIT();
    const int c = lane & 7;
#pragma unroll
    for (int j = 0; j < 4; ++j) { const int n = (lane >> 3) + 8 * j; const LAS float* s = scr + (8 * c) * 33 + n;
        v2u o; o.x = pk4_fp8(s[0 * 33], s[1 * 33], s[2 * 33], s[3 * 33]); o.y = pk4_fp8(s[4 * 33], s[5 * 33], s[6 * 33], s[7 * 33]);
        *(v2u*)(WT + (size_t)(drow0 + n) * K + k0 + 8 * c) = o; }
    LDS_WAIT();
}
__device__ __forceinline__ void tr_item_kt(const float* W, int ldw, int k0, int n0, bf16* WT, int K, LAS float* scr, int lane) {
#pragma unroll 8
    for (int i = 0; i < 32; ++i) { const int kk = 2 * i + (lane >> 5); scr[kk * 33 + (lane & 31)] = W[(size_t)(k0 + kk) * ldw + n0 + (lane & 31)]; }
    LDS_WAIT();
    const int c = lane & 7;
#pragma unroll
    for (int j = 0; j < 4; ++j) { const int n = n0 + (lane >> 3) + 8 * j; const LAS float* s = scr + (8 * c) * 33 + (lane >> 3) + 8 * j;
        v4u o; o.x = cvt_pk_bf16(s[0 * 33], s[1 * 33]); o.y = cvt_pk_bf16(s[2 * 33], s[3 * 33]); o.z = cvt_pk_bf16(s[4 * 33], s[5 * 33]); o.w = cvt_pk_bf16(s[6 * 33], s[7 * 33]);
        *(v4u*)(WT + (size_t)(n >> 8) * 256 * K + (size_t)(k0 >> 6) * (256 * 64) + (size_t)(n & 255) * 64 + 8 * c) = o; }
    LDS_WAIT();
}
__device__ __forceinline__ void tr_item8_kt(const float* W, int ldw, int k0, int n0, unsigned char* WT, int K, float scale, LAS float* scr, int lane) {
#pragma unroll 8
    for (int i = 0; i < 32; ++i) { const int kk = 2 * i + (lane >> 5); scr[kk * 33 + (lane & 31)] = W[(size_t)(k0 + kk) * ldw + n0 + (lane & 31)] * scale; }
    LDS_WAIT();
    const int c = lane & 7;
#pragma unroll
    for (int j = 0; j < 4; ++j) { const int n = n0 + (lane >> 3) + 8 * j; const LAS float* s = scr + (8 * c) * 33 + (lane >> 3) + 8 * j;
        v2u o; o.x = pk4_fp8(s[0 * 33], s[1 * 33], s[2 * 33], s[3 * 33]); o.y = pk4_fp8(s[4 * 33], s[5 * 33], s[6 * 33], s[7 * 33]);
        *(v2u*)(WT + (size_t)(n >> 8) * 256 * K + (size_t)(k0 >> 7) * (256 * 128) + (size_t)(n & 255) * 128 + (k0 & 127) + 8 * c) = o; }
    LDS_WAIT();
}
typedef float f32x16 __attribute__((ext_vector_type(16)));
typedef unsigned u32x6 __attribute__((ext_vector_type(6)));
__device__ __forceinline__ void store_fp6_block(unsigned char* piece, int fq, int swap, const f32x16& lo, const f32x16& hi) {
    const u32x6 p = __builtin_amdgcn_cvt_scalef32_2xpk16_fp6_f32(lo, hi, 1.0f);
    unsigned d0 = p[0], d1 = p[1], d2 = p[2], d3 = p[3], d4 = p[4], d5 = p[5];
    asm volatile("s_nop 7\n\ts_nop 7" : "+v"(d0), "+v"(d1), "+v"(d2), "+v"(d3), "+v"(d4), "+v"(d5));
    *(v4u*)(piece + 16 * fq) = (v4u){d0, d1, d2, d3};
    *(v2u*)(piece + 64 + 8 * (fq ^ (swap << 1))) = (v2u){d4, d5};
}
__device__ __forceinline__ void tr_item6(const float* W, int ldw, int k0, int n0, unsigned char* WT, int drow0, float scale, LAS float* scr, int lane) {
    const int q6 = k0 >> 6;
#pragma unroll 8
    for (int i = 0; i < 32; ++i) { const int kk = 2 * i + (lane >> 5); scr[kk * 33 + (lane & 31)] = W[(size_t)(256 * (kk >> 4) + 16 * q6 + (kk & 15)) * ldw + n0 + (lane & 31)] * scale; }
    LDS_WAIT();
    const int n = lane & 31, half = lane >> 5;
    f32x16 lo, hi;
#pragma unroll
    for (int i = 0; i < 16; ++i) { lo[i] = scr[(16 * (i >> 2) + 8 * half + (i & 3)) * 33 + n]; hi[i] = scr[(16 * (i >> 2) + 8 * half + 4 + (i & 3)) * 33 + n]; }
    const int drow = drow0 + n, r = drow & 255, q = r & 31, R = (r & ~31) + 16 * ((q >> 2) & 1) + 4 * (q >> 3) + (q & 3), blk = 2 * q6 + half;
    store_fp6_block(WT + (size_t)(drow >> 8) * (8 * 24576) + (size_t)(blk >> 2) * 24576 + (R >> 7) * 12288 + (R & 127) * 96, blk & 3, (R >> 3) & 1, lo, hi);
    LDS_WAIT();
}
__device__ __forceinline__ void ld_item6(const float* W, int ldw, int k0, int n0, int lane, float (&v)[32]) {
    const int q6 = k0 >> 6;
#pragma unroll
    for (int i = 0; i < 32; ++i) { const int kk = 2 * i + (lane >> 5); v[i] = W[(size_t)(256 * (kk >> 4) + 16 * q6 + (kk & 15)) * ldw + n0 + (lane & 31)]; }
}
__device__ __forceinline__ void fin_item6(const float (&v)[32], int k0, int n0, unsigned char* WT, int drow0, float scale, LAS float* scr, int lane) {
    const int q6 = k0 >> 6;
#pragma unroll
    for (int i = 0; i < 32; ++i) { const int kk = 2 * i + (lane >> 5); scr[kk * 33 + (lane & 31)] = v[i] * scale; }
    LDS_WAIT();
    const int n = lane & 31, half = lane >> 5;
    f32x16 lo, hi;
#pragma unroll
    for (int i = 0; i < 16; ++i) { lo[i] = scr[(16 * (i >> 2) + 8 * half + (i & 3)) * 33 + n]; hi[i] = scr[(16 * (i >> 2) + 8 * half + 4 + (i & 3)) * 33 + n]; }
    const int drow = drow0 + n, r = drow & 255, q = r & 31, R = (r & ~31) + 16 * ((q >> 2) & 1) + 4 * (q >> 3) + (q & 3), blk = 2 * q6 + half;
    store_fp6_block(WT + (size_t)(drow >> 8) * (8 * 24576) + (size_t)(blk >> 2) * 24576 + (R >> 7) * 12288 + (R & 127) * 96, blk & 3, (R >> 3) & 1, lo, hi);
    LDS_WAIT();
}
__device__ __forceinline__ void ld_item8_kt(const float* W, int ldw, int k0, int n0, int lane, float (&v)[32]) {
#pragma unroll
    for (int i = 0; i < 32; ++i) { const int kk = 2 * i + (lane >> 5); v[i] = W[(size_t)(k0 + kk) * ldw + n0 + (lane & 31)]; }
}
__device__ __forceinline__ void fin_item8_kt(const float (&v)[32], int k0, int n0, unsigned char* WT, int K, float scale, LAS float* scr, int lane) {
#pragma unroll
    for (int i = 0; i < 32; ++i) { const int kk = 2 * i + (lane >> 5); scr[kk * 33 + (lane & 31)] = v[i] * scale; }
    LDS_WAIT();
    const int c = lane & 7;
#pragma unroll
    for (int j = 0; j < 4; ++j) { const int n = n0 + (lane >> 3) + 8 * j; const LAS float* sp = scr + (8 * c) * 33 + (lane >> 3) + 8 * j;
        v2u o; o.x = pk4_fp8(sp[0 * 33], sp[1 * 33], sp[2 * 33], sp[3 * 33]); o.y = pk4_fp8(sp[4 * 33], sp[5 * 33], sp[6 * 33], sp[7 * 33]);
        *(v2u*)(WT + (size_t)(n >> 8) * 256 * K + (size_t)(k0 >> 7) * (256 * 128) + (size_t)(n & 255) * 128 + (k0 & 127) + 8 * c) = o; }
    LDS_WAIT();
}
__device__ __forceinline__ void cv_gateup(const float* Wg, const float* Wu, bf16* dst, int item, LAS float* scr, int lane, const float* kg = nullptr) {
    const int kind = item / 1792, r = item % 1792, kb = r / 112, nb = r % 112, n0 = 32 * nb;
    tr_item(kind ? Wu : Wg, FF, 64 * kb, n0, dst, D, (n0 >> 7) * 256 + (n0 & 127) + kind * 128, scr, lane, kg);
}
__device__ __forceinline__ void cv_plain(const float* W, int K, int N, bf16* dst, int drow_off, int item, LAS float* scr, int lane) {
    const int nbn = N / 32, kb = item / nbn, nb = item % nbn;
    tr_item(W, N, 64 * kb, 32 * nb, dst, K, drow_off + 32 * nb, scr, lane);
}
__device__ __forceinline__ void cv_convin(const float* W, const float* kg, bf16* dst, int item, LAS float* scr, int lane) {
    const int kb = item / 96, nb = item % 96, n0 = 32 * nb; int dr;
    if (n0 < 1024) dr = n0; else if (n0 < 2048) dr = 1024 + ((n0 - 1024) >> 7) * 256 + (n0 & 127); else dr = 1024 + ((n0 - 2048) >> 7) * 256 + 128 + (n0 & 127);
    tr_item(W, 3 * D, 64 * kb, n0, dst, D, dr, scr, lane, kg);
}
__device__ __forceinline__ void convert_moe_layer(Ctx& C, const Args& a, int j, const int gw_ = -1, const int ngw_ = 0  ) {
    static_assert(MOE_GU_FMT == 6, "split items write the fp6 image");
    LAS float* scr = (LAS float*)(C.lds + C.wave * 16384);
    constexpr int PER_E = 1792 + 896, NIT = NE * PER_E;
    const int start = gw_ >= 0 ? gw_ : C.gw, stride = gw_ >= 0 ? ngw_ : C.NGW;
    auto ldit = [&](const int it, float (&x0)[32], float (&x1)[32]) {
        const int e = it / PER_E, r = it % PER_E; const size_t wo = ((size_t)j * NE + e) * D * FF;
        if (r < 1792) { const int kind = r / 896, q = r % 896, kb2 = q / 112, nb = q % 112, n0 = 32 * nb; const float* Wp = (kind ? a.in[16] : a.in[15]) + wo;
            ld_item6(Wp, FF, 64 * (2 * kb2), n0, C.lane, x0); ld_item6(Wp, FF, 64 * (2 * kb2 + 1), n0, C.lane, x1); }
        else { const int q = r - 1792, kb2 = q / 32, nb = q % 32;
            ld_item8_kt(a.in[17] + wo, D, 64 * (2 * kb2), 32 * nb, C.lane, x0); ld_item8_kt(a.in[17] + wo, D, 64 * (2 * kb2 + 1), 32 * nb, C.lane, x1); }
    };
    auto finit = [&](const int it, const float (&x0)[32], const float (&x1)[32]) {
        const int e = it / PER_E, r = it % PER_E;
        if (r < 1792) { const int kind = r / 896, q = r % 896, kb2 = q / 112, nb = q % 112, n0 = 32 * nb; unsigned char* dst = C.ws + WS_WMGU + (size_t)(j * NE + e) * GU6_BYTES; const int dr = (n0 >> 7) * 256 + (n0 & 127) + kind * 128;
            fin_item6(x0, 64 * (2 * kb2), n0, dst, dr, W_GU_SCALE, scr, C.lane); fin_item6(x1, 64 * (2 * kb2 + 1), n0, dst, dr, W_GU_SCALE, scr, C.lane); }
        else { const int q = r - 1792, kb2 = q / 32, nb = q % 32; unsigned char* dst = C.ws + WS_WMDN + (size_t)(j * NE + e) * DN8_BYTES;
            fin_item8_kt(x0, 64 * (2 * kb2), 32 * nb, dst, FF, W_DN_SCALE, scr, C.lane); fin_item8_kt(x1, 64 * (2 * kb2 + 1), 32 * nb, dst, FF, W_DN_SCALE, scr, C.lane); }
    };
    float a0[32], a1[32], b0[32], b1[32];
    if (start < NIT) ldit(start, a0, a1);
#pragma nounroll
    for (int it = start; it < NIT; it += 2 * stride) {
        const int itb = it + stride;
        if (itb < NIT) ldit(itb, b0, b1);
        finit(it, a0, a1);
        if (it + 2 * stride < NIT) ldit(it + 2 * stride, a0, a1);
        if (itb < NIT) finit(itb, b0, b1);
    }
}
__device__ __forceinline__ void convert_small_weights(Ctx& C, const Args& a) {
    LAS float* scr = (LAS float*)(C.lds + C.wave * 16384);
    constexpr int I_POOL = 32, I_GU = 3584, I_DN = 1792, I_IN = 1536, I_OUT = 512;
    constexpr int PER_L = 4 * I_POOL + I_GU + I_DN + I_IN + I_OUT;
    for (int it = C.gw; it < 2 * PER_L; it += C.NGW) {
        const int l = it / PER_L; int r = it % PER_L;
        if (r < 4 * I_POOL) { const int g = r / I_POOL; cv_plain(a.in[3] + (size_t)(l * 4 + g) * 65536, 256, 256, (bf16*)(C.ws + WS_WPOOL + (size_t)l * 524288), g * 256, r % I_POOL, scr, C.lane); continue; } r -= 4 * I_POOL;
        if (r < I_GU) {
            if (l == DENSE_FP8_LAYER) { const int kind = r / 1792, q = r % 1792, kb = q / 112, nb = q % 112, n0 = 32 * nb;
                tr_item8((kind ? a.in[7] : a.in[6]) + (size_t)l * D * FF, FF, 64 * kb, n0, C.ws + WS_WGU + (size_t)l * GU_BYTES, D, (n0 >> 7) * 256 + (n0 & 127) + kind * 128, W_GU_SCALE, scr, C.lane); }
            else cv_gateup(a.in[6] + (size_t)l * D * FF, a.in[7] + (size_t)l * D * FF, (bf16*)(C.ws + WS_WGU + (size_t)l * GU_BYTES), r, scr, C.lane, (l == 0 && DENSE_NORM_FUSED_L0) ? a.in[5] + (size_t)l * D : nullptr);
            continue; } r -= I_GU;
        if (r < I_DN) {
            if (l == DENSE_FP8_LAYER || (l == 0 && DENSE_DN8_L0)) { const int kb = r / 32, nb = r % 32; tr_item8_kt(a.in[8] + (size_t)l * D * FF, D, 64 * kb, 32 * nb, C.ws + WS_WDN + (size_t)l * DN_BYTES, FF, W_DN_SCALE, scr, C.lane); }
            else { const int kb = r / 32, nb = r % 32; tr_item_kt(a.in[8] + (size_t)l * D * FF, D, 64 * kb, 32 * nb, (bf16*)(C.ws + WS_WDN + (size_t)l * DN_BYTES), FF, scr, C.lane); }
            continue; } r -= I_DN;
        if (r < I_IN) { cv_convin(a.in[10] + (size_t)l * D * 3 * D, a.in[9] + (size_t)l * D, (bf16*)(C.ws + WS_WIN + (size_t)l * 3 * D * D * 2), r, scr, C.lane); continue; } r -= I_IN;
        cv_plain(a.in[12] + (size_t)l * D * D, D, D, (bf16*)(C.ws + WS_WOUT + (size_t)l * D * D * 2), 0, r, scr, C.lane);
    }
}

__device__ __forceinline__ int prev_row(int row, int i) {
    if (row < MROWS) { const int tp = row & (TS - 1); return tp >= i ? row - i : MROWS + NMETA + tp - i; }
    return row - i;
}
__device__ __forceinline__ void load_heff(const Ctx& C, int row, bool addy1, f32x4 (&x)[4]) {
    const v2u* p = (const v2u*)(C.HB + (size_t)row * D) + C.lane;
#pragma unroll
    for (int j = 0; j < 4; ++j) { const v2u v = p[64 * j]; x[j] = (f32x4){bf_lo(v.x), bf_hi(v.x), bf_lo(v.y), bf_hi(v.y)}; }
    if (addy1) { const v2u* q = (const v2u*)(C.Y1 + (size_t)row * D) + C.lane;
#pragma unroll
        for (int j = 0; j < 4; ++j) { const v2u y = q[64 * j]; x[j] += (f32x4){bf_lo(y.x), bf_hi(y.x), bf_lo(y.y), bf_hi(y.y)}; } }
}
__device__ __forceinline__ float row_rstd(const f32x4 (&x)[4], int lane) {
    float s = 0.f;
#pragma unroll
    for (int j = 0; j < 4; ++j) s += (x[j][0] * x[j][0] + x[j][1] * x[j][1]) + (x[j][2] * x[j][2] + x[j][3] * x[j][3]);
    return __frsqrt_rn(wave_sum(s, lane) * (1.0f / D) + EPS);
}
__device__ __forceinline__ void store_bf16_row(bf16* dst, int row, int lane, const f32x4 (&v)[4]) {
    v2u* o = (v2u*)(dst + (size_t)row * D) + lane;
#pragma unroll
    for (int j = 0; j < 4; ++j) { v2u w; w.x = cvt_pk_bf16(v[j][0], v[j][1]); w.y = cvt_pk_bf16(v[j][2], v[j][3]); o[64 * j] = w; }
}
__device__ __forceinline__ void phase_norm(Ctx& C, const float* gain, bool addy1, bool out8 = false) {
    f32x4 g[4];
#pragma unroll
    for (int j = 0; j < 4; ++j) g[j] = ((const f32x4*)gain)[C.lane + 64 * j];
    f32x4 x[4], xnx[4];
    if (C.gw < RTOT) load_heff(C, C.gw, addy1, x);
    for (int row = C.gw; row < RTOT; row += C.NGW) {
        const int nrow = row + C.NGW;
        if (nrow < RTOT) load_heff(C, nrow, addy1, xnx);
        const float rs = row_rstd(x, C.lane);
#pragma unroll
        for (int j = 0; j < 4; ++j) x[j] = x[j] * rs * g[j];
        if (out8) { unsigned* o8 = (unsigned*)((unsigned char*)C.XN + (size_t)row * D) + C.lane;
#pragma unroll
            for (int j = 0; j < 4; ++j) o8[64 * j] = pk4_fp8(x[j][0], x[j][1], x[j][2], x[j][3]); }
        else store_bf16_row(C.XN, row, C.lane, x);
#pragma unroll
        for (int j = 0; j < 4; ++j) x[j] = xnx[j];
    }
}
__device__ __forceinline__ void norm_rows_wg(Ctx& C, const float* gain, int r0, int nr, bool out8) {
    f32x4 g[4];
#pragma unroll
    for (int j = 0; j < 4; ++j) g[j] = ((const f32x4*)gain)[C.lane + 64 * j];
    auto ldrow = [&](v2u (&q)[4], const int lr) { const v2u* p = (const v2u*)(C.HB + (size_t)(r0 + lr) * D) + C.lane;
#pragma unroll
        for (int j = 0; j < 4; ++j) q[j] = p[64 * j]; };
    auto process = [&](const v2u (&q)[4], const int lr) {
        const int row = r0 + lr; f32x4 x[4];
#pragma unroll
        for (int j = 0; j < 4; ++j) x[j] = (f32x4){bf_lo(q[j].x), bf_hi(q[j].x), bf_lo(q[j].y), bf_hi(q[j].y)};
        const float rs = row_rstd(x, C.lane);
#pragma unroll
        for (int j = 0; j < 4; ++j) x[j] = x[j] * rs * g[j];
        if (out8) { unsigned* o8 = (unsigned*)((unsigned char*)C.XN + (size_t)row * D * 2) + C.lane;
#pragma unroll
            for (int j = 0; j < 4; ++j) o8[64 * j] = pk4_fp8(x[j][0], x[j][1], x[j][2], x[j][3]); }
        else store_bf16_row(C.XN, row, C.lane, x);
    };
    v2u qa[4], qb[4], qc[4];
#pragma unroll
    for (int j = 0; j < 4; ++j) { qa[j] = (v2u){0u, 0u}; qb[j] = qa[j]; qc[j] = qa[j]; }
    if (C.wave < nr) ldrow(qa, C.wave);
    if (C.wave + NWAVES < nr) ldrow(qb, C.wave + NWAVES);
#pragma nounroll
    for (int lr = C.wave; lr < nr; lr += 3 * NWAVES) {
        if (lr + 2 * NWAVES < nr) ldrow(qc, lr + 2 * NWAVES);
        process(qa, lr);
        if (lr + NWAVES < nr) { if (lr + 3 * NWAVES < nr) ldrow(qa, lr + 3 * NWAVES); process(qb, lr + NWAVES); }
        if (lr + 2 * NWAVES < nr) { if (lr + 4 * NWAVES < nr) ldrow(qb, lr + 4 * NWAVES); process(qc, lr + 2 * NWAVES); }
    }
}
template <bool L0>
__device__ __forceinline__ void phase_pool(Ctx& C, const float* gain, bool addy1, const float* xin, const float* meta) {
    f32x4 g[4];
#pragma unroll
    for (int j = 0; j < 4; ++j) g[j] = ((const f32x4*)gain)[C.lane + 64 * j];
    constexpr int RUN = 32, NRUN = MROWS / RUN + 1;
    for (int run = C.gw; run < NRUN; run += C.NGW) {
        const bool mrun = run == NRUN - 1;
        const int r0 = run * RUN, tp0 = r0 & (TS - 1), nsteps = mrun ? NMETA : RUN + 15;
        f32x4 r1[2], r2[4], r3[8], r4[16], S[4];
#pragma unroll
        for (int q = 0; q < 2; ++q) r1[q] = (f32x4){0.f, 0.f, 0.f, 0.f};
#pragma unroll
        for (int q = 0; q < 4; ++q) r2[q] = (f32x4){0.f, 0.f, 0.f, 0.f};
#pragma unroll
        for (int q = 0; q < 8; ++q) r3[q] = (f32x4){0.f, 0.f, 0.f, 0.f};
#pragma unroll
        for (int q = 0; q < 16; ++q) r4[q] = (f32x4){0.f, 0.f, 0.f, 0.f};
#pragma unroll
        for (int j = 0; j < 4; ++j) S[j] = (f32x4){0.f, 0.f, 0.f, 0.f};
#define POOL_ROW(k_) (mrun ? MROWS + (k_) : ((tp0 + (k_) - 15 >= 0) ? r0 + (k_) - 15 : MROWS + NMETA + tp0 + (k_) - 15))
#define POOL_LOAD(dst, row_) do { if (L0) { const f32x4* p_ = (const f32x4*)((row_) < MROWS ? xin + (size_t)(row_) * D : meta + (size_t)((row_) - MROWS) * D) + C.lane; \
        _Pragma("unroll") for (int j = 0; j < 4; ++j) dst[j] = p_[64 * j]; } else load_heff(C, row_, addy1, dst); } while (0)
        f32x4 x[4], xnx[4];
        POOL_LOAD(x, POOL_ROW(0));
        for (int kb = 0; kb < nsteps; kb += 16) {
#pragma unroll
            for (int kk = 0; kk < 16; ++kk) {
                const int k = kb + kk;
                if (k < nsteps) {
                    const int i = mrun ? k : k - 15;
                    const int row = POOL_ROW(k);
                    if (k + 1 < nsteps) POOL_LOAD(xnx, POOL_ROW(k + 1));
                    const float rs = row_rstd(x, C.lane);
#pragma unroll
                    for (int j = 0; j < 4; ++j) x[j] = x[j] * rs * g[j];
                    S[0] += x[0] - r1[kk & 1]; r1[kk & 1] = x[0];
                    S[1] += x[1] - r2[kk & 3]; r2[kk & 3] = x[1];
                    S[2] += x[2] - r3[kk & 7]; r3[kk & 7] = x[2];
                    S[3] += x[3] - r4[kk]; r4[kk] = x[3];
                    if (i >= 0) {
                        const int pos = mrun ? k : NMETA;
                        f32x4 d[4];
#pragma unroll
                        for (int j = 0; j < 4; ++j) { const int w = 2 << j; const int cnt = (pos + 1) < w ? (pos + 1) : w; d[j] = S[j] * (1.0f / (float)cnt) - x[j]; }
                        store_bf16_row(C.XN, row, C.lane, d);
                    }
#pragma unroll
                    for (int j = 0; j < 4; ++j) x[j] = xnx[j];
                }
            }
        }
#undef POOL_ROW
#undef POOL_LOAD
    }
}
__device__ __forceinline__ void conv_tap(float (&s)[8], const float (&k)[8], const v4u& uu) {
    s[0] += k[0] * bf_lo(uu.x); s[1] += k[1] * bf_hi(uu.x); s[2] += k[2] * bf_lo(uu.y); s[3] += k[3] * bf_hi(uu.y);
    s[4] += k[4] * bf_lo(uu.z); s[5] += k[5] * bf_hi(uu.z); s[6] += k[6] * bf_lo(uu.w); s[7] += k[7] * bf_hi(uu.w);
}
__device__ __forceinline__ void phase_conv(Ctx& C, const float* ck, const bf16* BGp, const bf16* Up, bf16* Y, const bool meta_local = false  ) {
    float k[3][2][8];
#pragma unroll
    for (int t = 0; t < 3; ++t)
#pragma unroll
        for (int q = 0; q < 2; ++q) { const f32x4 a = *(const f32x4*)(ck + t * D + 8 * C.lane + 512 * q), b = *(const f32x4*)(ck + t * D + 8 * C.lane + 512 * q + 4);
            k[t][q][0] = a[0]; k[t][q][1] = a[1]; k[t][q][2] = a[2]; k[t][q][3] = a[3]; k[t][q][4] = b[0]; k[t][q][5] = b[1]; k[t][q][6] = b[2]; k[t][q][7] = b[3]; }
    constexpr int RUN = 32, NRUN = MROWS / RUN + 1;
    const v4u zero4 = (v4u){0u, 0u, 0u, 0u};
    const int nrun_deal = meta_local ? NRUN - 1 : NRUN;
    bool extra = meta_local && C.wave == 0 && (int)blockIdx.x < D / 16;
    for (int run = C.gw; run < nrun_deal || extra; run += C.NGW) {
        if (run >= nrun_deal) { run = NRUN - 1; extra = false; }
        const bool mrun = run == NRUN - 1;
        const int r0 = mrun ? MROWS : run * RUN, n = mrun ? NMETA : RUN;
        v4u um1[2], um2[2];
#pragma unroll
        for (int q = 0; q < 2; ++q) { const int co = 8 * C.lane + 512 * q;
            um1[q] = mrun ? zero4 : *(const v4u*)(Up + (size_t)prev_row(r0, 1) * D + co); um2[q] = mrun ? zero4 : *(const v4u*)(Up + (size_t)prev_row(r0, 2) * D + co); }
        v4u uc[2], bc[2], un[2], bn[2];
#pragma unroll
        for (int q = 0; q < 2; ++q) { const int co = 8 * C.lane + 512 * q; uc[q] = *(const v4u*)(Up + (size_t)r0 * D + co); bc[q] = *(const v4u*)(BGp + (size_t)r0 * D + co); }
        for (int i = 0; i < n; ++i) {
            const int row = r0 + i;
            if (i + 1 < n) {
#pragma unroll
                for (int q = 0; q < 2; ++q) { const int co = 8 * C.lane + 512 * q; un[q] = *(const v4u*)(Up + (size_t)(row + 1) * D + co); bn[q] = *(const v4u*)(BGp + (size_t)(row + 1) * D + co); } }
#pragma unroll
            for (int q = 0; q < 2; ++q) {
                const int co = 8 * C.lane + 512 * q;
                const v4u uu = uc[q], bb = bc[q];
                float sacc[8];
#pragma unroll
                for (int e = 0; e < 8; ++e) sacc[e] = 0.f;
                conv_tap(sacc, k[0][q], um2[q]); conv_tap(sacc, k[1][q], um1[q]); conv_tap(sacc, k[2][q], uu);
                um2[q] = um1[q]; um1[q] = uu;
                v4u o; o.x = cvt_pk_bf16(bf_lo(bb.x) * sacc[0], bf_hi(bb.x) * sacc[1]); o.y = cvt_pk_bf16(bf_lo(bb.y) * sacc[2], bf_hi(bb.y) * sacc[3]);
                o.z = cvt_pk_bf16(bf_lo(bb.z) * sacc[4], bf_hi(bb.z) * sacc[5]); o.w = cvt_pk_bf16(bf_lo(bb.w) * sacc[6], bf_hi(bb.w) * sacc[7]);
                *(v4u*)(Y + (size_t)row * D + co) = o;
                uc[q] = un[q]; bc[q] = bn[q];
            }
        }
    }
}
__device__ __forceinline__ float xchg(float v, int lane, int m) { return __int_as_float(__builtin_amdgcn_ds_bpermute((lane ^ m) << 2, __float_as_int(v))); }
__device__ __forceinline__ void phase_router(Ctx& C, const float* gain, const float* router, unsigned* gcnt  , const int ch0  , const bool do_meta  ) {
    LAS unsigned* lcnt = (LAS unsigned*)C.lds;
    LAS unsigned* lbase = lcnt + 8;
    LAS unsigned* ent = lcnt + 16;
    f32x4 g[4];
#pragma unroll
    for (int j = 0; j < 4; ++j) g[j] = ((const f32x4*)gain)[C.lane + 64 * j];
    f32x4 ra[4][4], rb[4][4];
#pragma unroll
    for (int j = 0; j < 4; ++j)
#pragma unroll
        for (int i = 0; i < 4; ++i) { const f32x4* rp = (const f32x4*)(router + (size_t)(4 * C.lane + 256 * j + i) * NE); ra[j][i] = rp[0]; rb[j][i] = rp[1]; }
    unsigned* rowidx = (unsigned*)(C.ws + WS_ROWIDX); int2* slot = (int2*)(C.ws + WS_SLOT);
    const int nchunk = (RTOT + 255) / 256;
    const bool up32 = (C.lane & 32) != 0, up16 = (C.lane & 16) != 0, up8 = (C.lane & 8) != 0;
    bool meta_todo = do_meta;
    for (int ch = ch0; ch < nchunk - 1 || meta_todo; ch += C.G) {
        if (ch >= nchunk - 1) { ch = nchunk - 1; meta_todo = false; }
        const int r0 = ch * 256, nr = (RTOT - r0) < 256 ? (RTOT - r0) : 256;
        __syncthreads();
        if (C.tid < 16) lcnt[C.tid] = 0u;
        __syncthreads();
        auto ldrow = [&](v2u (&q)[4], const int lr) { const v2u* p = (const v2u*)(C.HB + (size_t)(r0 + lr) * D) + C.lane;
#pragma unroll
            for (int j = 0; j < 4; ++j) q[j] = p[64 * j]; };
        auto process = [&](const v2u (&q)[4], const int lr) {
            const int row = r0 + lr; f32x4 x[4];
#pragma unroll
            for (int j = 0; j < 4; ++j) x[j] = (f32x4){bf_lo(q[j].x), bf_hi(q[j].x), bf_lo(q[j].y), bf_hi(q[j].y)};
            const float rs = row_rstd(x, C.lane);
#pragma unroll
            for (int j = 0; j < 4; ++j) x[j] = x[j] * rs * g[j];
            if (MOE_GU_FMT == 6) {
                f32x16 lo, hi;
#pragma unroll
                for (int j = 0; j < 4; ++j)
#pragma unroll
                    for (int i = 0; i < 4; ++i) { const float v = x[j][i] * X6_SCALE; lo[4 * j + i] = v; hi[4 * j + i] = DPP_F(v, 0xB1  ); }
                if ((C.lane & 1) == 0) store_fp6_block(C.ws + WS_XN6 + (size_t)row * 1024 + (C.lane >> 3) * 128, (C.lane >> 1) & 3, 0, lo, hi);
            } else { unsigned* o8 = (unsigned*)((unsigned char*)C.XN + (size_t)row * D) + C.lane;
#pragma unroll
              for (int j = 0; j < 4; ++j) o8[64 * j] = pk4_fp8(x[j][0], x[j][1], x[j][2], x[j][3]); }
            f32x4 la = (f32x4){0.f, 0.f, 0.f, 0.f}, lb = la;
#pragma unroll
            for (int j = 0; j < 4; ++j)
#pragma unroll
                for (int i = 0; i < 4; ++i) { la += ra[j][i] * x[j][i]; lb += rb[j][i] * x[j][i]; }
            f32x4 k4; { const f32x4 keep = up32 ? lb : la, give = up32 ? la : lb;
                k4[0] = keep[0] + xchg(give[0], C.lane, 32); k4[1] = keep[1] + xchg(give[1], C.lane, 32); k4[2] = keep[2] + xchg(give[2], C.lane, 32); k4[3] = keep[3] + xchg(give[3], C.lane, 32); }
            float k2a, k2b; { const float keep0 = up16 ? k4[2] : k4[0], keep1 = up16 ? k4[3] : k4[1], give0 = up16 ? k4[0] : k4[2], give1 = up16 ? k4[1] : k4[3];
                k2a = keep0 + xchg(give0, C.lane, 16); k2b = keep1 + xchg(give1, C.lane, 16); }
            float k1; { const float keep = up8 ? k2b : k2a, give = up8 ? k2a : k2b; k1 = keep + DPP_F(give, 0x128  ); }
            k1 += DPP_F(k1, 0xB1); k1 += DPP_F(k1, 0x4E); k1 += DPP_F(k1, 0x141);
            float lg[8];
#pragma unroll
            for (int e = 0; e < 8; ++e) lg[e] = __int_as_float(__builtin_amdgcn_readlane(__float_as_int(k1), 8 * e));
            int e1 = 0; float v1 = lg[0];
#pragma unroll
            for (int e = 1; e < 8; ++e) if (lg[e] > v1) { v1 = lg[e]; e1 = e; }
            int e2 = -1; float v2 = -3.0e38f;
#pragma unroll
            for (int e = 0; e < 8; ++e) if (e != e1 && lg[e] > v2) { v2 = lg[e]; e2 = e; }
            const float ex = __expf(v2 - v1), w1 = 1.0f / (1.0f + ex), w2 = ex * w1;
            if (C.lane == 0) {
                const unsigned k1_ = atomicAdd((unsigned*)&lcnt[e1], 1u), k2_ = atomicAdd((unsigned*)&lcnt[e2], 1u);
                ent[(lr * 2 + 0) * 2 + 0] = (unsigned)e1 | (k1_ << 8); ent[(lr * 2 + 0) * 2 + 1] = __float_as_uint(w1);
                ent[(lr * 2 + 1) * 2 + 0] = (unsigned)e2 | (k2_ << 8); ent[(lr * 2 + 1) * 2 + 1] = __float_as_uint(w2);
            }
        };
        v2u qa[4], qb[4], qc[4];
#pragma unroll
        for (int j = 0; j < 4; ++j) { qa[j] = (v2u){0u, 0u}; qb[j] = qa[j]; qc[j] = qa[j]; }
        if (C.wave < nr) ldrow(qa, C.wave);
        if (C.wave + NWAVES < nr) ldrow(qb, C.wave + NWAVES);
#pragma nounroll
        for (int lr = C.wave; lr < nr; lr += 3 * NWAVES) {
            if (lr + 2 * NWAVES < nr) ldrow(qc, lr + 2 * NWAVES);
            process(qa, lr);
            if (lr + NWAVES < nr) { if (lr + 3 * NWAVES < nr) ldrow(qa, lr + 3 * NWAVES); process(qb, lr + NWAVES); }
            if (lr + 2 * NWAVES < nr) { if (lr + 4 * NWAVES < nr) ldrow(qb, lr + 4 * NWAVES); process(qc, lr + 2 * NWAVES); }
        }
        __syncthreads();
        if (C.tid < 8) lbase[C.tid] = __hip_atomic_fetch_add(gcnt + 64 * C.tid, lcnt[C.tid], __ATOMIC_RELAXED, __HIP_MEMORY_SCOPE_AGENT);
        __syncthreads();
        for (int q = C.tid; q < nr * 2; q += NWAVES * 64) {
            const unsigned ek = ent[q * 2], wb = ent[q * 2 + 1]; const int e = ek & 255, rank = ek >> 8, row = r0 + (q >> 1), ch2 = q & 1;
            const int pos = e * CAP + (int)lbase[e] + rank;
            rowidx[pos] = (unsigned)row; slot[pos] = make_int2(row | (ch2 << 31), (int)wb);
        }
    }
    __syncthreads();
}
__device__ __forceinline__ void phase_final(Ctx& C, const float* gain, float* out) {
    f32x4 g[4];
#pragma unroll
    for (int j = 0; j < 4; ++j) g[j] = ((const f32x4*)gain)[C.lane + 64 * j];
    f32x4 x[4], xnx[4];
    if (C.gw < MROWS) load_heff(C, C.gw, true, x);
    for (int row = C.gw; row < MROWS; row += C.NGW) {
        const int nrow = row + C.NGW;
        if (nrow < MROWS) load_heff(C, nrow, true, xnx);
        const float rs = row_rstd(x, C.lane);
        f32x4* o = (f32x4*)(out + (size_t)row * D) + C.lane;
#pragma unroll
        for (int j = 0; j < 4; ++j) o[64 * j] = x[j] * rs * g[j];
#pragma unroll
        for (int j = 0; j < 4; ++j) x[j] = xnx[j];
    }
}
__device__ __forceinline__ void copy_params(Ctx& C, const Args& a) {
    float* P = (float*)(C.ws + WS_PARAMS);
    for (int i = C.gw * 64 + C.lane; i < PP_TOTAL; i += C.NGW * 64) {
        float v;
        if (i < PP_POOL_SCALE) v = a.in[2][i - PP_POOL_NORM];
        else if (i < PP_DENSE_NORM) v = a.in[4][i - PP_POOL_SCALE];
        else if (i < PP_CONV_NORM) v = a.in[5][i - PP_DENSE_NORM];
        else if (i < PP_MOE_NORM) v = a.in[9][i - PP_CONV_NORM];
        else if (i < PP_FINAL) v = a.in[13][i - PP_MOE_NORM];
        else if (i < PP_CONV_K) v = a.in[18][i - PP_FINAL];
        else if (i < PP_ROUTER) v = a.in[11][i - PP_CONV_K];
        else v = a.in[14][i - PP_ROUTER];
        P[i] = v;
    }
}
__device__ __forceinline__ int moe_cnt(unsigned* gcnt, int e) { return __builtin_amdgcn_readfirstlane((int)__hip_atomic_load(gcnt + 64 * e, __ATOMIC_RELAXED, __HIP_MEMORY_SCOPE_AGENT)); }
__device__ __forceinline__ void moe_sched_init(pg8::MoeSched& S, const Ctx& C, unsigned* gcnt, int pass, int nN) {
    S.n0 = moe_cnt(gcnt, 0); S.n1 = moe_cnt(gcnt, 1); S.n2 = moe_cnt(gcnt, 2); S.n3 = moe_cnt(gcnt, 3); S.n4 = moe_cnt(gcnt, 4); S.n5 = moe_cnt(gcnt, 5); S.n6 = moe_cnt(gcnt, 6); S.n7 = moe_cnt(gcnt, 7);
    S.m1 = (S.n0 + 255) >> 8; S.m2 = S.m1 + ((S.n1 + 255) >> 8); S.m3 = S.m2 + ((S.n2 + 255) >> 8); S.m4 = S.m3 + ((S.n3 + 255) >> 8);
    S.m5 = S.m4 + ((S.n4 + 255) >> 8); S.m6 = S.m5 + ((S.n5 + 255) >> 8); S.m7 = S.m6 + ((S.n6 + 255) >> 8);
    const int total = S.m7 + ((S.n7 + 255) >> 8);
    S.t0 = pass * MOE_CH; int nM = total - S.t0; const int cap = (pass == MOE_PASSES - 1) ? MOE_LAST_MAX : MOE_CH; nM = nM < 0 ? 0 : (nM > cap ? cap : nM);
    S.nM = nM; S.nN = nN; S.G = C.G; S.c = (int)blockIdx.x;
}
__device__ __forceinline__ bool relaunder(Ctx& C, unsigned char* ws) { C.lane = lane_id(); C.tid = C.wave * 64 + C.lane;
    { int g = C.gw0, w = C.wave0; asm volatile("" : "+s"(g), "+s"(w)); C.gw = g; C.wave = w; }
    size_t z_ = 0; asm volatile("" : "+s"(z_)); ws += z_; C.ws = ws;
    C.HB = (bf16*)(ws + WS_H32); C.XN = (bf16*)(ws + WS_XN); C.Y1 = (bf16*)(ws + WS_Y1); C.RSTD = (float*)(ws + WS_RSTD); return true; }
constexpr int N_PHASES = 1 + 2 * (4 + 2 + 2 * MOE_PASSES) + 1 + (PROBE_HOTA ? 1 : 0);

#define RUN() (ph >= lo && ph < hi && relaunder(C, args.ws))
#define REPE for (int rep_ = 0; rep_ < PROBE_REP_ELT; ++rep_)
#define REPG for (int rep_ = 0; rep_ < PROBE_REP_GEMM; ++rep_)
#define SEAM() do { if (ph >= lo && ph + 1 < hi) xcd_barrier(bar, C.wave0); \
    if (PROBE_TMASK != 0u && blockIdx.x == 0 && C.wave0 == 0) { volatile LAS unsigned long long* PW = (volatile LAS unsigned long long*)(C.lds + MISC_OFF + 64); \
        const unsigned long long rt_ = __builtin_amdgcn_s_memrealtime(), ck_ = __builtin_amdgcn_s_memtime(); \
        if (lane_id() == 0) { if ((PROBE_TMASK >> ph) & 1u) { PW[2] += PROBE_EPI ? PW[4] : rt_ - PW[0]; PW[3] += ck_ - PW[1]; } PW[0] = rt_; PW[1] = ck_; PW[4] = 0; } } \
    ++ph; } while (0)
#define INTER ((bf16*)(C.ws + WS_INTER))
#define PRM ((const float*)(C.ws + WS_PARAMS))

template <bool FP8, int NB>
__device__ __forceinline__ void meta_block(const Ctx& C, const char* A, int lda, unsigned kstepA, const char* Bt, unsigned tstepB, int ldb, unsigned kstepB, int nt, int n0, int n1, int sc_a, int sc_b, f32x4& o0, f32x4& o1) {
    const int lane = lane_id(), fr = lane & 15, fq = lane >> 4;
    const int kb = C.wave * nt / 8, ke = (C.wave + 1) * nt / 8;
    const int o = FP8 ? fq * 32 : fq * 16; constexpr int o2 = FP8 ? 16 : 64;
    const char* pa = A + (size_t)fr * lda + o;
    const char* pb0 = Bt + (size_t)((n0 + fr) >> 8) * tstepB + (size_t)((n0 + fr) & 255) * ldb + o;
    const char* pb1 = Bt + (size_t)((n1 + fr) >> 8) * tstepB + (size_t)((n1 + fr) & 255) * ldb + o;
    f32x4 a0 = (f32x4){0.f, 0.f, 0.f, 0.f}, a1 = a0;
    struct Frag { pg8::i32x4 xa, xb, wa, wb, va, vb; };
    auto ld = [&](int kt, Frag& f) {
        f.xa = *(const pg8::i32x4*)(pa + (size_t)kt * kstepA); f.xb = *(const pg8::i32x4*)(pa + (size_t)kt * kstepA + o2);
        f.wa = *(const pg8::i32x4*)(pb0 + (size_t)kt * kstepB); f.wb = *(const pg8::i32x4*)(pb0 + (size_t)kt * kstepB + o2);
        if constexpr (NB == 2) { f.va = *(const pg8::i32x4*)(pb1 + (size_t)kt * kstepB); f.vb = *(const pg8::i32x4*)(pb1 + (size_t)kt * kstepB + o2); }
    };
    auto mm = [&](const Frag& f) {
        if constexpr (FP8) a0 = __builtin_amdgcn_mfma_scale_f32_16x16x128_f8f6f4(__builtin_shufflevector(f.wa, f.wb, 0, 1, 2, 3, 4, 5, 6, 7), __builtin_shufflevector(f.xa, f.xb, 0, 1, 2, 3, 4, 5, 6, 7), a0, 0, 0, 0, sc_b, 0, sc_a);
        else { a0 = __builtin_amdgcn_mfma_f32_16x16x32_bf16((pg8::bf16x8)f.wa, (pg8::bf16x8)f.xa, a0, 0, 0, 0); a0 = __builtin_amdgcn_mfma_f32_16x16x32_bf16((pg8::bf16x8)f.wb, (pg8::bf16x8)f.xb, a0, 0, 0, 0); }
        if constexpr (NB == 2) {
            if constexpr (FP8) a1 = __builtin_amdgcn_mfma_scale_f32_16x16x128_f8f6f4(__builtin_shufflevector(f.va, f.vb, 0, 1, 2, 3, 4, 5, 6, 7), __builtin_shufflevector(f.xa, f.xb, 0, 1, 2, 3, 4, 5, 6, 7), a1, 0, 0, 0, sc_b, 0, sc_a);
            else { a1 = __builtin_amdgcn_mfma_f32_16x16x32_bf16((pg8::bf16x8)f.va, (pg8::bf16x8)f.xa, a1, 0, 0, 0); a1 = __builtin_amdgcn_mfma_f32_16x16x32_bf16((pg8::bf16x8)f.vb, (pg8::bf16x8)f.xb, a1, 0, 0, 0); }
        }
    };
    int kt = kb;
#pragma nounroll
    for (; kt + 3 < ke; kt += 4) { Frag f0, f1, f2, f3; ld(kt, f0); ld(kt + 1, f1); ld(kt + 2, f2); ld(kt + 3, f3); mm(f0); mm(f1); mm(f2); mm(f3); }
    if (kt + 1 < ke) { Frag f0, f1; ld(kt, f0); ld(kt + 1, f1); mm(f0); mm(f1); kt += 2; }
    if (kt < ke) { Frag f; ld(kt, f); mm(f); }
    LAS f32x4* red = (LAS f32x4*)C.lds;
    red[(C.wave * 2 + 0) * 64 + lane] = a0; if (NB == 2) red[(C.wave * 2 + 1) * 64 + lane] = a1;
    __syncthreads();
    o0 = red[lane]; o1 = red[64 + lane];
#pragma unroll
    for (int w = 1; w < 8; ++w) { o0 += red[(w * 2 + 0) * 64 + lane]; if (NB == 2) o1 += red[(w * 2 + 1) * 64 + lane]; }
}
template <bool FP8, bool OUT8, bool RS = false  >
__device__ __forceinline__ void meta_swiglu(const Ctx& C, const char* A, int lda, const char* Bt, unsigned tstepB, int ldb, int nt, int sc_a, int sc_b, unsigned char* Hm) {
    for (int t = (int)blockIdx.x; t < FF / 16; t += (int)gridDim.x) {
    LAS float* mr = (LAS float*)(C.lds + 16384);
    if constexpr (RS) { f32x4 x[4]; for (int rr = C.wave; rr < NMETA; rr += NWAVES) { load_heff(C, MROWS + rr, false, x); const float rs = row_rstd(x, C.lane); if (C.lane == 0) mr[rr] = rs; } }
    const int n0 = (t >> 3) * 256 + (t & 7) * 16; f32x4 g, u;
    meta_block<FP8, 2>(C, A, lda, 128u, Bt, tstepB, ldb, 128u, nt, n0, n0 + 128, sc_a, sc_b, g, u);
    if (C.wave == 0) { const int lane = lane_id(), fr = lane & 15, col = 16 * t + 4 * (lane >> 4);
        if constexpr (RS) { const float rs = mr[fr]; g *= rs; u *= rs; }
        constexpr float inv = OUT8 ? 1.0f / H8_SCALE : 1.0f;
        const f32x2 a = silu_mul_pk((f32x2){g[0], g[1]}, (f32x2){u[0], u[1]}, inv), b = silu_mul_pk((f32x2){g[2], g[3]}, (f32x2){u[2], u[3]}, inv);
        if constexpr (OUT8) *(unsigned*)(Hm + (size_t)(col >> 7) * (256 * 128) + fr * 128 + (col & 127)) = pk4_fp8(a.x, a.y, b.x, b.y);
        else *(v2u*)((bf16*)Hm + (size_t)(col >> 6) * (256 * 64) + fr * 64 + (col & 63)) = (v2u){cvt_pk_bf16(a.x, a.y), cvt_pk_bf16(b.x, b.y)}; }
    __syncthreads(); }
}
template <bool FP8, bool WT = false  >
__device__ __forceinline__ void meta_resid(const Ctx& C, const char* A, int lda, unsigned kstepA, const char* Bt, unsigned tstepB, int ldb, unsigned kstepB, int nt, int sc_a, int sc_b) {
    for (int t = (int)blockIdx.x; t < D / 16; t += (int)gridDim.x) {
    f32x4 r, dummy;
    meta_block<FP8, 1>(C, A, lda, kstepA, Bt, tstepB, ldb, kstepB, nt, 16 * t, 16 * t, sc_a, sc_b, r, dummy);
    if (C.wave == 0) { const int lane = lane_id(), fr = lane & 15, col = 16 * t + 4 * (lane >> 4);
        v2u* p = (v2u*)(C.HB + (size_t)(MROWS + fr) * D + col); const v2u v = *p;
        const v2u o = (v2u){cvt_pk_bf16(bf_lo(v.x) + r[0], bf_hi(v.x) + r[1]), cvt_pk_bf16(bf_lo(v.y) + r[2], bf_hi(v.y) + r[3])};
        if constexpr (WT) { __hip_atomic_store((unsigned*)p, o.x, __ATOMIC_RELAXED, __HIP_MEMORY_SCOPE_AGENT); __hip_atomic_store((unsigned*)p + 1, o.y, __ATOMIC_RELAXED, __HIP_MEMORY_SCOPE_AGENT); }
        else *p = o; }
    __syncthreads(); }
}
__device__ __forceinline__ void meta_convin(const Ctx& C, const char* A  , const char* Bt, bf16* BGp, bf16* Up) {
    LAS float* mr = (LAS float*)(C.lds + 16384);
    for (int t = (int)blockIdx.x; t < 128; t += (int)gridDim.x) {
    { f32x4 x[4]; for (int rr = C.wave; rr < NMETA; rr += NWAVES) { load_heff(C, MROWS + rr, false, x); const float rs = row_rstd(x, C.lane); if (C.lane == 0) mr[rr] = rs; } }
    const bool isb = t < 64; const int tt = t & 63, n0 = isb ? 16 * tt : (4 + (tt >> 3)) * 256 + (tt & 7) * 16;
    f32x4 c, v;
    meta_block<false, 2>(C, A, D * 2, 128u, Bt, 256u * D * 2, D * 2, 128u, D / 64, n0, isb ? n0 : n0 + 128, 0, 0, c, v);
    if (C.wave == 0) { const int lane = lane_id(), fr = lane & 15, col = 16 * tt + 4 * (lane >> 4); const float rs = mr[fr];
        c *= rs; if (!isb) c *= v * rs;
        *(v2u*)((isb ? BGp : Up) + (size_t)(MROWS + fr) * D + col) = (v2u){cvt_pk_bf16(c[0], c[1]), cvt_pk_bf16(c[2], c[3])}; }
    __syncthreads(); }
}

template <int lp>
__device__ __forceinline__ void layer_pair(Ctx& C, const Args& args, int& ph, const int lo, const int hi, const XcdBarrier& bar, LAS unsigned* idxbuf) {
        const bool addy1 = lp > 0;
        if (RUN()) REPE phase_pool<lp == 0>(C, PRM + PP_POOL_NORM + lp * D, addy1, args.in[0], args.in[1]);
    SEAM();
    if (RUN()) {
            pg8::PanelSched S; S.nN = 4; S.G = C.G; S.c = (int)blockIdx.x; S.A = (const char*)C.XN; S.Bt = (const char*)(C.ws + WS_WPOOL + (size_t)lp * 524288);
            S.tstepA = 256u * D * 2; S.tstepB = 256u * 256 * 2; S.a_colstep = 512;
            constexpr bool fused0 = (lp == 0) && DENSE_NORM_FUSED_L0 && DENSE_DN8_L0;
            typedef pg8::EpiResid<lp == 0, (lp > 0), fused0> EpiPG;
            EpiPG E{C.HB, addy1 ? C.Y1 : nullptr, PRM + PP_POOL_SCALE + lp * D, 0, lp == 0 ? args.in[0] : nullptr, lp == 0 ? args.in[1] : nullptr, 1.0f, (unsigned long long*)(C.ws + WS_ROWSQ) + (size_t)2 * 65536};
            pg8::gemm_phase<EpiPG, pg8::PanelSched, false>(C.lds, idxbuf, C.wave, 256 / 64, D * 2, 256 * 2, S, E);
            if constexpr (!fused0) {
            if (C.wave == 0) { __builtin_amdgcn_fence(__ATOMIC_ACQUIRE, "agent"); asm volatile("s_waitcnt vmcnt(0)" ::: "memory"); }
            __syncthreads();
            for (int p = (int)blockIdx.x; p < MROWS / 256; p += C.G) norm_rows_wg(C, PRM + PP_DENSE_NORM + lp * D, p * 256, 256, lp == DENSE_FP8_LAYER);
            }
        }
        SEAM();
        {
            constexpr int pm0 = 0, nM = MROWS / 256;
            constexpr bool dn8 = (lp == DENSE_FP8_LAYER) || (lp == 0 && DENSE_DN8_L0);
            unsigned char* const DH = C.ws + (dn8 ? WS_INTER : WS_DENSEH);
            if (PROBE_HOTA && lp == 0) {
                if (RUN()) {
                    pg8::DenseSched S; S.nM = nM; S.meta_pm = nM - 1; S.nN = FF / 128; S.G = C.G; S.c = (int)blockIdx.x; S.a_colstep = 0; S.Bt = (const char*)(C.ws + WS_WGU + (size_t)lp * GU_BYTES);
                    S.A = (const char*)C.XN; S.tstepA = (PROBE_HOTA == 1) ? 0u : 256u * D * 2; S.tstepB = (PROBE_HOTA == 2) ? 0u : 256u * D * 2;
                    pg8::EpiSwiGLU E{(bf16*)DH, FF};
                    pg8::gemm_phase<pg8::EpiSwiGLU, pg8::DenseSched, false>(C.lds, idxbuf, C.wave, D / 64, D * 2, D * 2, S, E);
                }
                SEAM();
            }
            if (RUN()) {
                constexpr bool fused0 = (lp == 0) && DENSE_NORM_FUSED_L0 && DENSE_DN8_L0;
                if constexpr (!fused0) { norm_rows_wg(C, PRM + PP_DENSE_NORM + lp * D, MROWS, NMETA, lp == DENSE_FP8_LAYER);
                    asm volatile("s_waitcnt vmcnt(0)" ::: "memory"); __syncthreads(); }
                pg8::DenseSched S; S.nM = nM; S.nN = FF / 128; S.G = C.G; S.c = (int)blockIdx.x; S.a_colstep = 0; S.Bt = (const char*)(C.ws + WS_WGU + (size_t)lp * GU_BYTES);
                if (lp == DENSE_FP8_LAYER) meta_swiglu<true, true>(C, (const char*)C.XN + (size_t)MROWS * D * 2, D * 2, S.Bt, 256u * D, D, D / 128, SC_ONE, SC_GU, DH + (size_t)MROWS * FF);
                else meta_swiglu<false, dn8, fused0>(C, (const char*)(fused0 ? C.HB : C.XN) + (size_t)MROWS * D * 2, D * 2, S.Bt, 256u * D * 2, D * 2, D / 64, 0, 0, DH + (size_t)MROWS * FF * (dn8 ? 1 : 2));
                if (lp == DENSE_FP8_LAYER) {
                    S.A = (const char*)C.XN + (size_t)pm0 * 256 * D * 2; S.tstepA = 256u * D * 2; S.tstepB = 256u * D;
                    pg8::EpiSwiGLU8 E{DH, FF};
                    for (int rep_ = 0; rep_ < ((PROBE_MASK & 2) ? 2 : 1); ++rep_) pg8::gemm_phase<pg8::EpiSwiGLU8, pg8::DenseSched, false, true>(C.lds, idxbuf, C.wave, D / 128, D * 2, D, S, E, SC_ONE, SC_GU);
                } else {
                    S.A = (const char*)((fused0 ? C.HB : C.XN) + (size_t)pm0 * 256 * D); S.tstepA = 256u * D * 2; S.tstepB = 256u * D * 2;
                    if constexpr (fused0) { pg8::EpiSwiGLU8R E{DH, FF, (const unsigned long long*)(C.ws + WS_ROWSQ) + (size_t)2 * 65536};
                        pg8::gemm_phase<pg8::EpiSwiGLU8R, pg8::DenseSched, false>(C.lds, idxbuf, C.wave, D / 64, D * 2, D * 2, S, E); }
                    else if constexpr (dn8) { pg8::EpiSwiGLU8 E{DH, FF};
                        pg8::gemm_phase<pg8::EpiSwiGLU8, pg8::DenseSched, false>(C.lds, idxbuf, C.wave, D / 64, D * 2, D * 2, S, E); }
                    else { pg8::EpiSwiGLU E{(bf16*)DH, FF};
                        for (int rep_ = 0; rep_ < ((PROBE_MASK & 1) ? 2 : 1); ++rep_) pg8::gemm_phase<pg8::EpiSwiGLU, pg8::DenseSched, false>(C.lds, idxbuf, C.wave, D / 64, D * 2, D * 2, S, E); }
                }
            }
            SEAM();
            if (RUN()) {
                pg8::DenseSched S; S.nM = nM; S.nN = 4; S.G = C.G; S.c = (int)blockIdx.x; S.A = (const char*)DH; S.a_colstep = 0; S.Bt = (const char*)(C.ws + WS_WDN + (size_t)lp * DN_BYTES);
                if (dn8) meta_resid<true>(C, (const char*)DH + (size_t)MROWS * FF, 128, 32768u, S.Bt, 256u * FF, 128, 32768u, FF / 128, SC_H, SC_DN);
                else meta_resid<false>(C, (const char*)DH + (size_t)MROWS * FF * 2, 128, 32768u, S.Bt, 256u * FF * 2, 128, 32768u, FF / 64, 0, 0);
                constexpr int PB = dn8 ? 2 : 1, NR = (PROBE_MASK & PB) ? 2 : 1;
                typedef pg8::EpiResid<false, false, true> EpiDN;
                EpiDN E{C.HB, nullptr, nullptr, pm0 * 256, nullptr, nullptr, 1.0f / NR, (unsigned long long*)(C.ws + WS_ROWSQ) + (size_t)lp * 65536};
                if (dn8) { S.tstepA = 256u * FF; S.tstepB = 256u * FF;
                    for (int rep_ = 0; rep_ < NR; ++rep_) pg8::gemm_phase<EpiDN, pg8::DenseSched, false, true>(C.lds, idxbuf, C.wave, FF / 128, 128, 128, S, E, SC_H, SC_DN, 32768u, 32768u); }
                else { S.tstepA = 256u * FF * 2; S.tstepB = 256u * FF * 2;
                    for (int rep_ = 0; rep_ < NR; ++rep_) pg8::gemm_phase<EpiDN, pg8::DenseSched, false>(C.lds, idxbuf, C.wave, FF / 64, 128, 128, S, E, 0x7f7f7f7f, 0x7f7f7f7f, 32768u, 32768u); }
            }
            SEAM();
        }
#define BG INTER
#define UU (INTER + (size_t)RPAD * D)
        if (RUN()) {
            pg8::DenseSched S; S.nM = MROWS / 256; S.nN = 12; S.G = C.G; S.c = (int)blockIdx.x; S.A = (const char*)C.HB; S.Bt = (const char*)(C.ws + WS_WIN + (size_t)lp * 3 * D * D * 2);
            meta_convin(C, (const char*)(C.HB + (size_t)MROWS * D), S.Bt, BG, UU);
            S.tstepA = 256u * D * 2; S.tstepB = 256u * D * 2; S.a_colstep = 0;
            pg8::EpiConvIn E{BG, UU, (const unsigned long long*)(C.ws + WS_ROWSQ) + (size_t)lp * 65536};
            for (int rep_ = 0; rep_ < ((PROBE_MASK & 4) ? 2 : 1); ++rep_) pg8::gemm_phase<pg8::EpiConvIn, pg8::DenseSched, false>(C.lds, idxbuf, C.wave, D / 64, D * 2, D * 2, S, E);
        }
        SEAM();
#define gcnt ((unsigned*)(C.ws + WS_CTL) + CW_MOECNT + lp * 8 * 64)
        if (RUN()) {
            phase_conv(C, PRM + PP_CONV_K + lp * 3 * D, BG, UU, C.XN, true);
            asm volatile("s_waitcnt vmcnt(0)" ::: "memory"); __syncthreads();
            pg8::PanelSched S; S.nN = 4; S.G = C.G; S.c = C.vcu; S.meta = false; S.A = (const char*)C.XN; S.Bt = (const char*)(C.ws + WS_WOUT + (size_t)lp * D * D * 2);
            meta_resid<false, true>(C, (const char*)(C.XN + (size_t)MROWS * D), D * 2, 128u, S.Bt, 256u * D * 2, D * 2, 128u, D / 64, 0, 0);
            { volatile LAS unsigned* mflag = (volatile LAS unsigned*)(C.lds + MISC_OFF + 48);
              const int nblk = C.G < D / 16 ? C.G : D / 16;
              if (C.tid == 0) { unsigned lastf = 0u;
                  if ((int)blockIdx.x < nblk) { asm volatile("s_waitcnt vmcnt(0)" ::: "memory");
                      const unsigned old_ = __hip_atomic_fetch_add(C.ctl + CW_METACNT + lp * 64, 1u, __ATOMIC_RELAXED, __HIP_MEMORY_SCOPE_AGENT); lastf = (old_ == (unsigned)(nblk - 1)) ? 1u : 0u; }
                  *mflag = lastf; } }
            S.tstepA = 256u * D * 2; S.tstepB = 256u * D * 2; S.a_colstep = 0;
            pg8::EpiResid<false, false> E{C.HB, nullptr, nullptr, 0, nullptr, nullptr, 1.0f};
            pg8::gemm_phase<pg8::EpiResid<false, false>, pg8::PanelSched, false>(C.lds, idxbuf, C.wave, D / 64, D * 2, D * 2, S, E);
            if (C.wave == 0) { __builtin_amdgcn_fence(__ATOMIC_ACQUIRE, "agent"); asm volatile("s_waitcnt vmcnt(0)" ::: "memory"); }
            __syncthreads();
            const bool do_meta = *(volatile LAS unsigned*)(C.lds + MISC_OFF + 48) != 0u;
            phase_router(C, PRM + PP_MOE_NORM + lp * D, PRM + PP_ROUTER + lp * D * NE, gcnt, C.vcu, do_meta);
        }
        SEAM();
        for (int pass = 0; pass < MOE_PASSES; ++pass) {
            if (RUN()) {
                pg8::MoeSched S; moe_sched_init(S, C, gcnt, pass, FF / 128);
                S.A = (const char*)(C.ws + (MOE_GU_FMT == 6 ? WS_XN6 : WS_XN)); S.tstepA = 0; S.rowidx = (const unsigned*)(C.ws + WS_ROWIDX);
                pg8::EpiSwiGLU8 E{C.ws + WS_H8MOE, FF};
                if (MOE_GU_FMT == 6) {
                    S.Bt = (const char*)(C.ws + WS_WMGU + (size_t)lp * NE * GU6_BYTES); S.estepB = (unsigned)GU6_BYTES; S.tstepB = 256u * 768;
                    pg8::gemm_phase6<pg8::EpiSwiGLU8, pg8::MoeSched, true>(C.lds, idxbuf, C.wave, D / 128, S, E, SC_X6, SC_GU);
                } else {
                    S.Bt = (const char*)(C.ws + WS_WMGU + (size_t)lp * NE * GU8_BYTES); S.estepB = (unsigned)GU8_BYTES; S.tstepB = 256u * D;
                    pg8::gemm_phase<pg8::EpiSwiGLU8, pg8::MoeSched, true, true>(C.lds, idxbuf, C.wave, D / 128, D, D, S, E, SC_ONE, SC_GU);
                }
            }
            SEAM();
            if (RUN()) {
                pg8::MoeSched S; moe_sched_init(S, C, gcnt, pass, 4);
                S.A = (const char*)(C.ws + WS_H8MOE); S.tstepA = 256u * FF; S.Bt = (const char*)(C.ws + WS_WMDN + (size_t)lp * NE * DN8_BYTES); S.estepB = (unsigned)DN8_BYTES; S.tstepB = 256u * FF; S.rowidx = nullptr;
                constexpr int NR = (PROBE_MASK & 16) ? 2 : 1;
                pg8::EpiMoeDown E{(const int2*)(C.ws + WS_SLOT), C.HB, C.Y1, 1.0f / NR};
                for (int rep_ = 0; rep_ < NR; ++rep_) pg8::gemm_phase<pg8::EpiMoeDown, pg8::MoeSched, false, true>(C.lds, idxbuf, C.wave, FF / 128, 128, 128, S, E, SC_H, SC_DN, 32768u, 32768u);
                if constexpr (lp == 0 && MOE_L1_CONV_IN_TAIL) {
                    const int extra = (S.nM * 4) % C.G, c = (int)blockIdx.x;
                    if (c >= extra) convert_moe_layer(C, args, 1, (c - extra) * NWAVES + C.wave, (C.G - extra) * NWAVES); }
            }
            SEAM();
        }
}

__global__ void __launch_bounds__(NWAVES * 64, 2) fwd(Args args) {
    extern __shared__ __attribute__((aligned(16))) unsigned char lds_raw[];
    Ctx C;
    C.lds = (LAS unsigned char*)lds_raw;
    C.tid = threadIdx.x; C.lane = C.tid & 63; C.wave0 = __builtin_amdgcn_readfirstlane(C.tid >> 6); C.wave = C.wave0;
    C.G = gridDim.x; { const int bx = blockIdx.x; C.vcu = (C.G % 8 == 0) ? (bx % 8) * (C.G / 8) + bx / 8 : bx; }
    C.gw0 = C.vcu * NWAVES + C.wave; C.gw = C.gw0; C.NGW = C.G * NWAVES;
    C.ws = args.ws; C.HB = (bf16*)(args.ws + WS_H32); C.XN = (bf16*)(args.ws + WS_XN); C.Y1 = (bf16*)(args.ws + WS_Y1); C.RSTD = (float*)(args.ws + WS_RSTD);
    C.ctl = (unsigned*)(args.ws + WS_CTL);
    LAS unsigned* idxbuf = (LAS unsigned*)(C.lds + IDX_OFF);
    volatile LAS unsigned* MISC = (volatile LAS unsigned*)(C.lds + MISC_OFF);
    for (int u = C.tid; u < (LDS_BYTES - IDX_OFF) / 4; u += NWAVES * 64) ((LAS unsigned*)(C.lds + IDX_OFF))[u] = 0u;
    __syncthreads();
    const int lo = args.ph_lo, hi = args.ph_hi;
    XcdBarrier bar; bar.bar = C.ctl + CW_BAR; bar.x = 0; bar.st = nullptr;
    if (hi - lo > 1) bar = xcd_barrier_post(C.ctl + CW_BAR, MISC + 8);
    int ph = 0;
    if (PROBE_TMASK != 0u && blockIdx.x == 0 && C.wave0 == 0 && lane_id() == 0) { volatile LAS unsigned long long* PW = (volatile LAS unsigned long long*)(C.lds + MISC_OFF + 64); PW[0] = __builtin_amdgcn_s_memrealtime(); PW[1] = __builtin_amdgcn_s_memtime(); }
    if (RUN()) REPE { copy_params(C, args); convert_small_weights(C, args); convert_moe_layer(C, args, 0); if (!MOE_L1_CONV_IN_TAIL) convert_moe_layer(C, args, 1); }
    SEAM();

    layer_pair<0>(C, args, ph, lo, hi, bar, idxbuf);
    layer_pair<1>(C, args, ph, lo, hi, bar, idxbuf);
    if (RUN()) REPE phase_final(C, PRM + PP_FINAL, args.out);
    SEAM();
    if (PROBE_TMASK != 0u && hi == N_PHASES && blockIdx.x == 0 && C.wave0 == 0) {
        volatile LAS unsigned long long* PW = (volatile LAS unsigned long long*)(C.lds + MISC_OFF + 64);
        unsigned long long ticks = PW[2];
        if (PROBE_CLK) ticks = PW[2] ? (PW[3] * 100ull / PW[2]) * 25ull : 0ull;
        const unsigned long long t0 = __builtin_amdgcn_s_memrealtime();
        while (__builtin_amdgcn_s_memrealtime() - t0 < ticks) __builtin_amdgcn_s_sleep(32);
    }
#undef RUN
#undef SEAM
#undef INTER
#undef PRM
#undef BG
#undef UU
#undef gcnt
}

extern "C" void kernel_launch(void* const* d_in, const int* in_sizes, int n_in, void* d_out, int out_size, void* d_ws, size_t ws_size, hipStream_t stream) {
    static int grid = 0;
    if (grid == 0) {
        if (n_in != 19 || in_sizes[0] != MROWS * D || out_size != MROWS * D || ws_size < WS_END) {
            fprintf(stderr, "kernel_launch: unexpected problem (n_in %d, in0 %d, out %d, ws %zu < %zu); nothing launched\n", n_in, n_in > 0 ? in_sizes[0] : -1, out_size, ws_size, (size_t)WS_END); grid = -1; return; }
        int dev = 0, cus = 0, per_cu = 0;
        if (hipGetDevice(&dev) != hipSuccess || hipDeviceGetAttribute(&cus, hipDeviceAttributeMultiprocessorCount, dev) != hipSuccess) { grid = -1; return; }
        if (hipFuncSetAttribute((const void*)fwd, hipFuncAttributeMaxDynamicSharedMemorySize, LDS_BYTES) != hipSuccess) { fprintf(stderr, "kernel_launch: hipFuncSetAttribute failed\n"); grid = -1; return; }
        if (hipOccupancyMaxActiveBlocksPerMultiprocessor(&per_cu, (const void*)fwd, NWAVES * 64, LDS_BYTES) != hipSuccess || per_cu < 1)
            fprintf(stderr, "kernel_launch: occupancy query reports %d workgroups per CU\n", per_cu);
        (void)hipGetLastError();
        grid = cus;
    }
    if (grid < 0) return;
    if (hipMemsetAsync((char*)d_ws + WS_ROWSQ, 0, ROWSQ_BYTES, stream) != hipSuccess) { fprintf(stderr, "kernel_launch: memset failed\n"); return; }
    if (hipMemsetAsync((char*)d_ws + WS_CTL, 0, CTL_ZERO_BYTES, stream) != hipSuccess) { fprintf(stderr, "kernel_launch: memset failed\n"); return; }
    Args a{};
    for (int i = 0; i < 19; ++i) a.in[i] = (const float*)d_in[i];
    a.out = (float*)d_out; a.ws = (unsigned char*)d_ws;
#if MK_ONE_LAUNCH
    a.ph_lo = 0; a.ph_hi = N_PHASES;
    hipLaunchKernelGGL(fwd, dim3(grid), dim3(NWAVES * 64), LDS_BYTES, stream, a);
#else
    for (int p = 0; p < N_PHASES; ++p) { a.ph_lo = p; a.ph_hi = p + 1; hipLaunchKernelGGL(fwd, dim3(grid), dim3(NWAVES * 64), LDS_BYTES, stream, a); }
#endif
    const hipError_t le = hipPeekAtLastError();
    if (le != hipSuccess) fprintf(stderr, "kernel_launch: launch failed: %s\n", hipGetErrorName(le));
}
```

```cpp
#include <hip/hip_runtime.h>
#include <cstdio>
#include <cstdint>
#include <type_traits>

#ifndef PROBE_REP_ELT
#define PROBE_REP_ELT 1
#endif
#ifndef PROBE_TMASK
#define PROBE_TMASK 0u
#endif
#ifndef PROBE_EPI
#define PROBE_EPI 0
#endif
#ifndef PROBE_HOTA
#define PROBE_HOTA 0
#endif
#ifndef PROBE_CLK
#define PROBE_CLK 0
#endif
#ifndef PROBE_MASK
#define PROBE_MASK 0
#endif
#ifndef PROBE_REP_GEMM
#define PROBE_REP_GEMM 1
#endif
#ifndef MK_ONE_LAUNCH
#define MK_ONE_LAUNCH 1
#endif

constexpr int D = 1024, FF = 3584, NE = 8, NB = 32, TS = 2048, NMETA = 16;
constexpr int MROWS = NB * TS;
constexpr int RTOT = MROWS + NMETA;
constexpr int MT_ALL = 257;
constexpr int RPAD = MT_ALL * 256;
constexpr int CAP = RPAD;
constexpr float EPS = 1e-6f;
constexpr int NWAVES = 8;
constexpr int MOE_CH = 256, MOE_PASSES = 1;
constexpr int MOE_LAST_MAX = 528;
constexpr float W_GU_SCALE = 64.f, W_DN_SCALE = 128.f, H8_SCALE = 4.f;
constexpr int MOE_GU_FMT = 6;
constexpr float X6_SCALE = 2.0f;
constexpr int SC_X6 = 0x7e7e7e7e  ;
constexpr size_t GU6_BYTES = (size_t)7168 * 768;
constexpr int SC_ONE = 0x7f7f7f7f, SC_GU = 0x79797979  , SC_DN = 0x78787878  , SC_H = 0x7d7d7d7d  ;
constexpr int DENSE_H0 = 128;
constexpr bool MOE_L1_CONV_IN_TAIL = true;
constexpr bool DENSE_NORM_FUSED_L0 = true;
constexpr bool DENSE_DN8_L0 = true;
constexpr int DENSE_FP8_LAYER = 1;

constexpr size_t MiB = 1u << 20;
constexpr size_t WS_CTL = 0, CTL_ZERO_BYTES = 1 * MiB;
constexpr size_t WS_WPOOL = 1 * MiB;
constexpr size_t WS_WGU = 2 * MiB;
constexpr size_t WS_WDN = 30 * MiB;
constexpr size_t WS_WIN = 44 * MiB;
constexpr size_t WS_WOUT = 56 * MiB;
constexpr size_t WS_WMGU = 60 * MiB;
constexpr size_t WS_WMDN = 172 * MiB;
constexpr size_t WS_ROWIDX = 228 * MiB;
constexpr size_t WS_SLOT = 231 * MiB;
constexpr size_t WS_RSTD = 236 * MiB;
constexpr size_t WS_PARAMS = 236 * MiB + 512 * 1024;
constexpr int PP_POOL_NORM = 0, PP_POOL_SCALE = 2048, PP_DENSE_NORM = 4096, PP_CONV_NORM = 6144, PP_MOE_NORM = 8192, PP_FINAL = 10240, PP_CONV_K = 11264, PP_ROUTER = 17408, PP_TOTAL = 17408 + 16384;
constexpr size_t WS_H32 = 237 * MiB;
constexpr size_t WS_Y1 = 366 * MiB;
constexpr size_t WS_XN = 495 * MiB;
constexpr size_t WS_XN6 = 366 * MiB;
constexpr size_t WS_H8MOE = 560 * MiB;
constexpr size_t WS_INTER = 624 * MiB;
constexpr size_t WS_DENSEH = WS_INTER;
constexpr size_t WS_ROWSQ = 1022 * MiB;
constexpr size_t ROWSQ_BYTES = (size_t)3 * 65536 * 8;
constexpr size_t WS_END = 1024 * MiB;
constexpr size_t GU_BYTES = (size_t)7168 * 1024 * 2, DN_BYTES = (size_t)1024 * 3584 * 2, GU8_BYTES = GU_BYTES / 2, DN8_BYTES = DN_BYTES / 2;
static_assert(WS_ROWIDX + (size_t)8 * CAP * 4 <= WS_SLOT && WS_SLOT + (size_t)8 * CAP * 8 <= WS_RSTD, "lists");
static_assert(WS_H32 + (size_t)RPAD * D * 2 <= WS_Y1 && WS_Y1 + (size_t)RPAD * D * 2 <= WS_XN && WS_XN + (size_t)RPAD * D * 2 <= WS_INTER && WS_XN6 == WS_Y1 && (size_t)RTOT * 1024 <= (size_t)RPAD * D * 2 && WS_H8MOE + (size_t)MOE_LAST_MAX * 256 * FF <= WS_ROWSQ && WS_ROWSQ + ROWSQ_BYTES <= WS_END, "act map");
static_assert((size_t)RPAD * FF <= WS_ROWSQ - WS_INTER && (size_t)2 * RPAD * D * 2 <= WS_ROWSQ - WS_INTER, "inter");
constexpr int CW_BAR = 4096;
constexpr int CW_METACNT = 20480;
constexpr int CW_MOECNT = 16384;

constexpr int RING_BYTES = 131072;
constexpr int IDX_OFF = RING_BYTES;
constexpr int MISC_OFF = IDX_OFF + 2048;
constexpr int TOUCH_OFF = MISC_OFF + 1024;
constexpr int LDS_BYTES = 147456;

#define GAS __attribute__((address_space(1)))
#define LAS __attribute__((address_space(3)))
typedef unsigned short bf16;
typedef float f32x4 __attribute__((ext_vector_type(4)));
typedef unsigned v4u __attribute__((ext_vector_type(4)));
typedef unsigned v2u __attribute__((ext_vector_type(2)));
#define LDS_WAIT() asm volatile("s_waitcnt lgkmcnt(0)" ::: "memory")
#define VM_WAIT() asm volatile("s_waitcnt vmcnt(0)" ::: "memory")

__device__ __forceinline__ int lane_id() { int l; asm volatile("v_mbcnt_lo_u32_b32 %0, -1, 0\n\tv_mbcnt_hi_u32_b32 %0, -1, %0" : "=v"(l)); return l; }
__device__ __forceinline__ unsigned cvt_pk_bf16(float lo, float hi) { unsigned r; asm volatile("v_cvt_pk_bf16_f32 %0, %1, %2" : "=v"(r) : "v"(lo), "v"(hi)); return r; }
__device__ __forceinline__ unsigned pk4_fp8(float a, float b, float c, float d) { int w = __builtin_amdgcn_cvt_pk_fp8_f32(a, b, 0, false); w = __builtin_amdgcn_cvt_pk_fp8_f32(c, d, w, true); return (unsigned)w; }
__device__ __forceinline__ float bf_lo(unsigned w) { return __uint_as_float(w << 16); }
__device__ __forceinline__ float bf_hi(unsigned w) { return __uint_as_float(w & 0xffff0000u); }
#define DPP_F(v, ctrl) __int_as_float(__builtin_amdgcn_update_dpp(0, __float_as_int(v), (ctrl), 0xF, 0xF, true))
__device__ __forceinline__ float row16_sum(float v) {
    v += DPP_F(v, 0xB1);     v += DPP_F(v, 0x4E);
    v += DPP_F(v, 0x141);        v += DPP_F(v, 0x140);
    return v;
}
__device__ __forceinline__ float wave_sum(float v, int lane) {
    (void)lane; v = row16_sum(v);
    const float a = __int_as_float(__builtin_amdgcn_readlane(__float_as_int(v), 0)), b = __int_as_float(__builtin_amdgcn_readlane(__float_as_int(v), 16));
    const float c = __int_as_float(__builtin_amdgcn_readlane(__float_as_int(v), 32)), d = __int_as_float(__builtin_amdgcn_readlane(__float_as_int(v), 48));
    return (a + b) + (c + d);
}
typedef float f32x2 __attribute__((ext_vector_type(2)));
__device__ __forceinline__ f32x2 silu_mul_pk(f32x2 g, f32x2 u, float inv) {
    const f32x2 t = g * -1.44269504f; f32x2 e; e.x = __builtin_amdgcn_exp2f(t.x); e.y = __builtin_amdgcn_exp2f(t.y);
    const f32x2 d = e * inv + inv; f32x2 r; r.x = __builtin_amdgcn_rcpf(d.x); r.y = __builtin_amdgcn_rcpf(d.y);
    return (g * u) * r;
}
__device__ __forceinline__ float silu_f(float a) { return a * __builtin_amdgcn_rcpf(1.0f + __builtin_amdgcn_exp2f(a * -1.44269504f)); }

#define XB_TMO      128
#define XB_XCNT(j)  (256  + 64 * (j))
#define XB_XSUB(j)  (1280 + 64 * (j))
#define XB_XGEN(j)  (2304 + 64 * (j))
#define XB_TOP      3328
#define XB_TOPGEN   3392
#define XCD_BAR_WORDS 3456
#define XB_SPIN_CAP (1u << 18)
__device__ __forceinline__ unsigned xb_ld(unsigned* p)              { return __hip_atomic_load(p, __ATOMIC_RELAXED, __HIP_MEMORY_SCOPE_AGENT); }
__device__ __forceinline__ unsigned xb_add(unsigned* p, unsigned v) { return __hip_atomic_fetch_add(p, v, __ATOMIC_RELAXED, __HIP_MEMORY_SCOPE_AGENT); }
__device__ __forceinline__ unsigned xb_xcc_id() { return (unsigned)__builtin_amdgcn_s_getreg((3 << 11) | 20) & 0xFu; }
#define XB_SPIN(cond, bar) do { unsigned _sp = 0; while (cond) { __builtin_amdgcn_s_sleep(1); \
    if ((++_sp & 255u) == 0u) { if (xb_ld(&(bar)[XB_TMO])) break; if (_sp > XB_SPIN_CAP) { atomicAdd(&(bar)[XB_TMO], 1u); break; } } } } while (0)
struct XcdBarrier { unsigned* bar; unsigned x; volatile LAS unsigned* st; };
__device__ __forceinline__ XcdBarrier xcd_barrier_post(unsigned* bar, volatile LAS unsigned* st) {
    XcdBarrier b; b.bar = bar; b.x = xb_xcc_id(); b.st = st;
    if (threadIdx.x == 0) (void)xb_add(&bar[XB_XCNT(b.x)], 1u);
    return b;
}
__device__ __forceinline__ void xcd_barrier_complete(unsigned* bar, unsigned x, unsigned& nloc, unsigned& nx) {
    const unsigned G = gridDim.x * gridDim.y * gridDim.z;
    unsigned sum, cnt, mine, sp = 0u;
    for (;;) {
        sum = 0u; cnt = 0u; mine = 0u;
#pragma unroll
        for (unsigned j = 0; j < 16; ++j) { const unsigned c = xb_ld(&bar[XB_XCNT(j)]); sum += c; cnt += (c > 0u) ? 1u : 0u; mine = (j == x) ? c : mine; }
        if (sum == G) break;
        __builtin_amdgcn_s_sleep(1);
        if ((++sp & 255u) == 0u) { if (xb_ld(&bar[XB_TMO])) break; if (sp > XB_SPIN_CAP) { atomicAdd(&bar[XB_TMO], 1u); break; } }
    }
    nloc = mine > 0u ? mine : 1u; nx = cnt > 0u ? cnt : 1u;
}
__device__ __forceinline__ void xcd_barrier(const XcdBarrier& b, const int wave  ) {
    asm volatile("s_waitcnt vmcnt(0)" ::: "memory");
    __syncthreads();
    if (wave == 0 && lane_id() == 0) {
        size_t z_ = 0; asm volatile("" : "+s"(z_)); unsigned* bar = b.bar + z_;
        __builtin_amdgcn_s_waitcnt(0);
        unsigned nloc = b.st[0], nx = b.st[1];
        if (nloc == 0u) { xcd_barrier_complete(bar, b.x, nloc, nx); b.st[0] = nloc; b.st[1] = nx; }
        const unsigned old = xb_add(&bar[XB_XSUB(b.x)], 1u);
        const unsigned gen = old / nloc;
        if (old + 1u == (gen + 1u) * nloc) {
            __builtin_amdgcn_fence(__ATOMIC_RELEASE, "agent");
            asm volatile("s_waitcnt vmcnt(0)" ::: "memory");
            const unsigned og = xb_add(&bar[XB_TOP], 1u);
            const unsigned tg = og / nx;
            if (og + 1u == (tg + 1u) * nx) xb_add(&bar[XB_TOPGEN], 1u);
            else XB_SPIN(xb_ld(&bar[XB_TOPGEN]) == tg, bar);
            __builtin_amdgcn_fence(__ATOMIC_ACQUIRE, "agent");
            xb_add(&bar[XB_XGEN(b.x)], 1u);
            asm volatile("s_waitcnt vmcnt(0)" ::: "memory");
        } else {
            XB_SPIN(xb_ld(&bar[XB_XGEN(b.x)]) == gen, bar);
            __builtin_amdgcn_fence(__ATOMIC_ACQUIRE, "agent");
            asm volatile("s_waitcnt vmcnt(0)" ::: "memory");
        }
    }
    __syncthreads();
}

namespace pg8 {
typedef short bf16x8 __attribute__((ext_vector_type(8)));
constexpr int BM = 256, BK = 64, HALF = 128, HTB = HALF * BK * 2, STAGE_BYTES = 8 * HTB;
static_assert(STAGE_BYTES == RING_BYTES, "ring");
__host__ __device__ __forceinline__ int lds_byte(int r, int c) { const int st = (r >> 4) * 2 + (c >> 5), rr = r & 15, cc = c & 31, ob = rr * 64 + cc * 2; return st * 1024 + (ob ^ (((ob >> 9) & 1) << 5)); }
__host__ __device__ __forceinline__ void stage_rc(int b, int& R, int& C) { const int st = b / 1024, sb = b % 1024, swz = sb ^ (((sb >> 9) & 1) << 5); R = (st >> 1) * 16 + swz / 64; C = (st & 1) * 32 + (swz % 64) / 2; }
__host__ __device__ __forceinline__ int perm32(int rho) { const int n = rho >> 4, i = rho & 15; return 8 * (i >> 2) + 4 * n + (i & 3); }

struct Unit { int pm, pn, e, rows, slot0; };

#ifndef PG8_WGM
#define PG8_WGM 8
#endif
constexpr int WGM = PG8_WGM;
__device__ __forceinline__ bool static_tile(int i, int G, int c, int nM, int nN, int& pm, int& pn) {
    const int nwg = nM * nN; const long L = (long)i * G + c; if (L >= nwg) return false;
    int wgid = (int)L; { const int q = nwg / 8, r = nwg % 8, xcd = wgid % 8, off = wgid / 8; wgid = (xcd < r ? xcd * (q + 1) : r * (q + 1) + (xcd - r) * q) + off; }
    const int nig = WGM * nN, gid = wgid / nig, fm = gid * WGM, gsz = (nM - fm) < WGM ? (nM - fm) : WGM;
    pm = fm + ((wgid % nig) % gsz); pn = (wgid % nig) / gsz; return true;
}
struct DenseSched {
    int nM, nN, G, c; const char* A; const char* Bt; unsigned tstepA, tstepB, a_colstep; int meta_pm = -1;
    __device__ __forceinline__ bool next(int i, Unit& u) const { if (!static_tile(i, G, c, nM, nN, u.pm, u.pn)) return false; u.e = 0; u.rows = (u.pm == meta_pm) ? NMETA : 256; u.slot0 = 0; return true; }
    __device__ __forceinline__ unsigned a_off(const Unit& u) const { return (unsigned)u.pm * tstepA + (unsigned)u.pn * a_colstep; }
    __device__ __forceinline__ unsigned b_off(const Unit& u) const { return (unsigned)u.pn * tstepB; }
    __device__ __forceinline__ const unsigned* idx_src(const Unit&) const { return nullptr; }
};
struct PanelSched {
    int nN, G, c; const char* A; const char* Bt; unsigned tstepA, tstepB, a_colstep; bool meta = true;
    __device__ __forceinline__ bool next(int i, Unit& u) const {
        const int nmain = c < 256 ? (256 - c + G - 1) / G : 0;
        u.e = 0; u.slot0 = 0;
        if (i < nmain * nN) { u.pm = c + (i / nN) * G; u.pn = i % nN; u.rows = 256; return true; }
        if (meta && i == nmain * nN && c < nN) { u.pm = 256; u.pn = c; u.rows = NMETA; return true; }
        return false;
    }
    __device__ __forceinline__ unsigned a_off(const Unit& u) const { return (unsigned)u.pm * tstepA + (unsigned)u.pn * a_colstep; }
    __device__ __forceinline__ unsigned b_off(const Unit& u) const { return (unsigned)u.pn * tstepB; }
    __device__ __forceinline__ const unsigned* idx_src(const Unit&) const { return nullptr; }
};
struct MoeSched {
    int nM, nN, G, c, t0; int m1, m2, m3, m4, m5, m6, m7; int n0, n1, n2, n3, n4, n5, n6, n7;
    const char* A; unsigned tstepA; const char* Bt; unsigned estepB, tstepB; const unsigned* rowidx;
    __device__ __forceinline__ bool next(int i, Unit& u) const {
        if (!static_tile(i, G, c, nM, nN, u.pm, u.pn)) return false;
        const int tg = t0 + u.pm; int e = 0, base = 0, cn = __builtin_amdgcn_readfirstlane(n0);
        if (tg >= m1) { e = 1; base = m1; cn = __builtin_amdgcn_readfirstlane(n1); }
        if (tg >= m2) { e = 2; base = m2; cn = __builtin_amdgcn_readfirstlane(n2); }
        if (tg >= m3) { e = 3; base = m3; cn = __builtin_amdgcn_readfirstlane(n3); }
        if (tg >= m4) { e = 4; base = m4; cn = __builtin_amdgcn_readfirstlane(n4); }
        if (tg >= m5) { e = 5; base = m5; cn = __builtin_amdgcn_readfirstlane(n5); }
        if (tg >= m6) { e = 6; base = m6; cn = __builtin_amdgcn_readfirstlane(n6); }
        if (tg >= m7) { e = 7; base = m7; cn = __builtin_amdgcn_readfirstlane(n7); }
        const int ti = tg - base; const int rem = cn - 256 * ti;
        u.e = e; u.rows = rem < 256 ? rem : 256; u.slot0 = e * CAP + ti * 256; return true;
    }
    __device__ __forceinline__ unsigned a_off(const Unit& u) const { return (unsigned)u.pm * tstepA; }
    __device__ __forceinline__ unsigned b_off(const Unit& u) const { return (unsigned)u.e * estepB + (unsigned)u.pn * tstepB; }
    __device__ __forceinline__ const unsigned* idx_src(const Unit& u) const { return rowidx + u.slot0; }
};

struct NoPre {};
struct EpiSwiGLU {
    static constexpr bool PERM = true; typedef NoPre Pre;
    __device__ __forceinline__ void load(Pre&, const Unit&, int, int, int, int) const {}
    bf16* H; int ldh;
    __device__ __forceinline__ void operator()(const f32x4 (&acc)[2][2][4][2], const Unit& u, int wr, int wc, int fr, int fq, const Pre&) const {
        const int row0 = u.pm * BM + wr * 64 + fr, col0 = u.pn * 128 + wc * 32 + 8 * fq;
#pragma unroll
        for (int ai = 0; ai < 2; ++ai)
#pragma unroll
            for (int m = 0; m < 4; ++m) {
                bf16* p = H + (size_t)u.pm * BM * ldh + (size_t)(2 * u.pn + (wc >> 1)) * (BM * 64) + (size_t)(wr * 64 + fr + ai * HALF + m * 16) * 64 + (wc & 1) * 32 + 8 * fq;
                const f32x4 g0 = acc[ai][0][m][0], g1 = acc[ai][0][m][1], u0 = acc[ai][1][m][0], u1 = acc[ai][1][m][1];
                const f32x2 a = silu_mul_pk((f32x2){g0[0], g0[1]}, (f32x2){u0[0], u0[1]}, 1.0f), b = silu_mul_pk((f32x2){g0[2], g0[3]}, (f32x2){u0[2], u0[3]}, 1.0f);
                const f32x2 c = silu_mul_pk((f32x2){g1[0], g1[1]}, (f32x2){u1[0], u1[1]}, 1.0f), d = silu_mul_pk((f32x2){g1[2], g1[3]}, (f32x2){u1[2], u1[3]}, 1.0f);
                v4u w; w.x = cvt_pk_bf16(a.x, a.y); w.y = cvt_pk_bf16(b.x, b.y); w.z = cvt_pk_bf16(c.x, c.y); w.w = cvt_pk_bf16(d.x, d.y);
                *(v4u*)p = w; }
    }
};
struct EpiSwiGLU8 {
    static constexpr bool PERM = true; typedef NoPre Pre;
    __device__ __forceinline__ void load(Pre&, const Unit&, int, int, int, int) const {}
    unsigned char* H; int ldh;
    __device__ __forceinline__ void operator()(const f32x4 (&acc)[2][2][4][2], const Unit& u, int wr, int wc, int fr, int fq, const Pre&) const {
        const int row0 = u.pm * BM + wr * 64 + fr, col0 = u.pn * 128 + wc * 32 + 8 * fq;
#pragma unroll
        for (int ai = 0; ai < 2; ++ai)
#pragma unroll
            for (int m = 0; m < 4; ++m) {
                unsigned char* p = H + (size_t)u.pm * BM * ldh + (size_t)u.pn * (BM * 128) + (size_t)(wr * 64 + fr + ai * HALF + m * 16) * 128 + wc * 32 + 8 * fq;
                const f32x4 g0 = acc[ai][0][m][0], g1 = acc[ai][0][m][1], u0 = acc[ai][1][m][0], u1 = acc[ai][1][m][1];
                constexpr float inv = 1.0f / H8_SCALE;
                const f32x2 a = silu_mul_pk((f32x2){g0[0], g0[1]}, (f32x2){u0[0], u0[1]}, inv), b = silu_mul_pk((f32x2){g0[2], g0[3]}, (f32x2){u0[2], u0[3]}, inv);
                const f32x2 c = silu_mul_pk((f32x2){g1[0], g1[1]}, (f32x2){u1[0], u1[1]}, inv), d = silu_mul_pk((f32x2){g1[2], g1[3]}, (f32x2){u1[2], u1[3]}, inv);
                v2u w; w.x = pk4_fp8(a.x, a.y, b.x, b.y); w.y = pk4_fp8(c.x, c.y, d.x, d.y);
                *(v2u*)p = w; }
    }
};
struct EpiSwiGLU8R {
    static constexpr bool PERM = true;
    struct Pre { unsigned long long q[2][4]; };
    unsigned char* H; int ldh; const unsigned long long* rowsq;
    __device__ __forceinline__ void load(Pre& P, const Unit& u, int wr, int, int fr, int) const {
#pragma unroll
        for (int ai = 0; ai < 2; ++ai)
#pragma unroll
            for (int m = 0; m < 4; ++m) P.q[ai][m] = rowsq[u.pm * BM + wr * 64 + fr + ai * HALF + m * 16];
    }
    __device__ __forceinline__ void operator()(const f32x4 (&acc)[2][2][4][2], const Unit& u, int wr, int wc, int fr, int fq, const Pre& P) const {
#pragma unroll
        for (int ai = 0; ai < 2; ++ai)
#pragma unroll
            for (int m = 0; m < 4; ++m) {
                unsigned char* p = H + (size_t)u.pm * BM * ldh + (size_t)u.pn * (BM * 128) + (size_t)(wr * 64 + fr + ai * HALF + m * 16) * 128 + wc * 32 + 8 * fq;
                const float rs = __frsqrt_rn((float)P.q[ai][m] * (1.0f / 1048576.0f / D) + EPS);
                const f32x4 g0 = acc[ai][0][m][0] * rs, g1 = acc[ai][0][m][1] * rs, u0 = acc[ai][1][m][0] * rs, u1 = acc[ai][1][m][1] * rs;
                constexpr float inv = 1.0f / H8_SCALE;
                const f32x2 a = silu_mul_pk((f32x2){g0[0], g0[1]}, (f32x2){u0[0], u0[1]}, inv), b = silu_mul_pk((f32x2){g0[2], g0[3]}, (f32x2){u0[2], u0[3]}, inv);
                const f32x2 c = silu_mul_pk((f32x2){g1[0], g1[1]}, (f32x2){u1[0], u1[1]}, inv), d = silu_mul_pk((f32x2){g1[2], g1[3]}, (f32x2){u1[2], u1[3]}, inv);
                v2u w; w.x = pk4_fp8(a.x, a.y, b.x, b.y); w.y = pk4_fp8(c.x, c.y, d.x, d.y);
                *(v2u*)p = w; }
    }
};
template <bool XIN  , bool Y1  , bool SQ = false  >
struct EpiResid {
    static constexpr bool PERM = true;
    struct PreH { v4u b[2][4][2]; };
    static constexpr bool USE_PRE = !XIN && !Y1;
    typedef typename std::conditional<USE_PRE, PreH, NoPre>::type Pre;
    bf16* h; const bf16* y1; const float* scale; int row_off; const float* xin; const float* meta; float ps = 1.0f; unsigned long long* rowsq = nullptr;
    __device__ __forceinline__ void load(Pre& P, const Unit& u, int wr, int wc, int fr, int fq) const {
        if constexpr (USE_PRE) {
            const int row0 = row_off + u.pm * BM + wr * 64 + fr, col0 = u.pn * BM + wc * 32 + 8 * fq;
#pragma unroll
            for (int ai = 0; ai < 2; ++ai)
#pragma unroll
                for (int m = 0; m < 4; ++m) { const size_t off = (size_t)(row0 + ai * HALF + m * 16) * D + col0;
#pragma unroll
                    for (int bj = 0; bj < 2; ++bj) P.b[ai][m][bj] = *(const v4u*)(h + off + bj * HALF); }
        }
    }
    __device__ __forceinline__ void operator()(const f32x4 (&acc)[2][2][4][2], const Unit& u, int wr, int wc, int fr, int fq, const Pre& P) const {
        const int row0 = row_off + u.pm * BM + wr * 64 + fr, col0 = u.pn * BM + wc * 32 + 8 * fq;
#pragma unroll
        for (int ai = 0; ai < 2; ++ai) {
            v4u yy[4][2], hh[4][2];
            if constexpr (Y1) {
#pragma unroll
                for (int m = 0; m < 4; ++m) { const size_t off = (size_t)(row0 + ai * HALF + m * 16) * D + col0;
#pragma unroll
                    for (int bj = 0; bj < 2; ++bj) { yy[m][bj] = *(const v4u*)(y1 + off + bj * HALF); hh[m][bj] = *(const v4u*)(h + off + bj * HALF); } } }
            float sq[4] = {0.f, 0.f, 0.f, 0.f};
#pragma unroll
            for (int m = 0; m < 4; ++m) { const int row = row0 + ai * HALF + m * 16; const size_t off = (size_t)row * D + col0;
#pragma unroll
                for (int bj = 0; bj < 2; ++bj) {
                    f32x4 b0, b1;
                    if constexpr (XIN) { const int mr = (row - MROWS) < NMETA ? (row - MROWS) : NMETA - 1; const float* src = (row < MROWS ? xin + off : meta + (size_t)mr * D + col0) + bj * HALF;
                        b0 = *(const f32x4*)src; b1 = *(const f32x4*)(src + 4); }
                    else { v4u v; if constexpr (USE_PRE) v = P.b[ai][m][bj]; else v = hh[m][bj]; b0 = (f32x4){bf_lo(v.x), bf_hi(v.x), bf_lo(v.y), bf_hi(v.y)}; b1 = (f32x4){bf_lo(v.z), bf_hi(v.z), bf_lo(v.w), bf_hi(v.w)}; }
                    if constexpr (Y1) { const v4u y = yy[m][bj]; b0 += (f32x4){bf_lo(y.x), bf_hi(y.x), bf_lo(y.y), bf_hi(y.y)}; b1 += (f32x4){bf_lo(y.z), bf_hi(y.z), bf_lo(y.w), bf_hi(y.w)}; }
                    f32x4 s0 = (f32x4){ps, ps, ps, ps}, s1 = s0;
                    if (scale) { s0 = *(const f32x4*)(scale + col0 + bj * HALF) * ps; s1 = *(const f32x4*)(scale + col0 + bj * HALF + 4) * ps; }
                    const f32x4 v0 = b0 + acc[ai][bj][m][0] * s0, v1 = b1 + acc[ai][bj][m][1] * s1;
                    v4u w; w.x = cvt_pk_bf16(v0[0], v0[1]); w.y = cvt_pk_bf16(v0[2], v0[3]); w.z = cvt_pk_bf16(v1[0], v1[1]); w.w = cvt_pk_bf16(v1[2], v1[3]);
                    *(v4u*)(h + off + bj * HALF) = w;
                    if constexpr (SQ) { const float a0 = bf_lo(w.x), a1 = bf_hi(w.x), a2 = bf_lo(w.y), a3 = bf_hi(w.y), a4 = bf_lo(w.z), a5 = bf_hi(w.z), a6 = bf_lo(w.w), a7 = bf_hi(w.w);
                        sq[m] += ((a0 * a0 + a1 * a1) + (a2 * a2 + a3 * a3)) + ((a4 * a4 + a5 * a5) + (a6 * a6 + a7 * a7)); } } }
            if constexpr (SQ) {
                const int ln = fr + 16 * fq, x16 = (ln ^ 16) << 2, x32 = (ln ^ 32) << 2;
#pragma unroll
                for (int m = 0; m < 4; ++m) { float t = sq[m]; t += __int_as_float(__builtin_amdgcn_ds_bpermute(x16, __float_as_int(t))); t += __int_as_float(__builtin_amdgcn_ds_bpermute(x32, __float_as_int(t))); sq[m] = t; }
                const float mine = fq == 0 ? sq[0] : fq == 1 ? sq[1] : fq == 2 ? sq[2] : sq[3];
                if (row0 + ai * HALF + fq * 16 < MROWS) __hip_atomic_fetch_add(rowsq + (row0 + ai * HALF + fq * 16), (unsigned long long)(mine * 1048576.0f + 0.5f), __ATOMIC_RELAXED, __HIP_MEMORY_SCOPE_AGENT); }
            asm volatile("" ::: "memory"); }
    }
};
struct EpiConvIn {
    static constexpr bool PERM = true;
    struct Pre { unsigned long long q[2][4]; };
    bf16* BG; bf16* U; const unsigned long long* rowsq;
    __device__ __forceinline__ void load(Pre& P, const Unit& u, int wr, int, int fr, int) const {
#pragma unroll
        for (int ai = 0; ai < 2; ++ai)
#pragma unroll
            for (int m = 0; m < 4; ++m) P.q[ai][m] = rowsq[u.pm * BM + wr * 64 + fr + ai * HALF + m * 16];
    }
    __device__ __forceinline__ void operator()(const f32x4 (&acc)[2][2][4][2], const Unit& u, int wr, int wc, int fr, int fq, const Pre& P) const {
        const int row0 = u.pm * BM + wr * 64 + fr;
        if (u.pn < 4) {
            const int col0 = u.pn * BM + wc * 32 + 8 * fq;
#pragma unroll
            for (int ai = 0; ai < 2; ++ai)
#pragma unroll
                for (int m = 0; m < 4; ++m) { bf16* p = BG + (size_t)(row0 + ai * HALF + m * 16) * D + col0;
                    const float rs = __frsqrt_rn((float)P.q[ai][m] * (1.0f / 1048576.0f / D) + EPS);
#pragma unroll
                    for (int bj = 0; bj < 2; ++bj) { const f32x4 v0 = acc[ai][bj][m][0] * rs, v1 = acc[ai][bj][m][1] * rs;
                        v4u w; w.x = cvt_pk_bf16(v0[0], v0[1]); w.y = cvt_pk_bf16(v0[2], v0[3]); w.z = cvt_pk_bf16(v1[0], v1[1]); w.w = cvt_pk_bf16(v1[2], v1[3]);
                        *(v4u*)(p + bj * HALF) = w; } }
        } else {
            const int col0 = (u.pn - 4) * 128 + wc * 32 + 8 * fq;
#pragma unroll
            for (int ai = 0; ai < 2; ++ai)
#pragma unroll
                for (int m = 0; m < 4; ++m) { bf16* p = U + (size_t)(row0 + ai * HALF + m * 16) * D + col0;
                    const float rs = __frsqrt_rn((float)P.q[ai][m] * (1.0f / 1048576.0f / D) + EPS);
                    const f32x4 c0 = acc[ai][0][m][0] * rs, c1 = acc[ai][0][m][1] * rs, v0 = acc[ai][1][m][0] * rs, v1 = acc[ai][1][m][1] * rs;
                    v4u w; w.x = cvt_pk_bf16(c0[0] * v0[0], c0[1] * v0[1]); w.y = cvt_pk_bf16(c0[2] * v0[2], c0[3] * v0[3]);
                    w.z = cvt_pk_bf16(c1[0] * v1[0], c1[1] * v1[1]); w.w = cvt_pk_bf16(c1[2] * v1[2], c1[3] * v1[3]);
                    *(v4u*)p = w; }
        }
    }
};
struct EpiMoeDown {
    static constexpr bool PERM = true;
    struct Pre { int2 inf[2][4]; };
    const int2* slot; bf16* h; bf16* y1; float ps = 1.0f;
    __device__ __forceinline__ void load(Pre& P, const Unit& u, int wr, int wc, int fr, int fq) const {
#pragma unroll
        for (int ai = 0; ai < 2; ++ai)
#pragma unroll
            for (int m = 0; m < 4; ++m) { const int rl = ai * HALF + wr * 64 + m * 16 + fr; P.inf[ai][m] = (rl < u.rows) ? slot[u.slot0 + rl] : make_int2(0, 0); }
    }
    __device__ __forceinline__ void operator()(const f32x4 (&acc)[2][2][4][2], const Unit& u, int wr, int wc, int fr, int fq, const Pre& P) const {
        const int col0 = u.pn * BM + wc * 32 + 8 * fq;
        v4u b[6][2];
        auto ldg = [&](int slot_, int ai, int m) { const size_t off = (size_t)(P.inf[ai][m].x & 0x7fffffff) * D + col0;
#pragma unroll
            for (int bj = 0; bj < 2; ++bj) { b[slot_][bj] = (v4u){0u, 0u, 0u, 0u}; if (P.inf[ai][m].x >= 0) b[slot_][bj] = *(const v4u*)(h + off + bj * HALF); } };
        auto fin = [&](int slot_, int ai, int m) { const int rl = ai * HALF + wr * 64 + m * 16 + fr; const int ix = P.inf[ai][m].x; const float w = __int_as_float(P.inf[ai][m].y);
            const size_t off = (size_t)(ix & 0x7fffffff) * D + col0;
            if (rl < u.rows) {
                const bool top1 = ix >= 0; const float ws = top1 ? w * ps : w; bf16* dst = top1 ? h : y1;
#pragma unroll
                for (int bj = 0; bj < 2; ++bj) { const v4u v = b[slot_][bj];
                    f32x4 v0 = acc[ai][bj][m][0] * ws, v1 = acc[ai][bj][m][1] * ws;
                    if (top1) { v0 += (f32x4){bf_lo(v.x), bf_hi(v.x), bf_lo(v.y), bf_hi(v.y)}; v1 += (f32x4){bf_lo(v.z), bf_hi(v.z), bf_lo(v.w), bf_hi(v.w)}; }
                    v4u o; o.x = cvt_pk_bf16(v0[0], v0[1]); o.y = cvt_pk_bf16(v0[2], v0[3]); o.z = cvt_pk_bf16(v1[0], v1[1]); o.w = cvt_pk_bf16(v1[2], v1[3]);
                    *(v4u*)(dst + off + bj * HALF) = o; }
            } };
        ldg(0, 0, 0); ldg(1, 0, 1); ldg(2, 0, 2); ldg(3, 0, 3); ldg(4, 1, 0); ldg(5, 1, 1);
        fin(0, 0, 0); fin(1, 0, 1);
        asm volatile("" ::: "memory");
        ldg(0, 1, 2); ldg(1, 1, 3);
        fin(2, 0, 2); fin(3, 0, 3); fin(4, 1, 0); fin(5, 1, 1);
        asm volatile("" ::: "memory");
        fin(0, 1, 2); fin(1, 1, 3);
    }
};

#ifndef PG8_ALIGN_EPI
#define PG8_ALIGN_EPI 1
#endif
constexpr bool ALIGN_EPI = PG8_ALIGN_EPI;
#ifndef PG8_UNIT_TOUCH
#define PG8_UNIT_TOUCH 0
#endif
constexpr bool UNIT_TOUCH = PG8_UNIT_TOUCH;
typedef int i32x4 __attribute__((ext_vector_type(4)));
typedef int i32x8 __attribute__((ext_vector_type(8)));
template <class Epi, class Sched, bool GATHER, bool FP8 = false>
__device__ __forceinline__ void gemm_phase(LAS unsigned char* lds, LAS unsigned* idxbuf, const int wid, const int nt, const int lda, const int ldb, const Sched& S, const Epi& E, const int sc_a = 0x7f7f7f7f, const int sc_b = 0x7f7f7f7f, const unsigned kstepA = 128u, const unsigned kstepB = 128u) {
    const int lane = lane_id(), tid = wid * 64 + lane, wr = wid >> 2, wc = wid & 3, fr = lane & 15, fq = lane >> 4;
    unsigned voffA[2], voffB[2], voffG[2][2];
#pragma unroll
    for (int i = 0; i < 2; ++i) { int R, C; stage_rc(tid * 16 + i * 8192, R, C); const int Rb = Epi::PERM ? ((R & ~31) + perm32(R & 31)) : R;
        voffA[i] = (unsigned)(R * lda + C * 2); voffB[i] = (unsigned)(Rb * ldb + C * 2); voffG[0][i] = 0u; voffG[1][i] = 0u; }
    const __amdgpu_buffer_rsrc_t rA = __builtin_amdgcn_make_buffer_rsrc((void*)S.A, 0, 0x7ffffff0, 0x00020000), rB = __builtin_amdgcn_make_buffer_rsrc((void*)S.Bt, 0, 0x7ffffff0, 0x00020000);
    const unsigned hstepA = (unsigned)HALF * lda, hstepB = (unsigned)HALF * ldb;
    const unsigned ldsw = (unsigned)wid * 1024u; unsigned ldsw_ = ldsw;
    const int aoff = lds_byte(wr * 64 + fr, fq * 8), boff = lds_byte(wc * 32 + fr, fq * 8);
#define PG8_SA(b, h) (((b) * 2 + (h)) * HTB)
#define PG8_SB(b, h) ((4 + (b) * 2 + (h)) * HTB)
#define PG8_STAGE(bufoff, rsrc, soff, voff) do { _Pragma("unroll") for (int _i = 0; _i < 2; ++_i) \
        __builtin_amdgcn_raw_ptr_buffer_load_lds(rsrc, (LAS void*)(lds + (bufoff) + ldsw_ + _i * 8192), 16, (int)(voff)[_i], (int)(soff), 0, 0); } while (0)
#define PG8_STAGE_A(bufoff, soff, h) do { if constexpr (GATHER) { PG8_STAGE(bufoff, rA, soff, voffG[h]); } else { PG8_STAGE(bufoff, rA, (soff) + (h) * hstepA, voffA); } } while (0)
#define PG8_STAGE_B(bufoff, soff, h) PG8_STAGE(bufoff, rB, (soff) + (h) * hstepB, voffB)
#define PG8_LDA(dst, b, h) do { _Pragma("unroll") for (int m = 0; m < 4; ++m) _Pragma("unroll") for (int k = 0; k < 2; ++k) dst[m][k] = *(const LAS bf16x8*)(lds + PG8_SA(b, h) + aoff + m * 2048 + k * 1024); } while (0)
#define PG8_LDB(dst, b, h) do { _Pragma("unroll") for (int n = 0; n < 2; ++n) _Pragma("unroll") for (int k = 0; k < 2; ++k) dst[n][k] = *(const LAS bf16x8*)(lds + PG8_SB(b, h) + boff + n * 2048 + k * 1024); } while (0)
#define PG8_MMA(ai, bj, At, Bt) do { _Pragma("unroll") for (int m = 0; m < 4; ++m) _Pragma("unroll") for (int n = 0; n < 2; ++n) _Pragma("unroll") for (int k = 0; k < 2; ++k) \
        acc[ai][bj][m][n] = __builtin_amdgcn_mfma_f32_16x16x32_bf16(Bt[n][k], At[m][k], acc[ai][bj][m][n], 0, 0, 0); } while (0)
#define PG8_CAT(x) __builtin_shufflevector((i32x4)(x)[0], (i32x4)(x)[1], 0, 1, 2, 3, 4, 5, 6, 7)
#define PG8_MMA8(ai, bj, At, Bt) do { _Pragma("unroll") for (int m = 0; m < 4; ++m) _Pragma("unroll") for (int n = 0; n < 2; ++n) \
        acc[ai][bj][m][n] = __builtin_amdgcn_mfma_scale_f32_16x16x128_f8f6f4(PG8_CAT(Bt[n]), PG8_CAT(At[m]), acc[ai][bj][m][n], 0, 0, 0, sc_b, 0, sc_a); } while (0)
#define PG8_MM(ai, bj, At, Bt) do { if ((ai) * HALF + wr * 64 < cur.rows) { if constexpr (FP8) PG8_MMA8(ai, bj, At, Bt); else PG8_MMA(ai, bj, At, Bt); } } while (0)
#define PG8_WAIT_V(n) asm volatile("s_waitcnt vmcnt(" #n ")" ::: "memory")
#define PG8_WAIT_L(n) asm volatile("s_waitcnt lgkmcnt(" #n ")" ::: "memory")
#define PG8_BAR __builtin_amdgcn_s_barrier()
#define PG8_SCHED __builtin_amdgcn_sched_barrier(0)
#define PG8_LOAD_VOFFG(ib, nrows) do { asm volatile("" ::: "memory"); _Pragma("unroll") for (int _i = 0; _i < 2; ++_i) { int _R, _C; stage_rc(tid * 16 + _i * 8192, _R, _C); \
        _Pragma("unroll") for (int _h = 0; _h < 2; ++_h) { const int _rl = _h * HALF + _R; unsigned _ix = (ib)[_rl]; _ix = (_rl < (nrows)) ? _ix : 0u; voffG[_h][_i] = _ix * (unsigned)lda + (unsigned)(_C * 2); } } } while (0)
#define PG8_IDX_DMA(src, ib) __builtin_amdgcn_global_load_lds((const unsigned*)((src) + lane * 4), (LAS unsigned*)(ib), 16, 0, 0)
    Unit cur, nxt; int ui = 0;
    if (!S.next(0, cur)) return;
    f32x4 acc[2][2][4][2];
#pragma unroll
    for (int a = 0; a < 2; ++a)
#pragma unroll
        for (int b = 0; b < 2; ++b)
#pragma unroll
            for (int m = 0; m < 4; ++m)
#pragma unroll
                for (int n = 0; n < 2; ++n) acc[a][b][m][n] = (f32x4){0.f, 0.f, 0.f, 0.f};
    bf16x8 At[4][2], B0[2][2], B1[2][2];
    unsigned cA = S.a_off(cur), cB = S.b_off(cur);
    if constexpr (GATHER) {
        if (wid == 0) PG8_IDX_DMA(S.idx_src(cur), idxbuf);
        PG8_WAIT_V(0); PG8_BAR;
        PG8_LOAD_VOFFG(idxbuf, cur.rows);
    }
    PG8_STAGE_B(PG8_SB(0, 0), cB, 0); PG8_STAGE_B(PG8_SB(0, 1), cB, 1); PG8_STAGE_A(PG8_SA(0, 0), cA, 0); PG8_STAGE_A(PG8_SA(0, 1), cA, 1);
    if (wr == 1) PG8_BAR;
    PG8_WAIT_V(2); PG8_BAR;
    PG8_STAGE_B(PG8_SB(1, 0), cB + kstepB, 0); PG8_STAGE_A(PG8_SA(1, 0), cA + kstepA, 0); PG8_STAGE_B(PG8_SB(1, 1), cB + kstepB, 1);
    PG8_WAIT_V(6); PG8_BAR;
    for (;;) {
        const bool has_next = S.next(ui + 1, nxt);
        const unsigned nA = has_next ? S.a_off(nxt) : cA, nB = has_next ? S.b_off(nxt) : cB;
        const int t_touch = nt >= 8 ? nt - 6 : 0;
        if constexpr (GATHER) { if (has_next && wid == 0) PG8_IDX_DMA(S.idx_src(nxt), idxbuf + ((ui + 1) & 1) * 256); }
#pragma nounroll
        for (int t = 0; t < nt; t += 2) {
            const bool last = (t == nt - 2);
            if (UNIT_TOUCH && has_next && t == t_touch) {
                unsigned trow = (unsigned)(tid >> 1);
                if constexpr (GATHER) { asm volatile("" ::: "memory"); const int rl_ = (int)trow; unsigned ix_ = (idxbuf + ((ui + 1) & 1) * 256)[rl_]; trow = (rl_ < nxt.rows) ? ix_ : 0u; }
                const unsigned tvo = trow * (unsigned)lda + (unsigned)(tid & 1) * 128u;
                __builtin_amdgcn_raw_ptr_buffer_load_lds(rA, (LAS void*)(lds + TOUCH_OFF + wid * 256), 4, (int)tvo, (int)nA, 0, 0);
            }
            asm volatile("" : "+s"(ldsw_));
            const unsigned a1 = cA + (unsigned)(t + 1) * kstepA;
            const unsigned a2 = last ? nA : cA + (unsigned)(t + 2) * kstepA, b2 = last ? nB : cB + (unsigned)(t + 2) * kstepB;
            const unsigned a3 = a2 + kstepA, b3 = b2 + kstepB;
            PG8_LDB(B0, 0, 0); PG8_LDB(B1, 0, 1); PG8_SCHED; PG8_LDA(At, 0, 0); PG8_STAGE_A(PG8_SA(1, 1), a1, 1);
            PG8_WAIT_V(8); PG8_WAIT_L(0); PG8_BAR; PG8_MM(0, 0, At, B0); PG8_MM(0, 1, At, B1); PG8_BAR; PG8_SCHED;
            if constexpr (GATHER) { if (last && has_next) PG8_LOAD_VOFFG(idxbuf + ((ui + 1) & 1) * 256, nxt.rows); }
            PG8_LDA(At, 0, 1); PG8_STAGE_B(PG8_SB(0, 0), b2, 0); PG8_STAGE_B(PG8_SB(0, 1), b2, 1); PG8_STAGE_A(PG8_SA(0, 0), a2, 0);
            PG8_WAIT_V(8); PG8_WAIT_L(0); PG8_BAR; PG8_MM(1, 0, At, B0); PG8_MM(1, 1, At, B1); PG8_BAR; PG8_SCHED;
            PG8_LDB(B0, 1, 0); PG8_LDB(B1, 1, 1); PG8_SCHED; PG8_LDA(At, 1, 0); PG8_STAGE_A(PG8_SA(0, 1), a2, 1);
            PG8_WAIT_V(8); PG8_WAIT_L(0); PG8_BAR; PG8_MM(0, 0, At, B0); PG8_MM(0, 1, At, B1); PG8_BAR; PG8_SCHED;
            PG8_LDA(At, 1, 1); PG8_STAGE_B(PG8_SB(1, 0), b3, 0); PG8_STAGE_B(PG8_SB(1, 1), b3, 1); PG8_STAGE_A(PG8_SA(1, 0), a3, 0);
            PG8_WAIT_V(8); PG8_WAIT_L(0); PG8_BAR; PG8_MM(1, 0, At, B0); PG8_MM(1, 1, At, B1); PG8_BAR; PG8_SCHED;
        }
        unsigned long long pe0_ = 0;
        if ((PROBE_EPI == 1 || PROBE_EPI == 3) && blockIdx.x == 0 && wid == 0) pe0_ = __builtin_amdgcn_s_memrealtime();
        typename Epi::Pre pre; const int eln = lane_id();
        E.load(pre, cur, wr, wc, eln & 15, eln >> 4);
        if (PROBE_EPI == 3 && blockIdx.x == 0 && wid == 0) { volatile LAS unsigned long long* PW = (volatile LAS unsigned long long*)(lds + MISC_OFF + 64); const unsigned long long q_ = __builtin_amdgcn_s_memrealtime(); if (lane_id() == 0) PW[4] += q_ - pe0_; }
        if (PROBE_EPI == 4 && blockIdx.x == 0 && wid == 0) pe0_ = __builtin_amdgcn_s_memrealtime();
        if (ALIGN_EPI) { if (wr == 0) PG8_BAR; }
        if (PROBE_EPI == 4 && blockIdx.x == 0 && wid == 0) { volatile LAS unsigned long long* PW = (volatile LAS unsigned long long*)(lds + MISC_OFF + 64); const unsigned long long q_ = __builtin_amdgcn_s_memrealtime(); if (lane_id() == 0) PW[4] += q_ - pe0_; }
        if (PROBE_EPI == 2 && blockIdx.x == 0 && wid == 0) pe0_ = __builtin_amdgcn_s_memrealtime();
        E(acc, cur, wr, wc, eln & 15, eln >> 4, pre);
        if ((PROBE_EPI == 1 || PROBE_EPI == 2) && blockIdx.x == 0 && wid == 0) { volatile LAS unsigned long long* PW = (volatile LAS unsigned long long*)(lds + MISC_OFF + 64);
            const unsigned long long pe1_ = __builtin_amdgcn_s_memrealtime(); if (lane_id() == 0) PW[4] += pe1_ - pe0_; }
        if (!has_next) break;
#pragma unroll
        for (int a = 0; a < 2; ++a)
#pragma unroll
            for (int b = 0; b < 2; ++b)
#pragma unroll
                for (int m = 0; m < 4; ++m)
#pragma unroll
                    for (int n = 0; n < 2; ++n) acc[a][b][m][n] = (f32x4){0.f, 0.f, 0.f, 0.f};
        cur = nxt; cA = nA; cB = nB; ++ui;
        if (ALIGN_EPI) { if (wr == 1) PG8_BAR; }
    }
    PG8_WAIT_V(0);
    if (!ALIGN_EPI) { if (wr == 0) PG8_BAR; }
    PG8_BAR;
#undef PG8_SA
#undef PG8_SB
#undef PG8_STAGE
#undef PG8_STAGE_A
#undef PG8_STAGE_B
#undef PG8_LDA
#undef PG8_LDB
#undef PG8_MMA
#undef PG8_MMA8
#undef PG8_MM
#undef PG8_CAT
#undef PG8_WAIT_V
#undef PG8_WAIT_L
#undef PG8_BAR
#undef PG8_SCHED
#undef PG8_LOAD_VOFFG
#undef PG8_IDX_DMA
}
#ifndef P6_STAGGER
#define P6_STAGGER 1
#endif
typedef int i32x2 __attribute__((ext_vector_type(2)));
typedef int i32x4 __attribute__((ext_vector_type(4)));
template <class Epi, class Sched, bool GATHER>
__device__ __forceinline__ void gemm_phase6(LAS unsigned char* lds, LAS unsigned* idxbuf, const int wid, const int nt, const Sched& S, const Epi& E, const int sc_a, const int sc_b) {
    static_assert(GATHER && Epi::PERM, "fp6 body: gathered A, permuted B image");
    constexpr int HT6 = HALF * 96; constexpr unsigned KSA = 128u, KSB = 2u * HT6, ROWA = 1024u;
    const int lane = lane_id(), tid = wid * 64 + lane, wr = wid >> 2, wc = wid & 3, fr = lane & 15, fq = lane >> 4;
    unsigned voffB[2], voffG[2][2]; int pR[2], pC[2];
#pragma unroll
    for (int i = 0; i < 2; ++i) { const int p = i ? 512 + (tid & 255) : tid; const int R = p / 6, Cc = p - 6 * R; pR[i] = R; pC[i] = (Cc < 4 ? Cc : (Cc ^ ((R >> 3) & 1))) * 16;
        voffB[i] = (unsigned)p * 16u; voffG[0][i] = 0u; voffG[1][i] = 0u; }
    const __amdgpu_buffer_rsrc_t rA = __builtin_amdgcn_make_buffer_rsrc((void*)S.A, 0, 0x7ffffff0, 0x00020000), rB = __builtin_amdgcn_make_buffer_rsrc((void*)S.Bt, 0, 0x7ffffff0, 0x00020000);
    const unsigned ldsw = (unsigned)wid * 1024u; unsigned ldsw_ = ldsw;
    const int aoff = 96 * (wr * 64 + fr) + 16 * fq, boff = 96 * (wc * 32 + fr) + 16 * fq;
    const int aoff8 = 96 * (wr * 64 + fr) + 64 + 8 * (fq ^ ((fr >> 2) & 2)), boff8 = 96 * (wc * 32 + fr) + 64 + 8 * (fq ^ ((fr >> 2) & 2));
#define P6_SA(b, h) (((b) * 2 + (h)) * HT6)
#define P6_SB(b, h) ((4 + (b) * 2 + (h)) * HT6)
#define P6_STAGE(bufoff, rsrc, soff, v0, v1, h) do { __builtin_amdgcn_raw_ptr_buffer_load_lds(rsrc, (LAS void*)(lds + (bufoff) + ldsw_), 16, (int)(v0), (int)(soff), 0, 0); \
        if (wr == (h)) __builtin_amdgcn_raw_ptr_buffer_load_lds(rsrc, (LAS void*)(lds + (bufoff) + 8192 + (ldsw_ & 3072u)), 16, (int)(v1), (int)(soff), 0, 0); } while (0)
#define P6_STAGE_A(bufoff, soff, h) P6_STAGE(bufoff, rA, soff, voffG[h][0], voffG[h][1], h)
#define P6_STAGE_B(bufoff, soff, h) P6_STAGE(bufoff, rB, (soff) + (h) * (unsigned)HT6, voffB[0], voffB[1], h)
#define P6_LDA(dst, b, h) do { _Pragma("unroll") for (int m = 0; m < 4; ++m) { dst##w[m] = *(const LAS i32x4*)(lds + P6_SA(b, h) + aoff + m * 1536); dst##n[m] = *(const LAS i32x2*)(lds + P6_SA(b, h) + aoff8 + m * 1536); } } while (0)
#define P6_LDB(dst, b, h) do { _Pragma("unroll") for (int n = 0; n < 2; ++n) { dst##w[n] = *(const LAS i32x4*)(lds + P6_SB(b, h) + boff + n * 1536); dst##n[n] = *(const LAS i32x2*)(lds + P6_SB(b, h) + boff8 + n * 1536); } } while (0)
#define P6_CAT(x, k) __builtin_shufflevector(x##w[k], __builtin_shufflevector(x##n[k], x##n[k], 0, 1, -1, -1), 0, 1, 2, 3, 4, 5, -1, -1)
#define P6_MM(ai, bj, At, Bt) do { if ((ai) * HALF + wr * 64 < cur.rows) { _Pragma("unroll") for (int m = 0; m < 4; ++m) _Pragma("unroll") for (int n = 0; n < 2; ++n) \
        acc[ai][bj][m][n] = __builtin_amdgcn_mfma_scale_f32_16x16x128_f8f6f4(P6_CAT(Bt, n), P6_CAT(At, m), acc[ai][bj][m][n], 2, 2, 0, sc_b, 0, sc_a); } } while (0)
#define P6_WAIT_V(nlead, ntrail) do { if (wr == 0) asm volatile("s_waitcnt vmcnt(" #nlead ")" ::: "memory"); else asm volatile("s_waitcnt vmcnt(" #ntrail ")" ::: "memory"); } while (0)
#define P6_WAIT_6 asm volatile("s_waitcnt vmcnt(6)" ::: "memory")
#define P6_WAIT_L0 asm volatile("s_waitcnt lgkmcnt(0)" ::: "memory")
#define P6_BAR __builtin_amdgcn_s_barrier()
#define P6_SCHED __builtin_amdgcn_sched_barrier(0)
#define P6_LOAD_VOFFG(ib, nrows) do { asm volatile("" ::: "memory"); _Pragma("unroll") for (int _i = 0; _i < 2; ++_i) _Pragma("unroll") for (int _h = 0; _h < 2; ++_h) { \
        const int _rl = _h * HALF + pR[_i]; unsigned _ix = (ib)[_rl & 255]; _ix = (_rl < (nrows)) ? _ix : 0u; voffG[_h][_i] = _ix * ROWA + (unsigned)pC[_i]; } } while (0)
#define P6_IDX_DMA(src, ib) __builtin_amdgcn_global_load_lds((const unsigned*)((src) + lane * 4), (LAS unsigned*)(ib), 16, 0, 0)
    Unit cur, nxt; int ui = 0;
    if (!S.next(0, cur)) return;
    f32x4 acc[2][2][4][2];
#pragma unroll
    for (int a = 0; a < 2; ++a)
#pragma unroll
        for (int b = 0; b < 2; ++b)
#pragma unroll
            for (int m = 0; m < 4; ++m)
#pragma unroll
                for (int n = 0; n < 2; ++n) acc[a][b][m][n] = (f32x4){0.f, 0.f, 0.f, 0.f};
    i32x4 Atw[4], B0w[2], B1w[2]; i32x2 Atn[4], B0n[2], B1n[2];
    unsigned cA = S.a_off(cur), cB = S.b_off(cur);
    if constexpr (GATHER) {
        if (wid == 0) P6_IDX_DMA(S.idx_src(cur), idxbuf);
        asm volatile("s_waitcnt vmcnt(0)" ::: "memory"); P6_BAR;
        P6_LOAD_VOFFG(idxbuf, cur.rows);
    }
    P6_STAGE_B(P6_SB(0, 0), cB, 0); P6_STAGE_B(P6_SB(0, 1), cB, 1); P6_STAGE_A(P6_SA(0, 0), cA, 0); P6_STAGE_A(P6_SA(0, 1), cA, 1);
    if (P6_STAGGER) { if (wr == 1) P6_BAR; }
    P6_WAIT_V(1, 2); P6_BAR;
    P6_STAGE_B(P6_SB(1, 0), cB + KSB, 0); P6_STAGE_A(P6_SA(1, 0), cA + KSA, 0); P6_STAGE_B(P6_SB(1, 1), cB + KSB, 1);
    P6_WAIT_V(5, 4); P6_BAR;
    for (;;) {
        const bool has_next = S.next(ui + 1, nxt);
        const unsigned nA = has_next ? S.a_off(nxt) : cA, nB = has_next ? S.b_off(nxt) : cB;
        if constexpr (GATHER) { if (has_next && wid == 0) P6_IDX_DMA(S.idx_src(nxt), idxbuf + ((ui + 1) & 1) * 256); }
#pragma nounroll
        for (int t = 0; t < nt; t += 2) {
            const bool last = (t == nt - 2);
            asm volatile("" : "+s"(ldsw_));
            const unsigned a1 = cA + (unsigned)(t + 1) * KSA;
            const unsigned a2 = last ? nA : cA + (unsigned)(t + 2) * KSA, b2 = last ? nB : cB + (unsigned)(t + 2) * KSB;
            const unsigned a3 = a2 + KSA, b3 = b2 + KSB;
            P6_LDB(B0, 0, 0); P6_LDB(B1, 0, 1); P6_SCHED; P6_LDA(At, 0, 0); P6_STAGE_A(P6_SA(1, 1), a1, 1);
            P6_WAIT_6; P6_WAIT_L0; P6_BAR; P6_MM(0, 0, At, B0); P6_MM(0, 1, At, B1); P6_BAR; P6_SCHED;
            if constexpr (GATHER) { if (last && has_next) P6_LOAD_VOFFG(idxbuf + ((ui + 1) & 1) * 256, nxt.rows); }
            P6_LDA(At, 0, 1); P6_STAGE_B(P6_SB(0, 0), b2, 0); P6_STAGE_B(P6_SB(0, 1), b2, 1); P6_STAGE_A(P6_SA(0, 0), a2, 0);
            P6_WAIT_6; P6_WAIT_L0; P6_BAR; P6_MM(1, 0, At, B0); P6_MM(1, 1, At, B1); P6_BAR; P6_SCHED;
            P6_LDB(B0, 1, 0); P6_LDB(B1, 1, 1); P6_SCHED; P6_LDA(At, 1, 0); P6_STAGE_A(P6_SA(0, 1), a2, 1);
            P6_WAIT_6; P6_WAIT_L0; P6_BAR; P6_MM(0, 0, At, B0); P6_MM(0, 1, At, B1); P6_BAR; P6_SCHED;
            P6_LDA(At, 1, 1); P6_STAGE_B(P6_SB(1, 0), b3, 0); P6_STAGE_B(P6_SB(1, 1), b3, 1); P6_STAGE_A(P6_SA(1, 0), a3, 0);
            P6_WAIT_6; P6_WAIT_L0; P6_BAR; P6_MM(1, 0, At, B0); P6_MM(1, 1, At, B1); P6_BAR; P6_SCHED;
        }
        typename Epi::Pre pre; const int eln = lane_id();
        E.load(pre, cur, wr, wc, eln & 15, eln >> 4);
        if (P6_STAGGER && ALIGN_EPI) { if (wr == 0) P6_BAR; }
        E(acc, cur, wr, wc, eln & 15, eln >> 4, pre);
        if (!has_next) break;
#pragma unroll
        for (int a = 0; a < 2; ++a)
#pragma unroll
            for (int b = 0; b < 2; ++b)
#pragma unroll
                for (int m = 0; m < 4; ++m)
#pragma unroll
                    for (int n = 0; n < 2; ++n) acc[a][b][m][n] = (f32x4){0.f, 0.f, 0.f, 0.f};
        cur = nxt; cA = nA; cB = nB; ++ui;
        if (P6_STAGGER && ALIGN_EPI) { if (wr == 1) P6_BAR; }
    }
    asm volatile("s_waitcnt vmcnt(0)" ::: "memory");
    if (P6_STAGGER && !ALIGN_EPI) { if (wr == 0) P6_BAR; }
    P6_BAR;
#undef P6_SA
#undef P6_SB
#undef P6_STAGE
#undef P6_STAGE_A
#undef P6_STAGE_B
#undef P6_LDA
#undef P6_LDB
#undef P6_CAT
#undef P6_MM
#undef P6_WAIT_V
#undef P6_WAIT_6
#undef P6_WAIT_L0
#undef P6_BAR
#undef P6_SCHED
#undef P6_LOAD_VOFFG
#undef P6_IDX_DMA
}
}


struct Args { const float* in[19]; float* out; unsigned char* ws; int ph_lo, ph_hi; };
struct Ctx {
    LAS unsigned char* lds; int tid, lane, wave, G, vcu, gw, NGW, gw0, wave0;
    unsigned char* ws; bf16* HB; bf16* XN; bf16* Y1; float* RSTD; unsigned* ctl;
};

__device__ __forceinline__ void tr_item(const float* W, int ldw, int k0, int n0, bf16* WT, int K, int drow0, LAS float* scr, int lane, const float* kg = nullptr  ) {
#pragma unroll 8
    for (int i = 0; i < 32; ++i) { const int kk = 2 * i + (lane >> 5); scr[kk * 33 + (lane & 31)] = W[(size_t)(k0 + kk) * ldw + n0 + (lane & 31)] * (kg ? kg[k0 + kk] : 1.0f); }
    LDS_WAIT();
    const int c = lane & 7;
#pragma unroll
    for (int j = 0; j < 4; ++j) { const int n = (lane >> 3) + 8 * j; const LAS float* s = scr + (8 * c) * 33 + n;
        v4u o; o.x = cvt_pk_bf16(s[0 * 33], s[1 * 33]); o.y = cvt_pk_bf16(s[2 * 33], s[3 * 33]); o.z = cvt_pk_bf16(s[4 * 33], s[5 * 33]); o.w = cvt_pk_bf16(s[6 * 33], s[7 * 33]);
        *(v4u*)(WT + (size_t)(drow0 + n) * K + k0 + 8 * c) = o; }
    LDS_WAIT();
}
__device__ __forceinline__ void tr_item8(const float* W, int ldw, int k0, int n0, unsigned char* WT, int K, int drow0, float scale, LAS float* scr, int lane) {
#pragma unroll 8
    for (int i = 0; i < 32; ++i) { const int kk = 2 * i + (lane >> 5); scr[kk * 33 + (lane & 31)] = W[(size_t)(k0 + kk) * ldw + n0 + (lane & 31)] * scale; }
    LDS_WAIT();
    const int c = lane & 7;
#pragma unroll
    for (int j = 0; j < 4; ++j) { const int n = (lane >> 3) + 8 * j; const LAS float* s = scr + (8 * c) * 33 + n;
        v2u o; o.x = pk4_fp8(s[0 * 33], s[1 * 33], s[2 * 33], s[3 * 33]); o.y = pk4_fp8(s[4 * 33], s[5 * 33], s[6 * 33], s[7 * 33]);
        *(v2u*)(WT + (size_t)(drow0 + n) * K + k0 + 8 * c) = o; }
    LDS_WAIT();
}
__device__ __forceinline__ void tr_item_kt(const float* W, int ldw, int k0, int n0, bf16* WT, int K, LAS float* scr, int lane) {
#pragma unroll 8
    for (int i = 0; i < 32; ++i) { const int kk = 2 * i + (lane >> 5); scr[kk * 33 + (lane & 31)] = W[(size_t)(k0 + kk) * ldw + n0 + (lane & 31)]; }
    LDS_WAIT();
    const int c = lane & 7;
#pragma unroll
    for (int j = 0; j < 4; ++j) { const int n = n0 + (lane >> 3) + 8 * j; const LAS float* s = scr + (8 * c) * 33 + (lane >> 3) + 8 * j;
        v4u o; o.x = cvt_pk_bf16(s[0 * 33], s[1 * 33]); o.y = cvt_pk_bf16(s[2 * 33], s[3 * 33]); o.z = cvt_pk_bf16(s[4 * 33], s[5 * 33]); o.w = cvt_pk_bf16(s[6 * 33], s[7 * 33]);
        *(v4u*)(WT + (size_t)(n >> 8) * 256 * K + (size_t)(k0 >> 6) * (256 * 64) + (size_t)(n & 255) * 64 + 8 * c) = o; }
    LDS_WAIT();
}
__device__ __forceinline__ void tr_item8_kt(const float* W, int ldw, int k0, int n0, unsigned char* WT, int K, float scale, LAS float* scr, int lane) {
#pragma unroll 8
    for (int i = 0; i < 32; ++i) { const int kk = 2 * i + (lane >> 5); scr[kk * 33 + (lane & 31)] = W[(size_t)(k0 + kk) * ldw + n0 + (lane & 31)] * scale; }
    LDS_WAIT();
    const int c = lane & 7;
#pragma unroll
    for (int j = 0; j < 4; ++j) { const int n = n0 + (lane >> 3) + 8 * j; const LAS float* s = scr + (8 * c) * 33 + (lane >> 3) + 8 * j;
        v2u o; o.x = pk4_fp8(s[0 * 33], s[1 * 33], s[2 * 33], s[3 * 33]); o.y = pk4_fp8(s[4 * 33], s[5 * 33], s[6 * 33], s[7 * 33]);
        *(v2u*)(WT + (size_t)(n >> 8) * 256 * K + (size_t)(k0 >> 7) * (256 * 128) + (size_t)(n & 255) * 128 + (k0 & 127) + 8 * c) = o; }
    LDS_WAIT();
}
typedef float f32x16 __attribute__((ext_vector_type(16)));
typedef unsigned u32x6 __attribute__((ext_vector_type(6)));
__device__ __forceinline__ void store_fp6_block(unsigned char* piece, int fq, int swap, const f32x16& lo, const f32x16& hi) {
    const u32x6 p = __builtin_amdgcn_cvt_scalef32_2xpk16_fp6_f32(lo, hi, 1.0f);
    unsigned d0 = p[0], d1 = p[1], d2 = p[2], d3 = p[3], d4 = p[4], d5 = p[5];
    asm volatile("s_nop 7\n\ts_nop 7" : "+v"(d0), "+v"(d1), "+v"(d2), "+v"(d3), "+v"(d4), "+v"(d5));
    *(v4u*)(piece + 16 * fq) = (v4u){d0, d1, d2, d3};
    *(v2u*)(piece + 64 + 8 * (fq ^ (swap << 1))) = (v2u){d4, d5};
}
__device__ __forceinline__ void tr_item6(const float* W, int ldw, int k0, int n0, unsigned char* WT, int drow0, float scale, LAS float* scr, int lane) {
    const int q6 = k0 >> 6;
#pragma unroll 8
    for (int i = 0; i < 32; ++i) { const int kk = 2 * i + (lane >> 5); scr[kk * 33 + (lane & 31)] = W[(size_t)(256 * (kk >> 4) + 16 * q6 + (kk & 15)) * ldw + n0 + (lane & 31)] * scale; }
    LDS_WAIT();
    const int n = lane & 31, half = lane >> 5;
    f32x16 lo, hi;
#pragma unroll
    for (int i = 0; i < 16; ++i) { lo[i] = scr[(16 * (i >> 2) + 8 * half + (i & 3)) * 33 + n]; hi[i] = scr[(16 * (i >> 2) + 8 * half + 4 + (i & 3)) * 33 + n]; }
    const int drow = drow0 + n, r = drow & 255, q = r & 31, R = (r & ~31) + 16 * ((q >> 2) & 1) + 4 * (q >> 3) + (q & 3), blk = 2 * q6 + half;
    store_fp6_block(WT + (size_t)(drow >> 8) * (8 * 24576) + (size_t)(blk >> 2) * 24576 + (R >> 7) * 12288 + (R & 127) * 96, blk & 3, (R >> 3) & 1, lo, hi);
    LDS_WAIT();
}
__device__ __forceinline__ void ld_item6(const float* W, int ldw, int k0, int n0, int lane, float (&v)[32]) {
    const int q6 = k0 >> 6;
#pragma unroll
    for (int i = 0; i < 32; ++i) { const int kk = 2 * i + (lane >> 5); v[i] = W[(size_t)(256 * (kk >> 4) + 16 * q6 + (kk & 15)) * ldw + n0 + (lane & 31)]; }
}
__device__ __forceinline__ void fin_item6(const float (&v)[32], int k0, int n0, unsigned char* WT, int drow0, float scale, LAS float* scr, int lane) {
    const int q6 = k0 >> 6;
#pragma unroll
    for (int i = 0; i < 32; ++i) { const int kk = 2 * i + (lane >> 5); scr[kk * 33 + (lane & 31)] = v[i] * scale; }
    LDS_WAIT();
    const int n = lane & 31, half = lane >> 5;
    f32x16 lo, hi;
#pragma unroll
    for (int i = 0; i < 16; ++i) { lo[i] = scr[(16 * (i >> 2) + 8 * half + (i & 3)) * 33 + n]; hi[i] = scr[(16 * (i >> 2) + 8 * half + 4 + (i & 3)) * 33 + n]; }
    const int drow = drow0 + n, r = drow & 255, q = r & 31, R = (r & ~31) + 16 * ((q >> 2) & 1) + 4 * (q >> 3) + (q & 3), blk = 2 * q6 + half;
    store_fp6_block(WT + (size_t)(drow >> 8) * (8 * 24576) + (size_t)(blk >> 2) * 24576 + (R >> 7) * 12288 + (R & 127) * 96, blk & 3, (R >> 3) & 1, lo, hi);
    LDS_WAIT();
}
__device__ __forceinline__ void ld_item8_kt(const float* W, int ldw, int k0, int n0, int lane, float (&v)[32]) {
#pragma unroll
    for (int i = 0; i < 32; ++i) { const int kk = 2 * i + (lane >> 5); v[i] = W[(size_t)(k0 + kk) * ldw + n0 + (lane & 31)]; }
}
__device__ __forceinline__ void fin_item8_kt(const float (&v)[32], int k0, int n0, unsigned char* WT, int K, float scale, LAS float* scr, int lane) {
#pragma unroll
    for (int i = 0; i < 32; ++i) { const int kk = 2 * i + (lane >> 5); scr[kk * 33 + (lane & 31)] = v[i] * scale; }
    LDS_WAIT();
    const int c = lane & 7;
#pragma unroll
    for (int j = 0; j < 4; ++j) { const int n = n0 + (lane >> 3) + 8 * j; const LAS float* sp = scr + (8 * c) * 33 + (lane >> 3) + 8 * j;
        v2u o; o.x = pk4_fp8(sp[0 * 33], sp[1 * 33], sp[2 * 33], sp[3 * 33]); o.y = pk4_fp8(sp[4 * 33], sp[5 * 33], sp[6 * 33], sp[7 * 33]);
        *(v2u*)(WT + (size_t)(n >> 8) * 256 * K + (size_t)(k0 >> 7) * (256 * 128) + (size_t)(n & 255) * 128 + (k0 & 127) + 8 * c) = o; }
    LDS_WAIT();
}
__device__ __forceinline__ void cv_gateup(const float* Wg, const float* Wu, bf16* dst, int item, LAS float* scr, int lane, const float* kg = nullptr) {
    const int kind = item / 1792, r = item % 1792, kb = r / 112, nb = r % 112, n0 = 32 * nb;
    tr_item(kind ? Wu : Wg, FF, 64 * kb, n0, dst, D, (n0 >> 7) * 256 + (n0 & 127) + kind * 128, scr, lane, kg);
}
__device__ __forceinline__ void cv_plain(const float* W, int K, int N, bf16* dst, int drow_off, int item, LAS float* scr, int lane) {
    const int nbn = N / 32, kb = item / nbn, nb = item % nbn;
    tr_item(W, N, 64 * kb, 32 * nb, dst, K, drow_off + 32 * nb, scr, lane);
}
__device__ __forceinline__ void cv_convin(const float* W, const float* kg, bf16* dst, int item, LAS float* scr, int lane) {
    const int kb = item / 96, nb = item % 96, n0 = 32 * nb; int dr;
    if (n0 < 1024) dr = n0; else if (n0 < 2048) dr = 1024 + ((n0 - 1024) >> 7) * 256 + (n0 & 127); else dr = 1024 + ((n0 - 2048) >> 7) * 256 + 128 + (n0 & 127);
    tr_item(W, 3 * D, 64 * kb, n0, dst, D, dr, scr, lane, kg);
}
__device__ __forceinline__ void convert_moe_layer(Ctx& C, const Args& a, int j, const int gw_ = -1, const int ngw_ = 0  ) {
    static_assert(MOE_GU_FMT == 6, "split items write the fp6 image");
    LAS float* scr = (LAS float*)(C.lds + C.wave * 16384);
    constexpr int PER_E = 1792 + 896, NIT = NE * PER_E;
    const int start = gw_ >= 0 ? gw_ : C.gw, stride = gw_ >= 0 ? ngw_ : C.NGW;
    auto ldit = [&](const int it, float (&x0)[32], float (&x1)[32]) {
        const int e = it / PER_E, r = it % PER_E; const size_t wo = ((size_t)j * NE + e) * D * FF;
        if (r < 1792) { const int kind = r / 896, q = r % 896, kb2 = q / 112, nb = q % 112, n0 = 32 * nb; const float* Wp = (kind ? a.in[16] : a.in[15]) + wo;
            ld_item6(Wp, FF, 64 * (2 * kb2), n0, C.lane, x0); ld_item6(Wp, FF, 64 * (2 * kb2 + 1), n0, C.lane, x1); }
        else { const int q = r - 1792, kb2 = q / 32, nb = q % 32;
            ld_item8_kt(a.in[17] + wo, D, 64 * (2 * kb2), 32 * nb, C.lane, x0); ld_item8_kt(a.in[17] + wo, D, 64 * (2 * kb2 + 1), 32 * nb, C.lane, x1); }
    };
    auto finit = [&](const int it, const float (&x0)[32], const float (&x1)[32]) {
        const int e = it / PER_E, r = it % PER_E;
        if (r < 1792) { const int kind = r / 896, q = r % 896, kb2 = q / 112, nb = q % 112, n0 = 32 * nb; unsigned char* dst = C.ws + WS_WMGU + (size_t)(j * NE + e) * GU6_BYTES; const int dr = (n0 >> 7) * 256 + (n0 & 127) + kind * 128;
            fin_item6(x0, 64 * (2 * kb2), n0, dst, dr, W_GU_SCALE, scr, C.lane); fin_item6(x1, 64 * (2 * kb2 + 1), n0, dst, dr, W_GU_SCALE, scr, C.lane); }
        else { const int q = r - 1792, kb2 = q / 32, nb = q % 32; unsigned char* dst = C.ws + WS_WMDN + (size_t)(j * NE + e) * DN8_BYTES;
            fin_item8_kt(x0, 64 * (2 * kb2), 32 * nb, dst, FF, W_DN_SCALE, scr, C.lane); fin_item8_kt(x1, 64 * (2 * kb2 + 1), 32 * nb, dst, FF, W_DN_SCALE, scr, C.lane); }
    };
    float a0[32], a1[32], b0[32], b1[32];
    if (start < NIT) ldit(start, a0, a1);
#pragma nounroll
    for (int it = start; it < NIT; it += 2 * stride) {
        const int itb = it + stride;
        if (itb < NIT) ldit(itb, b0, b1);
        finit(it, a0, a1);
        if (it + 2 * stride < NIT) ldit(it + 2 * stride, a0, a1);
        if (itb < NIT) finit(itb, b0, b1);
    }
}
__device__ __forceinline__ void fin_item(const float (&v)[32], int k0, bf16* WT, int K, int drow0, LAS float* scr, int lane, const float* kg) {
#pragma unroll
    for (int i = 0; i < 32; ++i) { const int kk = 2 * i + (lane >> 5); scr[kk * 33 + (lane & 31)] = v[i] * (kg ? kg[k0 + kk] : 1.0f); }
    LDS_WAIT();
    const int c = lane & 7;
#pragma unroll
    for (int j = 0; j < 4; ++j) { const int n = (lane >> 3) + 8 * j; const LAS float* sp = scr + (8 * c) * 33 + n;
        v4u o; o.x = cvt_pk_bf16(sp[0 * 33], sp[1 * 33]); o.y = cvt_pk_bf16(sp[2 * 33], sp[3 * 33]); o.z = cvt_pk_bf16(sp[4 * 33], sp[5 * 33]); o.w = cvt_pk_bf16(sp[6 * 33], sp[7 * 33]);
        *(v4u*)(WT + (size_t)(drow0 + n) * K + k0 + 8 * c) = o; }
    LDS_WAIT();
}
__device__ __forceinline__ void fin_item8(const float (&v)[32], int k0, unsigned char* WT, int K, int drow0, float scale, LAS float* scr, int lane) {
#pragma unroll
    for (int i = 0; i < 32; ++i) { const int kk = 2 * i + (lane >> 5); scr[kk * 33 + (lane & 31)] = v[i] * scale; }
    LDS_WAIT();
    const int c = lane & 7;
#pragma unroll
    for (int j = 0; j < 4; ++j) { const int n = (lane >> 3) + 8 * j; const LAS float* sp = scr + (8 * c) * 33 + n;
        v2u o; o.x = pk4_fp8(sp[0 * 33], sp[1 * 33], sp[2 * 33], sp[3 * 33]); o.y = pk4_fp8(sp[4 * 33], sp[5 * 33], sp[6 * 33], sp[7 * 33]);
        *(v2u*)(WT + (size_t)(drow0 + n) * K + k0 + 8 * c) = o; }
    LDS_WAIT();
}
__device__ __forceinline__ void convert_small_weights(Ctx& C, const Args& a) {
    static_assert(DENSE_DN8_L0 && DENSE_FP8_LAYER == 1, "both dense down projections are fp8 here");
    LAS float* scr = (LAS float*)(C.lds + C.wave * 16384);
    constexpr int I_POOL = 32, I_GU = 3584, I_DN = 1792, I_IN = 1536, I_OUT = 512;
    constexpr int PER_L = 4 * I_POOL + I_GU + I_DN + I_IN + I_OUT, NIT = 2 * PER_L;
    struct Item { const float* W; int ldw, k0, n0, kind, K, drow0; unsigned char* dst; const float* kg; };
    auto decode = [&](const int it) { Item t; const int l = it / PER_L; int r = it % PER_L; t.kg = nullptr;
        if (r < 4 * I_POOL) { const int g = r / I_POOL, item = r % I_POOL, kb = item / 8, nb = item % 8;
            t.W = a.in[3] + (size_t)(l * 4 + g) * 65536; t.ldw = 256; t.k0 = 64 * kb; t.n0 = 32 * nb; t.kind = 0; t.K = 256; t.drow0 = g * 256 + 32 * nb; t.dst = C.ws + WS_WPOOL + (size_t)l * 524288; return t; } r -= 4 * I_POOL;
        if (r < I_GU) { const int kind_ = r / 1792, q = r % 1792, kb = q / 112, nb = q % 112, n0 = 32 * nb;
            t.W = (kind_ ? a.in[7] : a.in[6]) + (size_t)l * D * FF; t.ldw = FF; t.k0 = 64 * kb; t.n0 = n0; t.K = D; t.drow0 = (n0 >> 7) * 256 + (n0 & 127) + kind_ * 128; t.dst = C.ws + WS_WGU + (size_t)l * GU_BYTES;
            t.kind = (l == DENSE_FP8_LAYER) ? 1 : 0; if (l == 0 && DENSE_NORM_FUSED_L0) t.kg = a.in[5] + (size_t)l * D; return t; } r -= I_GU;
        if (r < I_DN) { const int kb = r / 32, nb = r % 32;
            t.W = a.in[8] + (size_t)l * D * FF; t.ldw = D; t.k0 = 64 * kb; t.n0 = 32 * nb; t.kind = 2; t.K = FF; t.drow0 = 0; t.dst = C.ws + WS_WDN + (size_t)l * DN_BYTES; return t; } r -= I_DN;
        if (r < I_IN) { const int kb = r / 96, nb = r % 96, n0 = 32 * nb; int dr;
            if (n0 < 1024) dr = n0; else if (n0 < 2048) dr = 1024 + ((n0 - 1024) >> 7) * 256 + (n0 & 127); else dr = 1024 + ((n0 - 2048) >> 7) * 256 + 128 + (n0 & 127);
            t.W = a.in[10] + (size_t)l * D * 3 * D; t.ldw = 3 * D; t.k0 = 64 * kb; t.n0 = n0; t.kind = 0; t.K = D; t.drow0 = dr; t.dst = C.ws + WS_WIN + (size_t)l * 3 * D * D * 2; t.kg = a.in[9] + (size_t)l * D; return t; } r -= I_IN;
        { const int kb = r / 32, nb = r % 32;
            t.W = a.in[12] + (size_t)l * D * D; t.ldw = D; t.k0 = 64 * kb; t.n0 = 32 * nb; t.kind = 0; t.K = D; t.drow0 = 32 * nb; t.dst = C.ws + WS_WOUT + (size_t)l * D * D * 2; return t; }
    };
    auto ldit = [&](const int it, float (&x)[32]) { const Item t = decode(it); ld_item8_kt(t.W, t.ldw, t.k0, t.n0, C.lane, x); };
    auto finit = [&](const int it, const float (&x)[32]) { const Item t = decode(it);
        if (t.kind == 0) fin_item(x, t.k0, (bf16*)t.dst, t.K, t.drow0, scr, C.lane, t.kg);
        else if (t.kind == 1) fin_item8(x, t.k0, t.dst, t.K, t.drow0, W_GU_SCALE, scr, C.lane);
        else fin_item8_kt(x, t.k0, t.n0, t.dst, t.K, W_DN_SCALE, scr, C.lane); };
    float va[32], vb[32];
    const int start = C.gw, stride = C.NGW;
    if (start < NIT) ldit(start, va);
#pragma nounroll
    for (int it = start; it < NIT; it += 2 * stride) {
        const int itb = it + stride;
        if (itb < NIT) ldit(itb, vb);
        finit(it, va);
        if (it + 2 * stride < NIT) ldit(it + 2 * stride, va);
        if (itb < NIT) finit(itb, vb);
    }
}

__device__ __forceinline__ int prev_row(int row, int i) {
    if (row < MROWS) { const int tp = row & (TS - 1); return tp >= i ? row - i : MROWS + NMETA + tp - i; }
    return row - i;
}
__device__ __forceinline__ void load_heff(const Ctx& C, int row, bool addy1, f32x4 (&x)[4]) {
    const v2u* p = (const v2u*)(C.HB + (size_t)row * D) + C.lane;
#pragma unroll
    for (int j = 0; j < 4; ++j) { const v2u v = p[64 * j]; x[j] = (f32x4){bf_lo(v.x), bf_hi(v.x), bf_lo(v.y), bf_hi(v.y)}; }
    if (addy1) { const v2u* q = (const v2u*)(C.Y1 + (size_t)row * D) + C.lane;
#pragma unroll
        for (int j = 0; j < 4; ++j) { const v2u y = q[64 * j]; x[j] += (f32x4){bf_lo(y.x), bf_hi(y.x), bf_lo(y.y), bf_hi(y.y)}; } }
}
__device__ __forceinline__ float row_rstd(const f32x4 (&x)[4], int lane) {
    float s = 0.f;
#pragma unroll
    for (int j = 0; j < 4; ++j) s += (x[j][0] * x[j][0] + x[j][1] * x[j][1]) + (x[j][2] * x[j][2] + x[j][3] * x[j][3]);
    return __frsqrt_rn(wave_sum(s, lane) * (1.0f / D) + EPS);
}
__device__ __forceinline__ void store_bf16_row(bf16* dst, int row, int lane, const f32x4 (&v)[4]) {
    v2u* o = (v2u*)(dst + (size_t)row * D) + lane;
#pragma unroll
    for (int j = 0; j < 4; ++j) { v2u w; w.x = cvt_pk_bf16(v[j][0], v[j][1]); w.y = cvt_pk_bf16(v[j][2], v[j][3]); o[64 * j] = w; }
}
__device__ __forceinline__ void phase_norm(Ctx& C, const float* gain, bool addy1, bool out8 = false) {
    f32x4 g[4];
#pragma unroll
    for (int j = 0; j < 4; ++j) g[j] = ((const f32x4*)gain)[C.lane + 64 * j];
    f32x4 x[4], xnx[4];
    if (C.gw < RTOT) load_heff(C, C.gw, addy1, x);
    for (int row = C.gw; row < RTOT; row += C.NGW) {
        const int nrow = row + C.NGW;
        if (nrow < RTOT) load_heff(C, nrow, addy1, xnx);
        const float rs = row_rstd(x, C.lane);
#pragma unroll
        for (int j = 0; j < 4; ++j) x[j] = x[j] * rs * g[j];
        if (out8) { unsigned* o8 = (unsigned*)((unsigned char*)C.XN + (size_t)row * D) + C.lane;
#pragma unroll
            for (int j = 0; j < 4; ++j) o8[64 * j] = pk4_fp8(x[j][0], x[j][1], x[j][2], x[j][3]); }
        else store_bf16_row(C.XN, row, C.lane, x);
#pragma unroll
        for (int j = 0; j < 4; ++j) x[j] = xnx[j];
    }
}
__device__ __forceinline__ void norm_rows_wg(Ctx& C, const float* gain, int r0, int nr, bool out8) {
    f32x4 g[4];
#pragma unroll
    for (int j = 0; j < 4; ++j) g[j] = ((const f32x4*)gain)[C.lane + 64 * j];
    f32x4 x[4], xnx[4];
    if (C.wave < nr) load_heff(C, r0 + C.wave, false, x);
    for (int lr = C.wave; lr < nr; lr += NWAVES) {
        const int row = r0 + lr;
        if (lr + NWAVES < nr) load_heff(C, row + NWAVES, false, xnx);
        const float rs = row_rstd(x, C.lane);
#pragma unroll
        for (int j = 0; j < 4; ++j) x[j] = x[j] * rs * g[j];
        if (out8) { unsigned* o8 = (unsigned*)((unsigned char*)C.XN + (size_t)row * D * 2) + C.lane;
#pragma unroll
            for (int j = 0; j < 4; ++j) o8[64 * j] = pk4_fp8(x[j][0], x[j][1], x[j][2], x[j][3]); }
        else store_bf16_row(C.XN, row, C.lane, x);
#pragma unroll
        for (int j = 0; j < 4; ++j) x[j] = xnx[j];
    }
}
template <bool L0>
__device__ __forceinline__ void phase_pool(Ctx& C, const float* gain, bool addy1, const float* xin, const float* meta) {
    f32x4 g[4];
#pragma unroll
    for (int j = 0; j < 4; ++j) g[j] = ((const f32x4*)gain)[C.lane + 64 * j];
    constexpr int RUN = 32, NRUN = MROWS / RUN + 1;
    for (int run = C.gw; run < NRUN; run += C.NGW) {
        const bool mrun = run == NRUN - 1;
        const int r0 = run * RUN, tp0 = r0 & (TS - 1), nsteps = mrun ? NMETA : RUN + 15;
        f32x4 r1[2], r2[4], r3[8], r4[16], S[4];
#pragma unroll
        for (int q = 0; q < 2; ++q) r1[q] = (f32x4){0.f, 0.f, 0.f, 0.f};
#pragma unroll
        for (int q = 0; q < 4; ++q) r2[q] = (f32x4){0.f, 0.f, 0.f, 0.f};
#pragma unroll
        for (int q = 0; q < 8; ++q) r3[q] = (f32x4){0.f, 0.f, 0.f, 0.f};
#pragma unroll
        for (int q = 0; q < 16; ++q) r4[q] = (f32x4){0.f, 0.f, 0.f, 0.f};
#pragma unroll
        for (int j = 0; j < 4; ++j) S[j] = (f32x4){0.f, 0.f, 0.f, 0.f};
#define POOL_ROW(k_) (mrun ? MROWS + (k_) : ((tp0 + (k_) - 15 >= 0) ? r0 + (k_) - 15 : MROWS + NMETA + tp0 + (k_) - 15))
#define POOL_LOAD(dst, row_) do { if (L0) { const f32x4* p_ = (const f32x4*)((row_) < MROWS ? xin + (size_t)(row_) * D : meta + (size_t)((row_) - MROWS) * D) + C.lane; \
        _Pragma("unroll") for (int j = 0; j < 4; ++j) dst[j] = p_[64 * j]; } else load_heff(C, row_, addy1, dst); } while (0)
        f32x4 x[4], xnx[4];
        POOL_LOAD(x, POOL_ROW(0));
        for (int kb = 0; kb < nsteps; kb += 16) {
#pragma unroll
            for (int kk = 0; kk < 16; ++kk) {
                const int k = kb + kk;
                if (k < nsteps) {
                    const int i = mrun ? k : k - 15;
                    const int row = POOL_ROW(k);
                    if (k + 1 < nsteps) POOL_LOAD(xnx, POOL_ROW(k + 1));
                    const float rs = row_rstd(x, C.lane);
#pragma unroll
                    for (int j = 0; j < 4; ++j) x[j] = x[j] * rs * g[j];
                    S[0] += x[0] - r1[kk & 1]; r1[kk & 1] = x[0];
                    S[1] += x[1] - r2[kk & 3]; r2[kk & 3] = x[1];
                    S[2] += x[2] - r3[kk & 7]; r3[kk & 7] = x[2];
                    S[3] += x[3] - r4[kk]; r4[kk] = x[3];
                    if (i >= 0) {
                        const int pos = mrun ? k : NMETA;
                        f32x4 d[4];
#pragma unroll
                        for (int j = 0; j < 4; ++j) { const int w = 2 << j; const int cnt = (pos + 1) < w ? (pos + 1) : w; d[j] = S[j] * (1.0f / (float)cnt) - x[j]; }
                        store_bf16_row(C.XN, row, C.lane, d);
                    }
#pragma unroll
                    for (int j = 0; j < 4; ++j) x[j] = xnx[j];
                }
            }
        }
#undef POOL_ROW
#undef POOL_LOAD
    }
}
__device__ __forceinline__ void conv_tap(float (&s)[8], const float (&k)[8], const v4u& uu) {
    s[0] += k[0] * bf_lo(uu.x); s[1] += k[1] * bf_hi(uu.x); s[2] += k[2] * bf_lo(uu.y); s[3] += k[3] * bf_hi(uu.y);
    s[4] += k[4] * bf_lo(uu.z); s[5] += k[5] * bf_hi(uu.z); s[6] += k[6] * bf_lo(uu.w); s[7] += k[7] * bf_hi(uu.w);
}
__device__ __forceinline__ void phase_conv(Ctx& C, const float* ck, const bf16* BGp, const bf16* Up, bf16* Y, const bool meta_local = false  ) {
    float k[3][2][8];
#pragma unroll
    for (int t = 0; t < 3; ++t)
#pragma unroll
        for (int q = 0; q < 2; ++q) { const f32x4 a = *(const f32x4*)(ck + t * D + 8 * C.lane + 512 * q), b = *(const f32x4*)(ck + t * D + 8 * C.lane + 512 * q + 4);
            k[t][q][0] = a[0]; k[t][q][1] = a[1]; k[t][q][2] = a[2]; k[t][q][3] = a[3]; k[t][q][4] = b[0]; k[t][q][5] = b[1]; k[t][q][6] = b[2]; k[t][q][7] = b[3]; }
    constexpr int RUN = 32, NRUN = MROWS / RUN + 1;
    const v4u zero4 = (v4u){0u, 0u, 0u, 0u};
    const int nrun_deal = meta_local ? NRUN - 1 : NRUN;
    bool extra = meta_local && C.wave == 0 && (int)blockIdx.x < D / 16;
    for (int run = C.gw; run < nrun_deal || extra; run += C.NGW) {
        if (run >= nrun_deal) { run = NRUN - 1; extra = false; }
        const bool mrun = run == NRUN - 1;
        const int r0 = mrun ? MROWS : run * RUN, n = mrun ? NMETA : RUN;
        v4u um1[2], um2[2];
#pragma unroll
        for (int q = 0; q < 2; ++q) { const int co = 8 * C.lane + 512 * q;
            um1[q] = mrun ? zero4 : *(const v4u*)(Up + (size_t)prev_row(r0, 1) * D + co); um2[q] = mrun ? zero4 : *(const v4u*)(Up + (size_t)prev_row(r0, 2) * D + co); }
        v4u uc[2], bc[2], un[2], bn[2];
#pragma unroll
        for (int q = 0; q < 2; ++q) { const int co = 8 * C.lane + 512 * q; uc[q] = *(const v4u*)(Up + (size_t)r0 * D + co); bc[q] = *(const v4u*)(BGp + (size_t)r0 * D + co); }
        for (int i = 0; i < n; ++i) {
            const int row = r0 + i;
            if (i + 1 < n) {
#pragma unroll
                for (int q = 0; q < 2; ++q) { const int co = 8 * C.lane + 512 * q; un[q] = *(const v4u*)(Up + (size_t)(row + 1) * D + co); bn[q] = *(const v4u*)(BGp + (size_t)(row + 1) * D + co); } }
#pragma unroll
            for (int q = 0; q < 2; ++q) {
                const int co = 8 * C.lane + 512 * q;
                const v4u uu = uc[q], bb = bc[q];
                float sacc[8];
#pragma unroll
                for (int e = 0; e < 8; ++e) sacc[e] = 0.f;
                conv_tap(sacc, k[0][q], um2[q]); conv_tap(sacc, k[1][q], um1[q]); conv_tap(sacc, k[2][q], uu);
                um2[q] = um1[q]; um1[q] = uu;
                v4u o; o.x = cvt_pk_bf16(bf_lo(bb.x) * sacc[0], bf_hi(bb.x) * sacc[1]); o.y = cvt_pk_bf16(bf_lo(bb.y) * sacc[2], bf_hi(bb.y) * sacc[3]);
                o.z = cvt_pk_bf16(bf_lo(bb.z) * sacc[4], bf_hi(bb.z) * sacc[5]); o.w = cvt_pk_bf16(bf_lo(bb.w) * sacc[6], bf_hi(bb.w) * sacc[7]);
                *(v4u*)(Y + (size_t)row * D + co) = o;
                uc[q] = un[q]; bc[q] = bn[q];
            }
        }
    }
}
__device__ __forceinline__ float xchg(float v, int lane, int m) { return __int_as_float(__builtin_amdgcn_ds_bpermute((lane ^ m) << 2, __float_as_int(v))); }
__device__ __forceinline__ void phase_router(Ctx& C, const float* gain, const float* router, unsigned* gcnt  , const int ch0  , const bool do_meta  ) {
    LAS unsigned* lcnt = (LAS unsigned*)C.lds;
    LAS unsigned* lbase = lcnt + 8;
    LAS unsigned* ent = lcnt + 16;
    f32x4 g[4];
#pragma unroll
    for (int j = 0; j < 4; ++j) g[j] = ((const f32x4*)gain)[C.lane + 64 * j];
    f32x4 ra[4][4], rb[4][4];
#pragma unroll
    for (int j = 0; j < 4; ++j)
#pragma unroll
        for (int i = 0; i < 4; ++i) { const f32x4* rp = (const f32x4*)(router + (size_t)(4 * C.lane + 256 * j + i) * NE); ra[j][i] = rp[0]; rb[j][i] = rp[1]; }
    unsigned* rowidx = (unsigned*)(C.ws + WS_ROWIDX); int2* slot = (int2*)(C.ws + WS_SLOT);
    const int nchunk = (RTOT + 255) / 256;
    const bool up32 = (C.lane & 32) != 0, up16 = (C.lane & 16) != 0, up8 = (C.lane & 8) != 0;
    bool meta_todo = do_meta;
    for (int ch = ch0; ch < nchunk - 1 || meta_todo; ch += C.G) {
        if (ch >= nchunk - 1) { ch = nchunk - 1; meta_todo = false; }
        const int r0 = ch * 256, nr = (RTOT - r0) < 256 ? (RTOT - r0) : 256;
        __syncthreads();
        if (C.tid < 16) lcnt[C.tid] = 0u;
        __syncthreads();
        auto ldrow = [&](v2u (&q)[4], const int lr) { const v2u* p = (const v2u*)(C.HB + (size_t)(r0 + lr) * D) + C.lane;
#pragma unroll
            for (int j = 0; j < 4; ++j) q[j] = p[64 * j]; };
        auto process = [&](const v2u (&q)[4], const int lr) {
            const int row = r0 + lr; f32x4 x[4];
#pragma unroll
            for (int j = 0; j < 4; ++j) x[j] = (f32x4){bf_lo(q[j].x), bf_hi(q[j].x), bf_lo(q[j].y), bf_hi(q[j].y)};
            const float rs = row_rstd(x, C.lane);
#pragma unroll
            for (int j = 0; j < 4; ++j) x[j] = x[j] * rs * g[j];
            if (MOE_GU_FMT == 6) {
                f32x16 lo, hi;
#pragma unroll
                for (int j = 0; j < 4; ++j)
#pragma unroll
                    for (int i = 0; i < 4; ++i) { const float v = x[j][i] * X6_SCALE; lo[4 * j + i] = v; hi[4 * j + i] = DPP_F(v, 0xB1  ); }
                if ((C.lane & 1) == 0) store_fp6_block(C.ws + WS_XN6 + (size_t)row * 1024 + (C.lane >> 3) * 128, (C.lane >> 1) & 3, 0, lo, hi);
            } else { unsigned* o8 = (unsigned*)((unsigned char*)C.XN + (size_t)row * D) + C.lane;
#pragma unroll
              for (int j = 0; j < 4; ++j) o8[64 * j] = pk4_fp8(x[j][0], x[j][1], x[j][2], x[j][3]); }
            f32x4 la = (f32x4){0.f, 0.f, 0.f, 0.f}, lb = la;
#pragma unroll
            for (int j = 0; j < 4; ++j)
#pragma unroll
                for (int i = 0; i < 4; ++i) { la += ra[j][i] * x[j][i]; lb += rb[j][i] * x[j][i]; }
            f32x4 k4; { const f32x4 keep = up32 ? lb : la, give = up32 ? la : lb;
                k4[0] = keep[0] + xchg(give[0], C.lane, 32); k4[1] = keep[1] + xchg(give[1], C.lane, 32); k4[2] = keep[2] + xchg(give[2], C.lane, 32); k4[3] = keep[3] + xchg(give[3], C.lane, 32); }
            float k2a, k2b; { const float keep0 = up16 ? k4[2] : k4[0], keep1 = up16 ? k4[3] : k4[1], give0 = up16 ? k4[0] : k4[2], give1 = up16 ? k4[1] : k4[3];
                k2a = keep0 + xchg(give0, C.lane, 16); k2b = keep1 + xchg(give1, C.lane, 16); }
            float k1; { const float keep = up8 ? k2b : k2a, give = up8 ? k2a : k2b; k1 = keep + DPP_F(give, 0x128  ); }
            k1 += DPP_F(k1, 0xB1); k1 += DPP_F(k1, 0x4E); k1 += DPP_F(k1, 0x141);
            float lg[8];
#pragma unroll
            for (int e = 0; e < 8; ++e) lg[e] = __int_as_float(__builtin_amdgcn_readlane(__float_as_int(k1), 8 * e));
            int e1 = 0; float v1 = lg[0];
#pragma unroll
            for (int e = 1; e < 8; ++e) if (lg[e] > v1) { v1 = lg[e]; e1 = e; }
            int e2 = -1; float v2 = -3.0e38f;
#pragma unroll
            for (int e = 0; e < 8; ++e) if (e != e1 && lg[e] > v2) { v2 = lg[e]; e2 = e; }
            const float ex = __expf(v2 - v1), w1 = 1.0f / (1.0f + ex), w2 = ex * w1;
            if (C.lane == 0) {
                const unsigned k1_ = atomicAdd((unsigned*)&lcnt[e1], 1u), k2_ = atomicAdd((unsigned*)&lcnt[e2], 1u);
                ent[(lr * 2 + 0) * 2 + 0] = (unsigned)e1 | (k1_ << 8); ent[(lr * 2 + 0) * 2 + 1] = __float_as_uint(w1);
                ent[(lr * 2 + 1) * 2 + 0] = (unsigned)e2 | (k2_ << 8); ent[(lr * 2 + 1) * 2 + 1] = __float_as_uint(w2);
            }
        };
        v2u qa[4], qb[4], qc[4];
#pragma unroll
        for (int j = 0; j < 4; ++j) { qa[j] = (v2u){0u, 0u}; qb[j] = qa[j]; qc[j] = qa[j]; }
        if (C.wave < nr) ldrow(qa, C.wave);
        if (C.wave + NWAVES < nr) ldrow(qb, C.wave + NWAVES);
#pragma nounroll
        for (int lr = C.wave; lr < nr; lr += 3 * NWAVES) {
            if (lr + 2 * NWAVES < nr) ldrow(qc, lr + 2 * NWAVES);
            process(qa, lr);
            if (lr + NWAVES < nr) { if (lr + 3 * NWAVES < nr) ldrow(qa, lr + 3 * NWAVES); process(qb, lr + NWAVES); }
            if (lr + 2 * NWAVES < nr) { if (lr + 4 * NWAVES < nr) ldrow(qb, lr + 4 * NWAVES); process(qc, lr + 2 * NWAVES); }
        }
        __syncthreads();
        if (C.tid < 8) lbase[C.tid] = __hip_atomic_fetch_add(gcnt + 64 * C.tid, lcnt[C.tid], __ATOMIC_RELAXED, __HIP_MEMORY_SCOPE_AGENT);
        __syncthreads();
        for (int q = C.tid; q < nr * 2; q += NWAVES * 64) {
            const unsigned ek = ent[q * 2], wb = ent[q * 2 + 1]; const int e = ek & 255, rank = ek >> 8, row = r0 + (q >> 1), ch2 = q & 1;
            const int pos = e * CAP + (int)lbase[e] + rank;
            rowidx[pos] = (unsigned)row; slot[pos] = make_int2(row | (ch2 << 31), (int)wb);
        }
    }
    __syncthreads();
}
__device__ __forceinline__ void phase_final(Ctx& C, const float* gain, float* out) {
    f32x4 g[4];
#pragma unroll
    for (int j = 0; j < 4; ++j) g[j] = ((const f32x4*)gain)[C.lane + 64 * j];
    f32x4 x[4], xnx[4];
    if (C.gw < MROWS) load_heff(C, C.gw, true, x);
    for (int row = C.gw; row < MROWS; row += C.NGW) {
        const int nrow = row + C.NGW;
        if (nrow < MROWS) load_heff(C, nrow, true, xnx);
        const float rs = row_rstd(x, C.lane);
        f32x4* o = (f32x4*)(out + (size_t)row * D) + C.lane;
#pragma unroll
        for (int j = 0; j < 4; ++j) o[64 * j] = x[j] * rs * g[j];
#pragma unroll
        for (int j = 0; j < 4; ++j) x[j] = xnx[j];
    }
}
__device__ __forceinline__ void copy_params(Ctx& C, const Args& a) {
    float* P = (float*)(C.ws + WS_PARAMS);
    for (int i = C.gw * 64 + C.lane; i < PP_TOTAL; i += C.NGW * 64) {
        float v;
        if (i < PP_POOL_SCALE) v = a.in[2][i - PP_POOL_NORM];
        else if (i < PP_DENSE_NORM) v = a.in[4][i - PP_POOL_SCALE];
        else if (i < PP_CONV_NORM) v = a.in[5][i - PP_DENSE_NORM];
        else if (i < PP_MOE_NORM) v = a.in[9][i - PP_CONV_NORM];
        else if (i < PP_FINAL) v = a.in[13][i - PP_MOE_NORM];
        else if (i < PP_CONV_K) v = a.in[18][i - PP_FINAL];
        else if (i < PP_ROUTER) v = a.in[11][i - PP_CONV_K];
        else v = a.in[14][i - PP_ROUTER];
        P[i] = v;
    }
}
__device__ __forceinline__ int moe_cnt(unsigned* gcnt, int e) { return __builtin_amdgcn_readfirstlane((int)__hip_atomic_load(gcnt + 64 * e, __ATOMIC_RELAXED, __HIP_MEMORY_SCOPE_AGENT)); }
__device__ __forceinline__ void moe_sched_init(pg8::MoeSched& S, const Ctx& C, unsigned* gcnt, int pass, int nN) {
    S.n0 = moe_cnt(gcnt, 0); S.n1 = moe_cnt(gcnt, 1); S.n2 = moe_cnt(gcnt, 2); S.n3 = moe_cnt(gcnt, 3); S.n4 = moe_cnt(gcnt, 4); S.n5 = moe_cnt(gcnt, 5); S.n6 = moe_cnt(gcnt, 6); S.n7 = moe_cnt(gcnt, 7);
    S.m1 = (S.n0 + 255) >> 8; S.m2 = S.m1 + ((S.n1 + 255) >> 8); S.m3 = S.m2 + ((S.n2 + 255) >> 8); S.m4 = S.m3 + ((S.n3 + 255) >> 8);
    S.m5 = S.m4 + ((S.n4 + 255) >> 8); S.m6 = S.m5 + ((S.n5 + 255) >> 8); S.m7 = S.m6 + ((S.n6 + 255) >> 8);
    const int total = S.m7 + ((S.n7 + 255) >> 8);
    S.t0 = pass * MOE_CH; int nM = total - S.t0; const int cap = (pass == MOE_PASSES - 1) ? MOE_LAST_MAX : MOE_CH; nM = nM < 0 ? 0 : (nM > cap ? cap : nM);
    S.nM = nM; S.nN = nN; S.G = C.G; S.c = (int)blockIdx.x;
}
__device__ __forceinline__ bool relaunder(Ctx& C, unsigned char* ws) { C.lane = lane_id(); C.tid = C.wave * 64 + C.lane;
    { int g = C.gw0, w = C.wave0; asm volatile("" : "+s"(g), "+s"(w)); C.gw = g; C.wave = w; }
    size_t z_ = 0; asm volatile("" : "+s"(z_)); ws += z_; C.ws = ws;
    C.HB = (bf16*)(ws + WS_H32); C.XN = (bf16*)(ws + WS_XN); C.Y1 = (bf16*)(ws + WS_Y1); C.RSTD = (float*)(ws + WS_RSTD); return true; }
constexpr int N_PHASES = 1 + 2 * (4 + 2 + 2 * MOE_PASSES) + 1 + (PROBE_HOTA ? 1 : 0);

#define RUN() (ph >= lo && ph < hi && relaunder(C, args.ws))
#define REPE for (int rep_ = 0; rep_ < PROBE_REP_ELT; ++rep_)
#define REPG for (int rep_ = 0; rep_ < PROBE_REP_GEMM; ++rep_)
#define SEAM() do { if (ph >= lo && ph + 1 < hi) xcd_barrier(bar, C.wave0); \
    if (PROBE_TMASK != 0u && blockIdx.x == 0 && C.wave0 == 0) { volatile LAS unsigned long long* PW = (volatile LAS unsigned long long*)(C.lds + MISC_OFF + 64); \
        const unsigned long long rt_ = __builtin_amdgcn_s_memrealtime(), ck_ = __builtin_amdgcn_s_memtime(); \
        if (lane_id() == 0) { if ((PROBE_TMASK >> ph) & 1u) { PW[2] += PROBE_EPI ? PW[4] : rt_ - PW[0]; PW[3] += ck_ - PW[1]; } PW[0] = rt_; PW[1] = ck_; PW[4] = 0; } } \
    ++ph; } while (0)
#define INTER ((bf16*)(C.ws + WS_INTER))
#define PRM ((const float*)(C.ws + WS_PARAMS))

template <bool FP8, int NB>
__device__ __forceinline__ void meta_block(const Ctx& C, const char* A, int lda, unsigned kstepA, const char* Bt, unsigned tstepB, int ldb, unsigned kstepB, int nt, int n0, int n1, int sc_a, int sc_b, f32x4& o0, f32x4& o1) {
    const int lane = lane_id(), fr = lane & 15, fq = lane >> 4;
    const int kb = C.wave * nt / 8, ke = (C.wave + 1) * nt / 8;
    const int o = FP8 ? fq * 32 : fq * 16; constexpr int o2 = FP8 ? 16 : 64;
    const char* pa = A + (size_t)fr * lda + o;
    const char* pb0 = Bt + (size_t)((n0 + fr) >> 8) * tstepB + (size_t)((n0 + fr) & 255) * ldb + o;
    const char* pb1 = Bt + (size_t)((n1 + fr) >> 8) * tstepB + (size_t)((n1 + fr) & 255) * ldb + o;
    f32x4 a0 = (f32x4){0.f, 0.f, 0.f, 0.f}, a1 = a0;
    struct Frag { pg8::i32x4 xa, xb, wa, wb, va, vb; };
    auto ld = [&](int kt, Frag& f) {
        f.xa = *(const pg8::i32x4*)(pa + (size_t)kt * kstepA); f.xb = *(const pg8::i32x4*)(pa + (size_t)kt * kstepA + o2);
        f.wa = *(const pg8::i32x4*)(pb0 + (size_t)kt * kstepB); f.wb = *(const pg8::i32x4*)(pb0 + (size_t)kt * kstepB + o2);
        if constexpr (NB == 2) { f.va = *(const pg8::i32x4*)(pb1 + (size_t)kt * kstepB); f.vb = *(const pg8::i32x4*)(pb1 + (size_t)kt * kstepB + o2); }
    };
    auto mm = [&](const Frag& f) {
        if constexpr (FP8) a0 = __builtin_amdgcn_mfma_scale_f32_16x16x128_f8f6f4(__builtin_shufflevector(f.wa, f.wb, 0, 1, 2, 3, 4, 5, 6, 7), __builtin_shufflevector(f.xa, f.xb, 0, 1, 2, 3, 4, 5, 6, 7), a0, 0, 0, 0, sc_b, 0, sc_a);
        else { a0 = __builtin_amdgcn_mfma_f32_16x16x32_bf16((pg8::bf16x8)f.wa, (pg8::bf16x8)f.xa, a0, 0, 0, 0); a0 = __builtin_amdgcn_mfma_f32_16x16x32_bf16((pg8::bf16x8)f.wb, (pg8::bf16x8)f.xb, a0, 0, 0, 0); }
        if constexpr (NB == 2) {
            if constexpr (FP8) a1 = __builtin_amdgcn_mfma_scale_f32_16x16x128_f8f6f4(__builtin_shufflevector(f.va, f.vb, 0, 1, 2, 3, 4, 5, 6, 7), __builtin_shufflevector(f.xa, f.xb, 0, 1, 2, 3, 4, 5, 6, 7), a1, 0, 0, 0, sc_b, 0, sc_a);
            else { a1 = __builtin_amdgcn_mfma_f32_16x16x32_bf16((pg8::bf16x8)f.va, (pg8::bf16x8)f.xa, a1, 0, 0, 0); a1 = __builtin_amdgcn_mfma_f32_16x16x32_bf16((pg8::bf16x8)f.vb, (pg8::bf16x8)f.xb, a1, 0, 0, 0); }
        }
    };
    int kt = kb;
#pragma nounroll
    for (; kt + 3 < ke; kt += 4) { Frag f0, f1, f2, f3; ld(kt, f0); ld(kt + 1, f1); ld(kt + 2, f2); ld(kt + 3, f3); mm(f0); mm(f1); mm(f2); mm(f3); }
    if (kt + 1 < ke) { Frag f0, f1; ld(kt, f0); ld(kt + 1, f1); mm(f0); mm(f1); kt += 2; }
    if (kt < ke) { Frag f; ld(kt, f); mm(f); }
    LAS f32x4* red = (LAS f32x4*)C.lds;
    red[(C.wave * 2 + 0) * 64 + lane] = a0; if (NB == 2) red[(C.wave * 2 + 1) * 64 + lane] = a1;
    __syncthreads();
    o0 = red[lane]; o1 = red[64 + lane];
#pragma unroll
    for (int w = 1; w < 8; ++w) { o0 += red[(w * 2 + 0) * 64 + lane]; if (NB == 2) o1 += red[(w * 2 + 1) * 64 + lane]; }
}
template <bool FP8, bool OUT8, bool RS = false  >
__device__ __forceinline__ void meta_swiglu(const Ctx& C, const char* A, int lda, const char* Bt, unsigned tstepB, int ldb, int nt, int sc_a, int sc_b, unsigned char* Hm) {
    for (int t = (int)blockIdx.x; t < FF / 16; t += (int)gridDim.x) {
    LAS float* mr = (LAS float*)(C.lds + 16384);
    if constexpr (RS) { f32x4 x[4]; for (int rr = C.wave; rr < NMETA; rr += NWAVES) { load_heff(C, MROWS + rr, false, x); const float rs = row_rstd(x, C.lane); if (C.lane == 0) mr[rr] = rs; } }
    const int n0 = (t >> 3) * 256 + (t & 7) * 16; f32x4 g, u;
    meta_block<FP8, 2>(C, A, lda, 128u, Bt, tstepB, ldb, 128u, nt, n0, n0 + 128, sc_a, sc_b, g, u);
    if (C.wave == 0) { const int lane = lane_id(), fr = lane & 15, col = 16 * t + 4 * (lane >> 4);
        if constexpr (RS) { const float rs = mr[fr]; g *= rs; u *= rs; }
        constexpr float inv = OUT8 ? 1.0f / H8_SCALE : 1.0f;
        const f32x2 a = silu_mul_pk((f32x2){g[0], g[1]}, (f32x2){u[0], u[1]}, inv), b = silu_mul_pk((f32x2){g[2], g[3]}, (f32x2){u[2], u[3]}, inv);
        if constexpr (OUT8) *(unsigned*)(Hm + (size_t)(col >> 7) * (256 * 128) + fr * 128 + (col & 127)) = pk4_fp8(a.x, a.y, b.x, b.y);
        else *(v2u*)((bf16*)Hm + (size_t)(col >> 6) * (256 * 64) + fr * 64 + (col & 63)) = (v2u){cvt_pk_bf16(a.x, a.y), cvt_pk_bf16(b.x, b.y)}; }
    __syncthreads(); }
}
template <bool FP8, bool WT = false  >
__device__ __forceinline__ void meta_resid(const Ctx& C, const char* A, int lda, unsigned kstepA, const char* Bt, unsigned tstepB, int ldb, unsigned kstepB, int nt, int sc_a, int sc_b) {
    for (int t = (int)blockIdx.x; t < D / 16; t += (int)gridDim.x) {
    f32x4 r, dummy;
    meta_block<FP8, 1>(C, A, lda, kstepA, Bt, tstepB, ldb, kstepB, nt, 16 * t, 16 * t, sc_a, sc_b, r, dummy);
    if (C.wave == 0) { const int lane = lane_id(), fr = lane & 15, col = 16 * t + 4 * (lane >> 4);
        v2u* p = (v2u*)(C.HB + (size_t)(MROWS + fr) * D + col); const v2u v = *p;
        const v2u o = (v2u){cvt_pk_bf16(bf_lo(v.x) + r[0], bf_hi(v.x) + r[1]), cvt_pk_bf16(bf_lo(v.y) + r[2], bf_hi(v.y) + r[3])};
        if constexpr (WT) { __hip_atomic_store((unsigned*)p, o.x, __ATOMIC_RELAXED, __HIP_MEMORY_SCOPE_AGENT); __hip_atomic_store((unsigned*)p + 1, o.y, __ATOMIC_RELAXED, __HIP_MEMORY_SCOPE_AGENT); }
        else *p = o; }
    __syncthreads(); }
}
__device__ __forceinline__ void meta_convin(const Ctx& C, const char* A  , const char* Bt, bf16* BGp, bf16* Up) {
    LAS float* mr = (LAS float*)(C.lds + 16384);
    for (int t = (int)blockIdx.x; t < 128; t += (int)gridDim.x) {
    { f32x4 x[4]; for (int rr = C.wave; rr < NMETA; rr += NWAVES) { load_heff(C, MROWS + rr, false, x); const float rs = row_rstd(x, C.lane); if (C.lane == 0) mr[rr] = rs; } }
    const bool isb = t < 64; const int tt = t & 63, n0 = isb ? 16 * tt : (4 + (tt >> 3)) * 256 + (tt & 7) * 16;
    f32x4 c, v;
    meta_block<false, 2>(C, A, D * 2, 128u, Bt, 256u * D * 2, D * 2, 128u, D / 64, n0, isb ? n0 : n0 + 128, 0, 0, c, v);
    if (C.wave == 0) { const int lane = lane_id(), fr = lane & 15, col = 16 * tt + 4 * (lane >> 4); const float rs = mr[fr];
        c *= rs; if (!isb) c *= v * rs;
        *(v2u*)((isb ? BGp : Up) + (size_t)(MROWS + fr) * D + col) = (v2u){cvt_pk_bf16(c[0], c[1]), cvt_pk_bf16(c[2], c[3])}; }
    __syncthreads(); }
}

template <int lp>
__device__ __forceinline__ void layer_pair(Ctx& C, const Args& args, int& ph, const int lo, const int hi, const XcdBarrier& bar, LAS unsigned* idxbuf) {
        const bool addy1 = lp > 0;
        if (RUN()) REPE phase_pool<lp == 0>(C, PRM + PP_POOL_NORM + lp * D, addy1, args.in[0], args.in[1]);
    SEAM();
    if (RUN()) {
            pg8::PanelSched S; S.nN = 4; S.G = C.G; S.c = (int)blockIdx.x; S.A = (const char*)C.XN; S.Bt = (const char*)(C.ws + WS_WPOOL + (size_t)lp * 524288);
            S.tstepA = 256u * D * 2; S.tstepB = 256u * 256 * 2; S.a_colstep = 512;
            constexpr bool fused0 = (lp == 0) && DENSE_NORM_FUSED_L0 && DENSE_DN8_L0;
            typedef pg8::EpiResid<lp == 0, (lp > 0), fused0> EpiPG;
            EpiPG E{C.HB, addy1 ? C.Y1 : nullptr, PRM + PP_POOL_SCALE + lp * D, 0, lp == 0 ? args.in[0] : nullptr, lp == 0 ? args.in[1] : nullptr, 1.0f, (unsigned long long*)(C.ws + WS_ROWSQ) + (size_t)2 * 65536};
            pg8::gemm_phase<EpiPG, pg8::PanelSched, false>(C.lds, idxbuf, C.wave, 256 / 64, D * 2, 256 * 2, S, E);
            if constexpr (!fused0) {
            if (C.wave == 0) { __builtin_amdgcn_fence(__ATOMIC_ACQUIRE, "agent"); asm volatile("s_waitcnt vmcnt(0)" ::: "memory"); }
            __syncthreads();
            for (int p = (int)blockIdx.x; p < MROWS / 256; p += C.G) norm_rows_wg(C, PRM + PP_DENSE_NORM + lp * D, p * 256, 256, lp == DENSE_FP8_LAYER);
            }
        }
        SEAM();
        {
            constexpr int pm0 = 0, nM = MROWS / 256;
            constexpr bool dn8 = (lp == DENSE_FP8_LAYER) || (lp == 0 && DENSE_DN8_L0);
            unsigned char* const DH = C.ws + (dn8 ? WS_INTER : WS_DENSEH);
            if (PROBE_HOTA && lp == 0) {
                if (RUN()) {
                    pg8::DenseSched S; S.nM = nM; S.meta_pm = nM - 1; S.nN = FF / 128; S.G = C.G; S.c = (int)blockIdx.x; S.a_colstep = 0; S.Bt = (const char*)(C.ws + WS_WGU + (size_t)lp * GU_BYTES);
                    S.A = (const char*)C.XN; S.tstepA = (PROBE_HOTA == 1) ? 0u : 256u * D * 2; S.tstepB = (PROBE_HOTA == 2) ? 0u : 256u * D * 2;
                    pg8::EpiSwiGLU E{(bf16*)DH, FF};
                    pg8::gemm_phase<pg8::EpiSwiGLU, pg8::DenseSched, false>(C.lds, idxbuf, C.wave, D / 64, D * 2, D * 2, S, E);
                }
                SEAM();
            }
            if (RUN()) {
                constexpr bool fused0 = (lp == 0) && DENSE_NORM_FUSED_L0 && DENSE_DN8_L0;
                if constexpr (!fused0) { norm_rows_wg(C, PRM + PP_DENSE_NORM + lp * D, MROWS, NMETA, lp == DENSE_FP8_LAYER);
                    asm volatile("s_waitcnt vmcnt(0)" ::: "memory"); __syncthreads(); }
                pg8::DenseSched S; S.nM = nM; S.nN = FF / 128; S.G = C.G; S.c = (int)blockIdx.x; S.a_colstep = 0; S.Bt = (const char*)(C.ws + WS_WGU + (size_t)lp * GU_BYTES);
                if (lp == DENSE_FP8_LAYER) meta_swiglu<true, true>(C, (const char*)C.XN + (size_t)MROWS * D * 2, D * 2, S.Bt, 256u * D, D, D / 128, SC_ONE, SC_GU, DH + (size_t)MROWS * FF);
                else meta_swiglu<false, dn8, fused0>(C, (const char*)(fused0 ? C.HB : C.XN) + (size_t)MROWS * D * 2, D * 2, S.Bt, 256u * D * 2, D * 2, D / 64, 0, 0, DH + (size_t)MROWS * FF * (dn8 ? 1 : 2));
                if (lp == DENSE_FP8_LAYER) {
                    S.A = (const char*)C.XN + (size_t)pm0 * 256 * D * 2; S.tstepA = 256u * D * 2; S.tstepB = 256u * D;
                    pg8::EpiSwiGLU8 E{DH, FF};
                    for (int rep_ = 0; rep_ < ((PROBE_MASK & 2) ? 2 : 1); ++rep_) pg8::gemm_phase<pg8::EpiSwiGLU8, pg8::DenseSched, false, true>(C.lds, idxbuf, C.wave, D / 128, D * 2, D, S, E, SC_ONE, SC_GU);
                } else {
                    S.A = (const char*)((fused0 ? C.HB : C.XN) + (size_t)pm0 * 256 * D); S.tstepA = 256u * D * 2; S.tstepB = 256u * D * 2;
                    if constexpr (fused0) { pg8::EpiSwiGLU8R E{DH, FF, (const unsigned long long*)(C.ws + WS_ROWSQ) + (size_t)2 * 65536};
                        pg8::gemm_phase<pg8::EpiSwiGLU8R, pg8::DenseSched, false>(C.lds, idxbuf, C.wave, D / 64, D * 2, D * 2, S, E); }
                    else if constexpr (dn8) { pg8::EpiSwiGLU8 E{DH, FF};
                        pg8::gemm_phase<pg8::EpiSwiGLU8, pg8::DenseSched, false>(C.lds, idxbuf, C.wave, D / 64, D * 2, D * 2, S, E); }
                    else { pg8::EpiSwiGLU E{(bf16*)DH, FF};
                        for (int rep_ = 0; rep_ < ((PROBE_MASK & 1) ? 2 : 1); ++rep_) pg8::gemm_phase<pg8::EpiSwiGLU, pg8::DenseSched, false>(C.lds, idxbuf, C.wave, D / 64, D * 2, D * 2, S, E); }
                }
            }
            SEAM();
            if (RUN()) {
                pg8::DenseSched S; S.nM = nM; S.nN = 4; S.G = C.G; S.c = (int)blockIdx.x; S.A = (const char*)DH; S.a_colstep = 0; S.Bt = (const char*)(C.ws + WS_WDN + (size_t)lp * DN_BYTES);
                if (dn8) meta_resid<true>(C, (const char*)DH + (size_t)MROWS * FF, 128, 32768u, S.Bt, 256u * FF, 128, 32768u, FF / 128, SC_H, SC_DN);
                else meta_resid<false>(C, (const char*)DH + (size_t)MROWS * FF * 2, 128, 32768u, S.Bt, 256u * FF * 2, 128, 32768u, FF / 64, 0, 0);
                constexpr int PB = dn8 ? 2 : 1, NR = (PROBE_MASK & PB) ? 2 : 1;
                typedef pg8::EpiResid<false, false, true> EpiDN;
                EpiDN E{C.HB, nullptr, nullptr, pm0 * 256, nullptr, nullptr, 1.0f / NR, (unsigned long long*)(C.ws + WS_ROWSQ) + (size_t)lp * 65536};
                if (dn8) { S.tstepA = 256u * FF; S.tstepB = 256u * FF;
                    for (int rep_ = 0; rep_ < NR; ++rep_) pg8::gemm_phase<EpiDN, pg8::DenseSched, false, true>(C.lds, idxbuf, C.wave, FF / 128, 128, 128, S, E, SC_H, SC_DN, 32768u, 32768u); }
                else { S.tstepA = 256u * FF * 2; S.tstepB = 256u * FF * 2;
                    for (int rep_ = 0; rep_ < NR; ++rep_) pg8::gemm_phase<EpiDN, pg8::DenseSched, false>(C.lds, idxbuf, C.wave, FF / 64, 128, 128, S, E, 0x7f7f7f7f, 0x7f7f7f7f, 32768u, 32768u); }
            }
            SEAM();
        }
#define BG INTER
#define UU (INTER + (size_t)RPAD * D)
        if (RUN()) {
            pg8::DenseSched S; S.nM = MROWS / 256; S.nN = 12; S.G = C.G; S.c = (int)blockIdx.x; S.A = (const char*)C.HB; S.Bt = (const char*)(C.ws + WS_WIN + (size_t)lp * 3 * D * D * 2);
            meta_convin(C, (const char*)(C.HB + (size_t)MROWS * D), S.Bt, BG, UU);
            S.tstepA = 256u * D * 2; S.tstepB = 256u * D * 2; S.a_colstep = 0;
            pg8::EpiConvIn E{BG, UU, (const unsigned long long*)(C.ws + WS_ROWSQ) + (size_t)lp * 65536};
            for (int rep_ = 0; rep_ < ((PROBE_MASK & 4) ? 2 : 1); ++rep_) pg8::gemm_phase<pg8::EpiConvIn, pg8::DenseSched, false>(C.lds, idxbuf, C.wave, D / 64, D * 2, D * 2, S, E);
        }
        SEAM();
#define gcnt ((unsigned*)(C.ws + WS_CTL) + CW_MOECNT + lp * 8 * 64)
        if (RUN()) {
            phase_conv(C, PRM + PP_CONV_K + lp * 3 * D, BG, UU, C.XN, true);
            asm volatile("s_waitcnt vmcnt(0)" ::: "memory"); __syncthreads();
            pg8::PanelSched S; S.nN = 4; S.G = C.G; S.c = C.vcu; S.meta = false; S.A = (const char*)C.XN; S.Bt = (const char*)(C.ws + WS_WOUT + (size_t)lp * D * D * 2);
            meta_resid<false, true>(C, (const char*)(C.XN + (size_t)MROWS * D), D * 2, 128u, S.Bt, 256u * D * 2, D * 2, 128u, D / 64, 0, 0);
            { volatile LAS unsigned* mflag = (volatile LAS unsigned*)(C.lds + MISC_OFF + 48);
              const int nblk = C.G < D / 16 ? C.G : D / 16;
              if (C.tid == 0) { unsigned lastf = 0u;
                  if ((int)blockIdx.x < nblk) { asm volatile("s_waitcnt vmcnt(0)" ::: "memory");
                      const unsigned old_ = __hip_atomic_fetch_add(C.ctl + CW_METACNT + lp * 64, 1u, __ATOMIC_RELAXED, __HIP_MEMORY_SCOPE_AGENT); lastf = (old_ == (unsigned)(nblk - 1)) ? 1u : 0u; }
                  *mflag = lastf; } }
            S.tstepA = 256u * D * 2; S.tstepB = 256u * D * 2; S.a_colstep = 0;
            pg8::EpiResid<false, false> E{C.HB, nullptr, nullptr, 0, nullptr, nullptr, 1.0f};
            pg8::gemm_phase<pg8::EpiResid<false, false>, pg8::PanelSched, false>(C.lds, idxbuf, C.wave, D / 64, D * 2, D * 2, S, E);
            if (C.wave == 0) { __builtin_amdgcn_fence(__ATOMIC_ACQUIRE, "agent"); asm volatile("s_waitcnt vmcnt(0)" ::: "memory"); }
            __syncthreads();
            const bool do_meta = *(volatile LAS unsigned*)(C.lds + MISC_OFF + 48) != 0u;
            phase_router(C, PRM + PP_MOE_NORM + lp * D, PRM + PP_ROUTER + lp * D * NE, gcnt, C.vcu, do_meta);
        }
        SEAM();
        for (int pass = 0; pass < MOE_PASSES; ++pass) {
            if (RUN()) {
                pg8::MoeSched S; moe_sched_init(S, C, gcnt, pass, FF / 128);
                S.A = (const char*)(C.ws + (MOE_GU_FMT == 6 ? WS_XN6 : WS_XN)); S.tstepA = 0; S.rowidx = (const unsigned*)(C.ws + WS_ROWIDX);
                pg8::EpiSwiGLU8 E{C.ws + WS_H8MOE, FF};
                if (MOE_GU_FMT == 6) {
                    S.Bt = (const char*)(C.ws + WS_WMGU + (size_t)lp * NE * GU6_BYTES); S.estepB = (unsigned)GU6_BYTES; S.tstepB = 256u * 768;
                    pg8::gemm_phase6<pg8::EpiSwiGLU8, pg8::MoeSched, true>(C.lds, idxbuf, C.wave, D / 128, S, E, SC_X6, SC_GU);
                } else {
                    S.Bt = (const char*)(C.ws + WS_WMGU + (size_t)lp * NE * GU8_BYTES); S.estepB = (unsigned)GU8_BYTES; S.tstepB = 256u * D;
                    pg8::gemm_phase<pg8::EpiSwiGLU8, pg8::MoeSched, true, true>(C.lds, idxbuf, C.wave, D / 128, D, D, S, E, SC_ONE, SC_GU);
                }
            }
            SEAM();
            if (RUN()) {
                pg8::MoeSched S; moe_sched_init(S, C, gcnt, pass, 4);
                S.A = (const char*)(C.ws + WS_H8MOE); S.tstepA = 256u * FF; S.Bt = (const char*)(C.ws + WS_WMDN + (size_t)lp * NE * DN8_BYTES); S.estepB = (unsigned)DN8_BYTES; S.tstepB = 256u * FF; S.rowidx = nullptr;
                constexpr int NR = (PROBE_MASK & 16) ? 2 : 1;
                pg8::EpiMoeDown E{(const int2*)(C.ws + WS_SLOT), C.HB, C.Y1, 1.0f / NR};
                for (int rep_ = 0; rep_ < NR; ++rep_) pg8::gemm_phase<pg8::EpiMoeDown, pg8::MoeSched, false, true>(C.lds, idxbuf, C.wave, FF / 128, 128, 128, S, E, SC_H, SC_DN, 32768u, 32768u);
                if constexpr (lp == 0 && MOE_L1_CONV_IN_TAIL) {
                    const int extra = (S.nM * 4) % C.G, c = (int)blockIdx.x;
                    if (c >= extra) convert_moe_layer(C, args, 1, (c - extra) * NWAVES + C.wave, (C.G - extra) * NWAVES); }
            }
            SEAM();
        }
}

__global__ void __launch_bounds__(NWAVES * 64, 2) fwd(Args args) {
    extern __shared__ __attribute__((aligned(16))) unsigned char lds_raw[];
    Ctx C;
    C.lds = (LAS unsigned char*)lds_raw;
    C.tid = threadIdx.x; C.lane = C.tid & 63; C.wave0 = __builtin_amdgcn_readfirstlane(C.tid >> 6); C.wave = C.wave0;
    C.G = gridDim.x; { const int bx = blockIdx.x; C.vcu = (C.G % 8 == 0) ? (bx % 8) * (C.G / 8) + bx / 8 : bx; }
    C.gw0 = C.vcu * NWAVES + C.wave; C.gw = C.gw0; C.NGW = C.G * NWAVES;
    C.ws = args.ws; C.HB = (bf16*)(args.ws + WS_H32); C.XN = (bf16*)(args.ws + WS_XN); C.Y1 = (bf16*)(args.ws + WS_Y1); C.RSTD = (float*)(args.ws + WS_RSTD);
    C.ctl = (unsigned*)(args.ws + WS_CTL);
    LAS unsigned* idxbuf = (LAS unsigned*)(C.lds + IDX_OFF);
    volatile LAS unsigned* MISC = (volatile LAS unsigned*)(C.lds + MISC_OFF);
    for (int u = C.tid; u < (LDS_BYTES - IDX_OFF) / 4; u += NWAVES * 64) ((LAS unsigned*)(C.lds + IDX_OFF))[u] = 0u;
    __syncthreads();
    const int lo = args.ph_lo, hi = args.ph_hi;
    XcdBarrier bar; bar.bar = C.ctl + CW_BAR; bar.x = 0; bar.st = nullptr;
    if (hi - lo > 1) bar = xcd_barrier_post(C.ctl + CW_BAR, MISC + 8);
    int ph = 0;
    if (PROBE_TMASK != 0u && blockIdx.x == 0 && C.wave0 == 0 && lane_id() == 0) { volatile LAS unsigned long long* PW = (volatile LAS unsigned long long*)(C.lds + MISC_OFF + 64); PW[0] = __builtin_amdgcn_s_memrealtime(); PW[1] = __builtin_amdgcn_s_memtime(); }
    if (RUN()) REPE { { v4u* z = (v4u*)(C.ws + WS_ROWSQ);
            for (int i = C.gw * 64 + C.lane; i < (int)(ROWSQ_BYTES / 16); i += C.NGW * 64) z[i] = (v4u){0u, 0u, 0u, 0u}; }
        copy_params(C, args); convert_small_weights(C, args); convert_moe_layer(C, args, 0); if (!MOE_L1_CONV_IN_TAIL) convert_moe_layer(C, args, 1); }
    SEAM();

    layer_pair<0>(C, args, ph, lo, hi, bar, idxbuf);
    layer_pair<1>(C, args, ph, lo, hi, bar, idxbuf);
    if (RUN()) REPE phase_final(C, PRM + PP_FINAL, args.out);
    SEAM();
    if (PROBE_TMASK != 0u && hi == N_PHASES && blockIdx.x == 0 && C.wave0 == 0) {
        volatile LAS unsigned long long* PW = (volatile LAS unsigned long long*)(C.lds + MISC_OFF + 64);
        unsigned long long ticks = PW[2];
        if (PROBE_CLK) ticks = PW[2] ? (PW[3] * 100ull / PW[2]) * 25ull : 0ull;
        const unsigned long long t0 = __builtin_amdgcn_s_memrealtime();
        while (__builtin_amdgcn_s_memrealtime() - t0 < ticks) __builtin_amdgcn_s_sleep(32);
    }
#undef RUN
#undef SEAM
#undef INTER
#undef PRM
#undef BG
#undef UU
#undef gcnt
}

extern "C" void kernel_launch(void* const* d_in, const int* in_sizes, int n_in, void* d_out, int out_size, void* d_ws, size_t ws_size, hipStream_t stream) {
    static int grid = 0;
    if (grid == 0) {
        if (n_in != 19 || in_sizes[0] != MROWS * D || out_size != MROWS * D || ws_size < WS_END) {
            fprintf(stderr, "kernel_launch: unexpected problem (n_in %d, in0 %d, out %d, ws %zu < %zu); nothing launched\n", n_in, n_in > 0 ? in_sizes[0] : -1, out_size, ws_size, (size_t)WS_END); grid = -1; return; }
        int dev = 0, cus = 0, per_cu = 0;
        if (hipGetDevice(&dev) != hipSuccess || hipDeviceGetAttribute(&cus, hipDeviceAttributeMultiprocessorCount, dev) != hipSuccess) { grid = -1; return; }
        if (hipFuncSetAttribute((const void*)fwd, hipFuncAttributeMaxDynamicSharedMemorySize, LDS_BYTES) != hipSuccess) { fprintf(stderr, "kernel_launch: hipFuncSetAttribute failed\n"); grid = -1; return; }
        if (hipOccupancyMaxActiveBlocksPerMultiprocessor(&per_cu, (const void*)fwd, NWAVES * 64, LDS_BYTES) != hipSuccess || per_cu < 1)
            fprintf(stderr, "kernel_launch: occupancy query reports %d workgroups per CU\n", per_cu);
        (void)hipGetLastError();
        grid = cus;
    }
    if (grid < 0) return;
    if (hipMemsetAsync((char*)d_ws + WS_CTL, 0, CTL_ZERO_BYTES, stream) != hipSuccess) { fprintf(stderr, "kernel_launch: memset failed\n"); return; }
    Args a{};
    for (int i = 0; i < 19; ++i) a.in[i] = (const float*)d_in[i];
    a.out = (float*)d_out; a.ws = (unsigned char*)d_ws;
#if MK_ONE_LAUNCH
    a.ph_lo = 0; a.ph_hi = N_PHASES;
    hipLaunchKernelGGL(fwd, dim3(grid), dim3(NWAVES * 64), LDS_BYTES, stream, a);
#else
    for (int p = 0; p < N_PHASES; ++p) { a.ph_lo = p; a.ph_hi = p + 1; hipLaunchKernelGGL(fwd, dim3(grid), dim3(NWAVES * 64), LDS_BYTES, stream, a); }
#endif
    const hipError_t le = hipPeekAtLastError();
    if (le != hipSuccess) fprintf(stderr, "kernel_launch: launch failed: %s\n", hipGetErrorName(le));
}
```
